# Optimizing an MI355X kernel written in HIP

```python
import math
import jax, jax.numpy as jnp
from jax import lax
import numpy as np

D_MODEL = 1024
BATCH = 8
SEQ = 2048
DEPTH = 2
DEC_BATCH = 128
DEC_SEQ = 8
PAST_LEN = 16384
PAGE_SIZE = 128

N_MIXERS = 4
NH = 4
GROUP_WIDTH = D_MODEL // N_MIXERS
HEAD_DIM = GROUP_WIDTH // NH
MIX_WIDTH = N_MIXERS * GROUP_WIDTH
D_FF = 4 * D_MODEL
EPS = 1e-6

RWKV_R_W = 32
RWKV_R_A = 32
RWKV_R_G = 64
RWKV_GN_EPS = 64e-5
GLA_R = 16
GLA_CHUNK = 16
GLA_GATE_NORM = 16.0
DN_CONV = 4
DN_CHUNK = 64
SSM_STATE = 128
SSM_GROUPS = 2
SSM_CONV = 4
SSM_CHUNK = 64
SSM_XBC = GROUP_WIDTH + 2 * SSM_GROUPS * SSM_STATE

RWKV_SIZES = (GROUP_WIDTH, GROUP_WIDTH, GROUP_WIDTH, RWKV_R_W, RWKV_R_A, RWKV_R_G)
GLA_SIZES = (GROUP_WIDTH, GROUP_WIDTH, GROUP_WIDTH, GROUP_WIDTH, GLA_R)
DN_SIZES = (3 * GROUP_WIDTH, GROUP_WIDTH, NH, NH)
SSM_SIZES = (GROUP_WIDTH, SSM_XBC, NH)
RWKV_COLS = sum(RWKV_SIZES)
GLA_COLS = sum(GLA_SIZES)
DN_COLS = sum(DN_SIZES)
SSM_COLS = sum(SSM_SIZES)
IN_SIZES = (RWKV_COLS, GLA_COLS, DN_COLS, SSM_COLS)
P_TOTAL = sum(IN_SIZES)

kernel_name = "hybrid_rwkv7_gla_gdn_ssd_step"

F32 = jnp.float32


def split_last(x, sizes):
    offs, acc = [], 0
    for s in sizes[:-1]:
        acc += s
        offs.append(acc)
    return jnp.split(x, offs, axis=-1)


def heads(t):
    return t.reshape(t.shape[:-1] + (NH, HEAD_DIM))


def rmsnorm(x, w):
    xf = x.astype(F32)
    return (xf * lax.rsqrt(jnp.mean(xf * xf, -1, keepdims=True) + EPS)).astype(x.dtype) * w


def group_rmsnorm(y, w, n_groups):
    shp = y.shape
    yg = y.reshape(shp[:-1] + (n_groups, shp[-1] // n_groups)).astype(F32)
    yg = yg * lax.rsqrt(jnp.mean(yg * yg, -1, keepdims=True) + EPS)
    return yg.reshape(shp) * w


def l2norm(t):
    return t * lax.rsqrt(jnp.sum(t * t, -1, keepdims=True) + EPS)


def causal_conv(x, prev, w):
    K, T = w.shape[0], x.shape[1]
    xp = jnp.concatenate([prev, x], axis=1)
    y = sum(xp[:, i:i + T] * w[i] for i in range(K))
    return y, xp[:, T:]


def to_chunks(t, C):
    B, T, H = t.shape[:3]
    t = t.reshape((B, T // C, C, H) + t.shape[3:])
    return jnp.moveaxis(t, (1, 3), (0, 2))


def from_chunks(t):
    t = jnp.moveaxis(t, (0, 2), (1, 3))
    return t.reshape((t.shape[0], t.shape[1] * t.shape[2]) + t.shape[3:])


def seg_decay(cum):
    C = cum.shape[-1]
    mask = jnp.tril(jnp.ones((C, C), bool))
    diff = cum[..., :, None] - cum[..., None, :]
    return jnp.where(mask, jnp.exp(jnp.where(mask, diff, 0.0)), 0.0)


def rwkv7_mix(u, shift0, S0, mu, w0, w2, a0, a2, g2, k_k, k_a, r_k, ln_w, ln_b):
    odt = u.dtype
    u = u.astype(F32)
    B, T, _ = u.shape
    u_prev = jnp.concatenate([shift0.astype(F32)[:, None], u[:, :-1]], axis=1)
    xs = u + (u_prev - u) * mu
    r, k, v, xw, xa, xg = split_last(xs, RWKV_SIZES)
    log_w = -jax.nn.softplus(-(w0 + jnp.tanh(xw) @ w2)) - 0.5
    decay = jnp.exp(-jnp.exp(log_w))
    a = jax.nn.sigmoid(a0 + xa @ a2)
    g = jax.nn.sigmoid(xg) @ g2
    kk = l2norm(heads(k * k_k))
    k = k * (1 + (a - 1) * k_a)
    r, k, v, decay, a = (heads(t) for t in (r, k, v, decay, a))

    def step(S, inp):
        r_t, w_t, k_t, v_t, kk_t, a_t = inp
        Skk = jnp.einsum('bhvk,bhk->bhv', S, kk_t)
        S = (S * w_t[:, :, None, :] - Skk[..., None] * (kk_t * a_t)[:, :, None, :]
             + v_t[..., None] * k_t[:, :, None, :])
        return S, jnp.einsum('bhvk,bhk->bhv', S, r_t)

    seq = tuple(jnp.swapaxes(t, 0, 1) for t in (r, decay, k, v, kk, a))
    S, y = lax.scan(step, S0.astype(F32), seq)
    y = jnp.swapaxes(y, 0, 1)
    m = jnp.mean(y, -1, keepdims=True)
    var = jnp.mean(jnp.square(y - m), -1, keepdims=True)
    y = (y - m) * lax.rsqrt(var + RWKV_GN_EPS) * ln_w.reshape(NH, HEAD_DIM) + ln_b.reshape(NH, HEAD_DIM)
    y = y + jnp.sum(r * k * r_k.reshape(NH, HEAD_DIM), -1, keepdims=True) * v
    y = y.reshape(B, T, GROUP_WIDTH) * g
    return y.astype(odt), u[:, -1].astype(odt), S.astype(odt)


def gla_chunked(q, k, v, la, S0):
    C = math.gcd(q.shape[1], GLA_CHUNK)
    q, k, v, la = (to_chunks(t, C) for t in (q, k, v, la))
    b = jnp.cumsum(la, -2)
    last = b[..., -1:, :]
    q_in, k_in, k_out = q * jnp.exp(b), k * jnp.exp(-b), k * jnp.exp(last - b)
    causal = jnp.tril(jnp.ones((C, C), bool))
    A = jnp.where(causal, jnp.einsum('nbhid,nbhjd->nbhij', q_in, k_in), 0.0)
    o_intra = A @ v

    def step(S, inp):
        q_c, k_c, v_c, last_c, o_c = inp
        o = o_c + q_c @ S
        S = S * jnp.exp(last_c)[..., 0, :, None] + jnp.einsum('bhjd,bhjv->bhdv', k_c, v_c)
        return S, o

    S, o = lax.scan(step, S0, (q_in, k_out, v, last, o_intra))
    return from_chunks(o), S


def gla_mix(u, S0, gk_w2, gk_b, norm_w):
    odt = u.dtype
    u = u.astype(F32)
    B, T, _ = u.shape
    q, k, v, g, gl = split_last(u, GLA_SIZES)
    la = jax.nn.log_sigmoid(gl @ gk_w2 + gk_b) / GLA_GATE_NORM
    o, S = gla_chunked(heads(q) * HEAD_DIM ** -0.5, heads(k), heads(v), heads(la), S0.astype(F32))
    o = group_rmsnorm(o.reshape(B, T, GROUP_WIDTH), norm_w, NH) * jax.nn.silu(g)
    return o.astype(odt), S.astype(odt)


def gated_delta_chunked(q, k, v, g, beta, S0):
    C = math.gcd(q.shape[1], DN_CHUNK)
    q, k, v = (to_chunks(t, C) for t in (q, k, v))
    g, beta = to_chunks(g, C), to_chunks(beta, C)
    cum = jnp.cumsum(g, -1)
    L = seg_decay(cum)
    kb = k * beta[..., None]
    eye = jnp.eye(C, dtype=q.dtype)
    strict = jnp.tril(jnp.ones((C, C), bool), -1)
    M = jnp.where(strict, jnp.einsum('nbhid,nbhjd->nbhij', kb, k) * L, 0.0)
    Tm = lax.linalg.triangular_solve(eye + M, jnp.broadcast_to(eye, M.shape),
                                     left_side=True, lower=True, unit_diagonal=True)
    u = Tm @ (v * beta[..., None])
    w = Tm @ (kb * jnp.exp(cum)[..., None])
    A = jnp.einsum('nbhid,nbhjd->nbhij', q, k) * L

    def step(S, inp):
        q_c, k_c, u_c, w_c, A_c, cum_c = inp
        v_new = u_c - w_c @ S
        o = (q_c * jnp.exp(cum_c)[..., None]) @ S + A_c @ v_new
        last = cum_c[..., -1]
        S = (S * jnp.exp(last)[..., None, None]
             + jnp.einsum('bhjd,bhjv->bhdv', k_c * jnp.exp(last[..., None] - cum_c)[..., None], v_new))
        return S, o

    S, o = lax.scan(step, S0, (q, k, u, w, A, cum))
    return from_chunks(o), S


def deltanet_mix(u, conv0, S0, conv_w, A_log, dt_bias, norm_w):
    odt = u.dtype
    u = u.astype(F32)
    B, T, _ = u.shape
    qkv, z, a_in, b_in = split_last(u, DN_SIZES)
    qkv, conv1 = causal_conv(qkv, conv0.astype(F32), conv_w)
    q, k, v = split_last(jax.nn.silu(qkv), (GROUP_WIDTH,) * 3)
    q = l2norm(heads(q)) * HEAD_DIM ** -0.5
    k = l2norm(heads(k))
    beta = jax.nn.sigmoid(b_in)
    g = -jnp.exp(A_log) * jax.nn.softplus(a_in + dt_bias)
    o, S = gated_delta_chunked(q, k, heads(v), g, beta, S0.astype(F32))
    o = group_rmsnorm(o.reshape(B, T, GROUP_WIDTH), norm_w, NH) * jax.nn.silu(z)
    return o.astype(odt), conv1.astype(odt), S.astype(odt)


def ssd_chunked(xdt, la, Bh, Ch, S0):
    C = math.gcd(xdt.shape[1], SSM_CHUNK)
    xdt, Bh, Ch = (to_chunks(t, C) for t in (xdt, Bh, Ch))
    cum = jnp.cumsum(to_chunks(la, C), -1)
    L = seg_decay(cum)
    y_intra = (jnp.einsum('nbhis,nbhjs->nbhij', Ch, Bh) * L) @ xdt

    def step(S, inp):
        x_c, B_c, C_c, cum_c, y_c = inp
        last = cum_c[..., -1]
        y = y_c + jnp.exp(cum_c)[..., None] * jnp.einsum('bhis,bhps->bhip', C_c, S)
        S = (S * jnp.exp(last)[..., None, None]
             + jnp.einsum('bhjp,bhjs->bhps', x_c * jnp.exp(last[..., None] - cum_c)[..., None], B_c))
        return S, y

    S, y = lax.scan(step, S0, (xdt, Bh, Ch, cum, y_intra))
    return from_chunks(y), S


def ssd_mix(u, conv0, S0, conv_w, conv_b, dt_bias, A_log, D_skip, norm_w):
    odt = u.dtype
    u = u.astype(F32)
    B, T, _ = u.shape
    z, xbc, dt_raw = split_last(u, SSM_SIZES)
    xbc, conv1 = causal_conv(xbc, conv0.astype(F32), conv_w)
    xs, Bm, Cm = split_last(jax.nn.silu(xbc + conv_b),
                            (GROUP_WIDTH, SSM_GROUPS * SSM_STATE, SSM_GROUPS * SSM_STATE))
    rep = NH // SSM_GROUPS
    Bh = jnp.repeat(Bm.reshape(B, T, SSM_GROUPS, SSM_STATE), rep, axis=2)
    Ch = jnp.repeat(Cm.reshape(B, T, SSM_GROUPS, SSM_STATE), rep, axis=2)
    dt = jax.nn.softplus(dt_raw + dt_bias)
    la = dt * -jnp.exp(A_log)
    xh = heads(xs)
    y, S = ssd_chunked(xh * dt[..., None], la, Bh, Ch, S0.astype(F32))
    y = y + D_skip[:, None] * xh
    y = group_rmsnorm(y.reshape(B, T, GROUP_WIDTH) * jax.nn.silu(z), norm_w, SSM_GROUPS)
    return y.astype(odt), conv1.astype(odt), S.astype(odt)


def layer(x, c, states, p):
    shift0, wkv0, gla0, dnconv0, dn0, ssmconv0, ssm0 = states
    mod = jnp.einsum('bd,de->be', jax.nn.silu(c), p['ada_w']) + p['ada_b']
    sh1, sc1, gt1, sh2, sc2, gt2 = (m[:, None, :] for m in jnp.split(mod, 6, axis=-1))
    h = rmsnorm(x, p['norm1_w']) * (1 + sc1) + sh1
    u = jnp.einsum('btd,de->bte', h, p['w_in'])
    u_a, u_b, u_c, u_d = split_last(u, IN_SIZES)
    y_a, shift1, wkv1 = rwkv7_mix(u_a, shift0, wkv0, p['rwkv_mu'], p['rwkv_w0'], p['rwkv_w2'],
                                  p['rwkv_a0'], p['rwkv_a2'], p['rwkv_g2'], p['rwkv_k_k'],
                                  p['rwkv_k_a'], p['rwkv_r_k'], p['rwkv_ln_w'], p['rwkv_ln_b'])
    y_b, gla1 = gla_mix(u_b, gla0, p['gla_gk_w2'], p['gla_gk_b'], p['gla_norm_w'])
    y_c, dnconv1, dn1 = deltanet_mix(u_c, dnconv0, dn0, p['dn_conv_w'], p['dn_A_log'],
                                     p['dn_dt_bias'], p['dn_norm_w'])
    y_d, ssmconv1, ssm1 = ssd_mix(u_d, ssmconv0, ssm0, p['ssm_conv_w'], p['ssm_conv_b'],
                                  p['ssm_dt_bias'], p['ssm_A_log'], p['ssm_D'], p['ssm_norm_w'])
    y = jnp.concatenate([y_a, y_b, y_c, y_d], -1) @ p['w_out']
    x = x + gt1 * y
    h = rmsnorm(x, p['norm2_w']) * (1 + sc2) + sh2
    f = jnp.square(jax.nn.relu(h @ p['w_up'])) @ p['w_down']
    x = x + gt2 * f
    return x, (shift1, wkv1, gla1, dnconv1, dn1, ssmconv1, ssm1)


def trunk(x, c, states, P, final_norm_w):
    new = []
    for l in range(DEPTH):
        x, s = layer(x, c, tuple(st[l] for st in states), {n: w[l] for n, w in P.items()})
        new.append(s)
    y = rmsnorm(x, final_norm_w)
    return y, tuple(jnp.stack([s[i] for s in new]) for i in range(len(states)))


def setup_inputs(seed: int = 0) -> dict:
    key = jax.random.key(seed)
    ks = iter(jax.random.split(key, 64))
    def nrm(shape, s=1.0):
        return s * jax.random.normal(next(ks), shape, F32)
    def unif(shape, lo, hi):
        return jax.random.uniform(next(ks), shape, F32, lo, hi)
    L, GW = DEPTH, GROUP_WIDTH
    dn_dt = jnp.exp(unif((L, NH), math.log(1e-3), math.log(1e-1)))
    ssm_dt = jnp.exp(unif((L, NH), math.log(1e-3), math.log(1e-1)))
    inp = {}
    inp['x_prompt'] = nrm((BATCH, SEQ, D_MODEL))
    inp['x_sample'] = nrm((DEC_BATCH, DEC_SEQ, D_MODEL))
    inp['state_rwkv_shift'] = nrm((L, DEC_BATCH, RWKV_COLS))
    inp['state_rwkv_wkv'] = nrm((L, DEC_BATCH, NH, HEAD_DIM, HEAD_DIM), 0.1)
    inp['state_gla'] = nrm((L, DEC_BATCH, NH, HEAD_DIM, HEAD_DIM), 0.1)
    inp['state_dn_conv'] = nrm((L, DEC_BATCH, DN_CONV - 1, 3 * GW))
    inp['state_dn'] = nrm((L, DEC_BATCH, NH, HEAD_DIM, HEAD_DIM), 0.1)
    inp['state_ssm_conv'] = nrm((L, DEC_BATCH, SSM_CONV - 1, SSM_XBC))
    inp['state_ssm'] = nrm((L, DEC_BATCH, NH, HEAD_DIM, SSM_STATE), 0.1)
    inp['c_prompt'] = nrm((BATCH, D_MODEL))
    inp['c_sample'] = nrm((DEC_BATCH, D_MODEL))
    inp['ada_w'] = nrm((L, D_MODEL, 6 * D_MODEL), 0.3 * D_MODEL ** -0.5)
    inp['ada_b'] = nrm((L, 6 * D_MODEL), 0.02)
    inp['norm1_w'] = 1.0 + nrm((L, D_MODEL), 0.02)
    inp['norm2_w'] = 1.0 + nrm((L, D_MODEL), 0.02)
    inp['w_in'] = nrm((L, D_MODEL, P_TOTAL), D_MODEL ** -0.5)
    inp['w_out'] = nrm((L, MIX_WIDTH, D_MODEL), MIX_WIDTH ** -0.5)
    inp['w_up'] = nrm((L, D_MODEL, D_FF), D_MODEL ** -0.5)
    inp['w_down'] = nrm((L, D_FF, D_MODEL), D_FF ** -0.5)
    inp['rwkv_mu'] = unif((L, RWKV_COLS), 0.0, 1.0)
    inp['rwkv_w0'] = nrm((L, GW), 0.5)
    inp['rwkv_w2'] = nrm((L, RWKV_R_W, GW), 0.5 * RWKV_R_W ** -0.5)
    inp['rwkv_a0'] = nrm((L, GW), 0.1)
    inp['rwkv_a2'] = nrm((L, RWKV_R_A, GW), RWKV_R_A ** -0.5)
    inp['rwkv_g2'] = nrm((L, RWKV_R_G, GW), RWKV_R_G ** -0.5)
    inp['rwkv_k_k'] = 0.85 + nrm((L, GW), 0.05)
    inp['rwkv_k_a'] = 1.0 + nrm((L, GW), 0.05)
    inp['rwkv_r_k'] = nrm((L, GW), 0.1)
    inp['rwkv_ln_w'] = 1.0 + nrm((L, GW), 0.02)
    inp['rwkv_ln_b'] = nrm((L, GW), 0.01)
    inp['gla_gk_w2'] = nrm((L, GLA_R, GW), GLA_R ** -0.5)
    inp['gla_gk_b'] = nrm((L, GW), 0.5)
    inp['gla_norm_w'] = 1.0 + nrm((L, GW), 0.02)
    inp['dn_conv_w'] = nrm((L, DN_CONV, 3 * GW), 0.5)
    inp['dn_A_log'] = jnp.log(unif((L, NH), 1.0, 16.0))
    inp['dn_dt_bias'] = dn_dt + jnp.log(-jnp.expm1(-dn_dt))
    inp['dn_norm_w'] = 1.0 + nrm((L, GW), 0.02)
    inp['ssm_conv_w'] = nrm((L, SSM_CONV, SSM_XBC), 0.5)
    inp['ssm_conv_b'] = nrm((L, SSM_XBC), 0.01)
    inp['ssm_dt_bias'] = ssm_dt + jnp.log(-jnp.expm1(-ssm_dt))
    inp['ssm_A_log'] = jnp.log(unif((L, NH), 1.0, 16.0))
    inp['ssm_D'] = 1.0 + nrm((L, NH), 0.1)
    inp['ssm_norm_w'] = 1.0 + nrm((L, GW), 0.02)
    inp['final_norm_w'] = 1.0 + nrm((D_MODEL,), 0.02)
    return inp


def reference(x_prompt, x_sample, state_rwkv_shift, state_rwkv_wkv, state_gla, state_dn_conv,
              state_dn, state_ssm_conv, state_ssm, c_prompt, c_sample,
              ada_w, ada_b, norm1_w, norm2_w, w_in, w_out, w_up, w_down,
              rwkv_mu, rwkv_w0, rwkv_w2, rwkv_a0, rwkv_a2, rwkv_g2, rwkv_k_k, rwkv_k_a, rwkv_r_k,
              rwkv_ln_w, rwkv_ln_b, gla_gk_w2, gla_gk_b, gla_norm_w,
              dn_conv_w, dn_A_log, dn_dt_bias, dn_norm_w,
              ssm_conv_w, ssm_conv_b, ssm_dt_bias, ssm_A_log, ssm_D, ssm_norm_w, final_norm_w):
    P = dict(ada_w=ada_w, ada_b=ada_b, norm1_w=norm1_w, norm2_w=norm2_w, w_in=w_in, w_out=w_out,
             w_up=w_up, w_down=w_down, rwkv_mu=rwkv_mu, rwkv_w0=rwkv_w0, rwkv_w2=rwkv_w2,
             rwkv_a0=rwkv_a0, rwkv_a2=rwkv_a2, rwkv_g2=rwkv_g2, rwkv_k_k=rwkv_k_k, rwkv_k_a=rwkv_k_a,
             rwkv_r_k=rwkv_r_k, rwkv_ln_w=rwkv_ln_w, rwkv_ln_b=rwkv_ln_b, gla_gk_w2=gla_gk_w2,
             gla_gk_b=gla_gk_b, gla_norm_w=gla_norm_w, dn_conv_w=dn_conv_w, dn_A_log=dn_A_log,
             dn_dt_bias=dn_dt_bias, dn_norm_w=dn_norm_w, ssm_conv_w=ssm_conv_w, ssm_conv_b=ssm_conv_b,
             ssm_dt_bias=ssm_dt_bias, ssm_A_log=ssm_A_log, ssm_D=ssm_D, ssm_norm_w=ssm_norm_w)
    sample_states = (state_rwkv_shift, state_rwkv_wkv, state_gla, state_dn_conv,
                     state_dn, state_ssm_conv, state_ssm)
    prompt_states = tuple(jnp.zeros((DEPTH, x_prompt.shape[0]) + s.shape[2:], x_prompt.dtype)
                          for s in sample_states)
    y_prompt, ps = trunk(x_prompt, c_prompt, prompt_states, P, final_norm_w)
    y_sample, ss = trunk(x_sample, c_sample, sample_states, P, final_norm_w)
    p_shift, p_wkv, p_gla, p_dn_conv, p_dn, p_ssm_conv, p_ssm = ps
    s_shift, s_wkv, s_gla, s_dn_conv, s_dn, s_ssm_conv, s_ssm = ss
    return (y_prompt, y_sample, p_shift, p_wkv, p_gla, p_dn_conv, p_dn, p_ssm_conv, p_ssm,
            s_shift, s_wkv, s_gla, s_dn_conv, s_dn, s_ssm_conv, s_ssm)
```

```cpp
#include <hip/hip_runtime.h>
#include <hip/hip_cooperative_groups.h>
#include <cstdio>
#include <cstdint>
namespace cg = cooperative_groups;

namespace pg8 {
#define PG8_LAS __attribute__((address_space(3)))
typedef unsigned short bf16_t;
typedef short bf16x8 __attribute__((ext_vector_type(8)));
typedef float f32x4 __attribute__((ext_vector_type(4)));
typedef unsigned u32x4 __attribute__((ext_vector_type(4)));
constexpr int BM = 256, BK = 64, HALF = 128, HTB = HALF * BK * 2, STAGE_BYTES = 8 * HTB, NXCD = 8, WGM = 8;

__host__ __device__ __forceinline__ int lds_byte(int r, int c) { const int st = (r >> 4) * 2 + (c >> 5), rr = r & 15, cc = c & 31, ob = rr * 64 + cc * 2; return st * 1024 + (ob ^ (((ob >> 9) & 1) << 5)); }
__host__ __device__ __forceinline__ void stage_rc(int b, int& R, int& C) { const int st = b / 1024, sb = b % 1024, swz = sb ^ (((sb >> 9) & 1) << 5); R = (st >> 1) * 16 + swz / 64; C = (st & 1) * 32 + (swz % 64) / 2; }
__host__ __device__ __forceinline__ int perm32(int rho) { const int n = rho >> 4, i = rho & 15; return 8 * (i >> 2) + 4 * n + (i & 3); }

struct Unit { int pm, pn, pk; };
struct Gemm { const bf16_t* A; const bf16_t* Bt; int M, N, K, ld; };

struct StaticOrder {
    int nM, nN, nK, ntile, nwg, G, c;
    __host__ __device__ void init(int M, int N, int nK_, int G_, int c_) { nM = M / BM; nN = N / BM; nK = nK_; ntile = nM * nN; nwg = ntile * nK; G = G_; c = c_; }
    __host__ __device__ bool next(int i, Unit& u) const {
        const long L = (long)i * G + c; if (L >= nwg) return false;
        int wgid = (int)L; { const int q = nwg / NXCD, r = nwg % NXCD, xcd = wgid % NXCD, off = wgid / NXCD; wgid = (xcd < r ? xcd * (q + 1) : r * (q + 1) + (xcd - r) * q) + off; }
        u.pk = wgid / ntile; wgid -= u.pk * ntile;
        const int nig = WGM * nN, gid = wgid / nig, fm = gid * WGM, gsz = (nM - fm) < WGM ? (nM - fm) : WGM;
        u.pm = fm + ((wgid % nig) % gsz); u.pn = (wgid % nig) / gsz; return true;
    }
    __device__ __forceinline__ void a_ready(const Unit&) const {}
    __device__ __forceinline__ void done(const Unit&) const {}
};
__device__ __forceinline__ unsigned cvt_pk_bf16(float lo, float hi) { unsigned r; asm volatile("v_cvt_pk_bf16_f32 %0, %1, %2" : "=v"(r) : "v"(lo), "v"(hi)); return r; }

template <int ACT  > struct EpiBf16 {
    static constexpr bool PERM = true, AFTER_DRAIN = false;
    bf16_t* O; int ldc;
    __device__ __forceinline__ void operator()(const f32x4 (&acc)[2][2][4][2], const Unit& u, int wr, int wc, int fr, int fq) const {
        const int row0 = u.pm * BM + wr * 64 + fr, col0 = u.pn * BM + wc * 32 + 8 * fq;
#pragma unroll
        for (int ai = 0; ai < 2; ++ai)
#pragma unroll
            for (int m = 0; m < 4; ++m) { bf16_t* rowp = O + (size_t)(row0 + ai * HALF + m * 16) * ldc + col0;
#pragma unroll
                for (int bj = 0; bj < 2; ++bj) { f32x4 v0 = acc[ai][bj][m][0], v1 = acc[ai][bj][m][1];
                    if (ACT == 2) {
#pragma unroll
                        for (int j = 0; j < 4; ++j) { float a = fmaxf(v0[j], 0.f), b = fmaxf(v1[j], 0.f); v0[j] = a * a; v1[j] = b * b; } }
                    u32x4 w; w.x = cvt_pk_bf16(v0[0], v0[1]); w.y = cvt_pk_bf16(v0[2], v0[3]); w.z = cvt_pk_bf16(v1[0], v1[1]); w.w = cvt_pk_bf16(v1[2], v1[3]);
                    *(u32x4*)(rowp + bj * HALF) = w; } }
    }
};
template <bool SRCF32> struct EpiRes {
    static constexpr bool PERM = true, AFTER_DRAIN = false;
    const float* srcF; bf16_t* X; const float* gate;
    __device__ __forceinline__ void operator()(const f32x4 (&acc)[2][2][4][2], const Unit& u, int wr, int wc, int fr, int fq) const {
        const int row0 = u.pm * BM + wr * 64 + fr, col0 = u.pn * BM + wc * 32 + 8 * fq;
#pragma unroll
        for (int ai = 0; ai < 2; ++ai)
#pragma unroll
            for (int m = 0; m < 4; ++m) { const int row = row0 + ai * HALF + m * 16;
                const int cond = row < 16384 ? (row >> 11) : 8 + ((row - 16384) >> 3);
                const float* g = gate + (size_t)cond * 6144; bf16_t* d = X + (size_t)row * 1024;
#pragma unroll
                for (int bj = 0; bj < 2; ++bj) { const int c = col0 + bj * HALF; const f32x4 g0 = *(const f32x4*)(g + c), g1 = *(const f32x4*)(g + c + 4);
                    f32x4 x0, x1;
                    if (SRCF32) { const float* s = srcF + (size_t)row * 1024 + c; x0 = *(const f32x4*)s; x1 = *(const f32x4*)(s + 4); }
                    else { const u32x4 w = *(const u32x4*)(d + c);
                        x0 = (f32x4){__builtin_bit_cast(float, w.x << 16), __builtin_bit_cast(float, w.x & 0xffff0000u), __builtin_bit_cast(float, w.y << 16), __builtin_bit_cast(float, w.y & 0xffff0000u)};
                        x1 = (f32x4){__builtin_bit_cast(float, w.z << 16), __builtin_bit_cast(float, w.z & 0xffff0000u), __builtin_bit_cast(float, w.w << 16), __builtin_bit_cast(float, w.w & 0xffff0000u)}; }
                    x0 += g0 * acc[ai][bj][m][0]; x1 += g1 * acc[ai][bj][m][1];
                    u32x4 o; o.x = cvt_pk_bf16(x0[0], x0[1]); o.y = cvt_pk_bf16(x0[2], x0[3]); o.z = cvt_pk_bf16(x1[0], x1[1]); o.w = cvt_pk_bf16(x1[2], x1[3]);
                    *(u32x4*)(d + c) = o; } }
    }
};

struct SampleSplitOrder {
    int G, c;
    __device__ bool next(int i, Unit& u) const { const int L = i * G + c; if (L >= 64) return false; u.pk = L & 3; const int t = L >> 2; u.pm = 64 + (t >> 2); u.pn = t & 3; return true; }
    __device__ __forceinline__ void a_ready(const Unit&) const {}
    __device__ __forceinline__ void done(const Unit&) const {}
};
struct EpiPart {
    static constexpr bool PERM = true, AFTER_DRAIN = false;
    float* P;
    __device__ __forceinline__ void operator()(const f32x4 (&acc)[2][2][4][2], const Unit& u, int wr, int wc, int fr, int fq) const {
        const int row0 = (u.pm - 64) * BM + wr * 64 + fr, col0 = u.pn * BM + wc * 32 + 8 * fq;
#pragma unroll
        for (int ai = 0; ai < 2; ++ai)
#pragma unroll
            for (int m = 0; m < 4; ++m) { float* d = P + ((size_t)u.pk * 1024 + row0 + ai * HALF + m * 16) * 1024 + col0;
#pragma unroll
                for (int bj = 0; bj < 2; ++bj) { *(f32x4*)(d + bj * HALF) = acc[ai][bj][m][0]; *(f32x4*)(d + bj * HALF + 4) = acc[ai][bj][m][1]; } }
    }
};

struct SampleTilesOrder {
    int Gs, cs, nN;
    __device__ bool next(int i, Unit& u) const { if (cs < 0) return false; const int L = i * Gs + cs; if (L >= 4 * nN) return false; u.pk = 0; u.pm = 64 + L / nN; u.pn = L % nN; return true; }
    __device__ __forceinline__ void a_ready(const Unit&) const {}
    __device__ __forceinline__ void done(const Unit&) const {}
};

template <class Epi, class Sched, bool ALIGN_EPI = false, bool SP2 = false>
__device__ __forceinline__ void gemm_phase(PG8_LAS unsigned char* lds, const Gemm g, const Sched& S, const Epi& E) {
    int tid_ = threadIdx.x; asm volatile("" : "+v"(tid_));
    const int tid = tid_, wid = __builtin_amdgcn_readfirstlane(tid >> 6), lane = tid & 63, wr = wid >> 2, wc = wid & 3, fr = lane & 15, fq = lane >> 4;
    const int K = g.ld, nt = g.K / BK; const size_t kspl = (size_t)g.K * 2;
    unsigned voffA[2], voffB[2];
#pragma unroll
    for (int i = 0; i < 2; ++i) { int R, C; stage_rc(tid * 16 + i * 8192, R, C); const int Rb = Epi::PERM ? ((R & ~31) + perm32(R & 31)) : R;
        voffA[i] = (unsigned)(R * K + C) * 2u; voffB[i] = (unsigned)(Rb * K + C) * 2u; }
    const size_t kstep = (size_t)(BK * 2);
    const size_t hstep = (size_t)HALF * K * 2;
    const size_t tstep = 2 * hstep;
    const unsigned ldsw = (unsigned)wid * 1024u;
    const int aoff = lds_byte(wr * 64 + fr, fq * 8), boff = lds_byte(wc * 32 + fr, fq * 8);
#define PG8_SA(b, h) (((b) * 2 + (h)) * HTB)
#define PG8_SB(b, h) ((4 + (b) * 2 + (h)) * HTB)
#define PG8_STAGE(bufoff, gbase, voff) do { _Pragma("unroll") for (int _i = 0; _i < 2; ++_i) \
        __builtin_amdgcn_global_load_lds((const unsigned*)((const char*)(gbase) + (voff)[_i]), (PG8_LAS unsigned*)(lds + (bufoff) + ldsw + _i * 8192), 16, 0, 0); } while (0)
#define PG8_LDA(dst, b, h) do { _Pragma("unroll") for (int m = 0; m < 4; ++m) _Pragma("unroll") for (int k = 0; k < 2; ++k) dst[m][k] = *(const PG8_LAS bf16x8*)(lds + PG8_SA(b, h) + aoff + m * 2048 + k * 1024); } while (0)
#define PG8_LDB(dst, b, h) do { _Pragma("unroll") for (int n = 0; n < 2; ++n) _Pragma("unroll") for (int k = 0; k < 2; ++k) dst[n][k] = *(const PG8_LAS bf16x8*)(lds + PG8_SB(b, h) + boff + n * 2048 + k * 1024); } while (0)
#define PG8_MMA(ai, bj, At, Bt) do { __builtin_amdgcn_s_setprio(1); _Pragma("unroll") for (int m = 0; m < 4; ++m) _Pragma("unroll") for (int n = 0; n < 2; ++n) _Pragma("unroll") for (int k = 0; k < 2; ++k) \
        acc[ai][bj][m][n] = __builtin_amdgcn_mfma_f32_16x16x32_bf16(Bt[n][k], At[m][k], acc[ai][bj][m][n], 0, 0, 0); __builtin_amdgcn_s_setprio(0); } while (0)
#define PG8_WAIT_V(n) asm volatile("s_waitcnt vmcnt(" #n ")" ::: "memory")
#define PG8_WAIT_L(n) asm volatile("s_waitcnt lgkmcnt(" #n ")" ::: "memory")
#define PG8_BAR __builtin_amdgcn_s_barrier()
#define PG8_SCHED __builtin_amdgcn_sched_barrier(0)
    Unit cur, nxt; int ui = 0;
    if (!S.next(0, cur)) return;
    f32x4 acc[2][2][4][2];
#pragma unroll
    for (int a = 0; a < 2; ++a)
#pragma unroll
        for (int b = 0; b < 2; ++b)
#pragma unroll
            for (int m = 0; m < 4; ++m)
#pragma unroll
                for (int n = 0; n < 2; ++n) acc[a][b][m][n] = (f32x4){0.f, 0.f, 0.f, 0.f};
    bf16x8 At[4][2], B0[2][2], B1[2][2];
    const char* cA = (const char*)g.A + (size_t)cur.pm * tstep + (size_t)cur.pk * kspl; const char* cB = (const char*)g.Bt + (size_t)cur.pn * tstep + (size_t)cur.pk * kspl;
    S.a_ready(cur);
    if constexpr (SP2) {
        PG8_STAGE(PG8_SB(0, 0), cB, voffB); PG8_STAGE(PG8_SB(0, 1), cB + hstep, voffB); PG8_STAGE(PG8_SA(0, 0), cA, voffA); PG8_STAGE(PG8_SA(0, 1), cA + hstep, voffA);
        if (wr == 1) PG8_BAR;
        PG8_WAIT_V(2); PG8_BAR;
        PG8_STAGE(PG8_SB(1, 0), cB + kstep, voffB); PG8_STAGE(PG8_SA(1, 0), cA + kstep, voffA); PG8_STAGE(PG8_SB(1, 1), cB + hstep + kstep, voffB);
        PG8_WAIT_V(6); PG8_BAR;
    } else {
        PG8_STAGE(PG8_SB(0, 0), cB, voffB); PG8_STAGE(PG8_SA(0, 0), cA, voffA); PG8_STAGE(PG8_SB(0, 1), cB + hstep, voffB); PG8_STAGE(PG8_SA(0, 1), cA + hstep, voffA);
        if (wr == 1) PG8_BAR;
        PG8_WAIT_V(4); PG8_BAR;
        PG8_STAGE(PG8_SB(1, 0), cB + kstep, voffB); PG8_STAGE(PG8_SA(1, 0), cA + kstep, voffA); PG8_STAGE(PG8_SB(1, 1), cB + hstep + kstep, voffB);
        PG8_WAIT_V(6); PG8_BAR;
    }
    for (;;) {
        const bool has_next = S.next(ui + 1, nxt);
        const char* nA = has_next ? (const char*)g.A + (size_t)nxt.pm * tstep + (size_t)nxt.pk * kspl : cA; const char* nB = has_next ? (const char*)g.Bt + (size_t)nxt.pn * tstep + (size_t)nxt.pk * kspl : cB;
        for (int t = 0; t < nt; t += 2) {
            const bool last = (t == nt - 2);
            const char* a1 = cA + (size_t)(t + 1) * kstep;
            const char* a2 = last ? nA : cA + (size_t)(t + 2) * kstep; const char* b2 = last ? nB : cB + (size_t)(t + 2) * kstep;
            const char* a3 = a2 + kstep; const char* b3 = b2 + kstep;
            if (last && has_next) S.a_ready(nxt);
            if constexpr (SP2) {
            PG8_LDB(B0, 0, 0); PG8_LDB(B1, 0, 1); PG8_SCHED; PG8_LDA(At, 0, 0); PG8_STAGE(PG8_SA(1, 1), a1 + hstep, voffA);
            PG8_WAIT_V(8); PG8_WAIT_L(0); PG8_BAR; PG8_MMA(0, 0, At, B0); PG8_MMA(0, 1, At, B1); PG8_BAR; PG8_SCHED;
            PG8_LDA(At, 0, 1); PG8_STAGE(PG8_SB(0, 0), b2, voffB); PG8_STAGE(PG8_SB(0, 1), b2 + hstep, voffB); PG8_STAGE(PG8_SA(0, 0), a2, voffA);
            PG8_WAIT_V(8); PG8_WAIT_L(0); PG8_BAR; PG8_MMA(1, 0, At, B0); PG8_MMA(1, 1, At, B1); PG8_BAR; PG8_SCHED;
            PG8_LDB(B0, 1, 0); PG8_LDB(B1, 1, 1); PG8_SCHED; PG8_LDA(At, 1, 0); PG8_STAGE(PG8_SA(0, 1), a2 + hstep, voffA);
            PG8_WAIT_V(8); PG8_WAIT_L(0); PG8_BAR; PG8_MMA(0, 0, At, B0); PG8_MMA(0, 1, At, B1); PG8_BAR; PG8_SCHED;
            PG8_LDA(At, 1, 1); PG8_STAGE(PG8_SB(1, 0), b3, voffB); PG8_STAGE(PG8_SB(1, 1), b3 + hstep, voffB); PG8_STAGE(PG8_SA(1, 0), a3, voffA);
            PG8_WAIT_V(8); PG8_WAIT_L(0); PG8_BAR; PG8_MMA(1, 0, At, B0); PG8_MMA(1, 1, At, B1); PG8_BAR; PG8_SCHED;
            } else {
            PG8_LDB(B0, 0, 0); PG8_SCHED; PG8_LDA(At, 0, 0); PG8_STAGE(PG8_SA(1, 1), a1 + hstep, voffA);
            PG8_WAIT_L(8); PG8_BAR; PG8_WAIT_L(0); PG8_MMA(0, 0, At, B0); PG8_BAR; PG8_SCHED;
            PG8_LDB(B1, 0, 1); PG8_STAGE(PG8_SB(0, 0), b2, voffB);
            PG8_BAR; PG8_WAIT_L(0); PG8_MMA(0, 1, At, B1); PG8_BAR;
            PG8_LDA(At, 0, 1); PG8_STAGE(PG8_SA(0, 0), a2, voffA);
            PG8_BAR; PG8_WAIT_L(0); PG8_MMA(1, 0, At, B0); PG8_BAR; PG8_SCHED;
            PG8_STAGE(PG8_SB(0, 1), b2 + hstep, voffB);
            PG8_WAIT_V(6); PG8_BAR; PG8_MMA(1, 1, At, B1); PG8_BAR;
            PG8_LDB(B0, 1, 0); PG8_SCHED; PG8_LDA(At, 1, 0); PG8_STAGE(PG8_SA(0, 1), a2 + hstep, voffA);
            PG8_WAIT_L(8); PG8_BAR; PG8_WAIT_L(0); PG8_MMA(0, 0, At, B0); PG8_BAR; PG8_SCHED;
            PG8_LDB(B1, 1, 1); PG8_STAGE(PG8_SB(1, 0), b3, voffB);
            PG8_BAR; PG8_WAIT_L(0); PG8_MMA(0, 1, At, B1); PG8_BAR;
            PG8_LDA(At, 1, 1); PG8_STAGE(PG8_SA(1, 0), a3, voffA);
            PG8_BAR; PG8_WAIT_L(0); PG8_MMA(1, 0, At, B0); PG8_BAR; PG8_SCHED;
            PG8_STAGE(PG8_SB(1, 1), b3 + hstep, voffB);
            PG8_WAIT_V(6); PG8_BAR; PG8_MMA(1, 1, At, B1); PG8_BAR;
            }
        }
        if constexpr (ALIGN_EPI) { if (wr == 0) PG8_BAR; }
        if constexpr (!Epi::AFTER_DRAIN) { E(acc, cur, wr, wc, fr, fq); S.done(cur); }
        if (!has_next) break;
#pragma unroll
        for (int a = 0; a < 2; ++a)
#pragma unroll
            for (int b = 0; b < 2; ++b)
#pragma unroll
                for (int m = 0; m < 4; ++m)
#pragma unroll
                    for (int n = 0; n < 2; ++n) acc[a][b][m][n] = (f32x4){0.f, 0.f, 0.f, 0.f};
        cur = nxt; cA = nA; cB = nB; ++ui;
        if constexpr (ALIGN_EPI) { if (wr == 1) PG8_BAR; }
    }
    PG8_WAIT_V(0);
    if constexpr (!ALIGN_EPI) { if (wr == 0) PG8_BAR; }
    PG8_BAR;
    if constexpr (Epi::AFTER_DRAIN) { E.fused(acc, cur, wr, wc, fr, fq, lds, wid, lane); S.done(cur); }
#undef PG8_SA
#undef PG8_SB
#undef PG8_STAGE
#undef PG8_LDA
#undef PG8_LDB
#undef PG8_MMA
#undef PG8_WAIT_V
#undef PG8_WAIT_L
#undef PG8_BAR
#undef PG8_SCHED
}
}

typedef unsigned short bf16;
#define LAS __attribute__((address_space(3)))
typedef float f32x4 __attribute__((ext_vector_type(4)));
constexpr int DM = 1024, TP = 2048, BP = 8, BS = 128, TS = 8, MP = BP * TP, MS = BS * TS, MROWS = MP + MS, UP = 4096, PT = 3996, DFF = 4096;
constexpr int CA = 0, CB = 896, CC = 1936, CD = 2968;
constexpr int NTHR = 512, NWAVES = 8;
constexpr int LDS_BYTES = 135168;
constexpr size_t MiB = 1u << 20;
constexpr size_t WS_BAR = 59 * MiB + 512 * 1024;
constexpr size_t WS_WTIN = 0, WS_WTOUT = 16 * MiB, WS_WTUP = 20 * MiB, WS_WTDN = 36 * MiB, WS_MOD = 52 * MiB, WS_AUX = 59 * MiB, WS_H = 60 * MiB, WS_U = 94 * MiB, WS_PART = 230 * MiB, WS_X16 = 246 * MiB, WS_END = 280 * MiB;
static_assert(WS_MOD + (size_t)2 * 136 * 6144 * 4 <= WS_AUX && WS_AUX + (size_t)MROWS * 4 * 4 <= WS_H && WS_H + (size_t)MROWS * DM * 2 <= WS_U && WS_U + (size_t)MROWS * UP * 2 <= WS_PART, "ws map");
constexpr size_t O_PSHIFT = (size_t)MROWS * DM, O_PWKV = O_PSHIFT + 2 * 8 * 896, O_PGLA = O_PWKV + 2 * 8 * 4 * 4096, O_PDNC = O_PGLA + 2 * 8 * 4 * 4096, O_PDN = O_PDNC + 2 * 8 * 3 * 768,
                 O_PSSC = O_PDN + 2 * 8 * 4 * 4096, O_PSSM = O_PSSC + 2 * 8 * 3 * 768, O_SSHIFT = O_PSSM + 2 * 8 * 4 * 8192, O_SWKV = O_SSHIFT + 2 * 128 * 896, O_SGLA = O_SWKV + (size_t)2 * 128 * 4 * 4096,
                 O_SDNC = O_SGLA + (size_t)2 * 128 * 4 * 4096, O_SDN = O_SDNC + 2 * 128 * 3 * 768, O_SSSC = O_SDN + (size_t)2 * 128 * 4 * 4096, O_SSSM = O_SSSC + 2 * 128 * 3 * 768, O_TOTAL = O_SSSM + (size_t)2 * 128 * 4 * 8192;

#define GASP __attribute__((address_space(1)))
template <class T> __device__ __forceinline__ T* as_global(T* q) { return (T*)(GASP T*)(unsigned long long)q; }
struct KP {
    struct In { const float* v[44]; __device__ __forceinline__ const float* operator[](int i) const { return as_global(v[i]); } } in;
    struct Out { float* v; __device__ __forceinline__ operator float*() const { return as_global(v); } } out;
    struct Ws { unsigned char* v; __device__ __forceinline__ operator unsigned char*() const { return as_global(v); } } ws;
};

__device__ __forceinline__ int otid() { int t = threadIdx.x; asm volatile("" : "+v"(t)); return t; }
__device__ __forceinline__ float bf2f(bf16 h) { return __builtin_bit_cast(float, (unsigned)h << 16); }
__device__ __forceinline__ unsigned f2bf(float f) { unsigned u = __builtin_bit_cast(unsigned, f); return (u + 0x7fffu + ((u >> 16) & 1u)) >> 16; }
__device__ __forceinline__ unsigned pk2(float lo, float hi) { unsigned r; asm("v_cvt_pk_bf16_f32 %0, %1, %2" : "=v"(r) : "v"(lo), "v"(hi)); return r; }
typedef short bf16x8v __attribute__((ext_vector_type(8)));
__device__ __forceinline__ uint4 pack8f(const float* s) { uint4 v; v.x = pk2(s[0], s[1]); v.y = pk2(s[2], s[3]); v.z = pk2(s[4], s[5]); v.w = pk2(s[6], s[7]); return v; }
template <int CTRL> __device__ __forceinline__ float dppf(float x) { return __builtin_bit_cast(float, __builtin_amdgcn_mov_dpp(__builtin_bit_cast(int, x), CTRL, 0xf, 0xf, true)); }
__device__ __forceinline__ float red16(float v) { v += dppf<0xB1>(v); v += dppf<0x4E>(v); v += dppf<0x141>(v); v += dppf<0x128>(v); return v; }
__device__ __forceinline__ float wave_sum(float v) { v = red16(v); v += __shfl_xor(v, 16); v += __shfl_xor(v, 32); return v; }
__device__ __forceinline__ float sigmoidf_(float x) { return __builtin_amdgcn_rcpf(1.f + __expf(-x)); }
__device__ __forceinline__ float siluf_(float x) { return x * __builtin_amdgcn_rcpf(1.f + __expf(-x)); }
__device__ __forceinline__ float softplusf_(float x) { return fmaxf(x, 0.f) + __logf(1.f + __expf(-fabsf(x))); }
__device__ __forceinline__ float tanhf_(float x) { return 1.f - 2.f * __builtin_amdgcn_rcpf(__expf(2.f * x) + 1.f); }

__device__ __forceinline__ void transpose_item(const float* W, int K, int N, bf16* WT, float* scr, int item, int nblk, int lane) {
    const int kb = item / nblk, nb = item % nblk, k0 = 64 * kb, n0 = 32 * nb;
    const int kr = lane >> 3, c4 = (lane & 7) * 4; const bool ok = n0 + c4 < N;
    f32x4 v[8];
#pragma unroll
    for (int i = 0; i < 8; ++i) v[i] = ok ? *(const f32x4*)(W + (size_t)(k0 + i * 8 + kr) * N + n0 + c4) : (f32x4){0.f, 0.f, 0.f, 0.f};
#pragma unroll
    for (int i = 0; i < 8; ++i) { float* d = scr + (i * 8 + kr) * 33 + c4; d[0] = v[i][0]; d[1] = v[i][1]; d[2] = v[i][2]; d[3] = v[i][3]; }
    __builtin_amdgcn_s_waitcnt(0); __builtin_amdgcn_wave_barrier();
    const int c = lane & 7;
#pragma unroll
    for (int j = 0; j < 4; ++j) { const int nn = (lane >> 3) + 8 * j; const float* s = scr + (8 * c) * 33 + nn;
        uint4 o; o.x = pk2(s[0 * 33], s[1 * 33]); o.y = pk2(s[2 * 33], s[3 * 33]); o.z = pk2(s[4 * 33], s[5 * 33]); o.w = pk2(s[6 * 33], s[7 * 33]);
        *(uint4*)(WT + (size_t)(n0 + nn) * K + k0 + 8 * c) = o; }
    __builtin_amdgcn_s_waitcnt(0); __builtin_amdgcn_wave_barrier();
}

__device__ __forceinline__ void phase_p0(const KP& p, float* sm) {
    const int tid = otid(), lane = tid & 63, wv = tid >> 6, G = gridDim.x;
    { bf16* AS = (bf16*)sm; const int nt = wv & 3, mh = wv >> 2, n = lane & 15, fq = lane >> 4;
      for (int u = blockIdx.x; u < 2 * 96; u += G) {
        const int l = u / 96, n0 = (u % 96) * 64 + nt * 16 + n;
        const float* W = p.in[11] + (size_t)l * DM * 6144 + n0;
        f32x4 acc[5];
#pragma unroll
        for (int m = 0; m < 5; ++m) acc[m] = (f32x4){0.f, 0.f, 0.f, 0.f};
        float wb[2][8];
#pragma unroll
        for (int ks = 0; ks < 2; ++ks)
#pragma unroll
            for (int j = 0; j < 8; ++j) wb[ks][j] = W[(size_t)(ks * 32 + fq * 8 + j) * 6144];
        for (int kc = 0; kc < DM; kc += 64) {
            __syncthreads();
            for (int i = tid; i < 144 * 32; i += NTHR) { const int r = i >> 5, k = (i & 31) * 2;
                float c0 = 0.f, c1 = 0.f;
                if (r < 8) { const float2 c = *(const float2*)(p.in[9] + (size_t)r * DM + kc + k); c0 = siluf_(c.x); c1 = siluf_(c.y); }
                else if (r < 136) { const float2 c = *(const float2*)(p.in[10] + (size_t)(r - 8) * DM + kc + k); c0 = siluf_(c.x); c1 = siluf_(c.y); }
                *(unsigned*)(AS + r * 72 + k) = pk2(c0, c1); }
            __syncthreads();
            bf16x8v B[2];
#pragma unroll
            for (int ks = 0; ks < 2; ++ks) { const uint4 t = pack8f(wb[ks]); B[ks] = __builtin_bit_cast(bf16x8v, t); }
            if (kc + 64 < DM) {
#pragma unroll
                for (int ks = 0; ks < 2; ++ks)
#pragma unroll
                    for (int j = 0; j < 8; ++j) wb[ks][j] = W[(size_t)(kc + 64 + ks * 32 + fq * 8 + j) * 6144]; }
#pragma unroll
            for (int ks = 0; ks < 2; ++ks)
#pragma unroll
                for (int m = 0; m < 5; ++m) { const int mt = mh * 5 + m; if (mt < 9) { const bf16x8v A = *(const bf16x8v*)(AS + (mt * 16 + n) * 72 + ks * 32 + fq * 8);
                    acc[m] = __builtin_amdgcn_mfma_f32_16x16x32_bf16(A, B[ks], acc[m], 0, 0, 0); } }
        }
        const float bias = p.in[12][(size_t)l * 6144 + n0];
        float* M = (float*)(p.ws + WS_MOD) + (size_t)l * 136 * 6144 + n0;
#pragma unroll
        for (int m = 0; m < 5; ++m) { const int mt = mh * 5 + m;
#pragma unroll
            for (int i = 0; i < 4; ++i) { const int row = mt * 16 + fq * 4 + i; if (mt < 9 && row < 136) M[(size_t)row * 6144] = acc[m][i] + bias; } }
      }
      __syncthreads(); }
    const int gw = blockIdx.x * NWAVES + wv, NGW = G * NWAVES;
    float* scr = sm + wv * (64 * 33);
    constexpr int I_IN = 16 * 128, I_OUT = 16 * 32, I_UP = 16 * 128, I_DN = 64 * 32, I_L = I_IN + I_OUT + I_UP + I_DN;
    for (int it = gw; it < 2 * I_L; it += NGW) {
        const int l = it / I_L; int r = it % I_L;
        if (r < I_IN) { transpose_item(p.in[15] + (size_t)l * DM * PT, DM, PT, (bf16*)(p.ws + WS_WTIN) + (size_t)l * UP * DM, scr, r, 128, lane); continue; } r -= I_IN;
        if (r < I_OUT) { transpose_item(p.in[16] + (size_t)l * DM * DM, DM, DM, (bf16*)(p.ws + WS_WTOUT) + (size_t)l * DM * DM, scr, r, 32, lane); continue; } r -= I_OUT;
        if (r < I_UP) { transpose_item(p.in[17] + (size_t)l * DM * DFF, DM, DFF, (bf16*)(p.ws + WS_WTUP) + (size_t)l * DFF * DM, scr, r, 128, lane); continue; } r -= I_UP;
        transpose_item(p.in[18] + (size_t)l * DFF * DM, DFF, DM, (bf16*)(p.ws + WS_WTDN) + (size_t)l * DM * DFF, scr, r, 32, lane);
    }
    __syncthreads();
}

__device__ __forceinline__ void load_xrow(f32x4 (&v)[4], const float* xf, const bf16* x16, int lane) {
    if (xf) {
#pragma unroll
        for (int j = 0; j < 4; ++j) v[j] = *(const f32x4*)(xf + lane * 4 + 256 * j); }
    else {
#pragma unroll
        for (int j = 0; j < 4; ++j) { const uint2 w = *(const uint2*)(x16 + lane * 4 + 256 * j);
            v[j] = (f32x4){__builtin_bit_cast(float, w.x << 16), __builtin_bit_cast(float, w.x & 0xffff0000u), __builtin_bit_cast(float, w.y << 16), __builtin_bit_cast(float, w.y & 0xffff0000u)}; } }
}
__device__ __forceinline__ void phase_norm(const KP& p, const float* xPf, const float* xSf, const float* nw, const float* modl, int sh_off, int sc_off, int gate_off) {
    const int tid = otid(), lane = tid & 63, wv = tid >> 6; const int gw = blockIdx.x * NWAVES + wv, NGW = gridDim.x * NWAVES;
    bf16* H = (bf16*)(p.ws + WS_H); bf16* X16 = (bf16*)(p.ws + WS_X16);
    f32x4 v[4], vn[4];
#define NRM_LOAD(dst, row) load_xrow(dst, (row) < MP ? (xPf ? xPf + (size_t)(row) * DM : nullptr) : (xSf ? xSf + (size_t)((row) - MP) * DM : nullptr), X16 + (size_t)(row) * DM, lane)
    if (gw < MROWS) NRM_LOAD(v, gw);
    for (int row = gw; row < MROWS; row += NGW) {
        if (row + NGW < MROWS) NRM_LOAD(vn, row + NGW);
        const int cond = row < MP ? (row >> 11) : 8 + ((row - MP) >> 3);
        const float* md = modl + (size_t)cond * 6144;
        if (row >= MP && gate_off != -1) {
            const float* P = (const float*)(p.ws + WS_PART) + (size_t)(row - MP) * DM; bf16* xo_ = X16 + (size_t)row * DM;
#pragma unroll
            for (int j = 0; j < 4; ++j) { const int c = lane * 4 + 256 * j; const f32x4 g = *(const f32x4*)(md + gate_off + c);
                const f32x4 sp = (*(const f32x4*)(P + c) + *(const f32x4*)(P + (size_t)1024 * DM + c)) + (*(const f32x4*)(P + (size_t)2048 * DM + c) + *(const f32x4*)(P + (size_t)3072 * DM + c));
                v[j] += g * sp; uint2 o; o.x = pk2(v[j][0], v[j][1]); o.y = pk2(v[j][2], v[j][3]); *(uint2*)(xo_ + c) = o; } }
        float ss = 0.f;
#pragma unroll
        for (int j = 0; j < 4; ++j) ss += v[j][0] * v[j][0] + v[j][1] * v[j][1] + v[j][2] * v[j][2] + v[j][3] * v[j][3];
        const float rs = rsqrtf(wave_sum(ss) * (1.f / DM) + 1e-6f);
#pragma unroll
        for (int j = 0; j < 4; ++j) { const int c = lane * 4 + 256 * j; const f32x4 w = *(const f32x4*)(nw + c), sc = *(const f32x4*)(md + sc_off + c), sh = *(const f32x4*)(md + sh_off + c);
            const f32x4 h = v[j] * rs * w * (sc + 1.f) + sh;
            uint2 o; o.x = pk2(h[0], h[1]); o.y = pk2(h[2], h[3]); *(uint2*)(H + (size_t)row * DM + c) = o; }
#pragma unroll
        for (int j = 0; j < 4; ++j) v[j] = vn[j];
    }
#undef NRM_LOAD
}
__device__ __forceinline__ void phase_final(const KP& p) {
    const int tid = otid(), lane = tid & 63, wv = tid >> 6; const int gw = blockIdx.x * NWAVES + wv, NGW = gridDim.x * NWAVES;
    const float* nw = p.in[43]; const bf16* X16 = (const bf16*)(p.ws + WS_X16);
    f32x4 v[4], vn[4];
    if (gw < MROWS) load_xrow(v, nullptr, X16 + (size_t)gw * DM, lane);
    for (int row = gw; row < MROWS; row += NGW) {
        float* x = p.out + (size_t)row * DM;
        if (row + NGW < MROWS) load_xrow(vn, nullptr, X16 + (size_t)(row + NGW) * DM, lane);
        if (row >= MP) { const float* P = (const float*)(p.ws + WS_PART) + (size_t)(row - MP) * DM; const float* md = (const float*)(p.ws + WS_MOD) + ((size_t)136 + 8 + ((row - MP) >> 3)) * 6144 + 5120;
#pragma unroll
            for (int j = 0; j < 4; ++j) { const int c = lane * 4 + 256 * j; const f32x4 g = *(const f32x4*)(md + c);
                const f32x4 sp = (*(const f32x4*)(P + c) + *(const f32x4*)(P + (size_t)1024 * DM + c)) + (*(const f32x4*)(P + (size_t)2048 * DM + c) + *(const f32x4*)(P + (size_t)3072 * DM + c));
                v[j] += g * sp; } }
        float ss = 0.f;
#pragma unroll
        for (int j = 0; j < 4; ++j) ss += v[j][0] * v[j][0] + v[j][1] * v[j][1] + v[j][2] * v[j][2] + v[j][3] * v[j][3];
        const float rs = rsqrtf(wave_sum(ss) * (1.f / DM) + 1e-6f);
#pragma unroll
        for (int j = 0; j < 4; ++j) { const int c = lane * 4 + 256 * j; *(f32x4*)(x + c) = v[j] * rs * *(const f32x4*)(nw + c); }
#pragma unroll
        for (int j = 0; j < 4; ++j) v[j] = vn[j];
    }
}

typedef float f32x2 __attribute__((ext_vector_type(2)));
constexpr int VST = 320, SL_VEC = 0, SL_VROW = 16 * VST, SL_PART = SL_VROW + 16 * 64, SL_SCAL = SL_PART + 16 * 16, SL_SIZE = SL_SCAL + 16 * 8;
static_assert(4 * SL_SIZE * 4 <= 131072, "scan LDS ring");
struct Item { int tr, b, h, half, T, NB, row0; };
struct V8 { f32x4 a, b; };
__device__ __forceinline__ V8 ld8(const float* q) { V8 v; v.a = *(const f32x4*)q; v.b = *(const f32x4*)(q + 4); return v; }
__device__ __forceinline__ float dot8(const V8& s, const V8& x) { const f32x4 t = s.a * x.a + s.b * x.b; return (t[0] + t[1]) + (t[2] + t[3]); }
__device__ __forceinline__ f32x2 dot8x2(const V8& s, const f32x4& p0, const f32x4& p1, const f32x4& p2, const f32x4& p3) {
    f32x2 a = (f32x2){s.a[0], s.a[0]} * (f32x2){p0[0], p0[1]}; f32x2 b = (f32x2){s.a[1], s.a[1]} * (f32x2){p0[2], p0[3]};
    a += (f32x2){s.a[2], s.a[2]} * (f32x2){p1[0], p1[1]}; b += (f32x2){s.a[3], s.a[3]} * (f32x2){p1[2], p1[3]};
    a += (f32x2){s.b[0], s.b[0]} * (f32x2){p2[0], p2[1]}; b += (f32x2){s.b[1], s.b[1]} * (f32x2){p2[2], p2[3]};
    a += (f32x2){s.b[2], s.b[2]} * (f32x2){p3[0], p3[1]}; b += (f32x2){s.b[3], s.b[3]} * (f32x2){p3[2], p3[3]};
    return a + b; }
__device__ __forceinline__ float red8(float v) { v += dppf<0xB1>(v); v += dppf<0x4E>(v); v += dppf<0x141>(v); return v; }
__device__ __forceinline__ float ldu(const bf16* U, int row, int col, int T) { row = row < T ? row : T - 1; return bf2f(U[(size_t)row * UP + col]); }
__device__ __forceinline__ void unpack8(const uint4 v, float (&o)[8]) {
    o[0] = __builtin_bit_cast(float, v.x << 16); o[1] = __builtin_bit_cast(float, v.x & 0xffff0000u); o[2] = __builtin_bit_cast(float, v.y << 16); o[3] = __builtin_bit_cast(float, v.y & 0xffff0000u);
    o[4] = __builtin_bit_cast(float, v.z << 16); o[5] = __builtin_bit_cast(float, v.z & 0xffff0000u); o[6] = __builtin_bit_cast(float, v.w << 16); o[7] = __builtin_bit_cast(float, v.w & 0xffff0000u); }
#define YKEEP2(tt, ya, yb) do { if ((tt) == sub) { yk0 = (ya); yk1 = (yb); } } while (0)
#define YSTORE2(bb) do { const int g0 = 16 * (bb) + sub; if (g0 < T) { Y[(size_t)g0 * DM + irow] = (bf16)f2bf(yk0); Y[(size_t)g0 * DM + irow + 16] = (bf16)f2bf(yk1); } } while (0)
__device__ __forceinline__ f32x2 dot4x2(const f32x4& s, const f32x4& p0, const f32x4& p1) {
    f32x2 a = (f32x2){s[0], s[0]} * (f32x2){p0[0], p0[1]}; f32x2 b = (f32x2){s[1], s[1]} * (f32x2){p0[2], p0[3]};
    a += (f32x2){s[2], s[2]} * (f32x2){p1[0], p1[1]}; b += (f32x2){s[3], s[3]} * (f32x2){p1[2], p1[3]};
    return a + b; }
__device__ __forceinline__ void red16x4(float x0, float x1, float x2, float x3, bool p0, bool p1, float& r0, float& r1, float& r2, float& r3) {
    float k0 = p0 ? x2 : x0, k1 = p0 ? x3 : x1; const float t0 = p0 ? x0 : x2, t1 = p0 ? x1 : x3;
    k0 += dppf<0xB1>(t0); k1 += dppf<0xB1>(t1);
    float m = p1 ? k1 : k0; const float u = p1 ? k0 : k1;
    m += dppf<0x4E>(u); m += dppf<0x124>(m); m += dppf<0x128>(m);
    r0 = dppf<0x00>(m); r2 = dppf<0x55>(m); r1 = dppf<0xAA>(m); r3 = dppf<0xFF>(m);
}
__device__ __forceinline__ void red16x2(float xa, float xb, bool p0, float& ra, float& rb) {
    float k = p0 ? xb : xa; const float t = p0 ? xa : xb;
    k += dppf<0xB1>(t); k += dppf<0x4E>(k); k += dppf<0x124>(k); k += dppf<0x128>(k);
    ra = dppf<0x00>(k); rb = dppf<0x55>(k);
}
__device__ __forceinline__ float dot4(const f32x4& s, const f32x4& x) { const f32x4 t = s * x; return (t[0] + t[1]) + (t[2] + t[3]); }
#define TICK_BAR() do { asm volatile("s_waitcnt lgkmcnt(0)" ::: "memory"); __builtin_amdgcn_s_barrier(); asm volatile("" ::: "memory"); } while (0)
__device__ __forceinline__ void scan_rwkv(const KP& p, int l, const Item& it, float* sm) {
    const int tid = otid(), lane = tid & 63, wv = tid >> 6, T = it.T, NBAT = (T + 15) >> 4;
    const bool scanner = wv < 4;
    const bf16* U = (const bf16*)(p.ws + WS_U) + (size_t)it.row0 * UP;
    const float* sh0 = it.tr ? p.in[2] + ((size_t)l * BS + it.b) * 896 : nullptr;
    const int rp = (tid & 255) >> 4, sub = tid & 15, nh = it.tr ? 2 : 1; const bool lp0 = (tid & 1) != 0, lp1 = (tid & 2) != 0; int irow = it.half * 32 + rp;
    bf16* Y = (bf16*)(p.ws + WS_H) + (size_t)it.row0 * DM + 0 * 256 + it.h * 64;
    float* sbase_o = p.out + (it.tr ? O_SWKV : O_PWKV) + (((size_t)l * it.NB + it.b) * 4 + it.h) * 4096 + sub * 4;
    const float* sbase_i = p.in[3] + (((size_t)l * BS + it.b) * 4 + it.h) * 4096 + sub * 4;
    f32x4 S0 = {0.f, 0.f, 0.f, 0.f}, S1 = S0, Q0 = S0, Q1 = S0;
    if (it.tr) { const float* q = sbase_i + ((wv >> 2) * 32 + rp) * 64; Q0 = *(const f32x4*)q; Q1 = *(const f32x4*)(q + 16 * 64); }
    float yk0 = 0.f, yk1 = 0.f;
    const int pj = wv & 3, n = lane & 15, fq = lane >> 4, c = pj * 16 + n, hc = it.h * 64 + c;
    const float* mu = p.in[19] + l * 896;
    bf16x8v Bw, Ba;
#pragma unroll
    for (int j = 0; j < 8; ++j) { Bw[j] = (short)f2bf(p.in[21][((size_t)l * 32 + fq * 8 + j) * 256 + hc]); Ba[j] = (short)f2bf(p.in[23][((size_t)l * 32 + fq * 8 + j) * 256 + hc]); }
    const int ja = fq * 8 + 2 * pj; const float muw0 = mu[768 + ja], muw1 = mu[769 + ja], mua0 = mu[800 + ja], mua1 = mu[801 + ja];
    unsigned* AF = (unsigned*)(sm + 4 * SL_SIZE + 64);
    unsigned awc = 0u, awp = 0u, aac = 0u, aap = 0u;
#define RWA_LOAD(bb) do { const int ta = 16 * (bb) + n; const int tc_ = ta < T ? ta : T - 1; const bf16* q = U + (size_t)tc_ * UP + 768 + ja; awc = *(const unsigned*)q; aac = *(const unsigned*)(q + 32); \
        if (tc_ > 0) { awp = *(const unsigned*)(q - UP); aap = *(const unsigned*)(q + 32 - UP); } \
        else if (sh0) { awp = pk2(sh0[768 + ja], sh0[769 + ja]); aap = pk2(sh0[800 + ja], sh0[801 + ja]); } else { awp = 0u; aap = 0u; } } while (0)
#define RWA_CONV(bb) do { const float c0 = __builtin_bit_cast(float, awc << 16), c1 = __builtin_bit_cast(float, awc & 0xffff0000u), q0 = __builtin_bit_cast(float, awp << 16), q1 = __builtin_bit_cast(float, awp & 0xffff0000u); \
        const float d0 = __builtin_bit_cast(float, aac << 16), d1 = __builtin_bit_cast(float, aac & 0xffff0000u), e0 = __builtin_bit_cast(float, aap << 16), e1 = __builtin_bit_cast(float, aap & 0xffff0000u); \
        unsigned* A_ = AF + ((bb) & 1) * 512 + lane * 4 + pj; A_[0] = pk2(tanhf_(c0 + (q0 - c0) * muw0), tanhf_(c1 + (q1 - c1) * muw1)); A_[256] = pk2(d0 + (e0 - d0) * mua0, d1 + (e1 - d1) * mua1); } while (0)
    const float w0c = p.in[20][l * 256 + hc], a0c = p.in[22][l * 256 + hc], kkc = p.in[25][l * 256 + hc], kac = p.in[26][l * 256 + hc], rkc = p.in[27][l * 256 + hc];
    const float mur = mu[hc], muk = mu[256 + hc], muv = mu[512 + hc];
    struct RwRaw { float rr[5], rk[5], rv[5]; } cur;
#define RW_LOAD(R, bb) do { _Pragma("unroll") for (int i = 0; i < 5; ++i) { const int g = 16 * (bb) + fq * 4 - 1 + i; \
            if (g >= 0) { R.rr[i] = ldu(U, g, hc, T); R.rk[i] = ldu(U, g, 256 + hc, T); R.rv[i] = ldu(U, g, 512 + hc, T); } \
            else if (sh0) { R.rr[i] = sh0[hc]; R.rk[i] = sh0[256 + hc]; R.rv[i] = sh0[512 + hc]; } else { R.rr[i] = R.rk[i] = R.rv[i] = 0.f; } } } while (0)
    if (!scanner) { RWA_LOAD(0); RW_LOAD(cur, 0); RWA_CONV(0); if (NBAT > 1) RWA_LOAD(1); }
    TICK_BAR();
    for (int k = 0; k < NBAT + 2; ++k) {
        if (scanner || it.tr) {
            __builtin_amdgcn_s_setprio(3);
            const int b = k - 2;
            if (b >= 0 && b < NBAT) {
                const float* SL = sm + (b & 3) * SL_SIZE; const int ns = (T - 16 * b) < 16 ? (T - 16 * b) : 16;
                { const int hv = wv >> 2;
                if (it.tr) { irow = hv * 32 + rp; S0 = Q0; S1 = Q1; }
#define RW_STEP(tt, q0, q1, w, bb, kp, va, vb, sc) do { const f32x2 da = dot4x2(S0, q0, q1), db = dot4x2(S1, q0, q1); \
                    float a1, a2, b1, b2; red16x4(da.x, da.y, db.x, db.y, lp0, lp1, a1, a2, b1, b2); \
                    const float ca = sc[0] * a1, cb = sc[0] * b1;                                       \
                    const float ya = a2 - ca * sc[1] + va * sc[2], yb = b2 - cb * sc[1] + vb * sc[2]; \
                    S0 = S0 * w + (kp * va - bb * ca); S1 = S1 * w + (kp * vb - bb * cb); YKEEP2(tt, ya, yb); } while (0)
                for (int tt = 0; tt < ns; tt += 2) {
                    const float* V0 = SL + SL_VEC + tt * VST + sub * 4; const float* V1 = V0 + VST; const float* P0 = V0 + sub * 4; const float* P1 = P0 + VST;
                    const f32x4 a0 = *(const f32x4*)P0, a1_ = *(const f32x4*)(P0 + 4), w0 = *(const f32x4*)(V0 + 128), bb0 = *(const f32x4*)(V0 + 192), kp0 = *(const f32x4*)(V0 + 256);
                    const float va0 = SL[SL_VROW + tt * 64 + irow], vb0 = SL[SL_VROW + tt * 64 + irow + 16]; const f32x4 sc0 = *(const f32x4*)(SL + SL_SCAL + tt * 8);
                    const f32x4 e0 = *(const f32x4*)P1, e1 = *(const f32x4*)(P1 + 4), w1 = *(const f32x4*)(V1 + 128), bb1 = *(const f32x4*)(V1 + 192), kp1 = *(const f32x4*)(V1 + 256);
                    const float va1 = SL[SL_VROW + (tt + 1) * 64 + irow], vb1 = SL[SL_VROW + (tt + 1) * 64 + irow + 16]; const f32x4 sc1 = *(const f32x4*)(SL + SL_SCAL + (tt + 1) * 8);
                    RW_STEP(tt, a0, a1_, w0, bb0, kp0, va0, vb0, sc0);
                    RW_STEP(tt + 1, e0, e1, w1, bb1, kp1, va1, vb1, sc1);
                }
#undef RW_STEP
                YSTORE2(b);
                if (it.tr) { *(f32x4*)(sbase_o + irow * 64) = S0; *(f32x4*)(sbase_o + (irow + 16) * 64) = S1; }
                }
            }
            __builtin_amdgcn_s_setprio(0);
        }
        if (!scanner) {
            if (k >= 1 && k - 1 < NBAT && lane < 4) {
                const int tt = pj * 4 + lane; float* SL = sm + ((k - 1) & 3) * SL_SIZE; const float* P = SL + SL_PART + tt * 16;
                const f32x4 s = *(const f32x4*)P + *(const f32x4*)(P + 4) + *(const f32x4*)(P + 8) + *(const f32x4*)(P + 12);
                const float rn2 = __builtin_amdgcn_rcpf(s[0] + 1e-6f);
                *(f32x4*)(SL + SL_SCAL + tt * 8) = (f32x4){rn2, s[1], s[2], 0.f};
                const int g = 16 * (k - 1) + tt; if (it.half == 0 && g < T) ((float*)(p.ws + WS_AUX))[((size_t)it.row0 + g) * 4 + it.h] = s[3];
            }
            if (k + 1 < NBAT) { RWA_CONV(k + 1); if (k + 2 < NBAT) RWA_LOAD(k + 2); }
            if (k < NBAT) {
                const bf16x8v Aw = __builtin_bit_cast(bf16x8v, *(const uint4*)(AF + (k & 1) * 512 + lane * 4)), Aa = __builtin_bit_cast(bf16x8v, *(const uint4*)(AF + (k & 1) * 512 + 256 + lane * 4));
                const f32x4 z = {0.f, 0.f, 0.f, 0.f};
                const f32x4 dw = __builtin_amdgcn_mfma_f32_16x16x32_bf16(Aw, Bw, z, 0, 0, 0), da = __builtin_amdgcn_mfma_f32_16x16x32_bf16(Aa, Ba, z, 0, 0, 0);
                float xr_[4], xk_[4], xv_[4];
#pragma unroll
                for (int i = 0; i < 4; ++i) { xr_[i] = cur.rr[i + 1] + (cur.rr[i] - cur.rr[i + 1]) * mur; xk_[i] = cur.rk[i + 1] + (cur.rk[i] - cur.rk[i + 1]) * muk; xv_[i] = cur.rv[i + 1] + (cur.rv[i] - cur.rv[i + 1]) * muv; }
                if (k + 1 < NBAT) RW_LOAD(cur, k + 1);
                float* SL = sm + (k & 3) * SL_SIZE;
#pragma unroll
                for (int i = 0; i < 4; ++i) { const int tt = fq * 4 + i;
                    const float w = __expf(-0.6065306597f * sigmoidf_(w0c + dw[i])), a = sigmoidf_(a0c + da[i]);
                    const float kkraw = xk_[i] * kkc, braw = kkraw * a, kp = xk_[i] * (1.f + (a - 1.f) * kac);
                    float* V = SL + SL_VEC + tt * VST + c; *(f32x2*)(V + c) = (f32x2){kkraw, w * xr_[i]}; V[128] = w; V[192] = braw; V[256] = kp; SL[SL_VROW + tt * 64 + c] = xv_[i];
                    float p0, p1, p2, p3; red16x4(kkraw * kkraw, braw * xr_[i], kp * xr_[i], xr_[i] * kp * rkc, lp0, lp1, p0, p1, p2, p3);
                    if (n == 0) *(f32x4*)(SL + SL_PART + tt * 16 + pj * 4) = (f32x4){p0, p1, p2, p3}; }
            }
        }
        TICK_BAR();
    }
#undef RW_LOAD
#undef RWA_LOAD
#undef RWA_CONV
    if (scanner) { if (!it.tr) { *(f32x4*)(sbase_o + irow * 64) = S0; *(f32x4*)(sbase_o + (irow + 16) * 64) = S1; } }
    else if (it.h == 0 && it.half == 0) { float* so = p.out + (it.tr ? O_SSHIFT : O_PSHIFT) + ((size_t)l * it.NB + it.b) * 896;
        for (int cc = tid - 256; cc < 896; cc += 256) so[cc] = bf2f(U[(size_t)(T - 1) * UP + cc]); }
}

__device__ __forceinline__ void scan_gla(const KP& p, int l, const Item& it, float* sm) {
    const int tid = otid(), lane = tid & 63, wv = tid >> 6, T = it.T, NBAT = (T + 15) >> 4;
    const bool scanner = wv < 4;
    const bf16* U = (const bf16*)(p.ws + WS_U) + (size_t)it.row0 * UP + CB;
    const int rp = (tid & 255) >> 4, sub = tid & 15, nh = it.tr ? 2 : 1; const bool lp0 = (tid & 1) != 0, lp1 = (tid & 2) != 0; int irow = it.half * 32 + rp;
    bf16* Y = (bf16*)(p.ws + WS_H) + (size_t)it.row0 * DM + 1 * 256 + it.h * 64;
    const size_t sbase = (((size_t)l * it.NB + it.b) * 4 + it.h) * 4096;
    f32x4 S0 = {0.f, 0.f, 0.f, 0.f}, S1 = S0, Q0 = S0, Q1 = S0; float* so = p.out + (it.tr ? O_SGLA : O_PGLA) + sbase + (size_t)sub * 4 * 64; const float* si = p.in[4] + sbase + (size_t)sub * 4 * 64;
    if (it.tr) { const int r0 = (wv >> 2) * 32 + rp;
#pragma unroll
        for (int e = 0; e < 4; ++e) { Q0[e] = si[e * 64 + r0]; Q1[e] = si[e * 64 + r0 + 16]; } }
    float yk0 = 0.f, yk1 = 0.f;
    const int pj = wv & 3, n = lane & 15, fq = lane >> 4, c = pj * 16 + n, hc = it.h * 64 + c;
    float gkw[16];
#pragma unroll
    for (int j = 0; j < 16; ++j) gkw[j] = p.in[30][((size_t)l * 16 + j) * 256 + hc];
    const float gkb = p.in[31][l * 256 + hc];
    struct GlRaw { float q_[4], k_[4], v_[4]; uint4 g0[4], g1[4]; } cur;
#define GL_LOAD(R, bb) do { _Pragma("unroll") for (int i = 0; i < 4; ++i) { int g = 16 * (bb) + fq * 4 + i; g = g < T ? g : T - 1; const bf16* q = U + (size_t)g * UP; \
        R.q_[i] = bf2f(q[hc]); R.k_[i] = bf2f(q[256 + hc]); R.v_[i] = bf2f(q[512 + hc]); R.g0[i] = *(const uint4*)(q + 1024); R.g1[i] = *(const uint4*)(q + 1032); } } while (0)
    if (!scanner) GL_LOAD(cur, 0);
    for (int k = 0; k < NBAT + 2; ++k) {
        if (scanner || it.tr) {
            __builtin_amdgcn_s_setprio(3);
            const int b = k - 2;
            if (b >= 0 && b < NBAT) {
                const float* SL = sm + (b & 3) * SL_SIZE; const int ns = (T - 16 * b) < 16 ? (T - 16 * b) : 16;
                { const int hv = wv >> 2;
                if (it.tr) { irow = hv * 32 + rp; S0 = Q0; S1 = Q1; }
#define GL_STEP(tt, dec, kv, qd, va, vb, qk) do { float da, db; red16x2(dot4(S0, qd), dot4(S1, qd), lp0, da, db); const float ya = da + va * qk, yb = db + vb * qk; \
                    S0 = S0 * dec + kv * va; S1 = S1 * dec + kv * vb; YKEEP2(tt, ya, yb); } while (0)
                for (int tt = 0; tt < ns; tt += 2) {
                    const float* V0 = SL + SL_VEC + tt * VST + sub * 4; const float* V1 = V0 + VST;
                    const f32x4 qd0 = *(const f32x4*)(V0 + 128), dec0 = *(const f32x4*)V0, kv0 = *(const f32x4*)(V0 + 64); const float va0 = SL[SL_VROW + tt * 64 + irow], vb0 = SL[SL_VROW + tt * 64 + irow + 16], qk0 = SL[SL_SCAL + tt * 8];
                    const f32x4 qd1 = *(const f32x4*)(V1 + 128), dec1 = *(const f32x4*)V1, kv1 = *(const f32x4*)(V1 + 64); const float va1 = SL[SL_VROW + (tt + 1) * 64 + irow], vb1 = SL[SL_VROW + (tt + 1) * 64 + irow + 16], qk1 = SL[SL_SCAL + (tt + 1) * 8];
                    GL_STEP(tt, dec0, kv0, qd0, va0, vb0, qk0);
                    GL_STEP(tt + 1, dec1, kv1, qd1, va1, vb1, qk1);
                }
#undef GL_STEP
                YSTORE2(b);
                if (it.tr) {
#pragma unroll
                    for (int e = 0; e < 4; ++e) { so[e * 64 + irow] = S0[e]; so[e * 64 + irow + 16] = S1[e]; } }
                }
            }
            __builtin_amdgcn_s_setprio(0);
        }
        if (!scanner) {
            if (k >= 1 && k - 1 < NBAT && lane < 4) { const int tt = pj * 4 + lane; float* SL = sm + ((k - 1) & 3) * SL_SIZE; const float* P = SL + SL_PART + tt * 16;
                SL[SL_SCAL + tt * 8] = P[0] + P[4] + P[8] + P[12]; }
            if (k < NBAT) {
                float x[4], qq[4], kk[4], vv[4];
#pragma unroll
                for (int i = 0; i < 4; ++i) { float gl[8]; x[i] = gkb; unpack8(cur.g0[i], gl);
#pragma unroll
                    for (int j = 0; j < 8; ++j) x[i] += gl[j] * gkw[j];
                    unpack8(cur.g1[i], gl);
#pragma unroll
                    for (int j = 0; j < 8; ++j) x[i] += gl[j] * gkw[8 + j];
                    qq[i] = cur.q_[i] * 0.125f; kk[i] = cur.k_[i]; vv[i] = cur.v_[i]; }
                if (k + 1 < NBAT) GL_LOAD(cur, k + 1);
                float* SL = sm + (k & 3) * SL_SIZE;
#pragma unroll
                for (int i = 0; i < 4; ++i) { const int tt = fq * 4 + i;
                    const float dec = __expf(-softplusf_(-x[i]) * (1.f / 16.f));
                    float* V = SL + SL_VEC + tt * VST + c; V[0] = dec; V[64] = kk[i]; V[128] = qq[i] * dec; SL[SL_VROW + tt * 64 + c] = vv[i];
                    const float p0 = red16(qq[i] * kk[i]);
                    if (n == 0) SL[SL_PART + tt * 16 + pj * 4] = p0; }
            }
        }
        TICK_BAR();
    }
#undef GL_LOAD
    if (scanner && !it.tr) {
#pragma unroll
        for (int e = 0; e < 4; ++e) { so[e * 64 + irow] = S0[e]; so[e * 64 + irow + 16] = S1[e]; } }
}

__device__ __forceinline__ void scan_dn(const KP& p, int l, const Item& it, float* sm) {
    const int tid = otid(), lane = tid & 63, wv = tid >> 6, T = it.T, NBAT = (T + 15) >> 4;
    const bool scanner = wv < 4;
    const bf16* U = (const bf16*)(p.ws + WS_U) + (size_t)it.row0 * UP + CC;
    const float* cv0 = it.tr ? p.in[5] + ((size_t)l * BS + it.b) * 3 * 768 : nullptr;
    const int rp = (tid & 255) >> 4, sub = tid & 15, nh = it.tr ? 2 : 1; const bool lp0 = (tid & 1) != 0, lp1 = (tid & 2) != 0; int irow = it.half * 32 + rp;
    bf16* Y = (bf16*)(p.ws + WS_H) + (size_t)it.row0 * DM + 2 * 256 + it.h * 64;
    const size_t sbase = (((size_t)l * it.NB + it.b) * 4 + it.h) * 4096;
    f32x4 S0 = {0.f, 0.f, 0.f, 0.f}, S1 = S0, Q0 = S0, Q1 = S0; float* so = p.out + (it.tr ? O_SDN : O_PDN) + sbase + (size_t)sub * 4 * 64; const float* si = p.in[6] + sbase + (size_t)sub * 4 * 64;
    if (it.tr) { const int r0 = (wv >> 2) * 32 + rp;
#pragma unroll
        for (int e = 0; e < 4; ++e) { Q0[e] = si[e * 64 + r0]; Q1[e] = si[e * 64 + r0 + 16]; } }
    float yk0 = 0.f, yk1 = 0.f;
    const int pj = wv & 3, n = lane & 15, fq = lane >> 4, c = pj * 16 + n, hc = it.h * 64 + c;
    float cw[3][4];
#pragma unroll
    for (int pt = 0; pt < 3; ++pt)
#pragma unroll
        for (int i = 0; i < 4; ++i) cw[pt][i] = p.in[33][((size_t)l * 4 + i) * 768 + pt * 256 + hc];
    const float nA = -__expf(p.in[34][l * 4 + it.h]), dtb = p.in[35][l * 4 + it.h];
    struct DnRaw { float xin[3][7]; } cur;
#define DN_LOAD(R, bb) do { _Pragma("unroll") for (int pt = 0; pt < 3; ++pt) _Pragma("unroll") for (int i = 0; i < 7; ++i) { const int g = 16 * (bb) + fq * 4 - 3 + i; \
        R.xin[pt][i] = g >= 0 ? ldu(U, g, pt * 256 + hc, T) : (cv0 ? cv0[(3 + g) * 768 + pt * 256 + hc] : 0.f); } } while (0)
    if (!scanner) DN_LOAD(cur, 0);
    for (int k = 0; k < NBAT + 2; ++k) {
        if (scanner || it.tr) {
            __builtin_amdgcn_s_setprio(3);
            const int b = k - 2;
            if (b >= 0 && b < NBAT) {
                const float* SL = sm + (b & 3) * SL_SIZE; const int ns = (T - 16 * b) < 16 ? (T - 16 * b) : 16;
                { const int hv = wv >> 2;
                if (it.tr) { irow = hv * 32 + rp; S0 = Q0; S1 = Q1; }
#define DN_STEP(tt, q0, q1, kv, va, vb, sc, sq) do { const f32x2 da = dot4x2(S0, q0, q1), db = dot4x2(S1, q0, q1);        \
                    float a1, a2, b1, b2; red16x4(da.x, da.y, db.x, db.y, lp0, lp1, a1, a2, b1, b2); \
                    const float na = sc[1] * (va - sc[0] * sc[2] * a1), nb = sc[1] * (vb - sc[0] * sc[2] * b1); \
                    const float ya = sc[0] * sc[3] * a2 + na * sq, yb = sc[0] * sc[3] * b2 + nb * sq; \
                    S0 = S0 * sc[0] + kv * (na * sc[2]); S1 = S1 * sc[0] + kv * (nb * sc[2]); YKEEP2(tt, ya, yb); } while (0)
                for (int tt = 0; tt < ns; tt += 2) {
                    const float* V0 = SL + SL_VEC + tt * VST + sub * 4; const float* V1 = V0 + VST; const float* P0 = V0 + sub * 4; const float* P1 = P0 + VST;
                    const f32x4 a0 = *(const f32x4*)P0, a1_ = *(const f32x4*)(P0 + 4), kv0 = *(const f32x4*)(V0 + 128);
                    const float va0 = SL[SL_VROW + tt * 64 + irow], vb0 = SL[SL_VROW + tt * 64 + irow + 16]; const f32x4 sc0 = *(const f32x4*)(SL + SL_SCAL + tt * 8); const float sq0 = SL[SL_SCAL + tt * 8 + 4];
                    const f32x4 e0 = *(const f32x4*)P1, e1 = *(const f32x4*)(P1 + 4), kv1 = *(const f32x4*)(V1 + 128);
                    const float va1 = SL[SL_VROW + (tt + 1) * 64 + irow], vb1 = SL[SL_VROW + (tt + 1) * 64 + irow + 16]; const f32x4 sc1 = *(const f32x4*)(SL + SL_SCAL + (tt + 1) * 8); const float sq1 = SL[SL_SCAL + (tt + 1) * 8 + 4];
                    DN_STEP(tt, a0, a1_, kv0, va0, vb0, sc0, sq0);
                    DN_STEP(tt + 1, e0, e1, kv1, va1, vb1, sc1, sq1);
                }
#undef DN_STEP
                YSTORE2(b);
                if (it.tr) {
#pragma unroll
                    for (int e = 0; e < 4; ++e) { so[e * 64 + irow] = S0[e]; so[e * 64 + irow + 16] = S1[e]; } }
                }
            }
            __builtin_amdgcn_s_setprio(0);
        }
        if (!scanner) {
            if (k >= 1 && k - 1 < NBAT && lane < 4) { const int tt = pj * 4 + lane; float* SL = sm + ((k - 1) & 3) * SL_SIZE; const float* P = SL + SL_PART + tt * 16;
                const f32x4 s = *(const f32x4*)P + *(const f32x4*)(P + 4) + *(const f32x4*)(P + 8) + *(const f32x4*)(P + 12);
                const float rq8 = rsqrtf(s[0] + 1e-6f) * 0.125f, rk = rsqrtf(s[1] + 1e-6f);
                int g = 16 * (k - 1) + tt; g = g < T ? g : T - 1;
                const float beta = sigmoidf_(bf2f(U[(size_t)g * UP + 1028 + it.h])), eg = __expf(nA * softplusf_(bf2f(U[(size_t)g * UP + 1024 + it.h]) + dtb));
                *(f32x4*)(SL + SL_SCAL + tt * 8) = (f32x4){eg, beta, rk, rq8}; SL[SL_SCAL + tt * 8 + 4] = s[2] * rq8 * rk; }
            if (k < NBAT) {
                float o[3][4];
#pragma unroll
                for (int pt = 0; pt < 3; ++pt)
#pragma unroll
                    for (int i = 0; i < 4; ++i) o[pt][i] = siluf_(cw[pt][0] * cur.xin[pt][i] + cw[pt][1] * cur.xin[pt][i + 1] + cw[pt][2] * cur.xin[pt][i + 2] + cw[pt][3] * cur.xin[pt][i + 3]);
                if (k + 1 < NBAT) DN_LOAD(cur, k + 1);
                float* SL = sm + (k & 3) * SL_SIZE;
#pragma unroll
                for (int i = 0; i < 4; ++i) { const int tt = fq * 4 + i;
                    float* V = SL + SL_VEC + tt * VST + c; *(f32x2*)(V + c) = (f32x2){o[1][i], o[0][i]}; V[128] = o[1][i]; SL[SL_VROW + tt * 64 + c] = o[2][i];
                    const float p0 = red16(o[0][i] * o[0][i]), p1 = red16(o[1][i] * o[1][i]), p2 = red16(o[0][i] * o[1][i]);
                    if (n == 0) *(f32x4*)(SL + SL_PART + tt * 16 + pj * 4) = (f32x4){p0, p1, p2, 0.f}; }
            }
        }
        TICK_BAR();
    }
#undef DN_LOAD
    if (scanner) { if (!it.tr) {
#pragma unroll
        for (int e = 0; e < 4; ++e) { so[e * 64 + irow] = S0[e]; so[e * 64 + irow + 16] = S1[e]; } } }
    else if (it.h == 0 && it.half == 0) { float* so = p.out + (it.tr ? O_SDNC : O_PDNC) + ((size_t)l * it.NB + it.b) * 3 * 768;
        for (int i = tid - 256; i < 3 * 768; i += 256) { const int rr = i / 768, cc = i % 768; so[i] = bf2f(U[(size_t)(T - 3 + rr) * UP + cc]); } }
}

__device__ __forceinline__ void scan_ssd(const KP& p, int l, const Item& it, float* sm) {
    const int tid = otid(), lane = tid & 63, wv = tid >> 6, T = it.T, NBAT = (T + 15) >> 4, grp = it.h >> 1;
    const bool scanner = wv < 4;
    const bf16* U = (const bf16*)(p.ws + WS_U) + (size_t)it.row0 * UP + CD;
    const bf16* UX = U + 256;
    const float* cv0 = it.tr ? p.in[7] + ((size_t)l * BS + it.b) * 3 * 768 : nullptr;
    const int rp = (tid & 255) >> 4, sub = tid & 15, nh = it.tr ? 2 : 1; const bool lp0 = (tid & 1) != 0, lp1 = (tid & 2) != 0; int irow = it.half * 32 + rp;
    bf16* Y = (bf16*)(p.ws + WS_H) + (size_t)it.row0 * DM + 3 * 256 + it.h * 64;
    const size_t sbase = (((size_t)l * it.NB + it.b) * 4 + it.h) * 64 * 128 + sub * 8; float* so = p.out + (it.tr ? O_SSSM : O_PSSM) + sbase; const float* si = p.in[8] + sbase;
    V8 S0, S1; S0.a = (f32x4){0.f, 0.f, 0.f, 0.f}; S0.b = S0.a; S1 = S0;
    V8 Q0 = S0, Q1 = S0;
    if (it.tr) { const int r0 = (wv >> 2) * 32 + rp; Q0 = ld8(si + r0 * 128); Q1 = ld8(si + (r0 + 16) * 128); }
    float yk0 = 0.f, yk1 = 0.f;
    const int pj = wv & 3, n = lane & 15, fq = lane >> 4, c = pj * 16 + n;
    int ch[5]; ch[0] = it.h * 64 + c; ch[1] = 256 + grp * 128 + pj * 32 + n; ch[2] = ch[1] + 16; ch[3] = ch[1] + 256; ch[4] = ch[3] + 16;
    float cw[5][4], cb[5];
#pragma unroll
    for (int q = 0; q < 5; ++q) { cb[q] = p.in[38][(size_t)l * 768 + ch[q]];
#pragma unroll
        for (int i = 0; i < 4; ++i) cw[q][i] = p.in[37][((size_t)l * 4 + i) * 768 + ch[q]]; }
    const float nA = -__expf(p.in[40][l * 4 + it.h]), dtb = p.in[39][l * 4 + it.h], Dh = p.in[41][l * 4 + it.h];
    struct SsRaw { float xin[5][7]; } cur;
#define SS_LOAD(R, bb) do { _Pragma("unroll") for (int q = 0; q < 5; ++q) _Pragma("unroll") for (int i = 0; i < 7; ++i) { const int g = 16 * (bb) + fq * 4 - 3 + i; \
        R.xin[q][i] = g >= 0 ? ldu(UX, g, ch[q], T) : (cv0 ? cv0[(3 + g) * 768 + ch[q]] : 0.f); } } while (0)
    if (!scanner) SS_LOAD(cur, 0);
    for (int k = 0; k < NBAT + 2; ++k) {
        if (scanner || it.tr) {
            __builtin_amdgcn_s_setprio(3);
            const int b = k - 2;
            if (b >= 0 && b < NBAT) {
                const float* SL = sm + (b & 3) * SL_SIZE; const int ns = (T - 16 * b) < 16 ? (T - 16 * b) : 16;
                { const int hv = wv >> 2;
                if (it.tr) { irow = hv * 32 + rp; S0 = Q0; S1 = Q1; }
#define SS_STEP(tt, Bv, Cv, xa, xb, sc) do { float da, db; red16x2(dot8(S0, Cv), dot8(S1, Cv), lp0, da, db); const float ta = xa * sc[1], tb = xb * sc[1];        \
                    const float ya = sc[0] * da + ta * sc[2] + Dh * xa, yb = sc[0] * db + tb * sc[2] + Dh * xb; \
                    S0.a = S0.a * sc[0] + Bv.a * ta; S0.b = S0.b * sc[0] + Bv.b * ta; S1.a = S1.a * sc[0] + Bv.a * tb; S1.b = S1.b * sc[0] + Bv.b * tb; YKEEP2(tt, ya, yb); } while (0)
                for (int tt = 0; tt < ns; tt += 2) {
                    const float* V0 = SL + SL_VEC + tt * VST + sub * 8; const float* V1 = V0 + VST;
                    const V8 C0 = ld8(V0 + 128), B0 = ld8(V0); const float xa0 = SL[SL_VROW + tt * 64 + irow], xb0 = SL[SL_VROW + tt * 64 + irow + 16]; const f32x4 sc0 = *(const f32x4*)(SL + SL_SCAL + tt * 8);
                    const V8 C1 = ld8(V1 + 128), B1 = ld8(V1); const float xa1 = SL[SL_VROW + (tt + 1) * 64 + irow], xb1 = SL[SL_VROW + (tt + 1) * 64 + irow + 16]; const f32x4 sc1 = *(const f32x4*)(SL + SL_SCAL + (tt + 1) * 8);
                    SS_STEP(tt, B0, C0, xa0, xb0, sc0);
                    SS_STEP(tt + 1, B1, C1, xa1, xb1, sc1);
                }
#undef SS_STEP
                YSTORE2(b);
                if (it.tr) { float* o0 = so + irow * 128; float* o1 = so + (irow + 16) * 128; *(f32x4*)o0 = S0.a; *(f32x4*)(o0 + 4) = S0.b; *(f32x4*)o1 = S1.a; *(f32x4*)(o1 + 4) = S1.b; }
                }
            }
            __builtin_amdgcn_s_setprio(0);
        }
        if (!scanner) {
            if (k >= 1 && k - 1 < NBAT && lane < 4) { const int tt = pj * 4 + lane; float* SL = sm + ((k - 1) & 3) * SL_SIZE; const float* P = SL + SL_PART + tt * 16;
                const float bc = P[0] + P[4] + P[8] + P[12];
                int g = 16 * (k - 1) + tt; g = g < T ? g : T - 1;
                const float dt = softplusf_(bf2f(U[(size_t)g * UP + 1024 + it.h]) + dtb);
                *(f32x4*)(SL + SL_SCAL + tt * 8) = (f32x4){__expf(nA * dt), dt, bc, 0.f}; }
            if (k < NBAT) {
                float o[5][4];
#pragma unroll
                for (int q = 0; q < 5; ++q)
#pragma unroll
                    for (int i = 0; i < 4; ++i) o[q][i] = siluf_(cb[q] + cw[q][0] * cur.xin[q][i] + cw[q][1] * cur.xin[q][i + 1] + cw[q][2] * cur.xin[q][i + 2] + cw[q][3] * cur.xin[q][i + 3]);
                if (k + 1 < NBAT) SS_LOAD(cur, k + 1);
                float* SL = sm + (k & 3) * SL_SIZE;
#pragma unroll
                for (int i = 0; i < 4; ++i) { const int tt = fq * 4 + i;
                    float* V = SL + SL_VEC + tt * VST; V[pj * 32 + n] = o[1][i]; V[pj * 32 + 16 + n] = o[2][i]; V[128 + pj * 32 + n] = o[3][i]; V[128 + pj * 32 + 16 + n] = o[4][i]; SL[SL_VROW + tt * 64 + c] = o[0][i];
                    const float p0 = red16(o[1][i] * o[3][i] + o[2][i] * o[4][i]);
                    if (n == 0) SL[SL_PART + tt * 16 + pj * 4] = p0; }
            }
        }
        TICK_BAR();
    }
#undef SS_LOAD
    if (scanner) { if (!it.tr) { float* o0 = so + irow * 128; float* o1 = so + (irow + 16) * 128; *(f32x4*)o0 = S0.a; *(f32x4*)(o0 + 4) = S0.b; *(f32x4*)o1 = S1.a; *(f32x4*)(o1 + 4) = S1.b; } }
    else if (it.h == 0 && it.half == 0) { float* so = p.out + (it.tr ? O_SSSC : O_PSSC) + ((size_t)l * it.NB + it.b) * 3 * 768;
        for (int i = tid - 256; i < 3 * 768; i += 256) { const int rr = i / 768, cc = i % 768; so[i] = bf2f(UX[(size_t)(T - 3 + rr) * UP + cc]); } }
}

__device__ __forceinline__ void run_item(const KP& p, int l, int tr, int idx, float* sm) {
    Item it; it.tr = tr; const int mixer = idx & 3; int r = idx >> 2; if (tr) it.half = 0; else { it.half = r & 1; r >>= 1; } it.h = r & 3; it.b = r >> 2;
    it.T = tr ? TS : TP; it.NB = tr ? BS : BP; it.row0 = tr ? MP + it.b * TS : it.b * TP;
    if (mixer == 0) scan_rwkv(p, l, it, sm); else if (mixer == 1) scan_gla(p, l, it, sm); else if (mixer == 2) scan_dn(p, l, it, sm); else scan_ssd(p, l, it, sm);
    __syncthreads();
}
__device__ __forceinline__ void flag_signal(unsigned* cnt, unsigned n) {
    asm volatile("s_waitcnt vmcnt(0)" ::: "memory"); __syncthreads();
    if (threadIdx.x == 0 && n) { __builtin_amdgcn_fence(__ATOMIC_RELEASE, "agent"); asm volatile("s_waitcnt vmcnt(0)" ::: "memory"); __hip_atomic_fetch_add(cnt, n, __ATOMIC_RELAXED, __HIP_MEMORY_SCOPE_AGENT); }
}
__device__ __forceinline__ void flag_wait(unsigned* cnt, unsigned target) {
    if (threadIdx.x == 0) { unsigned sp = 0; while (__hip_atomic_load(cnt, __ATOMIC_RELAXED, __HIP_MEMORY_SCOPE_AGENT) < target) { __builtin_amdgcn_s_sleep(4); if (++sp > (1u << 22)) break; }
        __builtin_amdgcn_fence(__ATOMIC_ACQUIRE, "agent"); asm volatile("s_waitcnt vmcnt(0)" ::: "memory"); }
    __syncthreads();
}
__device__ __forceinline__ void phase_scan(const KP& p, int l, float* sm) {
    const int G = gridDim.x;
    constexpr int NPI = 4 * BP * 4 * 2, NSI = 4 * BS * 4;
    for (int i = blockIdx.x; i < NPI; i += G) run_item(p, l, 0, i, sm);
    unsigned* q = (unsigned*)(p.ws + WS_BAR) + 4096 + 64 * l;
    flag_wait((unsigned*)(p.ws + WS_BAR) + 4224 + 64 * l, 64u);
    volatile int* slot = (volatile int*)(sm + 4 * SL_SIZE);
    for (;;) {
        if (threadIdx.x == 0) *slot = (int)__hip_atomic_fetch_add(q, 2u, __ATOMIC_RELAXED, __HIP_MEMORY_SCOPE_AGENT);
        __syncthreads();
        const int i0 = *slot;
        __syncthreads();
        if (i0 >= NSI) break;
        run_item(p, l, 1, i0, sm);
        if (i0 + 1 < NSI) run_item(p, l, 1, i0 + 1, sm);
    }
}

__device__ __forceinline__ void ld4bf(const bf16* p, float (&o)[4]) { const uint2 v = *(const uint2*)p; o[0] = __builtin_bit_cast(float, v.x << 16); o[1] = __builtin_bit_cast(float, v.x & 0xffff0000u); o[2] = __builtin_bit_cast(float, v.y << 16); o[3] = __builtin_bit_cast(float, v.y & 0xffff0000u); }
__device__ __forceinline__ void st4bf(bf16* p, const float (&o)[4]) { uint2 v; v.x = pk2(o[0], o[1]); v.y = pk2(o[2], o[3]); *(uint2*)p = v; }
__device__ __forceinline__ void phase_post(const KP& p, int l, float* sm) {
    const int tid = otid(), lane = tid & 63, wv = tid >> 6; const int gw = blockIdx.x * NWAVES + wv, NGW = gridDim.x * NWAVES;
    const bf16* Ub = (const bf16*)(p.ws + WS_U); bf16* Yb = (bf16*)(p.ws + WS_H); const float* auxb = (const float*)(p.ws + WS_AUX);
    const float* mu = p.in[19] + l * 896;
    { const float* g2g = p.in[24] + (size_t)l * 64 * 256;
      for (int i = tid; i < 64 * 256 / 4; i += NTHR) *(f32x4*)(sm + 4 * i) = *(const f32x4*)(g2g + 4 * i);
      __syncthreads(); }
    const float* g2 = sm;
    const int c = lane * 4, hd = lane >> 4;
    const f32x4 lw = *(const f32x4*)(p.in[28] + l * 256 + c), lb = *(const f32x4*)(p.in[29] + l * 256 + c), muv = *(const f32x4*)(mu + 512 + c);
    const f32x4 wgl = *(const f32x4*)(p.in[32] + l * 256 + c), wdn = *(const f32x4*)(p.in[36] + l * 256 + c), wss = *(const f32x4*)(p.in[42] + l * 256 + c);
    const float mug = mu[832 + lane];
    struct PR { float y[4][4], uv[4], pv[4], gg[4], dz[4], sz[4], ug, pg, rkv; } cur, nxt;
#define POST_LOAD(R, row) do { int tr_, b_, t_; if ((row) < MP) { tr_ = 0; b_ = (row) >> 11; t_ = (row) & 2047; } else { tr_ = 1; b_ = ((row) - MP) >> 3; t_ = ((row) - MP) & 7; } \
        const bf16* u_ = Ub + (size_t)(row) * UP; const bf16* y_ = Yb + (size_t)(row) * DM; \
        _Pragma("unroll") for (int m = 0; m < 4; ++m) ld4bf(y_ + 256 * m + c, R.y[m]); \
        ld4bf(u_ + 512 + c, R.uv); ld4bf(u_ + CB + 768 + c, R.gg); ld4bf(u_ + CC + 768 + c, R.dz); ld4bf(u_ + CD + c, R.sz); R.ug = bf2f(u_[832 + lane]); R.rkv = auxb[(size_t)(row) * 4 + hd]; \
        if (t_ > 0) { ld4bf(u_ - UP + 512 + c, R.pv); R.pg = bf2f(u_[832 + lane - UP]); } \
        else if (tr_) { const float* sh0_ = p.in[2] + ((size_t)l * BS + b_) * 896; const f32x4 s_ = *(const f32x4*)(sh0_ + 512 + c); R.pv[0] = s_[0]; R.pv[1] = s_[1]; R.pv[2] = s_[2]; R.pv[3] = s_[3]; R.pg = sh0_[832 + lane]; } \
        else { R.pv[0] = R.pv[1] = R.pv[2] = R.pv[3] = 0.f; R.pg = 0.f; } } while (0)
    if (gw < MROWS) POST_LOAD(cur, gw);
    for (int row = gw; row < MROWS; row += NGW) {
        if (row + NGW < MROWS) POST_LOAD(nxt, row + NGW);
        bf16* y = Yb + (size_t)row * DM;
        { const float m = red16(cur.y[0][0] + cur.y[0][1] + cur.y[0][2] + cur.y[0][3]) * (1.f / 64.f);
          float d[4], vs = 0.f;
#pragma unroll
          for (int e = 0; e < 4; ++e) { d[e] = cur.y[0][e] - m; vs += d[e] * d[e]; }
          const float rs = rsqrtf(red16(vs) * (1.f / 64.f) + 64e-5f);
          const float sg = sigmoidf_(cur.ug + (cur.pg - cur.ug) * mug);
          f32x4 g = {0.f, 0.f, 0.f, 0.f};
#pragma unroll 8
          for (int j = 0; j < 64; ++j) { const float sj = __shfl(sg, j); g += *(const f32x4*)(g2 + j * 256 + c) * sj; }
          float o[4];
#pragma unroll
          for (int e = 0; e < 4; ++e) { const float v = cur.uv[e] + (cur.pv[e] - cur.uv[e]) * muv[e]; o[e] = (d[e] * rs * lw[e] + lb[e] + cur.rkv * v) * g[e]; }
          st4bf(y + c, o); }
        { const float* yv = cur.y[1];
          const float rs = rsqrtf(red16(yv[0] * yv[0] + yv[1] * yv[1] + yv[2] * yv[2] + yv[3] * yv[3]) * (1.f / 64.f) + 1e-6f); float o[4];
#pragma unroll
          for (int e = 0; e < 4; ++e) o[e] = yv[e] * rs * wgl[e] * siluf_(cur.gg[e]);
          st4bf(y + 256 + c, o); }
        { const float* yv = cur.y[2];
          const float rs = rsqrtf(red16(yv[0] * yv[0] + yv[1] * yv[1] + yv[2] * yv[2] + yv[3] * yv[3]) * (1.f / 64.f) + 1e-6f); float o[4];
#pragma unroll
          for (int e = 0; e < 4; ++e) o[e] = yv[e] * rs * wdn[e] * siluf_(cur.dz[e]);
          st4bf(y + 512 + c, o); }
        { float yv[4]; float ss = 0.f;
#pragma unroll
          for (int e = 0; e < 4; ++e) { yv[e] = cur.y[3][e] * siluf_(cur.sz[e]); ss += yv[e] * yv[e]; }
          ss = red16(ss); ss += __shfl_xor(ss, 16);
          const float rs = rsqrtf(ss * (1.f / 128.f) + 1e-6f); float o[4];
#pragma unroll
          for (int e = 0; e < 4; ++e) o[e] = yv[e] * rs * wss[e];
          st4bf(y + 768 + c, o); }
        cur = nxt;
    }
#undef POST_LOAD
}

#define XB_TMO      128
#define XB_XCNT(j)  (256  + 64 * (j))
#define XB_XSUB(j)  (1280 + 64 * (j))
#define XB_XGEN(j)  (2304 + 64 * (j))
#define XB_TOP      3328
#define XB_TOPGEN   3392
#define XCD_BAR_WORDS 3456
#define XB_SPIN_CAP (1u << 18)

__device__ __forceinline__ unsigned xb_ld(unsigned* p)              { return __hip_atomic_load(p, __ATOMIC_RELAXED, __HIP_MEMORY_SCOPE_AGENT); }
__device__ __forceinline__ unsigned xb_add(unsigned* p, unsigned v) { return __hip_atomic_fetch_add(p, v, __ATOMIC_RELAXED, __HIP_MEMORY_SCOPE_AGENT); }
__device__ __forceinline__ unsigned xb_xcc_id() { return (unsigned)__builtin_amdgcn_s_getreg((3 << 11) | 20) & 0xFu; }
#define XB_SPIN(cond, bar) do { unsigned _sp = 0; while (cond) { __builtin_amdgcn_s_sleep(1); \
    if ((++_sp & 255u) == 0u) { if (xb_ld(&(bar)[XB_TMO])) break; if (_sp > XB_SPIN_CAP) { atomicAdd(&(bar)[XB_TMO], 1u); break; } } } } while (0)

struct XcdBarrier {
    unsigned* bar; unsigned x;
    volatile LAS unsigned* st;
};

__device__ __forceinline__ XcdBarrier xcd_barrier_post(unsigned* bar, volatile LAS unsigned* st) {
    XcdBarrier b; b.bar = bar; b.x = xb_xcc_id(); b.st = st;
    if (threadIdx.x == 0) (void)xb_add(&bar[XB_XCNT(b.x)], 1u);
    return b;
}
__device__ __forceinline__ void xcd_barrier_complete(unsigned* bar, unsigned x, unsigned& nloc, unsigned& nx) {
    const unsigned G = gridDim.x * gridDim.y * gridDim.z;
    unsigned sum, cnt, mine, sp = 0u;
    for (;;) {
        sum = 0u; cnt = 0u; mine = 0u;
#pragma unroll
        for (unsigned j = 0; j < 16; ++j) { const unsigned c = xb_ld(&bar[XB_XCNT(j)]); sum += c; cnt += (c > 0u) ? 1u : 0u; mine = (j == x) ? c : mine; }
        if (sum == G) break;
        __builtin_amdgcn_s_sleep(1);
        if ((++sp & 255u) == 0u) { if (xb_ld(&bar[XB_TMO])) break; if (sp > XB_SPIN_CAP) { atomicAdd(&bar[XB_TMO], 1u); break; } }
    }
    nloc = mine > 0u ? mine : 1u; nx = cnt > 0u ? cnt : 1u;
}

__device__ __forceinline__ void xcd_barrier(const XcdBarrier& b) {
    asm volatile("s_waitcnt vmcnt(0)" ::: "memory");
    __syncthreads();
    if (threadIdx.x == 0) {
        unsigned* bar = b.bar;
        __builtin_amdgcn_s_waitcnt(0);
        unsigned nloc = b.st[0], nx = b.st[1];
        if (nloc == 0u) { xcd_barrier_complete(bar, b.x, nloc, nx); b.st[0] = nloc; b.st[1] = nx; }
        const unsigned old = xb_add(&bar[XB_XSUB(b.x)], 1u);
        const unsigned gen = old / nloc;
        if (old + 1u == (gen + 1u) * nloc) {
            __builtin_amdgcn_fence(__ATOMIC_RELEASE, "agent");
            asm volatile("s_waitcnt vmcnt(0)" ::: "memory");
            const unsigned og = xb_add(&bar[XB_TOP], 1u);
            const unsigned tg = og / nx;
            if (og + 1u == (tg + 1u) * nx) xb_add(&bar[XB_TOPGEN], 1u);
            else XB_SPIN(xb_ld(&bar[XB_TOPGEN]) == tg, bar);
            __builtin_amdgcn_fence(__ATOMIC_ACQUIRE, "agent");
            xb_add(&bar[XB_XGEN(b.x)], 1u);
            asm volatile("s_waitcnt vmcnt(0)" ::: "memory");
        } else {
            XB_SPIN(xb_ld(&bar[XB_XGEN(b.x)]) == gen, bar);
            __builtin_amdgcn_fence(__ATOMIC_ACQUIRE, "agent");
            asm volatile("s_waitcnt vmcnt(0)" ::: "memory");
        }
    }
    __syncthreads();
}

__device__ __forceinline__ const void* uni(const void* q) { const unsigned long long v = (unsigned long long)q; const unsigned lo = __builtin_amdgcn_readfirstlane((unsigned)v), hi = __builtin_amdgcn_readfirstlane((unsigned)(v >> 32)); return (const void*)(const GASP char*)(((unsigned long long)hi << 32) | lo); }
__global__ void __launch_bounds__(NTHR, 2) hybrid_fwd(KP kp) {
    extern __shared__ __attribute__((aligned(16))) unsigned char lds[];
    cg::grid_group grid = cg::this_grid();
    KP* lp = (KP*)(lds + 131072);
    if (threadIdx.x == 0) *lp = kp;
    volatile LAS unsigned* xst = (volatile LAS unsigned*)(lds + 131072 + 512);
    if (threadIdx.x < 2) xst[threadIdx.x] = 0u;
    if (blockIdx.x == 0) for (int i = threadIdx.x; i < 4096 + 512; i += NTHR) ((unsigned*)(kp.ws + WS_BAR))[i] = 0u;
    __syncthreads();
    const KP& p = *lp;
    float* sm = (float*)lds;
#define WSB ((unsigned char*)uni(p.ws))
#define OUTB ((float*)uni(p.out))
#define INP(i) ((const float*)uni(p.in[i]))
    phase_p0(p, sm);
    grid.sync();
    const XcdBarrier xbar = xcd_barrier_post((unsigned*)(WSB + WS_BAR), xst);
    for (int l = 0; l < 2; ++l) {
        { const float* modl = (const float*)(WSB + WS_MOD) + (size_t)l * 136 * 6144;
          const float* xP = l == 0 ? INP(0) : nullptr; const float* xS = l == 0 ? INP(1) : nullptr;
          phase_norm(p, xP, xS, INP(13) + l * DM, modl, 0, 1024, l == 0 ? -1 : 5120 - 136 * 6144); }
        xcd_barrier(xbar);
        { unsigned char* ws = WSB; pg8::Gemm g{(const bf16*)(ws + WS_H), (const bf16*)(ws + WS_WTIN) + (size_t)l * UP * DM, MP, UP, DM, DM}; pg8::StaticOrder S; S.init(MP, UP, 1, (int)gridDim.x, (int)blockIdx.x);
          pg8::EpiBf16<0> E{(bf16*)(ws + WS_U), UP}; pg8::gemm_phase<pg8::EpiBf16<0>, pg8::StaticOrder, true, true>((PG8_LAS unsigned char*)lds, g, S, E); }
        xcd_barrier(xbar);
        { unsigned char* ws = WSB; const int G = (int)gridDim.x, bx = (int)blockIdx.x;
          pg8::Gemm g{(const bf16*)(ws + WS_H), (const bf16*)(ws + WS_WTIN) + (size_t)l * UP * DM, MROWS, UP, DM, DM};
          pg8::SampleTilesOrder S{(G + 2) / 4, (bx & 3) == 1 ? (bx >> 2) : -1, 16}; pg8::EpiBf16<0> E{(bf16*)(ws + WS_U), UP};
          const unsigned nd = (S.cs >= 0 && S.cs < 64) ? (unsigned)((64 - S.cs + S.Gs - 1) / S.Gs) : 0u;
          if (nd) pg8::gemm_phase<pg8::EpiBf16<0>, pg8::SampleTilesOrder, false, true>((PG8_LAS unsigned char*)lds, g, S, E);
          flag_signal((unsigned*)(ws + WS_BAR) + 4224 + 64 * l, nd); }
        phase_scan(p, l, sm);
        xcd_barrier(xbar);
        phase_post(p, l, sm);
        xcd_barrier(xbar);
        { unsigned char* ws = WSB; const float* modl = (const float*)(ws + WS_MOD) + (size_t)l * 136 * 6144;
          pg8::Gemm g{(const bf16*)(ws + WS_H), (const bf16*)(ws + WS_WTOUT) + (size_t)l * DM * DM, MP, DM, DM, DM}; pg8::StaticOrder S; S.init(MP, DM, 1, (int)gridDim.x, (int)blockIdx.x);
          if (l == 0) { pg8::EpiRes<true> E{INP(0), (bf16*)(ws + WS_X16), modl + 2048}; pg8::gemm_phase<pg8::EpiRes<true>, pg8::StaticOrder, true, true>((PG8_LAS unsigned char*)lds, g, S, E); }
          else { pg8::EpiRes<false> E{nullptr, (bf16*)(ws + WS_X16), modl + 2048}; pg8::gemm_phase<pg8::EpiRes<false>, pg8::StaticOrder, true, true>((PG8_LAS unsigned char*)lds, g, S, E); }
          pg8::Gemm g2{(const bf16*)(ws + WS_H), (const bf16*)(ws + WS_WTOUT) + (size_t)l * DM * DM, MROWS, DM, DM / 4, DM}; pg8::SampleSplitOrder S2{(int)gridDim.x, (int)blockIdx.x};
          pg8::EpiPart E2{(float*)(ws + WS_PART)}; pg8::gemm_phase<pg8::EpiPart, pg8::SampleSplitOrder, false, true>((PG8_LAS unsigned char*)lds, g2, S2, E2); }
        xcd_barrier(xbar);
        { const float* modl = (const float*)(WSB + WS_MOD) + (size_t)l * 136 * 6144;
          phase_norm(p, nullptr, l == 0 ? INP(1) : nullptr, INP(14) + l * DM, modl, 3072, 4096, 2048); }
        xcd_barrier(xbar);
        { unsigned char* ws = WSB; pg8::Gemm g{(const bf16*)(ws + WS_H), (const bf16*)(ws + WS_WTUP) + (size_t)l * DFF * DM, MP, DFF, DM, DM}; pg8::StaticOrder S; S.init(MP, DFF, 1, (int)gridDim.x, (int)blockIdx.x);
          pg8::EpiBf16<2> E{(bf16*)(ws + WS_U), DFF}; pg8::gemm_phase<pg8::EpiBf16<2>, pg8::StaticOrder, true, true>((PG8_LAS unsigned char*)lds, g, S, E); }
        xcd_barrier(xbar);
        { unsigned char* ws = WSB; const int G = (int)gridDim.x, bx = (int)blockIdx.x;
          pg8::Gemm g{(const bf16*)(ws + WS_H), (const bf16*)(ws + WS_WTUP) + (size_t)l * DFF * DM, MROWS, DFF, DM, DM};
          const int Gs = G < 64 ? G : 64; pg8::SampleTilesOrder S{Gs, bx >= G - Gs ? bx - (G - Gs) : -1, 16}; pg8::EpiBf16<2> E{(bf16*)(ws + WS_U), DFF};
          const unsigned nd = (S.cs >= 0 && S.cs < 64) ? (unsigned)((64 - S.cs + S.Gs - 1) / S.Gs) : 0u;
          if (nd) pg8::gemm_phase<pg8::EpiBf16<2>, pg8::SampleTilesOrder, false, true>((PG8_LAS unsigned char*)lds, g, S, E);
          flag_signal((unsigned*)(ws + WS_BAR) + 4352 + 64 * l, nd); }
        { unsigned char* ws = WSB; const float* modl = (const float*)(ws + WS_MOD) + (size_t)l * 136 * 6144;
          pg8::Gemm g{(const bf16*)(ws + WS_U), (const bf16*)(ws + WS_WTDN) + (size_t)l * DM * DFF, MP, DM, DFF, DFF}; pg8::StaticOrder S; S.init(MP, DM, 1, (int)gridDim.x, (int)blockIdx.x);
          pg8::EpiRes<false> E{nullptr, (bf16*)(ws + WS_X16), modl + 5120}; pg8::gemm_phase<pg8::EpiRes<false>, pg8::StaticOrder, true, true>((PG8_LAS unsigned char*)lds, g, S, E);
          if ((int)blockIdx.x < 64) flag_wait((unsigned*)(ws + WS_BAR) + 4352 + 64 * l, 64u);
          pg8::Gemm g2{(const bf16*)(ws + WS_U), (const bf16*)(ws + WS_WTDN) + (size_t)l * DM * DFF, MROWS, DM, DFF / 4, DFF}; pg8::SampleSplitOrder S2{(int)gridDim.x, (int)blockIdx.x};
          pg8::EpiPart E2{(float*)(ws + WS_PART)}; pg8::gemm_phase<pg8::EpiPart, pg8::SampleSplitOrder, false, true>((PG8_LAS unsigned char*)lds, g2, S2, E2); }
        xcd_barrier(xbar);
    }
    phase_final(p);
}

extern "C" void kernel_launch(void* const* d_in, const int* in_sizes, int n_in, void* d_out, int out_size, void* d_ws, size_t ws_size, hipStream_t stream) {
    static int grid = 0;
    if (grid == 0) {
        if (n_in != 44 || (size_t)out_size != O_TOTAL || ws_size < WS_END) { fprintf(stderr, "kernel_launch: unexpected shapes: n_in %d out %d ws %zu\n", n_in, out_size, ws_size); grid = -1; return; }
        int dev = 0, cus = 0, per_cu = 0;
        hipGetDevice(&dev); hipDeviceGetAttribute(&cus, hipDeviceAttributeMultiprocessorCount, dev);
        if (hipFuncSetAttribute((const void*)hybrid_fwd, hipFuncAttributeMaxDynamicSharedMemorySize, LDS_BYTES) != hipSuccess) { fprintf(stderr, "kernel_launch: hipFuncSetAttribute failed\n"); grid = -1; return; }
        if (hipOccupancyMaxActiveBlocksPerMultiprocessor(&per_cu, (const void*)hybrid_fwd, NTHR, LDS_BYTES) != hipSuccess || per_cu < 1) { fprintf(stderr, "kernel_launch: occupancy query failed (%d)\n", per_cu); grid = -1; return; }
        grid = cus * per_cu;
    }
    if (grid < 0) return;
    KP p{};
    for (int i = 0; i < 44; ++i) p.in.v[i] = (const float*)d_in[i];
    p.out.v = (float*)d_out; p.ws.v = (unsigned char*)d_ws;
    void* args[] = {&p};
    hipError_t e = hipLaunchCooperativeKernel((const void*)hybrid_fwd, dim3(grid), dim3(NTHR), args, LDS_BYTES, stream);
    if (e != hipSuccess) fprintf(stderr, "kernel_launch: cooperative launch failed: %s (grid %d)\n", hipGetErrorString(e), grid);
}
```

```cpp
#include <hip/hip_runtime.h>
#include <hip/hip_cooperative_groups.h>
#include <cstdio>
#include <cstdint>
namespace cg = cooperative_groups;

namespace pg8 {
#define PG8_LAS __attribute__((address_space(3)))
typedef unsigned short bf16_t;
typedef short bf16x8 __attribute__((ext_vector_type(8)));
typedef float f32x4 __attribute__((ext_vector_type(4)));
typedef unsigned u32x4 __attribute__((ext_vector_type(4)));
constexpr int BM = 256, BK = 64, HALF = 128, HTB = HALF * BK * 2, STAGE_BYTES = 8 * HTB, NXCD = 8, WGM = 8;

__host__ __device__ __forceinline__ int lds_byte(int r, int c) { const int st = (r >> 4) * 2 + (c >> 5), rr = r & 15, cc = c & 31, ob = rr * 64 + cc * 2; return st * 1024 + (ob ^ (((ob >> 9) & 1) << 5)); }
__host__ __device__ __forceinline__ void stage_rc(int b, int& R, int& C) { const int st = b / 1024, sb = b % 1024, swz = sb ^ (((sb >> 9) & 1) << 5); R = (st >> 1) * 16 + swz / 64; C = (st & 1) * 32 + (swz % 64) / 2; }
__host__ __device__ __forceinline__ int perm32(int rho) { const int n = rho >> 4, i = rho & 15; return 8 * (i >> 2) + 4 * n + (i & 3); }

struct Unit { int pm, pn, pk; };
struct Gemm { const bf16_t* A; const bf16_t* Bt; int M, N, K, ld; };

struct StaticOrder {
    int nM, nN, nK, ntile, nwg, G, c;
    __host__ __device__ void init(int M, int N, int nK_, int G_, int c_) { nM = M / BM; nN = N / BM; nK = nK_; ntile = nM * nN; nwg = ntile * nK; G = G_; c = c_; }
    __host__ __device__ bool next(int i, Unit& u) const {
        const long L = (long)i * G + c; if (L >= nwg) return false;
        int wgid = (int)L; { const int q = nwg / NXCD, r = nwg % NXCD, xcd = wgid % NXCD, off = wgid / NXCD; wgid = (xcd < r ? xcd * (q + 1) : r * (q + 1) + (xcd - r) * q) + off; }
        u.pk = wgid / ntile; wgid -= u.pk * ntile;
        const int nig = WGM * nN, gid = wgid / nig, fm = gid * WGM, gsz = (nM - fm) < WGM ? (nM - fm) : WGM;
        u.pm = fm + ((wgid % nig) % gsz); u.pn = (wgid % nig) / gsz; return true;
    }
    __device__ __forceinline__ void a_ready(const Unit&) const {}
    __device__ __forceinline__ void done(const Unit&) const {}
};
__device__ __forceinline__ unsigned cvt_pk_bf16(float lo, float hi) { unsigned r; asm volatile("v_cvt_pk_bf16_f32 %0, %1, %2" : "=v"(r) : "v"(lo), "v"(hi)); return r; }

template <int ACT  > struct EpiBf16 {
    static constexpr bool PERM = true, AFTER_DRAIN = false;
    bf16_t* O; int ldc;
    __device__ __forceinline__ void operator()(const f32x4 (&acc)[2][2][4][2], const Unit& u, int wr, int wc, int fr, int fq) const {
        const int row0 = u.pm * BM + wr * 64 + fr, col0 = u.pn * BM + wc * 32 + 8 * fq;
#pragma unroll
        for (int ai = 0; ai < 2; ++ai)
#pragma unroll
            for (int m = 0; m < 4; ++m) { bf16_t* rowp = O + (size_t)(row0 + ai * HALF + m * 16) * ldc + col0;
#pragma unroll
                for (int bj = 0; bj < 2; ++bj) { f32x4 v0 = acc[ai][bj][m][0], v1 = acc[ai][bj][m][1];
                    if (ACT == 2) {
#pragma unroll
                        for (int j = 0; j < 4; ++j) { float a = fmaxf(v0[j], 0.f), b = fmaxf(v1[j], 0.f); v0[j] = a * a; v1[j] = b * b; } }
                    u32x4 w; w.x = cvt_pk_bf16(v0[0], v0[1]); w.y = cvt_pk_bf16(v0[2], v0[3]); w.z = cvt_pk_bf16(v1[0], v1[1]); w.w = cvt_pk_bf16(v1[2], v1[3]);
                    *(u32x4*)(rowp + bj * HALF) = w; } }
    }
};
template <bool SRCF32> struct EpiRes {
    static constexpr bool PERM = true, AFTER_DRAIN = false;
    const float* srcF; bf16_t* X; const float* gate;
    __device__ __forceinline__ void operator()(const f32x4 (&acc)[2][2][4][2], const Unit& u, int wr, int wc, int fr, int fq) const {
        const int row0 = u.pm * BM + wr * 64 + fr, col0 = u.pn * BM + wc * 32 + 8 * fq;
#pragma unroll
        for (int ai = 0; ai < 2; ++ai)
#pragma unroll
            for (int m = 0; m < 4; ++m) { const int row = row0 + ai * HALF + m * 16;
                const int cond = row < 16384 ? (row >> 11) : 8 + ((row - 16384) >> 3);
                const float* g = gate + (size_t)cond * 6144; bf16_t* d = X + (size_t)row * 1024;
#pragma unroll
                for (int bj = 0; bj < 2; ++bj) { const int c = col0 + bj * HALF; const f32x4 g0 = *(const f32x4*)(g + c), g1 = *(const f32x4*)(g + c + 4);
                    f32x4 x0, x1;
                    if (SRCF32) { const float* s = srcF + (size_t)row * 1024 + c; x0 = *(const f32x4*)s; x1 = *(const f32x4*)(s + 4); }
                    else { const u32x4 w = *(const u32x4*)(d + c);
                        x0 = (f32x4){__builtin_bit_cast(float, w.x << 16), __builtin_bit_cast(float, w.x & 0xffff0000u), __builtin_bit_cast(float, w.y << 16), __builtin_bit_cast(float, w.y & 0xffff0000u)};
                        x1 = (f32x4){__builtin_bit_cast(float, w.z << 16), __builtin_bit_cast(float, w.z & 0xffff0000u), __builtin_bit_cast(float, w.w << 16), __builtin_bit_cast(float, w.w & 0xffff0000u)}; }
                    x0 += g0 * acc[ai][bj][m][0]; x1 += g1 * acc[ai][bj][m][1];
                    u32x4 o; o.x = cvt_pk_bf16(x0[0], x0[1]); o.y = cvt_pk_bf16(x0[2], x0[3]); o.z = cvt_pk_bf16(x1[0], x1[1]); o.w = cvt_pk_bf16(x1[2], x1[3]);
                    *(u32x4*)(d + c) = o; } }
    }
};

struct SampleSplitOrder {
    int G, c;
    __device__ bool next(int i, Unit& u) const { const int L = i * G + c; if (L >= 64) return false; u.pk = L & 3; const int t = L >> 2; u.pm = 64 + (t >> 2); u.pn = t & 3; return true; }
    __device__ __forceinline__ void a_ready(const Unit&) const {}
    __device__ __forceinline__ void done(const Unit&) const {}
};
struct EpiPart {
    static constexpr bool PERM = true, AFTER_DRAIN = false;
    float* P;
    __device__ __forceinline__ void operator()(const f32x4 (&acc)[2][2][4][2], const Unit& u, int wr, int wc, int fr, int fq) const {
        const int row0 = (u.pm - 64) * BM + wr * 64 + fr, col0 = u.pn * BM + wc * 32 + 8 * fq;
#pragma unroll
        for (int ai = 0; ai < 2; ++ai)
#pragma unroll
            for (int m = 0; m < 4; ++m) { float* d = P + ((size_t)u.pk * 1024 + row0 + ai * HALF + m * 16) * 1024 + col0;
#pragma unroll
                for (int bj = 0; bj < 2; ++bj) { *(f32x4*)(d + bj * HALF) = acc[ai][bj][m][0]; *(f32x4*)(d + bj * HALF + 4) = acc[ai][bj][m][1]; } }
    }
};

struct SampleTilesOrder {
    int Gs, cs, nN;
    __device__ bool next(int i, Unit& u) const { if (cs < 0) return false; const int L = i * Gs + cs; if (L >= 4 * nN) return false; u.pk = 0; u.pm = 64 + L / nN; u.pn = L % nN; return true; }
    __device__ __forceinline__ void a_ready(const Unit&) const {}
    __device__ __forceinline__ void done(const Unit&) const {}
};

template <class Epi, class Sched, bool ALIGN_EPI = false, bool SP2 = false>
__device__ __forceinline__ void gemm_phase(PG8_LAS unsigned char* lds, const Gemm g, const Sched& S, const Epi& E) {
    int tid_ = threadIdx.x; asm volatile("" : "+v"(tid_));
    const int tid = tid_, wid = __builtin_amdgcn_readfirstlane(tid >> 6), lane = tid & 63, wr = wid >> 2, wc = wid & 3, fr = lane & 15, fq = lane >> 4;
    const int K = g.ld, nt = g.K / BK; const size_t kspl = (size_t)g.K * 2;
    unsigned voffA[2], voffB[2];
#pragma unroll
    for (int i = 0; i < 2; ++i) { int R, C; stage_rc(tid * 16 + i * 8192, R, C); const int Rb = Epi::PERM ? ((R & ~31) + perm32(R & 31)) : R;
        voffA[i] = (unsigned)(R * K + C) * 2u; voffB[i] = (unsigned)(Rb * K + C) * 2u; }
    const size_t kstep = (size_t)(BK * 2);
    const size_t hstep = (size_t)HALF * K * 2;
    const size_t tstep = 2 * hstep;
    const unsigned ldsw = (unsigned)wid * 1024u;
    const int aoff = lds_byte(wr * 64 + fr, fq * 8), boff = lds_byte(wc * 32 + fr, fq * 8);
#define PG8_SA(b, h) (((b) * 2 + (h)) * HTB)
#define PG8_SB(b, h) ((4 + (b) * 2 + (h)) * HTB)
#define PG8_STAGE(bufoff, gbase, voff) do { _Pragma("unroll") for (int _i = 0; _i < 2; ++_i) \
        __builtin_amdgcn_global_load_lds((const unsigned*)((const char*)(gbase) + (voff)[_i]), (PG8_LAS unsigned*)(lds + (bufoff) + ldsw + _i * 8192), 16, 0, 0); } while (0)
#define PG8_LDA(dst, b, h) do { _Pragma("unroll") for (int m = 0; m < 4; ++m) _Pragma("unroll") for (int k = 0; k < 2; ++k) dst[m][k] = *(const PG8_LAS bf16x8*)(lds + PG8_SA(b, h) + aoff + m * 2048 + k * 1024); } while (0)
#define PG8_LDB(dst, b, h) do { _Pragma("unroll") for (int n = 0; n < 2; ++n) _Pragma("unroll") for (int k = 0; k < 2; ++k) dst[n][k] = *(const PG8_LAS bf16x8*)(lds + PG8_SB(b, h) + boff + n * 2048 + k * 1024); } while (0)
#define PG8_MMA(ai, bj, At, Bt) do { __builtin_amdgcn_s_setprio(1); _Pragma("unroll") for (int m = 0; m < 4; ++m) _Pragma("unroll") for (int n = 0; n < 2; ++n) _Pragma("unroll") for (int k = 0; k < 2; ++k) \
        acc[ai][bj][m][n] = __builtin_amdgcn_mfma_f32_16x16x32_bf16(Bt[n][k], At[m][k], acc[ai][bj][m][n], 0, 0, 0); __builtin_amdgcn_s_setprio(0); } while (0)
#define PG8_WAIT_V(n) asm volatile("s_waitcnt vmcnt(" #n ")" ::: "memory")
#define PG8_WAIT_L(n) asm volatile("s_waitcnt lgkmcnt(" #n ")" ::: "memory")
#define PG8_BAR __builtin_amdgcn_s_barrier()
#define PG8_SCHED __builtin_amdgcn_sched_barrier(0)
    Unit cur, nxt; int ui = 0;
    if (!S.next(0, cur)) return;
    f32x4 acc[2][2][4][2];
#pragma unroll
    for (int a = 0; a < 2; ++a)
#pragma unroll
        for (int b = 0; b < 2; ++b)
#pragma unroll
            for (int m = 0; m < 4; ++m)
#pragma unroll
                for (int n = 0; n < 2; ++n) acc[a][b][m][n] = (f32x4){0.f, 0.f, 0.f, 0.f};
    bf16x8 At[4][2], B0[2][2], B1[2][2];
    const char* cA = (const char*)g.A + (size_t)cur.pm * tstep + (size_t)cur.pk * kspl; const char* cB = (const char*)g.Bt + (size_t)cur.pn * tstep + (size_t)cur.pk * kspl;
    S.a_ready(cur);
    if constexpr (SP2) {
        PG8_STAGE(PG8_SB(0, 0), cB, voffB); PG8_STAGE(PG8_SB(0, 1), cB + hstep, voffB); PG8_STAGE(PG8_SA(0, 0), cA, voffA); PG8_STAGE(PG8_SA(0, 1), cA + hstep, voffA);
        if (wr == 1) PG8_BAR;
        PG8_WAIT_V(2); PG8_BAR;
        PG8_STAGE(PG8_SB(1, 0), cB + kstep, voffB); PG8_STAGE(PG8_SA(1, 0), cA + kstep, voffA); PG8_STAGE(PG8_SB(1, 1), cB + hstep + kstep, voffB);
        PG8_WAIT_V(6); PG8_BAR;
    } else {
        PG8_STAGE(PG8_SB(0, 0), cB, voffB); PG8_STAGE(PG8_SA(0, 0), cA, voffA); PG8_STAGE(PG8_SB(0, 1), cB + hstep, voffB); PG8_STAGE(PG8_SA(0, 1), cA + hstep, voffA);
        if (wr == 1) PG8_BAR;
        PG8_WAIT_V(4); PG8_BAR;
        PG8_STAGE(PG8_SB(1, 0), cB + kstep, voffB); PG8_STAGE(PG8_SA(1, 0), cA + kstep, voffA); PG8_STAGE(PG8_SB(1, 1), cB + hstep + kstep, voffB);
        PG8_WAIT_V(6); PG8_BAR;
    }
    for (;;) {
        const bool has_next = S.next(ui + 1, nxt);
        const char* nA = has_next ? (const char*)g.A + (size_t)nxt.pm * tstep + (size_t)nxt.pk * kspl : cA; const char* nB = has_next ? (const char*)g.Bt + (size_t)nxt.pn * tstep + (size_t)nxt.pk * kspl : cB;
        for (int t = 0; t < nt; t += 2) {
            const bool last = (t == nt - 2);
            const char* a1 = cA + (size_t)(t + 1) * kstep;
            const char* a2 = last ? nA : cA + (size_t)(t + 2) * kstep; const char* b2 = last ? nB : cB + (size_t)(t + 2) * kstep;
            const char* a3 = a2 + kstep; const char* b3 = b2 + kstep;
            if (last && has_next) S.a_ready(nxt);
            if constexpr (SP2) {
            PG8_LDB(B0, 0, 0); PG8_LDB(B1, 0, 1); PG8_SCHED; PG8_LDA(At, 0, 0); PG8_STAGE(PG8_SA(1, 1), a1 + hstep, voffA);
            PG8_WAIT_V(8); PG8_WAIT_L(0); PG8_BAR; PG8_MMA(0, 0, At, B0); PG8_MMA(0, 1, At, B1); PG8_BAR; PG8_SCHED;
            PG8_LDA(At, 0, 1); PG8_STAGE(PG8_SB(0, 0), b2, voffB); PG8_STAGE(PG8_SB(0, 1), b2 + hstep, voffB); PG8_STAGE(PG8_SA(0, 0), a2, voffA);
            PG8_WAIT_V(8); PG8_WAIT_L(0); PG8_BAR; PG8_MMA(1, 0, At, B0); PG8_MMA(1, 1, At, B1); PG8_BAR; PG8_SCHED;
            PG8_LDB(B0, 1, 0); PG8_LDB(B1, 1, 1); PG8_SCHED; PG8_LDA(At, 1, 0); PG8_STAGE(PG8_SA(0, 1), a2 + hstep, voffA);
            PG8_WAIT_V(8); PG8_WAIT_L(0); PG8_BAR; PG8_MMA(0, 0, At, B0); PG8_MMA(0, 1, At, B1); PG8_BAR; PG8_SCHED;
            PG8_LDA(At, 1, 1); PG8_STAGE(PG8_SB(1, 0), b3, voffB); PG8_STAGE(PG8_SB(1, 1), b3 + hstep, voffB); PG8_STAGE(PG8_SA(1, 0), a3, voffA);
            PG8_WAIT_V(8); PG8_WAIT_L(0); PG8_BAR; PG8_MMA(1, 0, At, B0); PG8_MMA(1, 1, At, B1); PG8_BAR; PG8_SCHED;
            } else {
            PG8_LDB(B0, 0, 0); PG8_SCHED; PG8_LDA(At, 0, 0); PG8_STAGE(PG8_SA(1, 1), a1 + hstep, voffA);
            PG8_WAIT_L(8); PG8_BAR; PG8_WAIT_L(0); PG8_MMA(0, 0, At, B0); PG8_BAR; PG8_SCHED;
            PG8_LDB(B1, 0, 1); PG8_STAGE(PG8_SB(0, 0), b2, voffB);
            PG8_BAR; PG8_WAIT_L(0); PG8_MMA(0, 1, At, B1); PG8_BAR;
            PG8_LDA(At, 0, 1); PG8_STAGE(PG8_SA(0, 0), a2, voffA);
            PG8_BAR; PG8_WAIT_L(0); PG8_MMA(1, 0, At, B0); PG8_BAR; PG8_SCHED;
            PG8_STAGE(PG8_SB(0, 1), b2 + hstep, voffB);
            PG8_WAIT_V(6); PG8_BAR; PG8_MMA(1, 1, At, B1); PG8_BAR;
            PG8_LDB(B0, 1, 0); PG8_SCHED; PG8_LDA(At, 1, 0); PG8_STAGE(PG8_SA(0, 1), a2 + hstep, voffA);
            PG8_WAIT_L(8); PG8_BAR; PG8_WAIT_L(0); PG8_MMA(0, 0, At, B0); PG8_BAR; PG8_SCHED;
            PG8_LDB(B1, 1, 1); PG8_STAGE(PG8_SB(1, 0), b3, voffB);
            PG8_BAR; PG8_WAIT_L(0); PG8_MMA(0, 1, At, B1); PG8_BAR;
            PG8_LDA(At, 1, 1); PG8_STAGE(PG8_SA(1, 0), a3, voffA);
            PG8_BAR; PG8_WAIT_L(0); PG8_MMA(1, 0, At, B0); PG8_BAR; PG8_SCHED;
            PG8_STAGE(PG8_SB(1, 1), b3 + hstep, voffB);
            PG8_WAIT_V(6); PG8_BAR; PG8_MMA(1, 1, At, B1); PG8_BAR;
            }
        }
        if constexpr (ALIGN_EPI) { if (wr == 0) PG8_BAR; }
        if constexpr (!Epi::AFTER_DRAIN) { E(acc, cur, wr, wc, fr, fq); S.done(cur); }
        if (!has_next) break;
#pragma unroll
        for (int a = 0; a < 2; ++a)
#pragma unroll
            for (int b = 0; b < 2; ++b)
#pragma unroll
                for (int m = 0; m < 4; ++m)
#pragma unroll
                    for (int n = 0; n < 2; ++n) acc[a][b][m][n] = (f32x4){0.f, 0.f, 0.f, 0.f};
        cur = nxt; cA = nA; cB = nB; ++ui;
        if constexpr (ALIGN_EPI) { if (wr == 1) PG8_BAR; }
    }
    PG8_WAIT_V(0);
    if constexpr (!ALIGN_EPI) { if (wr == 0) PG8_BAR; }
    PG8_BAR;
    if constexpr (Epi::AFTER_DRAIN) { E.fused(acc, cur, wr, wc, fr, fq, lds, wid, lane); S.done(cur); }
#undef PG8_SA
#undef PG8_SB
#undef PG8_STAGE
#undef PG8_LDA
#undef PG8_LDB
#undef PG8_MMA
#undef PG8_WAIT_V
#undef PG8_WAIT_L
#undef PG8_BAR
#undef PG8_SCHED
}
}

typedef unsigned short bf16;
#define LAS __attribute__((address_space(3)))
typedef float f32x4 __attribute__((ext_vector_type(4)));
constexpr int DM = 1024, TP = 2048, BP = 8, BS = 128, TS = 8, MP = BP * TP, MS = BS * TS, MROWS = MP + MS, UP = 4096, PT = 3996, DFF = 4096;
constexpr int CA = 0, CB = 896, CC = 1936, CD = 2968;
constexpr int NTHR = 512, NWAVES = 8;
constexpr int LDS_BYTES = 135168;
constexpr size_t MiB = 1u << 20;
constexpr size_t WS_BAR = 59 * MiB + 512 * 1024;
constexpr size_t WS_WTIN = 0, WS_WTOUT = 16 * MiB, WS_WTUP = 20 * MiB, WS_WTDN = 36 * MiB, WS_MOD = 52 * MiB, WS_AUX = 59 * MiB, WS_H = 60 * MiB, WS_U = 94 * MiB, WS_PART = 230 * MiB, WS_X16 = 246 * MiB, WS_END = 280 * MiB;
static_assert(WS_MOD + (size_t)2 * 136 * 6144 * 4 <= WS_AUX && WS_AUX + (size_t)MROWS * 4 * 4 <= WS_H && WS_H + (size_t)MROWS * DM * 2 <= WS_U && WS_U + (size_t)MROWS * UP * 2 <= WS_PART, "ws map");
constexpr size_t O_PSHIFT = (size_t)MROWS * DM, O_PWKV = O_PSHIFT + 2 * 8 * 896, O_PGLA = O_PWKV + 2 * 8 * 4 * 4096, O_PDNC = O_PGLA + 2 * 8 * 4 * 4096, O_PDN = O_PDNC + 2 * 8 * 3 * 768,
                 O_PSSC = O_PDN + 2 * 8 * 4 * 4096, O_PSSM = O_PSSC + 2 * 8 * 3 * 768, O_SSHIFT = O_PSSM + 2 * 8 * 4 * 8192, O_SWKV = O_SSHIFT + 2 * 128 * 896, O_SGLA = O_SWKV + (size_t)2 * 128 * 4 * 4096,
                 O_SDNC = O_SGLA + (size_t)2 * 128 * 4 * 4096, O_SDN = O_SDNC + 2 * 128 * 3 * 768, O_SSSC = O_SDN + (size_t)2 * 128 * 4 * 4096, O_SSSM = O_SSSC + 2 * 128 * 3 * 768, O_TOTAL = O_SSSM + (size_t)2 * 128 * 4 * 8192;

#define GASP __attribute__((address_space(1)))
template <class T> __device__ __forceinline__ T* as_global(T* q) { return (T*)(GASP T*)(unsigned long long)q; }
struct KP {
    struct In { const float* v[44]; __device__ __forceinline__ const float* operator[](int i) const { return as_global(v[i]); } } in;
    struct Out { float* v; __device__ __forceinline__ operator float*() const { return as_global(v); } } out;
    struct Ws { unsigned char* v; __device__ __forceinline__ operator unsigned char*() const { return as_global(v); } } ws;
};

__device__ __forceinline__ int otid() { int t = threadIdx.x; asm volatile("" : "+v"(t)); return t; }
__device__ __forceinline__ float bf2f(bf16 h) { return __builtin_bit_cast(float, (unsigned)h << 16); }
__device__ __forceinline__ unsigned f2bf(float f) { unsigned u = __builtin_bit_cast(unsigned, f); return (u + 0x7fffu + ((u >> 16) & 1u)) >> 16; }
__device__ __forceinline__ unsigned pk2(float lo, float hi) { unsigned r; asm("v_cvt_pk_bf16_f32 %0, %1, %2" : "=v"(r) : "v"(lo), "v"(hi)); return r; }
typedef short bf16x8v __attribute__((ext_vector_type(8)));
__device__ __forceinline__ uint4 pack8f(const float* s) { uint4 v; v.x = pk2(s[0], s[1]); v.y = pk2(s[2], s[3]); v.z = pk2(s[4], s[5]); v.w = pk2(s[6], s[7]); return v; }
template <int CTRL> __device__ __forceinline__ float dppf(float x) { return __builtin_bit_cast(float, __builtin_amdgcn_mov_dpp(__builtin_bit_cast(int, x), CTRL, 0xf, 0xf, true)); }
__device__ __forceinline__ float red16(float v) { v += dppf<0xB1>(v); v += dppf<0x4E>(v); v += dppf<0x141>(v); v += dppf<0x128>(v); return v; }
__device__ __forceinline__ float wave_sum(float v) { v = red16(v); v += __shfl_xor(v, 16); v += __shfl_xor(v, 32); return v; }
__device__ __forceinline__ float sigmoidf_(float x) { return __builtin_amdgcn_rcpf(1.f + __expf(-x)); }
__device__ __forceinline__ float siluf_(float x) { return x * __builtin_amdgcn_rcpf(1.f + __expf(-x)); }
__device__ __forceinline__ float softplusf_(float x) { return fmaxf(x, 0.f) + __logf(1.f + __expf(-fabsf(x))); }
__device__ __forceinline__ float tanhf_(float x) { return 1.f - 2.f * __builtin_amdgcn_rcpf(__expf(2.f * x) + 1.f); }

__device__ __forceinline__ void transpose_item(const float* W, int K, int N, bf16* WT, float* scr, int item, int nblk, int lane) {
    const int kb = item / nblk, nb = item % nblk, k0 = 64 * kb, n0 = 32 * nb;
    const int kr = lane >> 3, c4 = (lane & 7) * 4; const bool ok = n0 + c4 < N;
    f32x4 v[8];
#pragma unroll
    for (int i = 0; i < 8; ++i) v[i] = ok ? *(const f32x4*)(W + (size_t)(k0 + i * 8 + kr) * N + n0 + c4) : (f32x4){0.f, 0.f, 0.f, 0.f};
#pragma unroll
    for (int i = 0; i < 8; ++i) { float* d = scr + (i * 8 + kr) * 33 + c4; d[0] = v[i][0]; d[1] = v[i][1]; d[2] = v[i][2]; d[3] = v[i][3]; }
    __builtin_amdgcn_s_waitcnt(0); __builtin_amdgcn_wave_barrier();
    const int c = lane & 7;
#pragma unroll
    for (int j = 0; j < 4; ++j) { const int nn = (lane >> 3) + 8 * j; const float* s = scr + (8 * c) * 33 + nn;
        uint4 o; o.x = pk2(s[0 * 33], s[1 * 33]); o.y = pk2(s[2 * 33], s[3 * 33]); o.z = pk2(s[4 * 33], s[5 * 33]); o.w = pk2(s[6 * 33], s[7 * 33]);
        *(uint4*)(WT + (size_t)(n0 + nn) * K + k0 + 8 * c) = o; }
    __builtin_amdgcn_s_waitcnt(0); __builtin_amdgcn_wave_barrier();
}

__device__ __forceinline__ void phase_p0(const KP& p, float* sm) {
    const int tid = otid(), lane = tid & 63, wv = tid >> 6, G = gridDim.x;
    { bf16* AS = (bf16*)sm; const int nt = wv & 3, mh = wv >> 2, n = lane & 15, fq = lane >> 4;
      for (int u = blockIdx.x; u < 2 * 96; u += G) {
        const int l = u / 96, n0 = (u % 96) * 64 + nt * 16 + n;
        const float* W = p.in[11] + (size_t)l * DM * 6144 + n0;
        f32x4 acc[5];
#pragma unroll
        for (int m = 0; m < 5; ++m) acc[m] = (f32x4){0.f, 0.f, 0.f, 0.f};
        float wb[2][8];
#pragma unroll
        for (int ks = 0; ks < 2; ++ks)
#pragma unroll
            for (int j = 0; j < 8; ++j) wb[ks][j] = W[(size_t)(ks * 32 + fq * 8 + j) * 6144];
        for (int kc = 0; kc < DM; kc += 64) {
            __syncthreads();
            for (int i = tid; i < 144 * 32; i += NTHR) { const int r = i >> 5, k = (i & 31) * 2;
                float c0 = 0.f, c1 = 0.f;
                if (r < 8) { const float2 c = *(const float2*)(p.in[9] + (size_t)r * DM + kc + k); c0 = siluf_(c.x); c1 = siluf_(c.y); }
                else if (r < 136) { const float2 c = *(const float2*)(p.in[10] + (size_t)(r - 8) * DM + kc + k); c0 = siluf_(c.x); c1 = siluf_(c.y); }
                *(unsigned*)(AS + r * 72 + k) = pk2(c0, c1); }
            __syncthreads();
            bf16x8v B[2];
#pragma unroll
            for (int ks = 0; ks < 2; ++ks) { const uint4 t = pack8f(wb[ks]); B[ks] = __builtin_bit_cast(bf16x8v, t); }
            if (kc + 64 < DM) {
#pragma unroll
                for (int ks = 0; ks < 2; ++ks)
#pragma unroll
                    for (int j = 0; j < 8; ++j) wb[ks][j] = W[(size_t)(kc + 64 + ks * 32 + fq * 8 + j) * 6144]; }
#pragma unroll
            for (int ks = 0; ks < 2; ++ks)
#pragma unroll
                for (int m = 0; m < 5; ++m) { const int mt = mh * 5 + m; if (mt < 9) { const bf16x8v A = *(const bf16x8v*)(AS + (mt * 16 + n) * 72 + ks * 32 + fq * 8);
                    acc[m] = __builtin_amdgcn_mfma_f32_16x16x32_bf16(A, B[ks], acc[m], 0, 0, 0); } }
        }
        const float bias = p.in[12][(size_t)l * 6144 + n0];
        float* M = (float*)(p.ws + WS_MOD) + (size_t)l * 136 * 6144 + n0;
#pragma unroll
        for (int m = 0; m < 5; ++m) { const int mt = mh * 5 + m;
#pragma unroll
            for (int i = 0; i < 4; ++i) { const int row = mt * 16 + fq * 4 + i; if (mt < 9 && row < 136) M[(size_t)row * 6144] = acc[m][i] + bias; } }
      }
      __syncthreads(); }
    const int gw = blockIdx.x * NWAVES + wv, NGW = G * NWAVES;
    float* scr = sm + wv * (64 * 33);
    constexpr int I_IN = 16 * 128, I_OUT = 16 * 32, I_UP = 16 * 128, I_DN = 64 * 32, I_L = I_IN + I_OUT + I_UP + I_DN;
    for (int it = gw; it < 2 * I_L; it += NGW) {
        const int l = it / I_L; int r = it % I_L;
        if (r < I_IN) { transpose_item(p.in[15] + (size_t)l * DM * PT, DM, PT, (bf16*)(p.ws + WS_WTIN) + (size_t)l * UP * DM, scr, r, 128, lane); continue; } r -= I_IN;
        if (r < I_OUT) { transpose_item(p.in[16] + (size_t)l * DM * DM, DM, DM, (bf16*)(p.ws + WS_WTOUT) + (size_t)l * DM * DM, scr, r, 32, lane); continue; } r -= I_OUT;
        if (r < I_UP) { transpose_item(p.in[17] + (size_t)l * DM * DFF, DM, DFF, (bf16*)(p.ws + WS_WTUP) + (size_t)l * DFF * DM, scr, r, 128, lane); continue; } r -= I_UP;
        transpose_item(p.in[18] + (size_t)l * DFF * DM, DFF, DM, (bf16*)(p.ws + WS_WTDN) + (size_t)l * DM * DFF, scr, r, 32, lane);
    }
    __syncthreads();
}

__device__ __forceinline__ void load_xrow(f32x4 (&v)[4], const float* xf, const bf16* x16, int lane) {
    if (xf) {
#pragma unroll
        for (int j = 0; j < 4; ++j) v[j] = *(const f32x4*)(xf + lane * 4 + 256 * j); }
    else {
#pragma unroll
        for (int j = 0; j < 4; ++j) { const uint2 w = *(const uint2*)(x16 + lane * 4 + 256 * j);
            v[j] = (f32x4){__builtin_bit_cast(float, w.x << 16), __builtin_bit_cast(float, w.x & 0xffff0000u), __builtin_bit_cast(float, w.y << 16), __builtin_bit_cast(float, w.y & 0xffff0000u)}; } }
}
__device__ __forceinline__ void phase_norm(const KP& p, const float* xPf, const float* xSf, const float* nw, const float* modl, int sh_off, int sc_off, int gate_off) {
    const int tid = otid(), lane = tid & 63, wv = tid >> 6; const int gw = blockIdx.x * NWAVES + wv, NGW = gridDim.x * NWAVES;
    bf16* H = (bf16*)(p.ws + WS_H); bf16* X16 = (bf16*)(p.ws + WS_X16);
    f32x4 v[4], vn[4];
#define NRM_LOAD(dst, row) load_xrow(dst, (row) < MP ? (xPf ? xPf + (size_t)(row) * DM : nullptr) : (xSf ? xSf + (size_t)((row) - MP) * DM : nullptr), X16 + (size_t)(row) * DM, lane)
    if (gw < MROWS) NRM_LOAD(v, gw);
    for (int row = gw; row < MROWS; row += NGW) {
        if (row + NGW < MROWS) NRM_LOAD(vn, row + NGW);
        const int cond = row < MP ? (row >> 11) : 8 + ((row - MP) >> 3);
        const float* md = modl + (size_t)cond * 6144;
        if (row >= MP && gate_off != -1) {
            const float* P = (const float*)(p.ws + WS_PART) + (size_t)(row - MP) * DM; bf16* xo_ = X16 + (size_t)row * DM;
#pragma unroll
            for (int j = 0; j < 4; ++j) { const int c = lane * 4 + 256 * j; const f32x4 g = *(const f32x4*)(md + gate_off + c);
                const f32x4 sp = (*(const f32x4*)(P + c) + *(const f32x4*)(P + (size_t)1024 * DM + c)) + (*(const f32x4*)(P + (size_t)2048 * DM + c) + *(const f32x4*)(P + (size_t)3072 * DM + c));
                v[j] += g * sp; uint2 o; o.x = pk2(v[j][0], v[j][1]); o.y = pk2(v[j][2], v[j][3]); *(uint2*)(xo_ + c) = o; } }
        float ss = 0.f;
#pragma unroll
        for (int j = 0; j < 4; ++j) ss += v[j][0] * v[j][0] + v[j][1] * v[j][1] + v[j][2] * v[j][2] + v[j][3] * v[j][3];
        const float rs = rsqrtf(wave_sum(ss) * (1.f / DM) + 1e-6f);
#pragma unroll
        for (int j = 0; j < 4; ++j) { const int c = lane * 4 + 256 * j; const f32x4 w = *(const f32x4*)(nw + c), sc = *(const f32x4*)(md + sc_off + c), sh = *(const f32x4*)(md + sh_off + c);
            const f32x4 h = v[j] * rs * w * (sc + 1.f) + sh;
            uint2 o; o.x = pk2(h[0], h[1]); o.y = pk2(h[2], h[3]); *(uint2*)(H + (size_t)row * DM + c) = o; }
#pragma unroll
        for (int j = 0; j < 4; ++j) v[j] = vn[j];
    }
#undef NRM_LOAD
}
__device__ __forceinline__ void phase_final(const KP& p) {
    const int tid = otid(), lane = tid & 63, wv = tid >> 6; const int gw = blockIdx.x * NWAVES + wv, NGW = gridDim.x * NWAVES;
    const float* nw = p.in[43]; const bf16* X16 = (const bf16*)(p.ws + WS_X16);
    f32x4 v[4], vn[4];
    if (gw < MROWS) load_xrow(v, nullptr, X16 + (size_t)gw * DM, lane);
    for (int row = gw; row < MROWS; row += NGW) {
        float* x = p.out + (size_t)row * DM;
        if (row + NGW < MROWS) load_xrow(vn, nullptr, X16 + (size_t)(row + NGW) * DM, lane);
        if (row >= MP) { const float* P = (const float*)(p.ws + WS_PART) + (size_t)(row - MP) * DM; const float* md = (const float*)(p.ws + WS_MOD) + ((size_t)136 + 8 + ((row - MP) >> 3)) * 6144 + 5120;
#pragma unroll
            for (int j = 0; j < 4; ++j) { const int c = lane * 4 + 256 * j; const f32x4 g = *(const f32x4*)(md + c);
                const f32x4 sp = (*(const f32x4*)(P + c) + *(const f32x4*)(P + (size_t)1024 * DM + c)) + (*(const f32x4*)(P + (size_t)2048 * DM + c) + *(const f32x4*)(P + (size_t)3072 * DM + c));
                v[j] += g * sp; } }
        float ss = 0.f;
#pragma unroll
        for (int j = 0; j < 4; ++j) ss += v[j][0] * v[j][0] + v[j][1] * v[j][1] + v[j][2] * v[j][2] + v[j][3] * v[j][3];
        const float rs = rsqrtf(wave_sum(ss) * (1.f / DM) + 1e-6f);
#pragma unroll
        for (int j = 0; j < 4; ++j) { const int c = lane * 4 + 256 * j; *(f32x4*)(x + c) = v[j] * rs * *(const f32x4*)(nw + c); }
#pragma unroll
        for (int j = 0; j < 4; ++j) v[j] = vn[j];
    }
}

typedef float f32x2 __attribute__((ext_vector_type(2)));
constexpr int VST = 320, SL_VEC = 0, SL_VROW = 16 * VST, SL_PART = SL_VROW + 16 * 64, SL_SCAL = SL_PART + 16 * 16, SL_SIZE = SL_SCAL + 16 * 8;
static_assert(4 * SL_SIZE * 4 <= 131072, "scan LDS ring");
struct Item { int tr, b, h, half, T, NB, row0; };
struct V8 { f32x4 a, b; };
__device__ __forceinline__ V8 ld8(const float* q) { V8 v; v.a = *(const f32x4*)q; v.b = *(const f32x4*)(q + 4); return v; }
__device__ __forceinline__ float dot8(const V8& s, const V8& x) { const f32x4 t = s.a * x.a + s.b * x.b; return (t[0] + t[1]) + (t[2] + t[3]); }
__device__ __forceinline__ f32x2 dot8x2(const V8& s, const f32x4& p0, const f32x4& p1, const f32x4& p2, const f32x4& p3) {
    f32x2 a = (f32x2){s.a[0], s.a[0]} * (f32x2){p0[0], p0[1]}; f32x2 b = (f32x2){s.a[1], s.a[1]} * (f32x2){p0[2], p0[3]};
    a += (f32x2){s.a[2], s.a[2]} * (f32x2){p1[0], p1[1]}; b += (f32x2){s.a[3], s.a[3]} * (f32x2){p1[2], p1[3]};
    a += (f32x2){s.b[0], s.b[0]} * (f32x2){p2[0], p2[1]}; b += (f32x2){s.b[1], s.b[1]} * (f32x2){p2[2], p2[3]};
    a += (f32x2){s.b[2], s.b[2]} * (f32x2){p3[0], p3[1]}; b += (f32x2){s.b[3], s.b[3]} * (f32x2){p3[2], p3[3]};
    return a + b; }
__device__ __forceinline__ float red8(float v) { v += dppf<0xB1>(v); v += dppf<0x4E>(v); v += dppf<0x141>(v); return v; }
__device__ __forceinline__ float ldu(const bf16* U, int row, int col, int T) { row = row < T ? row : T - 1; return bf2f(U[(size_t)row * UP + col]); }
__device__ __forceinline__ void unpack8(const uint4 v, float (&o)[8]) {
    o[0] = __builtin_bit_cast(float, v.x << 16); o[1] = __builtin_bit_cast(float, v.x & 0xffff0000u); o[2] = __builtin_bit_cast(float, v.y << 16); o[3] = __builtin_bit_cast(float, v.y & 0xffff0000u);
    o[4] = __builtin_bit_cast(float, v.z << 16); o[5] = __builtin_bit_cast(float, v.z & 0xffff0000u); o[6] = __builtin_bit_cast(float, v.w << 16); o[7] = __builtin_bit_cast(float, v.w & 0xffff0000u); }
#define YKEEP2(tt, ya, yb) do { if ((tt) == sub) { yk0 = (ya); yk1 = (yb); } } while (0)
#define YSTORE2(bb) do { const int g0 = 16 * (bb) + sub; if (g0 < T) { Y[(size_t)g0 * DM + irow] = (bf16)f2bf(yk0); Y[(size_t)g0 * DM + irow + 16] = (bf16)f2bf(yk1); } } while (0)
__device__ __forceinline__ f32x2 dot4x2(const f32x4& s, const f32x4& p0, const f32x4& p1) {
    f32x2 a = (f32x2){s[0], s[0]} * (f32x2){p0[0], p0[1]}; f32x2 b = (f32x2){s[1], s[1]} * (f32x2){p0[2], p0[3]};
    a += (f32x2){s[2], s[2]} * (f32x2){p1[0], p1[1]}; b += (f32x2){s[3], s[3]} * (f32x2){p1[2], p1[3]};
    return a + b; }
__device__ __forceinline__ void red16x4(float x0, float x1, float x2, float x3, bool p0, bool p1, float& r0, float& r1, float& r2, float& r3) {
    float k0 = p0 ? x2 : x0, k1 = p0 ? x3 : x1; const float t0 = p0 ? x0 : x2, t1 = p0 ? x1 : x3;
    k0 += dppf<0xB1>(t0); k1 += dppf<0xB1>(t1);
    float m = p1 ? k1 : k0; const float u = p1 ? k0 : k1;
    m += dppf<0x4E>(u); m += dppf<0x124>(m); m += dppf<0x128>(m);
    r0 = dppf<0x00>(m); r2 = dppf<0x55>(m); r1 = dppf<0xAA>(m); r3 = dppf<0xFF>(m);
}
__device__ __forceinline__ void red16x2(float xa, float xb, bool p0, float& ra, float& rb) {
    float k = p0 ? xb : xa; const float t = p0 ? xa : xb;
    k += dppf<0xB1>(t); k += dppf<0x4E>(k); k += dppf<0x124>(k); k += dppf<0x128>(k);
    ra = dppf<0x00>(k); rb = dppf<0x55>(k);
}
__device__ __forceinline__ float dot4(const f32x4& s, const f32x4& x) { const f32x4 t = s * x; return (t[0] + t[1]) + (t[2] + t[3]); }
#define TICK_BAR() do { asm volatile("s_waitcnt lgkmcnt(0)" ::: "memory"); __builtin_amdgcn_s_barrier(); asm volatile("" ::: "memory"); } while (0)
__device__ __forceinline__ void scan_rwkv(const KP& p, int l, const Item& it, float* sm) {
    const int tid = otid(), lane = tid & 63, wv = tid >> 6, T = it.T, NBAT = (T + 15) >> 4;
    const bool scanner = wv < 4;
    const bf16* U = (const bf16*)(p.ws + WS_U) + (size_t)it.row0 * UP;
    const float* sh0 = it.tr ? p.in[2] + ((size_t)l * BS + it.b) * 896 : nullptr;
    const int rp = (tid & 255) >> 4, sub = tid & 15, nh = it.tr ? 2 : 1; const bool lp0 = (tid & 1) != 0, lp1 = (tid & 2) != 0; int irow = it.half * 32 + rp;
    bf16* Y = (bf16*)(p.ws + WS_H) + (size_t)it.row0 * DM + 0 * 256 + it.h * 64;
    float* sbase_o = p.out + (it.tr ? O_SWKV : O_PWKV) + (((size_t)l * it.NB + it.b) * 4 + it.h) * 4096 + sub * 4;
    const float* sbase_i = p.in[3] + (((size_t)l * BS + it.b) * 4 + it.h) * 4096 + sub * 4;
    f32x4 S0 = {0.f, 0.f, 0.f, 0.f}, S1 = S0, Q0 = S0, Q1 = S0;
    if (it.tr) { const float* q = sbase_i + ((wv >> 2) * 32 + rp) * 64; Q0 = *(const f32x4*)q; Q1 = *(const f32x4*)(q + 16 * 64); }
    float yk0 = 0.f, yk1 = 0.f;
    const int pj = wv & 3, n = lane & 15, fq = lane >> 4, c = pj * 16 + n, hc = it.h * 64 + c;
    const float* mu = p.in[19] + l * 896;
    bf16x8v Bw, Ba; float muw[8], mua[8];
#pragma unroll
    for (int j = 0; j < 8; ++j) { Bw[j] = (short)f2bf(p.in[21][((size_t)l * 32 + fq * 8 + j) * 256 + hc]); Ba[j] = (short)f2bf(p.in[23][((size_t)l * 32 + fq * 8 + j) * 256 + hc]);
        muw[j] = mu[768 + fq * 8 + j]; mua[j] = mu[800 + fq * 8 + j]; }
    const float w0c = p.in[20][l * 256 + hc], a0c = p.in[22][l * 256 + hc], kkc = p.in[25][l * 256 + hc], kac = p.in[26][l * 256 + hc], rkc = p.in[27][l * 256 + hc];
    const float mur = mu[hc], muk = mu[256 + hc], muv = mu[512 + hc];
    struct RwRaw { uint4 wc, wp, ac, ap; float rr[5], rk[5], rv[5]; } cur;
#define RW_LOAD(R, bb) do { const int ta = 16 * (bb) + n;              \
        { const int tc_ = ta < T ? ta : T - 1; const bf16* q = U + (size_t)tc_ * UP + 768 + fq * 8; R.wc = *(const uint4*)q; R.ac = *(const uint4*)(q + 32); \
          if (tc_ > 0) { R.wp = *(const uint4*)(q - UP); R.ap = *(const uint4*)(q + 32 - UP); } \
          else if (sh0) { R.wp = pack8f(sh0 + 768 + fq * 8); R.ap = pack8f(sh0 + 800 + fq * 8); } else { R.wp = (uint4){0u, 0u, 0u, 0u}; R.ap = R.wp; } } \
        _Pragma("unroll") for (int i = 0; i < 5; ++i) { const int g = 16 * (bb) + fq * 4 - 1 + i; \
            if (g >= 0) { R.rr[i] = ldu(U, g, hc, T); R.rk[i] = ldu(U, g, 256 + hc, T); R.rv[i] = ldu(U, g, 512 + hc, T); } \
            else if (sh0) { R.rr[i] = sh0[hc]; R.rk[i] = sh0[256 + hc]; R.rv[i] = sh0[512 + hc]; } else { R.rr[i] = R.rk[i] = R.rv[i] = 0.f; } } } while (0)
    if (!scanner) RW_LOAD(cur, 0);
    for (int k = 0; k < NBAT + 2; ++k) {
        if (scanner || it.tr) {
            const int b = k - 2;
            if (b >= 0 && b < NBAT) {
                const float* SL = sm + (b & 3) * SL_SIZE; const int ns = (T - 16 * b) < 16 ? (T - 16 * b) : 16;
                { const int hv = wv >> 2;
                if (it.tr) { irow = hv * 32 + rp; S0 = Q0; S1 = Q1; }
#define RW_STEP(tt, q0, q1, w, bb, kp, va, vb, sc) do { const f32x2 da = dot4x2(S0, q0, q1), db = dot4x2(S1, q0, q1); \
                    float a1, a2, b1, b2; red16x4(da.x, da.y, db.x, db.y, lp0, lp1, a1, a2, b1, b2); \
                    const float ca = sc[0] * a1, cb = sc[0] * b1;                                       \
                    const float ya = a2 - ca * sc[1] + va * sc[2], yb = b2 - cb * sc[1] + vb * sc[2]; \
                    S0 = S0 * w + (kp * va - bb * ca); S1 = S1 * w + (kp * vb - bb * cb); YKEEP2(tt, ya, yb); } while (0)
                for (int tt = 0; tt < ns; tt += 2) {
                    const float* V0 = SL + SL_VEC + tt * VST + sub * 4; const float* V1 = V0 + VST; const float* P0 = V0 + sub * 4; const float* P1 = P0 + VST;
                    const f32x4 a0 = *(const f32x4*)P0, a1_ = *(const f32x4*)(P0 + 4), w0 = *(const f32x4*)(V0 + 128), bb0 = *(const f32x4*)(V0 + 192), kp0 = *(const f32x4*)(V0 + 256);
                    const float va0 = SL[SL_VROW + tt * 64 + irow], vb0 = SL[SL_VROW + tt * 64 + irow + 16]; const f32x4 sc0 = *(const f32x4*)(SL + SL_SCAL + tt * 8);
                    const f32x4 e0 = *(const f32x4*)P1, e1 = *(const f32x4*)(P1 + 4), w1 = *(const f32x4*)(V1 + 128), bb1 = *(const f32x4*)(V1 + 192), kp1 = *(const f32x4*)(V1 + 256);
                    const float va1 = SL[SL_VROW + (tt + 1) * 64 + irow], vb1 = SL[SL_VROW + (tt + 1) * 64 + irow + 16]; const f32x4 sc1 = *(const f32x4*)(SL + SL_SCAL + (tt + 1) * 8);
                    RW_STEP(tt, a0, a1_, w0, bb0, kp0, va0, vb0, sc0);
                    RW_STEP(tt + 1, e0, e1, w1, bb1, kp1, va1, vb1, sc1);
                }
#undef RW_STEP
                YSTORE2(b);
                if (it.tr) { *(f32x4*)(sbase_o + irow * 64) = S0; *(f32x4*)(sbase_o + (irow + 16) * 64) = S1; }
                }
            }
        }
        if (!scanner) {
            if (k >= 1 && k - 1 < NBAT && lane < 4) {
                const int tt = pj * 4 + lane; float* SL = sm + ((k - 1) & 3) * SL_SIZE; const float* P = SL + SL_PART + tt * 16;
                const f32x4 s = *(const f32x4*)P + *(const f32x4*)(P + 4) + *(const f32x4*)(P + 8) + *(const f32x4*)(P + 12);
                const float rn2 = __builtin_amdgcn_rcpf(s[0] + 1e-6f);
                *(f32x4*)(SL + SL_SCAL + tt * 8) = (f32x4){rn2, s[1], s[2], 0.f};
                const int g = 16 * (k - 1) + tt; if (it.half == 0 && g < T) ((float*)(p.ws + WS_AUX))[((size_t)it.row0 + g) * 4 + it.h] = s[3];
            }
            if (k < NBAT) {
                float xw[8], xa[8], cu[8], pr[8];
                unpack8(cur.wc, cu); unpack8(cur.wp, pr);
#pragma unroll
                for (int j = 0; j < 8; ++j) xw[j] = tanhf_(cu[j] + (pr[j] - cu[j]) * muw[j]);
                unpack8(cur.ac, cu); unpack8(cur.ap, pr);
#pragma unroll
                for (int j = 0; j < 8; ++j) xa[j] = cu[j] + (pr[j] - cu[j]) * mua[j];
                const uint4 Awu = pack8f(xw), Aau = pack8f(xa);
                const bf16x8v Aw = __builtin_bit_cast(bf16x8v, Awu), Aa = __builtin_bit_cast(bf16x8v, Aau);
                const f32x4 z = {0.f, 0.f, 0.f, 0.f};
                const f32x4 dw = __builtin_amdgcn_mfma_f32_16x16x32_bf16(Aw, Bw, z, 0, 0, 0), da = __builtin_amdgcn_mfma_f32_16x16x32_bf16(Aa, Ba, z, 0, 0, 0);
                float xr_[4], xk_[4], xv_[4];
#pragma unroll
                for (int i = 0; i < 4; ++i) { xr_[i] = cur.rr[i + 1] + (cur.rr[i] - cur.rr[i + 1]) * mur; xk_[i] = cur.rk[i + 1] + (cur.rk[i] - cur.rk[i + 1]) * muk; xv_[i] = cur.rv[i + 1] + (cur.rv[i] - cur.rv[i + 1]) * muv; }
                if (k + 1 < NBAT) RW_LOAD(cur, k + 1);
                float* SL = sm + (k & 3) * SL_SIZE;
#pragma unroll
                for (int i = 0; i < 4; ++i) { const int tt = fq * 4 + i;
                    const float w = __expf(-0.6065306597f * sigmoidf_(w0c + dw[i])), a = sigmoidf_(a0c + da[i]);
                    const float kkraw = xk_[i] * kkc, braw = kkraw * a, kp = xk_[i] * (1.f + (a - 1.f) * kac);
                    float* V = SL + SL_VEC + tt * VST + c; *(f32x2*)(V + c) = (f32x2){kkraw, w * xr_[i]}; V[128] = w; V[192] = braw; V[256] = kp; SL[SL_VROW + tt * 64 + c] = xv_[i];
                    float p0, p1, p2, p3; red16x4(kkraw * kkraw, braw * xr_[i], kp * xr_[i], xr_[i] * kp * rkc, lp0, lp1, p0, p1, p2, p3);
                    if (n == 0) *(f32x4*)(SL + SL_PART + tt * 16 + pj * 4) = (f32x4){p0, p1, p2, p3}; }
            }
        }
        TICK_BAR();
    }
#undef RW_LOAD
    if (scanner) { if (!it.tr) { *(f32x4*)(sbase_o + irow * 64) = S0; *(f32x4*)(sbase_o + (irow + 16) * 64) = S1; } }
    else if (it.h == 0 && it.half == 0) { float* so = p.out + (it.tr ? O_SSHIFT : O_PSHIFT) + ((size_t)l * it.NB + it.b) * 896;
        for (int cc = tid - 256; cc < 896; cc += 256) so[cc] = bf2f(U[(size_t)(T - 1) * UP + cc]); }
}

__device__ __forceinline__ void scan_gla(const KP& p, int l, const Item& it, float* sm) {
    const int tid = otid(), lane = tid & 63, wv = tid >> 6, T = it.T, NBAT = (T + 15) >> 4;
    const bool scanner = wv < 4;
    const bf16* U = (const bf16*)(p.ws + WS_U) + (size_t)it.row0 * UP + CB;
    const int rp = (tid & 255) >> 4, sub = tid & 15, nh = it.tr ? 2 : 1; const bool lp0 = (tid & 1) != 0, lp1 = (tid & 2) != 0; int irow = it.half * 32 + rp;
    bf16* Y = (bf16*)(p.ws + WS_H) + (size_t)it.row0 * DM + 1 * 256 + it.h * 64;
    const size_t sbase = (((size_t)l * it.NB + it.b) * 4 + it.h) * 4096;
    f32x4 S0 = {0.f, 0.f, 0.f, 0.f}, S1 = S0, Q0 = S0, Q1 = S0; float* so = p.out + (it.tr ? O_SGLA : O_PGLA) + sbase + (size_t)sub * 4 * 64; const float* si = p.in[4] + sbase + (size_t)sub * 4 * 64;
    if (it.tr) { const int r0 = (wv >> 2) * 32 + rp;
#pragma unroll
        for (int e = 0; e < 4; ++e) { Q0[e] = si[e * 64 + r0]; Q1[e] = si[e * 64 + r0 + 16]; } }
    float yk0 = 0.f, yk1 = 0.f;
    const int pj = wv & 3, n = lane & 15, fq = lane >> 4, c = pj * 16 + n, hc = it.h * 64 + c;
    float gkw[16];
#pragma unroll
    for (int j = 0; j < 16; ++j) gkw[j] = p.in[30][((size_t)l * 16 + j) * 256 + hc];
    const float gkb = p.in[31][l * 256 + hc];
    struct GlRaw { float q_[4], k_[4], v_[4]; uint4 g0[4], g1[4]; } cur;
#define GL_LOAD(R, bb) do { _Pragma("unroll") for (int i = 0; i < 4; ++i) { int g = 16 * (bb) + fq * 4 + i; g = g < T ? g : T - 1; const bf16* q = U + (size_t)g * UP; \
        R.q_[i] = bf2f(q[hc]); R.k_[i] = bf2f(q[256 + hc]); R.v_[i] = bf2f(q[512 + hc]); R.g0[i] = *(const uint4*)(q + 1024); R.g1[i] = *(const uint4*)(q + 1032); } } while (0)
    if (!scanner) GL_LOAD(cur, 0);
    for (int k = 0; k < NBAT + 2; ++k) {
        if (scanner || it.tr) {
            const int b = k - 2;
            if (b >= 0 && b < NBAT) {
                const float* SL = sm + (b & 3) * SL_SIZE; const int ns = (T - 16 * b) < 16 ? (T - 16 * b) : 16;
                { const int hv = wv >> 2;
                if (it.tr) { irow = hv * 32 + rp; S0 = Q0; S1 = Q1; }
#define GL_STEP(tt, dec, kv, qd, va, vb, qk) do { float da, db; red16x2(dot4(S0, qd), dot4(S1, qd), lp0, da, db); const float ya = da + va * qk, yb = db + vb * qk; \
                    S0 = S0 * dec + kv * va; S1 = S1 * dec + kv * vb; YKEEP2(tt, ya, yb); } while (0)
                for (int tt = 0; tt < ns; tt += 2) {
                    const float* V0 = SL + SL_VEC + tt * VST + sub * 4; const float* V1 = V0 + VST;
                    const f32x4 qd0 = *(const f32x4*)(V0 + 128), dec0 = *(const f32x4*)V0, kv0 = *(const f32x4*)(V0 + 64); const float va0 = SL[SL_VROW + tt * 64 + irow], vb0 = SL[SL_VROW + tt * 64 + irow + 16], qk0 = SL[SL_SCAL + tt * 8];
                    const f32x4 qd1 = *(const f32x4*)(V1 + 128), dec1 = *(const f32x4*)V1, kv1 = *(const f32x4*)(V1 + 64); const float va1 = SL[SL_VROW + (tt + 1) * 64 + irow], vb1 = SL[SL_VROW + (tt + 1) * 64 + irow + 16], qk1 = SL[SL_SCAL + (tt + 1) * 8];
                    GL_STEP(tt, dec0, kv0, qd0, va0, vb0, qk0);
                    GL_STEP(tt + 1, dec1, kv1, qd1, va1, vb1, qk1);
                }
#undef GL_STEP
                YSTORE2(b);
                if (it.tr) {
#pragma unroll
                    for (int e = 0; e < 4; ++e) { so[e * 64 + irow] = S0[e]; so[e * 64 + irow + 16] = S1[e]; } }
                }
            }
        }
        if (!scanner) {
            if (k >= 1 && k - 1 < NBAT && lane < 4) { const int tt = pj * 4 + lane; float* SL = sm + ((k - 1) & 3) * SL_SIZE; const float* P = SL + SL_PART + tt * 16;
                SL[SL_SCAL + tt * 8] = P[0] + P[4] + P[8] + P[12]; }
            if (k < NBAT) {
                float x[4], qq[4], kk[4], vv[4];
#pragma unroll
                for (int i = 0; i < 4; ++i) { float gl[8]; x[i] = gkb; unpack8(cur.g0[i], gl);
#pragma unroll
                    for (int j = 0; j < 8; ++j) x[i] += gl[j] * gkw[j];
                    unpack8(cur.g1[i], gl);
#pragma unroll
                    for (int j = 0; j < 8; ++j) x[i] += gl[j] * gkw[8 + j];
                    qq[i] = cur.q_[i] * 0.125f; kk[i] = cur.k_[i]; vv[i] = cur.v_[i]; }
                if (k + 1 < NBAT) GL_LOAD(cur, k + 1);
                float* SL = sm + (k & 3) * SL_SIZE;
#pragma unroll
                for (int i = 0; i < 4; ++i) { const int tt = fq * 4 + i;
                    const float dec = __expf(-softplusf_(-x[i]) * (1.f / 16.f));
                    float* V = SL + SL_VEC + tt * VST + c; V[0] = dec; V[64] = kk[i]; V[128] = qq[i] * dec; SL[SL_VROW + tt * 64 + c] = vv[i];
                    const float p0 = red16(qq[i] * kk[i]);
                    if (n == 0) SL[SL_PART + tt * 16 + pj * 4] = p0; }
            }
        }
        TICK_BAR();
    }
#undef GL_LOAD
    if (scanner && !it.tr) {
#pragma unroll
        for (int e = 0; e < 4; ++e) { so[e * 64 + irow] = S0[e]; so[e * 64 + irow + 16] = S1[e]; } }
}

__device__ __forceinline__ void scan_dn(const KP& p, int l, const Item& it, float* sm) {
    const int tid = otid(), lane = tid & 63, wv = tid >> 6, T = it.T, NBAT = (T + 15) >> 4;
    const bool scanner = wv < 4;
    const bf16* U = (const bf16*)(p.ws + WS_U) + (size_t)it.row0 * UP + CC;
    const float* cv0 = it.tr ? p.in[5] + ((size_t)l * BS + it.b) * 3 * 768 : nullptr;
    const int rp = (tid & 255) >> 4, sub = tid & 15, nh = it.tr ? 2 : 1; const bool lp0 = (tid & 1) != 0, lp1 = (tid & 2) != 0; int irow = it.half * 32 + rp;
    bf16* Y = (bf16*)(p.ws + WS_H) + (size_t)it.row0 * DM + 2 * 256 + it.h * 64;
    const size_t sbase = (((size_t)l * it.NB + it.b) * 4 + it.h) * 4096;
    f32x4 S0 = {0.f, 0.f, 0.f, 0.f}, S1 = S0, Q0 = S0, Q1 = S0; float* so = p.out + (it.tr ? O_SDN : O_PDN) + sbase + (size_t)sub * 4 * 64; const float* si = p.in[6] + sbase + (size_t)sub * 4 * 64;
    if (it.tr) { const int r0 = (wv >> 2) * 32 + rp;
#pragma unroll
        for (int e = 0; e < 4; ++e) { Q0[e] = si[e * 64 + r0]; Q1[e] = si[e * 64 + r0 + 16]; } }
    float yk0 = 0.f, yk1 = 0.f;
    const int pj = wv & 3, n = lane & 15, fq = lane >> 4, c = pj * 16 + n, hc = it.h * 64 + c;
    float cw[3][4];
#pragma unroll
    for (int pt = 0; pt < 3; ++pt)
#pragma unroll
        for (int i = 0; i < 4; ++i) cw[pt][i] = p.in[33][((size_t)l * 4 + i) * 768 + pt * 256 + hc];
    const float nA = -__expf(p.in[34][l * 4 + it.h]), dtb = p.in[35][l * 4 + it.h];
    struct DnRaw { float xin[3][7]; } cur;
#define DN_LOAD(R, bb) do { _Pragma("unroll") for (int pt = 0; pt < 3; ++pt) _Pragma("unroll") for (int i = 0; i < 7; ++i) { const int g = 16 * (bb) + fq * 4 - 3 + i; \
        R.xin[pt][i] = g >= 0 ? ldu(U, g, pt * 256 + hc, T) : (cv0 ? cv0[(3 + g) * 768 + pt * 256 + hc] : 0.f); } } while (0)
    if (!scanner) DN_LOAD(cur, 0);
    for (int k = 0; k < NBAT + 2; ++k) {
        if (scanner || it.tr) {
            const int b = k - 2;
            if (b >= 0 && b < NBAT) {
                const float* SL = sm + (b & 3) * SL_SIZE; const int ns = (T - 16 * b) < 16 ? (T - 16 * b) : 16;
                { const int hv = wv >> 2;
                if (it.tr) { irow = hv * 32 + rp; S0 = Q0; S1 = Q1; }
#define DN_STEP(tt, q0, q1, kv, va, vb, sc, sq) do { const f32x2 da = dot4x2(S0, q0, q1), db = dot4x2(S1, q0, q1);        \
                    float a1, a2, b1, b2; red16x4(da.x, da.y, db.x, db.y, lp0, lp1, a1, a2, b1, b2); \
                    const float na = sc[1] * (va - sc[0] * sc[2] * a1), nb = sc[1] * (vb - sc[0] * sc[2] * b1); \
                    const float ya = sc[0] * sc[3] * a2 + na * sq, yb = sc[0] * sc[3] * b2 + nb * sq; \
                    S0 = S0 * sc[0] + kv * (na * sc[2]); S1 = S1 * sc[0] + kv * (nb * sc[2]); YKEEP2(tt, ya, yb); } while (0)
                for (int tt = 0; tt < ns; tt += 2) {
                    const float* V0 = SL + SL_VEC + tt * VST + sub * 4; const float* V1 = V0 + VST; const float* P0 = V0 + sub * 4; const float* P1 = P0 + VST;
                    const f32x4 a0 = *(const f32x4*)P0, a1_ = *(const f32x4*)(P0 + 4), kv0 = *(const f32x4*)(V0 + 128);
                    const float va0 = SL[SL_VROW + tt * 64 + irow], vb0 = SL[SL_VROW + tt * 64 + irow + 16]; const f32x4 sc0 = *(const f32x4*)(SL + SL_SCAL + tt * 8); const float sq0 = SL[SL_SCAL + tt * 8 + 4];
                    const f32x4 e0 = *(const f32x4*)P1, e1 = *(const f32x4*)(P1 + 4), kv1 = *(const f32x4*)(V1 + 128);
                    const float va1 = SL[SL_VROW + (tt + 1) * 64 + irow], vb1 = SL[SL_VROW + (tt + 1) * 64 + irow + 16]; const f32x4 sc1 = *(const f32x4*)(SL + SL_SCAL + (tt + 1) * 8); const float sq1 = SL[SL_SCAL + (tt + 1) * 8 + 4];
                    DN_STEP(tt, a0, a1_, kv0, va0, vb0, sc0, sq0);
                    DN_STEP(tt + 1, e0, e1, kv1, va1, vb1, sc1, sq1);
                }
#undef DN_STEP
                YSTORE2(b);
                if (it.tr) {
#pragma unroll
                    for (int e = 0; e < 4; ++e) { so[e * 64 + irow] = S0[e]; so[e * 64 + irow + 16] = S1[e]; } }
                }
            }
        }
        if (!scanner) {
            if (k >= 1 && k - 1 < NBAT && lane < 4) { const int tt = pj * 4 + lane; float* SL = sm + ((k - 1) & 3) * SL_SIZE; const float* P = SL + SL_PART + tt * 16;
                const f32x4 s = *(const f32x4*)P + *(const f32x4*)(P + 4) + *(const f32x4*)(P + 8) + *(const f32x4*)(P + 12);
                const float rq8 = rsqrtf(s[0] + 1e-6f) * 0.125f, rk = rsqrtf(s[1] + 1e-6f);
                int g = 16 * (k - 1) + tt; g = g < T ? g : T - 1;
                const float beta = sigmoidf_(bf2f(U[(size_t)g * UP + 1028 + it.h])), eg = __expf(nA * softplusf_(bf2f(U[(size_t)g * UP + 1024 + it.h]) + dtb));
                *(f32x4*)(SL + SL_SCAL + tt * 8) = (f32x4){eg, beta, rk, rq8}; SL[SL_SCAL + tt * 8 + 4] = s[2] * rq8 * rk; }
            if (k < NBAT) {
                float o[3][4];
#pragma unroll
                for (int pt = 0; pt < 3; ++pt)
#pragma unroll
                    for (int i = 0; i < 4; ++i) o[pt][i] = siluf_(cw[pt][0] * cur.xin[pt][i] + cw[pt][1] * cur.xin[pt][i + 1] + cw[pt][2] * cur.xin[pt][i + 2] + cw[pt][3] * cur.xin[pt][i + 3]);
                if (k + 1 < NBAT) DN_LOAD(cur, k + 1);
                float* SL = sm + (k & 3) * SL_SIZE;
#pragma unroll
                for (int i = 0; i < 4; ++i) { const int tt = fq * 4 + i;
                    float* V = SL + SL_VEC + tt * VST + c; *(f32x2*)(V + c) = (f32x2){o[1][i], o[0][i]}; V[128] = o[1][i]; SL[SL_VROW + tt * 64 + c] = o[2][i];
                    const float p0 = red16(o[0][i] * o[0][i]), p1 = red16(o[1][i] * o[1][i]), p2 = red16(o[0][i] * o[1][i]);
                    if (n == 0) *(f32x4*)(SL + SL_PART + tt * 16 + pj * 4) = (f32x4){p0, p1, p2, 0.f}; }
            }
        }
        TICK_BAR();
    }
#undef DN_LOAD
    if (scanner) { if (!it.tr) {
#pragma unroll
        for (int e = 0; e < 4; ++e) { so[e * 64 + irow] = S0[e]; so[e * 64 + irow + 16] = S1[e]; } } }
    else if (it.h == 0 && it.half == 0) { float* so = p.out + (it.tr ? O_SDNC : O_PDNC) + ((size_t)l * it.NB + it.b) * 3 * 768;
        for (int i = tid - 256; i < 3 * 768; i += 256) { const int rr = i / 768, cc = i % 768; so[i] = bf2f(U[(size_t)(T - 3 + rr) * UP + cc]); } }
}

__device__ __forceinline__ void scan_ssd(const KP& p, int l, const Item& it, float* sm) {
    const int tid = otid(), lane = tid & 63, wv = tid >> 6, T = it.T, NBAT = (T + 15) >> 4, grp = it.h >> 1;
    const bool scanner = wv < 4;
    const bf16* U = (const bf16*)(p.ws + WS_U) + (size_t)it.row0 * UP + CD;
    const bf16* UX = U + 256;
    const float* cv0 = it.tr ? p.in[7] + ((size_t)l * BS + it.b) * 3 * 768 : nullptr;
    const int rp = (tid & 255) >> 4, sub = tid & 15, nh = it.tr ? 2 : 1; const bool lp0 = (tid & 1) != 0, lp1 = (tid & 2) != 0; int irow = it.half * 32 + rp;
    bf16* Y = (bf16*)(p.ws + WS_H) + (size_t)it.row0 * DM + 3 * 256 + it.h * 64;
    const size_t sbase = (((size_t)l * it.NB + it.b) * 4 + it.h) * 64 * 128 + sub * 8; float* so = p.out + (it.tr ? O_SSSM : O_PSSM) + sbase; const float* si = p.in[8] + sbase;
    V8 S0, S1; S0.a = (f32x4){0.f, 0.f, 0.f, 0.f}; S0.b = S0.a; S1 = S0;
    V8 Q0 = S0, Q1 = S0;
    if (it.tr) { const int r0 = (wv >> 2) * 32 + rp; Q0 = ld8(si + r0 * 128); Q1 = ld8(si + (r0 + 16) * 128); }
    float yk0 = 0.f, yk1 = 0.f;
    const int pj = wv & 3, n = lane & 15, fq = lane >> 4, c = pj * 16 + n;
    int ch[5]; ch[0] = it.h * 64 + c; ch[1] = 256 + grp * 128 + pj * 32 + n; ch[2] = ch[1] + 16; ch[3] = ch[1] + 256; ch[4] = ch[3] + 16;
    float cw[5][4], cb[5];
#pragma unroll
    for (int q = 0; q < 5; ++q) { cb[q] = p.in[38][(size_t)l * 768 + ch[q]];
#pragma unroll
        for (int i = 0; i < 4; ++i) cw[q][i] = p.in[37][((size_t)l * 4 + i) * 768 + ch[q]]; }
    const float nA = -__expf(p.in[40][l * 4 + it.h]), dtb = p.in[39][l * 4 + it.h], Dh = p.in[41][l * 4 + it.h];
    struct SsRaw { float xin[5][7]; } cur;
#define SS_LOAD(R, bb) do { _Pragma("unroll") for (int q = 0; q < 5; ++q) _Pragma("unroll") for (int i = 0; i < 7; ++i) { const int g = 16 * (bb) + fq * 4 - 3 + i; \
        R.xin[q][i] = g >= 0 ? ldu(UX, g, ch[q], T) : (cv0 ? cv0[(3 + g) * 768 + ch[q]] : 0.f); } } while (0)
    if (!scanner) SS_LOAD(cur, 0);
    for (int k = 0; k < NBAT + 2; ++k) {
        if (scanner || it.tr) {
            const int b = k - 2;
            if (b >= 0 && b < NBAT) {
                const float* SL = sm + (b & 3) * SL_SIZE; const int ns = (T - 16 * b) < 16 ? (T - 16 * b) : 16;
                { const int hv = wv >> 2;
                if (it.tr) { irow = hv * 32 + rp; S0 = Q0; S1 = Q1; }
#define SS_STEP(tt, Bv, Cv, xa, xb, sc) do { float da, db; red16x2(dot8(S0, Cv), dot8(S1, Cv), lp0, da, db); const float ta = xa * sc[1], tb = xb * sc[1];        \
                    const float ya = sc[0] * da + ta * sc[2] + Dh * xa, yb = sc[0] * db + tb * sc[2] + Dh * xb; \
                    S0.a = S0.a * sc[0] + Bv.a * ta; S0.b = S0.b * sc[0] + Bv.b * ta; S1.a = S1.a * sc[0] + Bv.a * tb; S1.b = S1.b * sc[0] + Bv.b * tb; YKEEP2(tt, ya, yb); } while (0)
                for (int tt = 0; tt < ns; tt += 2) {
                    const float* V0 = SL + SL_VEC + tt * VST + sub * 8; const float* V1 = V0 + VST;
                    const V8 C0 = ld8(V0 + 128), B0 = ld8(V0); const float xa0 = SL[SL_VROW + tt * 64 + irow], xb0 = SL[SL_VROW + tt * 64 + irow + 16]; const f32x4 sc0 = *(const f32x4*)(SL + SL_SCAL + tt * 8);
                    const V8 C1 = ld8(V1 + 128), B1 = ld8(V1); const float xa1 = SL[SL_VROW + (tt + 1) * 64 + irow], xb1 = SL[SL_VROW + (tt + 1) * 64 + irow + 16]; const f32x4 sc1 = *(const f32x4*)(SL + SL_SCAL + (tt + 1) * 8);
                    SS_STEP(tt, B0, C0, xa0, xb0, sc0);
                    SS_STEP(tt + 1, B1, C1, xa1, xb1, sc1);
                }
#undef SS_STEP
                YSTORE2(b);
                if (it.tr) { float* o0 = so + irow * 128; float* o1 = so + (irow + 16) * 128; *(f32x4*)o0 = S0.a; *(f32x4*)(o0 + 4) = S0.b; *(f32x4*)o1 = S1.a; *(f32x4*)(o1 + 4) = S1.b; }
                }
            }
        }
        if (!scanner) {
            if (k >= 1 && k - 1 < NBAT && lane < 4) { const int tt = pj * 4 + lane; float* SL = sm + ((k - 1) & 3) * SL_SIZE; const float* P = SL + SL_PART + tt * 16;
                const float bc = P[0] + P[4] + P[8] + P[12];
                int g = 16 * (k - 1) + tt; g = g < T ? g : T - 1;
                const float dt = softplusf_(bf2f(U[(size_t)g * UP + 1024 + it.h]) + dtb);
                *(f32x4*)(SL + SL_SCAL + tt * 8) = (f32x4){__expf(nA * dt), dt, bc, 0.f}; }
            if (k < NBAT) {
                float o[5][4];
#pragma unroll
                for (int q = 0; q < 5; ++q)
#pragma unroll
                    for (int i = 0; i < 4; ++i) o[q][i] = siluf_(cb[q] + cw[q][0] * cur.xin[q][i] + cw[q][1] * cur.xin[q][i + 1] + cw[q][2] * cur.xin[q][i + 2] + cw[q][3] * cur.xin[q][i + 3]);
                if (k + 1 < NBAT) SS_LOAD(cur, k + 1);
                float* SL = sm + (k & 3) * SL_SIZE;
#pragma unroll
                for (int i = 0; i < 4; ++i) { const int tt = fq * 4 + i;
                    float* V = SL + SL_VEC + tt * VST; V[pj * 32 + n] = o[1][i]; V[pj * 32 + 16 + n] = o[2][i]; V[128 + pj * 32 + n] = o[3][i]; V[128 + pj * 32 + 16 + n] = o[4][i]; SL[SL_VROW + tt * 64 + c] = o[0][i];
                    const float p0 = red16(o[1][i] * o[3][i] + o[2][i] * o[4][i]);
                    if (n == 0) SL[SL_PART + tt * 16 + pj * 4] = p0; }
            }
        }
        TICK_BAR();
    }
#undef SS_LOAD
    if (scanner) { if (!it.tr) { float* o0 = so + irow * 128; float* o1 = so + (irow + 16) * 128; *(f32x4*)o0 = S0.a; *(f32x4*)(o0 + 4) = S0.b; *(f32x4*)o1 = S1.a; *(f32x4*)(o1 + 4) = S1.b; } }
    else if (it.h == 0 && it.half == 0) { float* so = p.out + (it.tr ? O_SSSC : O_PSSC) + ((size_t)l * it.NB + it.b) * 3 * 768;
        for (int i = tid - 256; i < 3 * 768; i += 256) { const int rr = i / 768, cc = i % 768; so[i] = bf2f(UX[(size_t)(T - 3 + rr) * UP + cc]); } }
}

__device__ __forceinline__ void run_item(const KP& p, int l, int tr, int idx, float* sm) {
    Item it; it.tr = tr; const int mixer = idx & 3; int r = idx >> 2; if (tr) it.half = 0; else { it.half = r & 1; r >>= 1; } it.h = r & 3; it.b = r >> 2;
    it.T = tr ? TS : TP; it.NB = tr ? BS : BP; it.row0 = tr ? MP + it.b * TS : it.b * TP;
    if (mixer == 0) scan_rwkv(p, l, it, sm); else if (mixer == 1) scan_gla(p, l, it, sm); else if (mixer == 2) scan_dn(p, l, it, sm); else scan_ssd(p, l, it, sm);
    __syncthreads();
}
__device__ __forceinline__ void flag_signal(unsigned* cnt, unsigned n) {
    asm volatile("s_waitcnt vmcnt(0)" ::: "memory"); __syncthreads();
    if (threadIdx.x == 0 && n) { __builtin_amdgcn_fence(__ATOMIC_RELEASE, "agent"); asm volatile("s_waitcnt vmcnt(0)" ::: "memory"); __hip_atomic_fetch_add(cnt, n, __ATOMIC_RELAXED, __HIP_MEMORY_SCOPE_AGENT); }
}
__device__ __forceinline__ void flag_wait(unsigned* cnt, unsigned target) {
    if (threadIdx.x == 0) { unsigned sp = 0; while (__hip_atomic_load(cnt, __ATOMIC_RELAXED, __HIP_MEMORY_SCOPE_AGENT) < target) { __builtin_amdgcn_s_sleep(4); if (++sp > (1u << 22)) break; }
        __builtin_amdgcn_fence(__ATOMIC_ACQUIRE, "agent"); asm volatile("s_waitcnt vmcnt(0)" ::: "memory"); }
    __syncthreads();
}
__device__ __forceinline__ void phase_scan(const KP& p, int l, float* sm) {
    const int G = gridDim.x;
    constexpr int NPI = 4 * BP * 4 * 2, NSI = 4 * BS * 4;
    for (int i = blockIdx.x; i < NPI; i += G) run_item(p, l, 0, i, sm);
    unsigned* q = (unsigned*)(p.ws + WS_BAR) + 4096 + 64 * l;
    flag_wait((unsigned*)(p.ws + WS_BAR) + 4224 + 64 * l, 64u);
    volatile int* slot = (volatile int*)(sm + 4 * SL_SIZE);
    for (;;) {
        if (threadIdx.x == 0) *slot = (int)__hip_atomic_fetch_add(q, 2u, __ATOMIC_RELAXED, __HIP_MEMORY_SCOPE_AGENT);
        __syncthreads();
        const int i0 = *slot;
        __syncthreads();
        if (i0 >= NSI) break;
        run_item(p, l, 1, i0, sm);
        if (i0 + 1 < NSI) run_item(p, l, 1, i0 + 1, sm);
    }
}

__device__ __forceinline__ void ld4bf(const bf16* p, float (&o)[4]) { const uint2 v = *(const uint2*)p; o[0] = __builtin_bit_cast(float, v.x << 16); o[1] = __builtin_bit_cast(float, v.x & 0xffff0000u); o[2] = __builtin_bit_cast(float, v.y << 16); o[3] = __builtin_bit_cast(float, v.y & 0xffff0000u); }
__device__ __forceinline__ void st4bf(bf16* p, const float (&o)[4]) { uint2 v; v.x = pk2(o[0], o[1]); v.y = pk2(o[2], o[3]); *(uint2*)p = v; }
__device__ __forceinline__ void phase_post(const KP& p, int l, float* sm) {
    const int tid = otid(), lane = tid & 63, wv = tid >> 6; const int gw = blockIdx.x * NWAVES + wv, NGW = gridDim.x * NWAVES;
    const bf16* Ub = (const bf16*)(p.ws + WS_U); bf16* Yb = (bf16*)(p.ws + WS_H); const float* auxb = (const float*)(p.ws + WS_AUX);
    const float* mu = p.in[19] + l * 896;
    { const float* g2g = p.in[24] + (size_t)l * 64 * 256;
      for (int i = tid; i < 64 * 256 / 4; i += NTHR) *(f32x4*)(sm + 4 * i) = *(const f32x4*)(g2g + 4 * i);
      __syncthreads(); }
    const float* g2 = sm;
    const int c = lane * 4, hd = lane >> 4;
    const f32x4 lw = *(const f32x4*)(p.in[28] + l * 256 + c), lb = *(const f32x4*)(p.in[29] + l * 256 + c), muv = *(const f32x4*)(mu + 512 + c);
    const f32x4 wgl = *(const f32x4*)(p.in[32] + l * 256 + c), wdn = *(const f32x4*)(p.in[36] + l * 256 + c), wss = *(const f32x4*)(p.in[42] + l * 256 + c);
    const float mug = mu[832 + lane];
    struct PR { float y[4][4], uv[4], pv[4], gg[4], dz[4], sz[4], ug, pg, rkv; } cur, nxt;
#define POST_LOAD(R, row) do { int tr_, b_, t_; if ((row) < MP) { tr_ = 0; b_ = (row) >> 11; t_ = (row) & 2047; } else { tr_ = 1; b_ = ((row) - MP) >> 3; t_ = ((row) - MP) & 7; } \
        const bf16* u_ = Ub + (size_t)(row) * UP; const bf16* y_ = Yb + (size_t)(row) * DM; \
        _Pragma("unroll") for (int m = 0; m < 4; ++m) ld4bf(y_ + 256 * m + c, R.y[m]); \
        ld4bf(u_ + 512 + c, R.uv); ld4bf(u_ + CB + 768 + c, R.gg); ld4bf(u_ + CC + 768 + c, R.dz); ld4bf(u_ + CD + c, R.sz); R.ug = bf2f(u_[832 + lane]); R.rkv = auxb[(size_t)(row) * 4 + hd]; \
        if (t_ > 0) { ld4bf(u_ - UP + 512 + c, R.pv); R.pg = bf2f(u_[832 + lane - UP]); } \
        else if (tr_) { const float* sh0_ = p.in[2] + ((size_t)l * BS + b_) * 896; const f32x4 s_ = *(const f32x4*)(sh0_ + 512 + c); R.pv[0] = s_[0]; R.pv[1] = s_[1]; R.pv[2] = s_[2]; R.pv[3] = s_[3]; R.pg = sh0_[832 + lane]; } \
        else { R.pv[0] = R.pv[1] = R.pv[2] = R.pv[3] = 0.f; R.pg = 0.f; } } while (0)
    if (gw < MROWS) POST_LOAD(cur, gw);
    for (int row = gw; row < MROWS; row += NGW) {
        if (row + NGW < MROWS) POST_LOAD(nxt, row + NGW);
        bf16* y = Yb + (size_t)row * DM;
        { const float m = red16(cur.y[0][0] + cur.y[0][1] + cur.y[0][2] + cur.y[0][3]) * (1.f / 64.f);
          float d[4], vs = 0.f;
#pragma unroll
          for (int e = 0; e < 4; ++e) { d[e] = cur.y[0][e] - m; vs += d[e] * d[e]; }
          const float rs = rsqrtf(red16(vs) * (1.f / 64.f) + 64e-5f);
          const float sg = sigmoidf_(cur.ug + (cur.pg - cur.ug) * mug);
          f32x4 g = {0.f, 0.f, 0.f, 0.f};
#pragma unroll 8
          for (int j = 0; j < 64; ++j) { const float sj = __shfl(sg, j); g += *(const f32x4*)(g2 + j * 256 + c) * sj; }
          float o[4];
#pragma unroll
          for (int e = 0; e < 4; ++e) { const float v = cur.uv[e] + (cur.pv[e] - cur.uv[e]) * muv[e]; o[e] = (d[e] * rs * lw[e] + lb[e] + cur.rkv * v) * g[e]; }
          st4bf(y + c, o); }
        { const float* yv = cur.y[1];
          const float rs = rsqrtf(red16(yv[0] * yv[0] + yv[1] * yv[1] + yv[2] * yv[2] + yv[3] * yv[3]) * (1.f / 64.f) + 1e-6f); float o[4];
#pragma unroll
          for (int e = 0; e < 4; ++e) o[e] = yv[e] * rs * wgl[e] * siluf_(cur.gg[e]);
          st4bf(y + 256 + c, o); }
        { const float* yv = cur.y[2];
          const float rs = rsqrtf(red16(yv[0] * yv[0] + yv[1] * yv[1] + yv[2] * yv[2] + yv[3] * yv[3]) * (1.f / 64.f) + 1e-6f); float o[4];
#pragma unroll
          for (int e = 0; e < 4; ++e) o[e] = yv[e] * rs * wdn[e] * siluf_(cur.dz[e]);
          st4bf(y + 512 + c, o); }
        { float yv[4]; float ss = 0.f;
#pragma unroll
          for (int e = 0; e < 4; ++e) { yv[e] = cur.y[3][e] * siluf_(cur.sz[e]); ss += yv[e] * yv[e]; }
          ss = red16(ss); ss += __shfl_xor(ss, 16);
          const float rs = rsqrtf(ss * (1.f / 128.f) + 1e-6f); float o[4];
#pragma unroll
          for (int e = 0; e < 4; ++e) o[e] = yv[e] * rs * wss[e];
          st4bf(y + 768 + c, o); }
        cur = nxt;
    }
#undef POST_LOAD
}

#define XB_TMO      128
#define XB_XCNT(j)  (256  + 64 * (j))
#define XB_XSUB(j)  (1280 + 64 * (j))
#define XB_XGEN(j)  (2304 + 64 * (j))
#define XB_TOP      3328
#define XB_TOPGEN   3392
#define XCD_BAR_WORDS 3456
#define XB_SPIN_CAP (1u << 18)

__device__ __forceinline__ unsigned xb_ld(unsigned* p)              { return __hip_atomic_load(p, __ATOMIC_RELAXED, __HIP_MEMORY_SCOPE_AGENT); }
__device__ __forceinline__ unsigned xb_add(unsigned* p, unsigned v) { return __hip_atomic_fetch_add(p, v, __ATOMIC_RELAXED, __HIP_MEMORY_SCOPE_AGENT); }
__device__ __forceinline__ unsigned xb_xcc_id() { return (unsigned)__builtin_amdgcn_s_getreg((3 << 11) | 20) & 0xFu; }
#define XB_SPIN(cond, bar) do { unsigned _sp = 0; while (cond) { __builtin_amdgcn_s_sleep(1); \
    if ((++_sp & 255u) == 0u) { if (xb_ld(&(bar)[XB_TMO])) break; if (_sp > XB_SPIN_CAP) { atomicAdd(&(bar)[XB_TMO], 1u); break; } } } } while (0)

struct XcdBarrier {
    unsigned* bar; unsigned x;
    volatile LAS unsigned* st;
};

__device__ __forceinline__ XcdBarrier xcd_barrier_post(unsigned* bar, volatile LAS unsigned* st) {
    XcdBarrier b; b.bar = bar; b.x = xb_xcc_id(); b.st = st;
    if (threadIdx.x == 0) (void)xb_add(&bar[XB_XCNT(b.x)], 1u);
    return b;
}
__device__ __forceinline__ void xcd_barrier_complete(unsigned* bar, unsigned x, unsigned& nloc, unsigned& nx) {
    const unsigned G = gridDim.x * gridDim.y * gridDim.z;
    unsigned sum, cnt, mine, sp = 0u;
    for (;;) {
        sum = 0u; cnt = 0u; mine = 0u;
#pragma unroll
        for (unsigned j = 0; j < 16; ++j) { const unsigned c = xb_ld(&bar[XB_XCNT(j)]); sum += c; cnt += (c > 0u) ? 1u : 0u; mine = (j == x) ? c : mine; }
        if (sum == G) break;
        __builtin_amdgcn_s_sleep(1);
        if ((++sp & 255u) == 0u) { if (xb_ld(&bar[XB_TMO])) break; if (sp > XB_SPIN_CAP) { atomicAdd(&bar[XB_TMO], 1u); break; } }
    }
    nloc = mine > 0u ? mine : 1u; nx = cnt > 0u ? cnt : 1u;
}

__device__ __forceinline__ void xcd_barrier(const XcdBarrier& b) {
    asm volatile("s_waitcnt vmcnt(0)" ::: "memory");
    __syncthreads();
    if (threadIdx.x == 0) {
        unsigned* bar = b.bar;
        __builtin_amdgcn_s_waitcnt(0);
        unsigned nloc = b.st[0], nx = b.st[1];
        if (nloc == 0u) { xcd_barrier_complete(bar, b.x, nloc, nx); b.st[0] = nloc; b.st[1] = nx; }
        const unsigned old = xb_add(&bar[XB_XSUB(b.x)], 1u);
        const unsigned gen = old / nloc;
        if (old + 1u == (gen + 1u) * nloc) {
            __builtin_amdgcn_fence(__ATOMIC_RELEASE, "agent");
            asm volatile("s_waitcnt vmcnt(0)" ::: "memory");
            const unsigned og = xb_add(&bar[XB_TOP], 1u);
            const unsigned tg = og / nx;
            if (og + 1u == (tg + 1u) * nx) xb_add(&bar[XB_TOPGEN], 1u);
            else XB_SPIN(xb_ld(&bar[XB_TOPGEN]) == tg, bar);
            __builtin_amdgcn_fence(__ATOMIC_ACQUIRE, "agent");
            xb_add(&bar[XB_XGEN(b.x)], 1u);
            asm volatile("s_waitcnt vmcnt(0)" ::: "memory");
        } else {
            XB_SPIN(xb_ld(&bar[XB_XGEN(b.x)]) == gen, bar);
            __builtin_amdgcn_fence(__ATOMIC_ACQUIRE, "agent");
            asm volatile("s_waitcnt vmcnt(0)" ::: "memory");
        }
    }
    __syncthreads();
}

__device__ __forceinline__ const void* uni(const void* q) { const unsigned long long v = (unsigned long long)q; const unsigned lo = __builtin_amdgcn_readfirstlane((unsigned)v), hi = __builtin_amdgcn_readfirstlane((unsigned)(v >> 32)); return (const void*)(const GASP char*)(((unsigned long long)hi << 32) | lo); }
__global__ void __launch_bounds__(NTHR, 2) hybrid_fwd(KP kp) {
    extern __shared__ __attribute__((aligned(16))) unsigned char lds[];
    cg::grid_group grid = cg::this_grid();
    KP* lp = (KP*)(lds + 131072);
    if (threadIdx.x == 0) *lp = kp;
    volatile LAS unsigned* xst = (volatile LAS unsigned*)(lds + 131072 + 512);
    if (threadIdx.x < 2) xst[threadIdx.x] = 0u;
    if (blockIdx.x == 0) for (int i = threadIdx.x; i < 4096 + 512; i += NTHR) ((unsigned*)(kp.ws + WS_BAR))[i] = 0u;
    __syncthreads();
    const KP& p = *lp;
    float* sm = (float*)lds;
#define WSB ((unsigned char*)uni(p.ws))
#define OUTB ((float*)uni(p.out))
#define INP(i) ((const float*)uni(p.in[i]))
    phase_p0(p, sm);
    grid.sync();
    const XcdBarrier xbar = xcd_barrier_post((unsigned*)(WSB + WS_BAR), xst);
    for (int l = 0; l < 2; ++l) {
        { const float* modl = (const float*)(WSB + WS_MOD) + (size_t)l * 136 * 6144;
          const float* xP = l == 0 ? INP(0) : nullptr; const float* xS = l == 0 ? INP(1) : nullptr;
          phase_norm(p, xP, xS, INP(13) + l * DM, modl, 0, 1024, l == 0 ? -1 : 5120 - 136 * 6144); }
        xcd_barrier(xbar);
        { unsigned char* ws = WSB; pg8::Gemm g{(const bf16*)(ws + WS_H), (const bf16*)(ws + WS_WTIN) + (size_t)l * UP * DM, MP, UP, DM, DM}; pg8::StaticOrder S; S.init(MP, UP, 1, (int)gridDim.x, (int)blockIdx.x);
          pg8::EpiBf16<0> E{(bf16*)(ws + WS_U), UP}; pg8::gemm_phase<pg8::EpiBf16<0>, pg8::StaticOrder, true, true>((PG8_LAS unsigned char*)lds, g, S, E); }
        xcd_barrier(xbar);
        { unsigned char* ws = WSB; const int G = (int)gridDim.x, bx = (int)blockIdx.x;
          pg8::Gemm g{(const bf16*)(ws + WS_H), (const bf16*)(ws + WS_WTIN) + (size_t)l * UP * DM, MROWS, UP, DM, DM};
          pg8::SampleTilesOrder S{(G + 2) / 4, (bx & 3) == 1 ? (bx >> 2) : -1, 16}; pg8::EpiBf16<0> E{(bf16*)(ws + WS_U), UP};
          const unsigned nd = (S.cs >= 0 && S.cs < 64) ? (unsigned)((64 - S.cs + S.Gs - 1) / S.Gs) : 0u;
          if (nd) pg8::gemm_phase<pg8::EpiBf16<0>, pg8::SampleTilesOrder, false, true>((PG8_LAS unsigned char*)lds, g, S, E);
          flag_signal((unsigned*)(ws + WS_BAR) + 4224 + 64 * l, nd); }
        phase_scan(p, l, sm);
        xcd_barrier(xbar);
        phase_post(p, l, sm);
        xcd_barrier(xbar);
        { unsigned char* ws = WSB; const float* modl = (const float*)(ws + WS_MOD) + (size_t)l * 136 * 6144;
          pg8::Gemm g{(const bf16*)(ws + WS_H), (const bf16*)(ws + WS_WTOUT) + (size_t)l * DM * DM, MP, DM, DM, DM}; pg8::StaticOrder S; S.init(MP, DM, 1, (int)gridDim.x, (int)blockIdx.x);
          if (l == 0) { pg8::EpiRes<true> E{INP(0), (bf16*)(ws + WS_X16), modl + 2048}; pg8::gemm_phase<pg8::EpiRes<true>, pg8::StaticOrder, true, true>((PG8_LAS unsigned char*)lds, g, S, E); }
          else { pg8::EpiRes<false> E{nullptr, (bf16*)(ws + WS_X16), modl + 2048}; pg8::gemm_phase<pg8::EpiRes<false>, pg8::StaticOrder, true, true>((PG8_LAS unsigned char*)lds, g, S, E); }
          pg8::Gemm g2{(const bf16*)(ws + WS_H), (const bf16*)(ws + WS_WTOUT) + (size_t)l * DM * DM, MROWS, DM, DM / 4, DM}; pg8::SampleSplitOrder S2{(int)gridDim.x, (int)blockIdx.x};
          pg8::EpiPart E2{(float*)(ws + WS_PART)}; pg8::gemm_phase<pg8::EpiPart, pg8::SampleSplitOrder, false, true>((PG8_LAS unsigned char*)lds, g2, S2, E2); }
        xcd_barrier(xbar);
        { const float* modl = (const float*)(WSB + WS_MOD) + (size_t)l * 136 * 6144;
          phase_norm(p, nullptr, l == 0 ? INP(1) : nullptr, INP(14) + l * DM, modl, 3072, 4096, 2048); }
        xcd_barrier(xbar);
        { unsigned char* ws = WSB; pg8::Gemm g{(const bf16*)(ws + WS_H), (const bf16*)(ws + WS_WTUP) + (size_t)l * DFF * DM, MP, DFF, DM, DM}; pg8::StaticOrder S; S.init(MP, DFF, 1, (int)gridDim.x, (int)blockIdx.x);
          pg8::EpiBf16<2> E{(bf16*)(ws + WS_U), DFF}; pg8::gemm_phase<pg8::EpiBf16<2>, pg8::StaticOrder, true, true>((PG8_LAS unsigned char*)lds, g, S, E); }
        xcd_barrier(xbar);
        { unsigned char* ws = WSB; const int G = (int)gridDim.x, bx = (int)blockIdx.x;
          pg8::Gemm g{(const bf16*)(ws + WS_H), (const bf16*)(ws + WS_WTUP) + (size_t)l * DFF * DM, MROWS, DFF, DM, DM};
          const int Gs = G < 64 ? G : 64; pg8::SampleTilesOrder S{Gs, bx >= G - Gs ? bx - (G - Gs) : -1, 16}; pg8::EpiBf16<2> E{(bf16*)(ws + WS_U), DFF};
          const unsigned nd = (S.cs >= 0 && S.cs < 64) ? (unsigned)((64 - S.cs + S.Gs - 1) / S.Gs) : 0u;
          if (nd) pg8::gemm_phase<pg8::EpiBf16<2>, pg8::SampleTilesOrder, false, true>((PG8_LAS unsigned char*)lds, g, S, E);
          flag_signal((unsigned*)(ws + WS_BAR) + 4352 + 64 * l, nd); }
        { unsigned char* ws = WSB; const float* modl = (const float*)(ws + WS_MOD) + (size_t)l * 136 * 6144;
          pg8::Gemm g{(const bf16*)(ws + WS_U), (const bf16*)(ws + WS_WTDN) + (size_t)l * DM * DFF, MP, DM, DFF, DFF}; pg8::StaticOrder S; S.init(MP, DM, 1, (int)gridDim.x, (int)blockIdx.x);
          pg8::EpiRes<false> E{nullptr, (bf16*)(ws + WS_X16), modl + 5120}; pg8::gemm_phase<pg8::EpiRes<false>, pg8::StaticOrder, true, true>((PG8_LAS unsigned char*)lds, g, S, E);
          if ((int)blockIdx.x < 64) flag_wait((unsigned*)(ws + WS_BAR) + 4352 + 64 * l, 64u);
          pg8::Gemm g2{(const bf16*)(ws + WS_U), (const bf16*)(ws + WS_WTDN) + (size_t)l * DM * DFF, MROWS, DM, DFF / 4, DFF}; pg8::SampleSplitOrder S2{(int)gridDim.x, (int)blockIdx.x};
          pg8::EpiPart E2{(float*)(ws + WS_PART)}; pg8::gemm_phase<pg8::EpiPart, pg8::SampleSplitOrder, false, true>((PG8_LAS unsigned char*)lds, g2, S2, E2); }
        xcd_barrier(xbar);
    }
    phase_final(p);
}

extern "C" void kernel_launch(void* const* d_in, const int* in_sizes, int n_in, void* d_out, int out_size, void* d_ws, size_t ws_size, hipStream_t stream) {
    static int grid = 0;
    if (grid == 0) {
        if (n_in != 44 || (size_t)out_size != O_TOTAL || ws_size < WS_END) { fprintf(stderr, "kernel_launch: unexpected shapes: n_in %d out %d ws %zu\n", n_in, out_size, ws_size); grid = -1; return; }
        int dev = 0, cus = 0, per_cu = 0;
        hipGetDevice(&dev); hipDeviceGetAttribute(&cus, hipDeviceAttributeMultiprocessorCount, dev);
        if (hipFuncSetAttribute((const void*)hybrid_fwd, hipFuncAttributeMaxDynamicSharedMemorySize, LDS_BYTES) != hipSuccess) { fprintf(stderr, "kernel_launch: hipFuncSetAttribute failed\n"); grid = -1; return; }
        if (hipOccupancyMaxActiveBlocksPerMultiprocessor(&per_cu, (const void*)hybrid_fwd, NTHR, LDS_BYTES) != hipSuccess || per_cu < 1) { fprintf(stderr, "kernel_launch: occupancy query failed (%d)\n", per_cu); grid = -1; return; }
        grid = cus * per_cu;
    }
    if (grid < 0) return;
    KP p{};
    for (int i = 0; i < 44; ++i) p.in.v[i] = (const float*)d_in[i];
    p.out.v = (float*)d_out; p.ws.v = (unsigned char*)d_ws;
    void* args[] = {&p};
    hipError_t e = hipLaunchCooperativeKernel((const void*)hybrid_fwd, dim3(grid), dim3(NTHR), args, LDS_BYTES, stream);
    if (e != hipSuccess) fprintf(stderr, "kernel_launch: cooperative launch failed: %s (grid %d)\n", hipGetErrorString(e), grid);
}
```

```cpp
#include <hip/hip_runtime.h>
#include <hip/hip_cooperative_groups.h>
#include <cstdio>
#include <cstdint>
namespace cg = cooperative_groups;

namespace pg8 {
#define PG8_LAS __attribute__((address_space(3)))
typedef unsigned short bf16_t;
typedef short bf16x8 __attribute__((ext_vector_type(8)));
typedef float f32x4 __attribute__((ext_vector_type(4)));
typedef unsigned u32x4 __attribute__((ext_vector_type(4)));
constexpr int BM = 256, BK = 64, HALF = 128, HTB = HALF * BK * 2, STAGE_BYTES = 8 * HTB, NXCD = 8, WGM = 8;

__host__ __device__ __forceinline__ int lds_byte(int r, int c) { const int st = (r >> 4) * 2 + (c >> 5), rr = r & 15, cc = c & 31, ob = rr * 64 + cc * 2; return st * 1024 + (ob ^ (((ob >> 9) & 1) << 5)); }
__host__ __device__ __forceinline__ void stage_rc(int b, int& R, int& C) { const int st = b / 1024, sb = b % 1024, swz = sb ^ (((sb >> 9) & 1) << 5); R = (st >> 1) * 16 + swz / 64; C = (st & 1) * 32 + (swz % 64) / 2; }
__host__ __device__ __forceinline__ int perm32(int rho) { const int n = rho >> 4, i = rho & 15; return 8 * (i >> 2) + 4 * n + (i & 3); }

struct Unit { int pm, pn, pk; };
struct Gemm { const bf16_t* A; const bf16_t* Bt; int M, N, K, ld; };

struct StaticOrder {
    int nM, nN, nK, ntile, nwg, G, c;
    __host__ __device__ void init(int M, int N, int nK_, int G_, int c_) { nM = M / BM; nN = N / BM; nK = nK_; ntile = nM * nN; nwg = ntile * nK; G = G_; c = c_; }
    __host__ __device__ bool next(int i, Unit& u) const {
        const long L = (long)i * G + c; if (L >= nwg) return false;
        int wgid = (int)L; { const int q = nwg / NXCD, r = nwg % NXCD, xcd = wgid % NXCD, off = wgid / NXCD; wgid = (xcd < r ? xcd * (q + 1) : r * (q + 1) + (xcd - r) * q) + off; }
        u.pk = wgid / ntile; wgid -= u.pk * ntile;
        const int nig = WGM * nN, gid = wgid / nig, fm = gid * WGM, gsz = (nM - fm) < WGM ? (nM - fm) : WGM;
        u.pm = fm + ((wgid % nig) % gsz); u.pn = (wgid % nig) / gsz; return true;
    }
    __device__ __forceinline__ void a_ready(const Unit&) const {}
    __device__ __forceinline__ void done(const Unit&) const {}
};
__device__ __forceinline__ unsigned cvt_pk_bf16(float lo, float hi) { unsigned r; asm volatile("v_cvt_pk_bf16_f32 %0, %1, %2" : "=v"(r) : "v"(lo), "v"(hi)); return r; }

template <int ACT  > struct EpiBf16 {
    static constexpr bool PERM = true, AFTER_DRAIN = false;
    bf16_t* O; int ldc;
    __device__ __forceinline__ void operator()(const f32x4 (&acc)[2][2][4][2], const Unit& u, int wr, int wc, int fr, int fq) const {
        const int row0 = u.pm * BM + wr * 64 + fr, col0 = u.pn * BM + wc * 32 + 8 * fq;
#pragma unroll
        for (int ai = 0; ai < 2; ++ai)
#pragma unroll
            for (int m = 0; m < 4; ++m) { bf16_t* rowp = O + (size_t)(row0 + ai * HALF + m * 16) * ldc + col0;
#pragma unroll
                for (int bj = 0; bj < 2; ++bj) { f32x4 v0 = acc[ai][bj][m][0], v1 = acc[ai][bj][m][1];
                    if (ACT == 2) {
#pragma unroll
                        for (int j = 0; j < 4; ++j) { float a = fmaxf(v0[j], 0.f), b = fmaxf(v1[j], 0.f); v0[j] = a * a; v1[j] = b * b; } }
                    u32x4 w; w.x = cvt_pk_bf16(v0[0], v0[1]); w.y = cvt_pk_bf16(v0[2], v0[3]); w.z = cvt_pk_bf16(v1[0], v1[1]); w.w = cvt_pk_bf16(v1[2], v1[3]);
                    *(u32x4*)(rowp + bj * HALF) = w; } }
    }
};
template <bool SRCF32> struct EpiRes {
    static constexpr bool PERM = true, AFTER_DRAIN = false;
    const float* srcF; bf16_t* X; const float* gate;
    __device__ __forceinline__ void operator()(const f32x4 (&acc)[2][2][4][2], const Unit& u, int wr, int wc, int fr, int fq) const {
        const int row0 = u.pm * BM + wr * 64 + fr, col0 = u.pn * BM + wc * 32 + 8 * fq;
#pragma unroll
        for (int ai = 0; ai < 2; ++ai)
#pragma unroll
            for (int m = 0; m < 4; ++m) { const int row = row0 + ai * HALF + m * 16;
                const int cond = row < 16384 ? (row >> 11) : 8 + ((row - 16384) >> 3);
                const float* g = gate + (size_t)cond * 6144; bf16_t* d = X + (size_t)row * 1024;
#pragma unroll
                for (int bj = 0; bj < 2; ++bj) { const int c = col0 + bj * HALF; const f32x4 g0 = *(const f32x4*)(g + c), g1 = *(const f32x4*)(g + c + 4);
                    f32x4 x0, x1;
                    if (SRCF32) { const float* s = srcF + (size_t)row * 1024 + c; x0 = *(const f32x4*)s; x1 = *(const f32x4*)(s + 4); }
                    else { const u32x4 w = *(const u32x4*)(d + c);
                        x0 = (f32x4){__builtin_bit_cast(float, w.x << 16), __builtin_bit_cast(float, w.x & 0xffff0000u), __builtin_bit_cast(float, w.y << 16), __builtin_bit_cast(float, w.y & 0xffff0000u)};
                        x1 = (f32x4){__builtin_bit_cast(float, w.z << 16), __builtin_bit_cast(float, w.z & 0xffff0000u), __builtin_bit_cast(float, w.w << 16), __builtin_bit_cast(float, w.w & 0xffff0000u)}; }
                    x0 += g0 * acc[ai][bj][m][0]; x1 += g1 * acc[ai][bj][m][1];
                    u32x4 o; o.x = cvt_pk_bf16(x0[0], x0[1]); o.y = cvt_pk_bf16(x0[2], x0[3]); o.z = cvt_pk_bf16(x1[0], x1[1]); o.w = cvt_pk_bf16(x1[2], x1[3]);
                    *(u32x4*)(d + c) = o; } }
    }
};

struct SampleSplitOrder {
    int G, c;
    __device__ bool next(int i, Unit& u) const { const int L = i * G + c; if (L >= 64) return false; u.pk = L & 3; const int t = L >> 2; u.pm = 64 + (t >> 2); u.pn = t & 3; return true; }
    __device__ __forceinline__ void a_ready(const Unit&) const {}
    __device__ __forceinline__ void done(const Unit&) const {}
};
struct EpiPart {
    static constexpr bool PERM = true, AFTER_DRAIN = false;
    float* P;
    __device__ __forceinline__ void operator()(const f32x4 (&acc)[2][2][4][2], const Unit& u, int wr, int wc, int fr, int fq) const {
        const int row0 = (u.pm - 64) * BM + wr * 64 + fr, col0 = u.pn * BM + wc * 32 + 8 * fq;
#pragma unroll
        for (int ai = 0; ai < 2; ++ai)
#pragma unroll
            for (int m = 0; m < 4; ++m) { float* d = P + ((size_t)u.pk * 1024 + row0 + ai * HALF + m * 16) * 1024 + col0;
#pragma unroll
                for (int bj = 0; bj < 2; ++bj) { *(f32x4*)(d + bj * HALF) = acc[ai][bj][m][0]; *(f32x4*)(d + bj * HALF + 4) = acc[ai][bj][m][1]; } }
    }
};

struct SampleTilesOrder {
    int Gs, cs, nN;
    __device__ bool next(int i, Unit& u) const { if (cs < 0) return false; const int L = i * Gs + cs; if (L >= 4 * nN) return false; u.pk = 0; u.pm = 64 + L / nN; u.pn = L % nN; return true; }
    __device__ __forceinline__ void a_ready(const Unit&) const {}
    __device__ __forceinline__ void done(const Unit&) const {}
};

template <class Epi, class Sched, bool ALIGN_EPI = false, bool SP2 = false>
__device__ __forceinline__ void gemm_phase(PG8_LAS unsigned char* lds, const Gemm g, const Sched& S, const Epi& E) {
    int tid_ = threadIdx.x; asm volatile("" : "+v"(tid_));
    const int tid = tid_, wid = __builtin_amdgcn_readfirstlane(tid >> 6), lane = tid & 63, wr = wid >> 2, wc = wid & 3, fr = lane & 15, fq = lane >> 4;
    const int K = g.ld, nt = g.K / BK; const size_t kspl = (size_t)g.K * 2;
    unsigned voffA[2], voffB[2];
#pragma unroll
    for (int i = 0; i < 2; ++i) { int R, C; stage_rc(tid * 16 + i * 8192, R, C); const int Rb = Epi::PERM ? ((R & ~31) + perm32(R & 31)) : R;
        voffA[i] = (unsigned)(R * K + C) * 2u; voffB[i] = (unsigned)(Rb * K + C) * 2u; }
    const size_t kstep = (size_t)(BK * 2);
    const size_t hstep = (size_t)HALF * K * 2;
    const size_t tstep = 2 * hstep;
    const unsigned ldsw = (unsigned)wid * 1024u;
    const int aoff = lds_byte(wr * 64 + fr, fq * 8), boff = lds_byte(wc * 32 + fr, fq * 8);
#define PG8_SA(b, h) (((b) * 2 + (h)) * HTB)
#define PG8_SB(b, h) ((4 + (b) * 2 + (h)) * HTB)
#define PG8_STAGE(bufoff, gbase, voff) do { _Pragma("unroll") for (int _i = 0; _i < 2; ++_i) \
        __builtin_amdgcn_global_load_lds((const unsigned*)((const char*)(gbase) + (voff)[_i]), (PG8_LAS unsigned*)(lds + (bufoff) + ldsw + _i * 8192), 16, 0, 0); } while (0)
#define PG8_LDA(dst, b, h) do { _Pragma("unroll") for (int m = 0; m < 4; ++m) _Pragma("unroll") for (int k = 0; k < 2; ++k) dst[m][k] = *(const PG8_LAS bf16x8*)(lds + PG8_SA(b, h) + aoff + m * 2048 + k * 1024); } while (0)
#define PG8_LDB(dst, b, h) do { _Pragma("unroll") for (int n = 0; n < 2; ++n) _Pragma("unroll") for (int k = 0; k < 2; ++k) dst[n][k] = *(const PG8_LAS bf16x8*)(lds + PG8_SB(b, h) + boff + n * 2048 + k * 1024); } while (0)
#define PG8_MMA(ai, bj, At, Bt) do { __builtin_amdgcn_s_setprio(1); _Pragma("unroll") for (int m = 0; m < 4; ++m) _Pragma("unroll") for (int n = 0; n < 2; ++n) _Pragma("unroll") for (int k = 0; k < 2; ++k) \
        acc[ai][bj][m][n] = __builtin_amdgcn_mfma_f32_16x16x32_bf16(Bt[n][k], At[m][k], acc[ai][bj][m][n], 0, 0, 0); __builtin_amdgcn_s_setprio(0); } while (0)
#define PG8_WAIT_V(n) asm volatile("s_waitcnt vmcnt(" #n ")" ::: "memory")
#define PG8_WAIT_L(n) asm volatile("s_waitcnt lgkmcnt(" #n ")" ::: "memory")
#define PG8_BAR __builtin_amdgcn_s_barrier()
#define PG8_SCHED __builtin_amdgcn_sched_barrier(0)
    Unit cur, nxt; int ui = 0;
    if (!S.next(0, cur)) return;
    f32x4 acc[2][2][4][2];
#pragma unroll
    for (int a = 0; a < 2; ++a)
#pragma unroll
        for (int b = 0; b < 2; ++b)
#pragma unroll
            for (int m = 0; m < 4; ++m)
#pragma unroll
                for (int n = 0; n < 2; ++n) acc[a][b][m][n] = (f32x4){0.f, 0.f, 0.f, 0.f};
    bf16x8 At[4][2], B0[2][2], B1[2][2];
    const char* cA = (const char*)g.A + (size_t)cur.pm * tstep + (size_t)cur.pk * kspl; const char* cB = (const char*)g.Bt + (size_t)cur.pn * tstep + (size_t)cur.pk * kspl;
    S.a_ready(cur);
    if constexpr (SP2) {
        PG8_STAGE(PG8_SB(0, 0), cB, voffB); PG8_STAGE(PG8_SB(0, 1), cB + hstep, voffB); PG8_STAGE(PG8_SA(0, 0), cA, voffA); PG8_STAGE(PG8_SA(0, 1), cA + hstep, voffA);
        if (wr == 1) PG8_BAR;
        PG8_WAIT_V(2); PG8_BAR;
        PG8_STAGE(PG8_SB(1, 0), cB + kstep, voffB); PG8_STAGE(PG8_SA(1, 0), cA + kstep, voffA); PG8_STAGE(PG8_SB(1, 1), cB + hstep + kstep, voffB);
        PG8_WAIT_V(6); PG8_BAR;
    } else {
        PG8_STAGE(PG8_SB(0, 0), cB, voffB); PG8_STAGE(PG8_SA(0, 0), cA, voffA); PG8_STAGE(PG8_SB(0, 1), cB + hstep, voffB); PG8_STAGE(PG8_SA(0, 1), cA + hstep, voffA);
        if (wr == 1) PG8_BAR;
        PG8_WAIT_V(4); PG8_BAR;
        PG8_STAGE(PG8_SB(1, 0), cB + kstep, voffB); PG8_STAGE(PG8_SA(1, 0), cA + kstep, voffA); PG8_STAGE(PG8_SB(1, 1), cB + hstep + kstep, voffB);
        PG8_WAIT_V(6); PG8_BAR;
    }
    for (;;) {
        const bool has_next = S.next(ui + 1, nxt);
        const char* nA = has_next ? (const char*)g.A + (size_t)nxt.pm * tstep + (size_t)nxt.pk * kspl : cA; const char* nB = has_next ? (const char*)g.Bt + (size_t)nxt.pn * tstep + (size_t)nxt.pk * kspl : cB;
        for (int t = 0; t < nt; t += 2) {
            const bool last = (t == nt - 2);
            const char* a1 = cA + (size_t)(t + 1) * kstep;
            const char* a2 = last ? nA : cA + (size_t)(t + 2) * kstep; const char* b2 = last ? nB : cB + (size_t)(t + 2) * kstep;
            const char* a3 = a2 + kstep; const char* b3 = b2 + kstep;
            if (last && has_next) S.a_ready(nxt);
            if constexpr (SP2) {
            PG8_LDB(B0, 0, 0); PG8_LDB(B1, 0, 1); PG8_SCHED; PG8_LDA(At, 0, 0); PG8_STAGE(PG8_SA(1, 1), a1 + hstep, voffA);
            PG8_WAIT_V(8); PG8_WAIT_L(0); PG8_BAR; PG8_MMA(0, 0, At, B0); PG8_MMA(0, 1, At, B1); PG8_BAR; PG8_SCHED;
            PG8_LDA(At, 0, 1); PG8_STAGE(PG8_SB(0, 0), b2, voffB); PG8_STAGE(PG8_SB(0, 1), b2 + hstep, voffB); PG8_STAGE(PG8_SA(0, 0), a2, voffA);
            PG8_WAIT_V(8); PG8_WAIT_L(0); PG8_BAR; PG8_MMA(1, 0, At, B0); PG8_MMA(1, 1, At, B1); PG8_BAR; PG8_SCHED;
            PG8_LDB(B0, 1, 0); PG8_LDB(B1, 1, 1); PG8_SCHED; PG8_LDA(At, 1, 0); PG8_STAGE(PG8_SA(0, 1), a2 + hstep, voffA);
            PG8_WAIT_V(8); PG8_WAIT_L(0); PG8_BAR; PG8_MMA(0, 0, At, B0); PG8_MMA(0, 1, At, B1); PG8_BAR; PG8_SCHED;
            PG8_LDA(At, 1, 1); PG8_STAGE(PG8_SB(1, 0), b3, voffB); PG8_STAGE(PG8_SB(1, 1), b3 + hstep, voffB); PG8_STAGE(PG8_SA(1, 0), a3, voffA);
            PG8_WAIT_V(8); PG8_WAIT_L(0); PG8_BAR; PG8_MMA(1, 0, At, B0); PG8_MMA(1, 1, At, B1); PG8_BAR; PG8_SCHED;
            } else {
            PG8_LDB(B0, 0, 0); PG8_SCHED; PG8_LDA(At, 0, 0); PG8_STAGE(PG8_SA(1, 1), a1 + hstep, voffA);
            PG8_WAIT_L(8); PG8_BAR; PG8_WAIT_L(0); PG8_MMA(0, 0, At, B0); PG8_BAR; PG8_SCHED;
            PG8_LDB(B1, 0, 1); PG8_STAGE(PG8_SB(0, 0), b2, voffB);
            PG8_BAR; PG8_WAIT_L(0); PG8_MMA(0, 1, At, B1); PG8_BAR;
            PG8_LDA(At, 0, 1); PG8_STAGE(PG8_SA(0, 0), a2, voffA);
            PG8_BAR; PG8_WAIT_L(0); PG8_MMA(1, 0, At, B0); PG8_BAR; PG8_SCHED;
            PG8_STAGE(PG8_SB(0, 1), b2 + hstep, voffB);
            PG8_WAIT_V(6); PG8_BAR; PG8_MMA(1, 1, At, B1); PG8_BAR;
            PG8_LDB(B0, 1, 0); PG8_SCHED; PG8_LDA(At, 1, 0); PG8_STAGE(PG8_SA(0, 1), a2 + hstep, voffA);
            PG8_WAIT_L(8); PG8_BAR; PG8_WAIT_L(0); PG8_MMA(0, 0, At, B0); PG8_BAR; PG8_SCHED;
            PG8_LDB(B1, 1, 1); PG8_STAGE(PG8_SB(1, 0), b3, voffB);
            PG8_BAR; PG8_WAIT_L(0); PG8_MMA(0, 1, At, B1); PG8_BAR;
            PG8_LDA(At, 1, 1); PG8_STAGE(PG8_SA(1, 0), a3, voffA);
            PG8_BAR; PG8_WAIT_L(0); PG8_MMA(1, 0, At, B0); PG8_BAR; PG8_SCHED;
            PG8_STAGE(PG8_SB(1, 1), b3 + hstep, voffB);
            PG8_WAIT_V(6); PG8_BAR; PG8_MMA(1, 1, At, B1); PG8_BAR;
            }
        }
        if constexpr (ALIGN_EPI) { if (wr == 0) PG8_BAR; }
        if constexpr (!Epi::AFTER_DRAIN) { E(acc, cur, wr, wc, fr, fq); S.done(cur); }
        if (!has_next) break;
#pragma unroll
        for (int a = 0; a < 2; ++a)
#pragma unroll
            for (int b = 0; b < 2; ++b)
#pragma unroll
                for (int m = 0; m < 4; ++m)
#pragma unroll
                    for (int n = 0; n < 2; ++n) acc[a][b][m][n] = (f32x4){0.f, 0.f, 0.f, 0.f};
        cur = nxt; cA = nA; cB = nB; ++ui;
        if constexpr (ALIGN_EPI) { if (wr == 1) PG8_BAR; }
    }
    PG8_WAIT_V(0);
    if constexpr (!ALIGN_EPI) { if (wr == 0) PG8_BAR; }
    PG8_BAR;
    if constexpr (Epi::AFTER_DRAIN) { E.fused(acc, cur, wr, wc, fr, fq, lds, wid, lane); S.done(cur); }
#undef PG8_SA
#undef PG8_SB
#undef PG8_STAGE
#undef PG8_LDA
#undef PG8_LDB
#undef PG8_MMA
#undef PG8_WAIT_V
#undef PG8_WAIT_L
#undef PG8_BAR
#undef PG8_SCHED
}
}

typedef unsigned short bf16;
#define LAS __attribute__((address_space(3)))
typedef float f32x4 __attribute__((ext_vector_type(4)));
constexpr int DM = 1024, TP = 2048, BP = 8, BS = 128, TS = 8, MP = BP * TP, MS = BS * TS, MROWS = MP + MS, UP = 4096, PT = 3996, DFF = 4096;
constexpr int CA = 0, CB = 896, CC = 1936, CD = 2968;
constexpr int NTHR = 512, NWAVES = 8;
constexpr int LDS_BYTES = 135168;
constexpr size_t MiB = 1u << 20;
constexpr size_t WS_BAR = 59 * MiB + 512 * 1024;
constexpr size_t WS_WTIN = 0, WS_WTOUT = 16 * MiB, WS_WTUP = 20 * MiB, WS_WTDN = 36 * MiB, WS_MOD = 52 * MiB, WS_AUX = 59 * MiB, WS_H = 60 * MiB, WS_U = 94 * MiB, WS_PART = 230 * MiB, WS_X16 = 246 * MiB, WS_END = 280 * MiB;
static_assert(WS_MOD + (size_t)2 * 136 * 6144 * 4 <= WS_AUX && WS_AUX + (size_t)MROWS * 4 * 4 <= WS_H && WS_H + (size_t)MROWS * DM * 2 <= WS_U && WS_U + (size_t)MROWS * UP * 2 <= WS_PART, "ws map");
constexpr size_t O_PSHIFT = (size_t)MROWS * DM, O_PWKV = O_PSHIFT + 2 * 8 * 896, O_PGLA = O_PWKV + 2 * 8 * 4 * 4096, O_PDNC = O_PGLA + 2 * 8 * 4 * 4096, O_PDN = O_PDNC + 2 * 8 * 3 * 768,
                 O_PSSC = O_PDN + 2 * 8 * 4 * 4096, O_PSSM = O_PSSC + 2 * 8 * 3 * 768, O_SSHIFT = O_PSSM + 2 * 8 * 4 * 8192, O_SWKV = O_SSHIFT + 2 * 128 * 896, O_SGLA = O_SWKV + (size_t)2 * 128 * 4 * 4096,
                 O_SDNC = O_SGLA + (size_t)2 * 128 * 4 * 4096, O_SDN = O_SDNC + 2 * 128 * 3 * 768, O_SSSC = O_SDN + (size_t)2 * 128 * 4 * 4096, O_SSSM = O_SSSC + 2 * 128 * 3 * 768, O_TOTAL = O_SSSM + (size_t)2 * 128 * 4 * 8192;

#define GASP __attribute__((address_space(1)))
template <class T> __device__ __forceinline__ T* as_global(T* q) { return (T*)(GASP T*)(unsigned long long)q; }
struct KP {
    struct In { const float* v[44]; __device__ __forceinline__ const float* operator[](int i) const { return as_global(v[i]); } } in;
    struct Out { float* v; __device__ __forceinline__ operator float*() const { return as_global(v); } } out;
    struct Ws { unsigned char* v; __device__ __forceinline__ operator unsigned char*() const { return as_global(v); } } ws;
};

__device__ __forceinline__ int otid() { int t = threadIdx.x; asm volatile("" : "+v"(t)); return t; }
__device__ __forceinline__ float bf2f(bf16 h) { return __builtin_bit_cast(float, (unsigned)h << 16); }
__device__ __forceinline__ unsigned f2bf(float f) { unsigned u = __builtin_bit_cast(unsigned, f); return (u + 0x7fffu + ((u >> 16) & 1u)) >> 16; }
__device__ __forceinline__ unsigned pk2(float lo, float hi) { unsigned r; asm("v_cvt_pk_bf16_f32 %0, %1, %2" : "=v"(r) : "v"(lo), "v"(hi)); return r; }
typedef short bf16x8v __attribute__((ext_vector_type(8)));
__device__ __forceinline__ uint4 pack8f(const float* s) { uint4 v; v.x = pk2(s[0], s[1]); v.y = pk2(s[2], s[3]); v.z = pk2(s[4], s[5]); v.w = pk2(s[6], s[7]); return v; }
template <int CTRL> __device__ __forceinline__ float dppf(float x) { return __builtin_bit_cast(float, __builtin_amdgcn_mov_dpp(__builtin_bit_cast(int, x), CTRL, 0xf, 0xf, true)); }
__device__ __forceinline__ float red16(float v) { v += dppf<0xB1>(v); v += dppf<0x4E>(v); v += dppf<0x141>(v); v += dppf<0x128>(v); return v; }
__device__ __forceinline__ float wave_sum(float v) { v = red16(v); v += __shfl_xor(v, 16); v += __shfl_xor(v, 32); return v; }
__device__ __forceinline__ float sigmoidf_(float x) { return __builtin_amdgcn_rcpf(1.f + __expf(-x)); }
__device__ __forceinline__ float siluf_(float x) { return x * __builtin_amdgcn_rcpf(1.f + __expf(-x)); }
__device__ __forceinline__ float softplusf_(float x) { return fmaxf(x, 0.f) + __logf(1.f + __expf(-fabsf(x))); }
__device__ __forceinline__ float tanhf_(float x) { return 1.f - 2.f * __builtin_amdgcn_rcpf(__expf(2.f * x) + 1.f); }

__device__ __forceinline__ void transpose_item(const float* W, int K, int N, bf16* WT, float* scr, int item, int nblk, int lane) {
    const int kb = item / nblk, nb = item % nblk, k0 = 64 * kb, n0 = 32 * nb;
    const int kr = lane >> 3, c4 = (lane & 7) * 4; const bool ok = n0 + c4 < N;
    f32x4 v[8];
#pragma unroll
    for (int i = 0; i < 8; ++i) v[i] = ok ? *(const f32x4*)(W + (size_t)(k0 + i * 8 + kr) * N + n0 + c4) : (f32x4){0.f, 0.f, 0.f, 0.f};
#pragma unroll
    for (int i = 0; i < 8; ++i) { float* d = scr + (i * 8 + kr) * 33 + c4; d[0] = v[i][0]; d[1] = v[i][1]; d[2] = v[i][2]; d[3] = v[i][3]; }
    __builtin_amdgcn_s_waitcnt(0); __builtin_amdgcn_wave_barrier();
    const int c = lane & 7;
#pragma unroll
    for (int j = 0; j < 4; ++j) { const int nn = (lane >> 3) + 8 * j; const float* s = scr + (8 * c) * 33 + nn;
        uint4 o; o.x = pk2(s[0 * 33], s[1 * 33]); o.y = pk2(s[2 * 33], s[3 * 33]); o.z = pk2(s[4 * 33], s[5 * 33]); o.w = pk2(s[6 * 33], s[7 * 33]);
        *(uint4*)(WT + (size_t)(n0 + nn) * K + k0 + 8 * c) = o; }
    __builtin_amdgcn_s_waitcnt(0); __builtin_amdgcn_wave_barrier();
}

__device__ __forceinline__ void phase_p0(const KP& p, float* sm) {
    const int tid = otid(), lane = tid & 63, wv = tid >> 6, G = gridDim.x;
    { bf16* AS = (bf16*)sm; const int nt = wv & 3, mh = wv >> 2, n = lane & 15, fq = lane >> 4;
      for (int u = blockIdx.x; u < 2 * 96; u += G) {
        const int l = u / 96, n0 = (u % 96) * 64 + nt * 16 + n;
        const float* W = p.in[11] + (size_t)l * DM * 6144 + n0;
        f32x4 acc[5];
#pragma unroll
        for (int m = 0; m < 5; ++m) acc[m] = (f32x4){0.f, 0.f, 0.f, 0.f};
        float wb[2][8];
#pragma unroll
        for (int ks = 0; ks < 2; ++ks)
#pragma unroll
            for (int j = 0; j < 8; ++j) wb[ks][j] = W[(size_t)(ks * 32 + fq * 8 + j) * 6144];
        for (int kc = 0; kc < DM; kc += 64) {
            __syncthreads();
            for (int i = tid; i < 144 * 32; i += NTHR) { const int r = i >> 5, k = (i & 31) * 2;
                float c0 = 0.f, c1 = 0.f;
                if (r < 8) { const float2 c = *(const float2*)(p.in[9] + (size_t)r * DM + kc + k); c0 = siluf_(c.x); c1 = siluf_(c.y); }
                else if (r < 136) { const float2 c = *(const float2*)(p.in[10] + (size_t)(r - 8) * DM + kc + k); c0 = siluf_(c.x); c1 = siluf_(c.y); }
                *(unsigned*)(AS + r * 72 + k) = pk2(c0, c1); }
            __syncthreads();
            bf16x8v B[2];
#pragma unroll
            for (int ks = 0; ks < 2; ++ks) { const uint4 t = pack8f(wb[ks]); B[ks] = __builtin_bit_cast(bf16x8v, t); }
            if (kc + 64 < DM) {
#pragma unroll
                for (int ks = 0; ks < 2; ++ks)
#pragma unroll
                    for (int j = 0; j < 8; ++j) wb[ks][j] = W[(size_t)(kc + 64 + ks * 32 + fq * 8 + j) * 6144]; }
#pragma unroll
            for (int ks = 0; ks < 2; ++ks)
#pragma unroll
                for (int m = 0; m < 5; ++m) { const int mt = mh * 5 + m; if (mt < 9) { const bf16x8v A = *(const bf16x8v*)(AS + (mt * 16 + n) * 72 + ks * 32 + fq * 8);
                    acc[m] = __builtin_amdgcn_mfma_f32_16x16x32_bf16(A, B[ks], acc[m], 0, 0, 0); } }
        }
        const float bias = p.in[12][(size_t)l * 6144 + n0];
        float* M = (float*)(p.ws + WS_MOD) + (size_t)l * 136 * 6144 + n0;
#pragma unroll
        for (int m = 0; m < 5; ++m) { const int mt = mh * 5 + m;
#pragma unroll
            for (int i = 0; i < 4; ++i) { const int row = mt * 16 + fq * 4 + i; if (mt < 9 && row < 136) M[(size_t)row * 6144] = acc[m][i] + bias; } }
      }
      __syncthreads(); }
    const int gw = blockIdx.x * NWAVES + wv, NGW = G * NWAVES;
    float* scr = sm + wv * (64 * 33);
    constexpr int I_IN = 16 * 128, I_OUT = 16 * 32, I_UP = 16 * 128, I_DN = 64 * 32, I_L = I_IN + I_OUT + I_UP + I_DN;
    for (int it = gw; it < 2 * I_L; it += NGW) {
        const int l = it / I_L; int r = it % I_L;
        if (r < I_IN) { transpose_item(p.in[15] + (size_t)l * DM * PT, DM, PT, (bf16*)(p.ws + WS_WTIN) + (size_t)l * UP * DM, scr, r, 128, lane); continue; } r -= I_IN;
        if (r < I_OUT) { transpose_item(p.in[16] + (size_t)l * DM * DM, DM, DM, (bf16*)(p.ws + WS_WTOUT) + (size_t)l * DM * DM, scr, r, 32, lane); continue; } r -= I_OUT;
        if (r < I_UP) { transpose_item(p.in[17] + (size_t)l * DM * DFF, DM, DFF, (bf16*)(p.ws + WS_WTUP) + (size_t)l * DFF * DM, scr, r, 128, lane); continue; } r -= I_UP;
        transpose_item(p.in[18] + (size_t)l * DFF * DM, DFF, DM, (bf16*)(p.ws + WS_WTDN) + (size_t)l * DM * DFF, scr, r, 32, lane);
    }
    __syncthreads();
}

__device__ __forceinline__ void load_xrow(f32x4 (&v)[4], const float* xf, const bf16* x16, int lane) {
    if (xf) {
#pragma unroll
        for (int j = 0; j < 4; ++j) v[j] = *(const f32x4*)(xf + lane * 4 + 256 * j); }
    else {
#pragma unroll
        for (int j = 0; j < 4; ++j) { const uint2 w = *(const uint2*)(x16 + lane * 4 + 256 * j);
            v[j] = (f32x4){__builtin_bit_cast(float, w.x << 16), __builtin_bit_cast(float, w.x & 0xffff0000u), __builtin_bit_cast(float, w.y << 16), __builtin_bit_cast(float, w.y & 0xffff0000u)}; } }
}
__device__ __forceinline__ void phase_norm(const KP& p, const float* xPf, const float* xSf, const float* nw, const float* modl, int sh_off, int sc_off, int gate_off) {
    const int tid = otid(), lane = tid & 63, wv = tid >> 6; const int gw = blockIdx.x * NWAVES + wv, NGW = gridDim.x * NWAVES;
    bf16* H = (bf16*)(p.ws + WS_H); bf16* X16 = (bf16*)(p.ws + WS_X16);
    f32x4 v[4], vn[4];
#define NRM_LOAD(dst, row) load_xrow(dst, (row) < MP ? (xPf ? xPf + (size_t)(row) * DM : nullptr) : (xSf ? xSf + (size_t)((row) - MP) * DM : nullptr), X16 + (size_t)(row) * DM, lane)
    if (gw < MROWS) NRM_LOAD(v, gw);
    for (int row = gw; row < MROWS; row += NGW) {
        if (row + NGW < MROWS) NRM_LOAD(vn, row + NGW);
        const int cond = row < MP ? (row >> 11) : 8 + ((row - MP) >> 3);
        const float* md = modl + (size_t)cond * 6144;
        if (row >= MP && gate_off != -1) {
            const float* P = (const float*)(p.ws + WS_PART) + (size_t)(row - MP) * DM; bf16* xo_ = X16 + (size_t)row * DM;
#pragma unroll
            for (int j = 0; j < 4; ++j) { const int c = lane * 4 + 256 * j; const f32x4 g = *(const f32x4*)(md + gate_off + c);
                const f32x4 sp = (*(const f32x4*)(P + c) + *(const f32x4*)(P + (size_t)1024 * DM + c)) + (*(const f32x4*)(P + (size_t)2048 * DM + c) + *(const f32x4*)(P + (size_t)3072 * DM + c));
                v[j] += g * sp; uint2 o; o.x = pk2(v[j][0], v[j][1]); o.y = pk2(v[j][2], v[j][3]); *(uint2*)(xo_ + c) = o; } }
        float ss = 0.f;
#pragma unroll
        for (int j = 0; j < 4; ++j) ss += v[j][0] * v[j][0] + v[j][1] * v[j][1] + v[j][2] * v[j][2] + v[j][3] * v[j][3];
        const float rs = rsqrtf(wave_sum(ss) * (1.f / DM) + 1e-6f);
#pragma unroll
        for (int j = 0; j < 4; ++j) { const int c = lane * 4 + 256 * j; const f32x4 w = *(const f32x4*)(nw + c), sc = *(const f32x4*)(md + sc_off + c), sh = *(const f32x4*)(md + sh_off + c);
            const f32x4 h = v[j] * rs * w * (sc + 1.f) + sh;
            uint2 o; o.x = pk2(h[0], h[1]); o.y = pk2(h[2], h[3]); *(uint2*)(H + (size_t)row * DM + c) = o; }
#pragma unroll
        for (int j = 0; j < 4; ++j) v[j] = vn[j];
    }
#undef NRM_LOAD
}
__device__ __forceinline__ void phase_final(const KP& p) {
    const int tid = otid(), lane = tid & 63, wv = tid >> 6; const int gw = blockIdx.x * NWAVES + wv, NGW = gridDim.x * NWAVES;
    const float* nw = p.in[43]; const bf16* X16 = (const bf16*)(p.ws + WS_X16);
    f32x4 v[4], vn[4];
    if (gw < MROWS) load_xrow(v, nullptr, X16 + (size_t)gw * DM, lane);
    for (int row = gw; row < MROWS; row += NGW) {
        float* x = p.out + (size_t)row * DM;
        if (row + NGW < MROWS) load_xrow(vn, nullptr, X16 + (size_t)(row + NGW) * DM, lane);
        if (row >= MP) { const float* P = (const float*)(p.ws + WS_PART) + (size_t)(row - MP) * DM; const float* md = (const float*)(p.ws + WS_MOD) + ((size_t)136 + 8 + ((row - MP) >> 3)) * 6144 + 5120;
#pragma unroll
            for (int j = 0; j < 4; ++j) { const int c = lane * 4 + 256 * j; const f32x4 g = *(const f32x4*)(md + c);
                const f32x4 sp = (*(const f32x4*)(P + c) + *(const f32x4*)(P + (size_t)1024 * DM + c)) + (*(const f32x4*)(P + (size_t)2048 * DM + c) + *(const f32x4*)(P + (size_t)3072 * DM + c));
                v[j] += g * sp; } }
        float ss = 0.f;
#pragma unroll
        for (int j = 0; j < 4; ++j) ss += v[j][0] * v[j][0] + v[j][1] * v[j][1] + v[j][2] * v[j][2] + v[j][3] * v[j][3];
        const float rs = rsqrtf(wave_sum(ss) * (1.f / DM) + 1e-6f);
#pragma unroll
        for (int j = 0; j < 4; ++j) { const int c = lane * 4 + 256 * j; *(f32x4*)(x + c) = v[j] * rs * *(const f32x4*)(nw + c); }
#pragma unroll
        for (int j = 0; j < 4; ++j) v[j] = vn[j];
    }
}

typedef float f32x2 __attribute__((ext_vector_type(2)));
constexpr int VST = 320, SL_VEC = 0, SL_VROW = 16 * VST, SL_PART = SL_VROW + 16 * 64, SL_SCAL = SL_PART + 16 * 16, SL_SIZE = SL_SCAL + 16 * 8;
static_assert(4 * SL_SIZE * 4 <= 131072, "scan LDS ring");
struct Item { int tr, b, h, half, T, NB, row0; };
struct V8 { f32x4 a, b; };
__device__ __forceinline__ V8 ld8(const float* q) { V8 v; v.a = *(const f32x4*)q; v.b = *(const f32x4*)(q + 4); return v; }
__device__ __forceinline__ float dot8(const V8& s, const V8& x) { const f32x4 t = s.a * x.a + s.b * x.b; return (t[0] + t[1]) + (t[2] + t[3]); }
__device__ __forceinline__ f32x2 dot8x2(const V8& s, const f32x4& p0, const f32x4& p1, const f32x4& p2, const f32x4& p3) {
    f32x2 a = (f32x2){s.a[0], s.a[0]} * (f32x2){p0[0], p0[1]}; f32x2 b = (f32x2){s.a[1], s.a[1]} * (f32x2){p0[2], p0[3]};
    a += (f32x2){s.a[2], s.a[2]} * (f32x2){p1[0], p1[1]}; b += (f32x2){s.a[3], s.a[3]} * (f32x2){p1[2], p1[3]};
    a += (f32x2){s.b[0], s.b[0]} * (f32x2){p2[0], p2[1]}; b += (f32x2){s.b[1], s.b[1]} * (f32x2){p2[2], p2[3]};
    a += (f32x2){s.b[2], s.b[2]} * (f32x2){p3[0], p3[1]}; b += (f32x2){s.b[3], s.b[3]} * (f32x2){p3[2], p3[3]};
    return a + b; }
__device__ __forceinline__ float red8(float v) { v += dppf<0xB1>(v); v += dppf<0x4E>(v); v += dppf<0x141>(v); return v; }
__device__ __forceinline__ float ldu(const bf16* U, int row, int col, int T) { row = row < T ? row : T - 1; return bf2f(U[(size_t)row * UP + col]); }
__device__ __forceinline__ void unpack8(const uint4 v, float (&o)[8]) {
    o[0] = __builtin_bit_cast(float, v.x << 16); o[1] = __builtin_bit_cast(float, v.x & 0xffff0000u); o[2] = __builtin_bit_cast(float, v.y << 16); o[3] = __builtin_bit_cast(float, v.y & 0xffff0000u);
    o[4] = __builtin_bit_cast(float, v.z << 16); o[5] = __builtin_bit_cast(float, v.z & 0xffff0000u); o[6] = __builtin_bit_cast(float, v.w << 16); o[7] = __builtin_bit_cast(float, v.w & 0xffff0000u); }
#define YKEEP2(tt, ya, yb) do { if ((tt) == sub) { yk0 = (ya); yk1 = (yb); } } while (0)
#define YSTORE2(bb) do { const int g0 = 16 * (bb) + sub; if (g0 < T) { Y[(size_t)g0 * DM + irow] = (bf16)f2bf(yk0); Y[(size_t)g0 * DM + irow + 16] = (bf16)f2bf(yk1); } } while (0)
__device__ __forceinline__ f32x2 dot4x2(const f32x4& s, const f32x4& p0, const f32x4& p1) {
    f32x2 a = (f32x2){s[0], s[0]} * (f32x2){p0[0], p0[1]}; f32x2 b = (f32x2){s[1], s[1]} * (f32x2){p0[2], p0[3]};
    a += (f32x2){s[2], s[2]} * (f32x2){p1[0], p1[1]}; b += (f32x2){s[3], s[3]} * (f32x2){p1[2], p1[3]};
    return a + b; }
__device__ __forceinline__ void red16x4(float x0, float x1, float x2, float x3, bool p0, bool p1, float& r0, float& r1, float& r2, float& r3) {
    float k0 = p0 ? x2 : x0, k1 = p0 ? x3 : x1; const float t0 = p0 ? x0 : x2, t1 = p0 ? x1 : x3;
    k0 += dppf<0xB1>(t0); k1 += dppf<0xB1>(t1);
    float m = p1 ? k1 : k0; const float u = p1 ? k0 : k1;
    m += dppf<0x4E>(u); m += dppf<0x124>(m); m += dppf<0x128>(m);
    r0 = dppf<0x00>(m); r2 = dppf<0x55>(m); r1 = dppf<0xAA>(m); r3 = dppf<0xFF>(m);
}
__device__ __forceinline__ void red16x2(float xa, float xb, bool p0, float& ra, float& rb) {
    float k = p0 ? xb : xa; const float t = p0 ? xa : xb;
    k += dppf<0xB1>(t); k += dppf<0x4E>(k); k += dppf<0x124>(k); k += dppf<0x128>(k);
    ra = dppf<0x00>(k); rb = dppf<0x55>(k);
}
__device__ __forceinline__ float dot4(const f32x4& s, const f32x4& x) { const f32x4 t = s * x; return (t[0] + t[1]) + (t[2] + t[3]); }
#define TICK_BAR() do { asm volatile("s_waitcnt lgkmcnt(0)" ::: "memory"); __builtin_amdgcn_s_barrier(); asm volatile("" ::: "memory"); } while (0)
__device__ __forceinline__ void scan_rwkv(const KP& p, int l, const Item& it, float* sm) {
    const int tid = otid(), lane = tid & 63, wv = tid >> 6, T = it.T, NBAT = (T + 15) >> 4;
    const bool scanner = wv < 4;
    const bf16* U = (const bf16*)(p.ws + WS_U) + (size_t)it.row0 * UP;
    const float* sh0 = it.tr ? p.in[2] + ((size_t)l * BS + it.b) * 896 : nullptr;
    const int rp = (tid & 255) >> 4, sub = tid & 15, nh = it.tr ? 2 : 1; const bool lp0 = (tid & 1) != 0, lp1 = (tid & 2) != 0; int irow = it.half * 32 + rp;
    bf16* Y = (bf16*)(p.ws + WS_H) + (size_t)it.row0 * DM + 0 * 256 + it.h * 64;
    float* sbase_o = p.out + (it.tr ? O_SWKV : O_PWKV) + (((size_t)l * it.NB + it.b) * 4 + it.h) * 4096 + sub * 4;
    const float* sbase_i = p.in[3] + (((size_t)l * BS + it.b) * 4 + it.h) * 4096 + sub * 4;
    f32x4 S0 = {0.f, 0.f, 0.f, 0.f}, S1 = S0, Q0 = S0, Q1 = S0, R0 = S0, R1 = S0;
    if (it.tr) { const float* q = sbase_i + ((wv >> 2) * 32 + rp) * 64; Q0 = *(const f32x4*)q; Q1 = *(const f32x4*)(q + 16 * 64); R0 = *(const f32x4*)(q + 4 * 4096); R1 = *(const f32x4*)(q + 4 * 4096 + 16 * 64); }
    float yk0 = 0.f, yk1 = 0.f;
    const int pj = wv & 3, n = lane & 15, fq = lane >> 4, c = pj * 16 + n, hc = it.h * 64 + c;
    const float* mu = p.in[19] + l * 896;
    bf16x8v Bw, Ba; float muw[8], mua[8];
#pragma unroll
    for (int j = 0; j < 8; ++j) { Bw[j] = (short)f2bf(p.in[21][((size_t)l * 32 + fq * 8 + j) * 256 + hc]); Ba[j] = (short)f2bf(p.in[23][((size_t)l * 32 + fq * 8 + j) * 256 + hc]);
        muw[j] = mu[768 + fq * 8 + j]; mua[j] = mu[800 + fq * 8 + j]; }
    const float w0c = p.in[20][l * 256 + hc], a0c = p.in[22][l * 256 + hc], kkc = p.in[25][l * 256 + hc], kac = p.in[26][l * 256 + hc], rkc = p.in[27][l * 256 + hc];
    const float mur = mu[hc], muk = mu[256 + hc], muv = mu[512 + hc];
    struct RwRaw { uint4 wc, wp, ac, ap; float rr[5], rk[5], rv[5]; } cur;
#define RW_LOAD(R, bb) do { const int ta = 16 * (bb) + n;              \
        { const int tc_ = ta < T ? ta : T - 1; const bf16* q = U + (size_t)tc_ * UP + 768 + fq * 8; R.wc = *(const uint4*)q; R.ac = *(const uint4*)(q + 32); \
          const bool sb_ = it.tr && tc_ == 8; const float* shx_ = sb_ ? sh0 + 896 : sh0;     \
          if (tc_ > 0 && !sb_) { R.wp = *(const uint4*)(q - UP); R.ap = *(const uint4*)(q + 32 - UP); } \
          else if (sh0) { R.wp = pack8f(shx_ + 768 + fq * 8); R.ap = pack8f(shx_ + 800 + fq * 8); } else { R.wp = (uint4){0u, 0u, 0u, 0u}; R.ap = R.wp; } } \
        _Pragma("unroll") for (int i = 0; i < 5; ++i) { const int g = 16 * (bb) + fq * 4 - 1 + i; \
            const bool sb_ = it.tr && fq == 2 && i == 0; const float* shx_ = sb_ ? sh0 + 896 : sh0;     \
            if (g >= 0 && !sb_) { R.rr[i] = ldu(U, g, hc, T); R.rk[i] = ldu(U, g, 256 + hc, T); R.rv[i] = ldu(U, g, 512 + hc, T); } \
            else if (sh0) { R.rr[i] = shx_[hc]; R.rk[i] = shx_[256 + hc]; R.rv[i] = shx_[512 + hc]; } else { R.rr[i] = R.rk[i] = R.rv[i] = 0.f; } } } while (0)
    if (!scanner) RW_LOAD(cur, 0);
    for (int k = 0; k < NBAT + 2; ++k) {
        if (scanner || it.tr) {
            const int b = k - 2;
            if (b >= 0 && b < NBAT) {
                const float* SL = sm + (b & 3) * SL_SIZE; const int ns = (T - 16 * b) < 16 ? (T - 16 * b) : 16;
                { const int hv = wv >> 2;
                if (it.tr) irow = hv * 32 + rp;
                const int nsq = it.tr ? 8 : ns;
                for (int sq = 0; sq < (it.tr ? 2 : 1); ++sq) {
                if (it.tr) { S0 = sq ? R0 : Q0; S1 = sq ? R1 : Q1; }
#define RW_STEP(tt, q0, q1, w, bb, kp, va, vb, sc) do { const f32x2 da = dot4x2(S0, q0, q1), db = dot4x2(S1, q0, q1); \
                    float a1, a2, b1, b2; red16x4(da.x, da.y, db.x, db.y, lp0, lp1, a1, a2, b1, b2); \
                    const float ca = sc[0] * a1, cb = sc[0] * b1;                                       \
                    const float ya = a2 - ca * sc[1] + va * sc[2], yb = b2 - cb * sc[1] + vb * sc[2]; \
                    S0 = S0 * w + (kp * va - bb * ca); S1 = S1 * w + (kp * vb - bb * cb); YKEEP2(tt, ya, yb); } while (0)
                for (int tt = sq * 8; tt < sq * 8 + nsq; tt += 2) {
                    const float* V0 = SL + SL_VEC + tt * VST + sub * 4; const float* V1 = V0 + VST; const float* P0 = V0 + sub * 4; const float* P1 = P0 + VST;
                    const f32x4 a0 = *(const f32x4*)P0, a1_ = *(const f32x4*)(P0 + 4), w0 = *(const f32x4*)(V0 + 128), bb0 = *(const f32x4*)(V0 + 192), kp0 = *(const f32x4*)(V0 + 256);
                    const float va0 = SL[SL_VROW + tt * 64 + irow], vb0 = SL[SL_VROW + tt * 64 + irow + 16]; const f32x4 sc0 = *(const f32x4*)(SL + SL_SCAL + tt * 8);
                    const f32x4 e0 = *(const f32x4*)P1, e1 = *(const f32x4*)(P1 + 4), w1 = *(const f32x4*)(V1 + 128), bb1 = *(const f32x4*)(V1 + 192), kp1 = *(const f32x4*)(V1 + 256);
                    const float va1 = SL[SL_VROW + (tt + 1) * 64 + irow], vb1 = SL[SL_VROW + (tt + 1) * 64 + irow + 16]; const f32x4 sc1 = *(const f32x4*)(SL + SL_SCAL + (tt + 1) * 8);
                    RW_STEP(tt, a0, a1_, w0, bb0, kp0, va0, vb0, sc0);
                    RW_STEP(tt + 1, e0, e1, w1, bb1, kp1, va1, vb1, sc1);
                }
                if (it.tr) { float* o_ = sbase_o + sq * (4 * 4096); *(f32x4*)(o_ + irow * 64) = S0; *(f32x4*)(o_ + (irow + 16) * 64) = S1; }
                }
#undef RW_STEP
                YSTORE2(b);
                }
            }
        }
        if (!scanner) {
            if (k >= 1 && k - 1 < NBAT && lane < 4) {
                const int tt = pj * 4 + lane; float* SL = sm + ((k - 1) & 3) * SL_SIZE; const float* P = SL + SL_PART + tt * 16;
                const f32x4 s = *(const f32x4*)P + *(const f32x4*)(P + 4) + *(const f32x4*)(P + 8) + *(const f32x4*)(P + 12);
                const float rn2 = __builtin_amdgcn_rcpf(s[0] + 1e-6f);
                *(f32x4*)(SL + SL_SCAL + tt * 8) = (f32x4){rn2, s[1], s[2], 0.f};
                const int g = 16 * (k - 1) + tt; if (it.half == 0 && g < T) ((float*)(p.ws + WS_AUX))[((size_t)it.row0 + g) * 4 + it.h] = s[3];
            }
            if (k < NBAT) {
                float xw[8], xa[8], cu[8], pr[8];
                unpack8(cur.wc, cu); unpack8(cur.wp, pr);
#pragma unroll
                for (int j = 0; j < 8; ++j) xw[j] = tanhf_(cu[j] + (pr[j] - cu[j]) * muw[j]);
                unpack8(cur.ac, cu); unpack8(cur.ap, pr);
#pragma unroll
                for (int j = 0; j < 8; ++j) xa[j] = cu[j] + (pr[j] - cu[j]) * mua[j];
                const uint4 Awu = pack8f(xw), Aau = pack8f(xa);
                const bf16x8v Aw = __builtin_bit_cast(bf16x8v, Awu), Aa = __builtin_bit_cast(bf16x8v, Aau);
                const f32x4 z = {0.f, 0.f, 0.f, 0.f};
                const f32x4 dw = __builtin_amdgcn_mfma_f32_16x16x32_bf16(Aw, Bw, z, 0, 0, 0), da = __builtin_amdgcn_mfma_f32_16x16x32_bf16(Aa, Ba, z, 0, 0, 0);
                float xr_[4], xk_[4], xv_[4];
#pragma unroll
                for (int i = 0; i < 4; ++i) { xr_[i] = cur.rr[i + 1] + (cur.rr[i] - cur.rr[i + 1]) * mur; xk_[i] = cur.rk[i + 1] + (cur.rk[i] - cur.rk[i + 1]) * muk; xv_[i] = cur.rv[i + 1] + (cur.rv[i] - cur.rv[i + 1]) * muv; }
                if (k + 1 < NBAT) RW_LOAD(cur, k + 1);
                float* SL = sm + (k & 3) * SL_SIZE;
#pragma unroll
                for (int i = 0; i < 4; ++i) { const int tt = fq * 4 + i;
                    const float w = __expf(-0.6065306597f * sigmoidf_(w0c + dw[i])), a = sigmoidf_(a0c + da[i]);
                    const float kkraw = xk_[i] * kkc, braw = kkraw * a, kp = xk_[i] * (1.f + (a - 1.f) * kac);
                    float* V = SL + SL_VEC + tt * VST + c; *(f32x2*)(V + c) = (f32x2){kkraw, w * xr_[i]}; V[128] = w; V[192] = braw; V[256] = kp; SL[SL_VROW + tt * 64 + c] = xv_[i];
                    float p0, p1, p2, p3; red16x4(kkraw * kkraw, braw * xr_[i], kp * xr_[i], xr_[i] * kp * rkc, lp0, lp1, p0, p1, p2, p3);
                    if (n == 0) *(f32x4*)(SL + SL_PART + tt * 16 + pj * 4) = (f32x4){p0, p1, p2, p3}; }
            }
        }
        TICK_BAR();
    }
#undef RW_LOAD
    if (scanner) { if (!it.tr) { *(f32x4*)(sbase_o + irow * 64) = S0; *(f32x4*)(sbase_o + (irow + 16) * 64) = S1; } }
    else if (it.h == 0 && it.half == 0) { float* so = p.out + (it.tr ? O_SSHIFT : O_PSHIFT) + ((size_t)l * it.NB + it.b) * 896;
        for (int cc = tid - 256; cc < 896; cc += 256) { so[cc] = bf2f(U[(size_t)(it.tr ? 7 : T - 1) * UP + cc]); if (it.tr) so[896 + cc] = bf2f(U[(size_t)15 * UP + cc]); } }
}

__device__ __forceinline__ void scan_gla(const KP& p, int l, const Item& it, float* sm) {
    const int tid = otid(), lane = tid & 63, wv = tid >> 6, T = it.T, NBAT = (T + 15) >> 4;
    const bool scanner = wv < 4;
    const bf16* U = (const bf16*)(p.ws + WS_U) + (size_t)it.row0 * UP + CB;
    const int rp = (tid & 255) >> 4, sub = tid & 15, nh = it.tr ? 2 : 1; const bool lp0 = (tid & 1) != 0, lp1 = (tid & 2) != 0; int irow = it.half * 32 + rp;
    bf16* Y = (bf16*)(p.ws + WS_H) + (size_t)it.row0 * DM + 1 * 256 + it.h * 64;
    const size_t sbase = (((size_t)l * it.NB + it.b) * 4 + it.h) * 4096;
    f32x4 S0 = {0.f, 0.f, 0.f, 0.f}, S1 = S0, Q0 = S0, Q1 = S0, R0 = S0, R1 = S0; float* so = p.out + (it.tr ? O_SGLA : O_PGLA) + sbase + (size_t)sub * 4 * 64; const float* si = p.in[4] + sbase + (size_t)sub * 4 * 64;
    if (it.tr) { const int r0 = (wv >> 2) * 32 + rp;
#pragma unroll
        for (int e = 0; e < 4; ++e) { Q0[e] = si[e * 64 + r0]; Q1[e] = si[e * 64 + r0 + 16]; R0[e] = si[4 * 4096 + e * 64 + r0]; R1[e] = si[4 * 4096 + e * 64 + r0 + 16]; } }
    float yk0 = 0.f, yk1 = 0.f;
    const int pj = wv & 3, n = lane & 15, fq = lane >> 4, c = pj * 16 + n, hc = it.h * 64 + c;
    float gkw[16];
#pragma unroll
    for (int j = 0; j < 16; ++j) gkw[j] = p.in[30][((size_t)l * 16 + j) * 256 + hc];
    const float gkb = p.in[31][l * 256 + hc];
    struct GlRaw { float q_[4], k_[4], v_[4]; uint4 g0[4], g1[4]; } cur;
#define GL_LOAD(R, bb) do { _Pragma("unroll") for (int i = 0; i < 4; ++i) { int g = 16 * (bb) + fq * 4 + i; g = g < T ? g : T - 1; const bf16* q = U + (size_t)g * UP; \
        R.q_[i] = bf2f(q[hc]); R.k_[i] = bf2f(q[256 + hc]); R.v_[i] = bf2f(q[512 + hc]); R.g0[i] = *(const uint4*)(q + 1024); R.g1[i] = *(const uint4*)(q + 1032); } } while (0)
    if (!scanner) GL_LOAD(cur, 0);
    for (int k = 0; k < NBAT + 2; ++k) {
        if (scanner || it.tr) {
            const int b = k - 2;
            if (b >= 0 && b < NBAT) {
                const float* SL = sm + (b & 3) * SL_SIZE; const int ns = (T - 16 * b) < 16 ? (T - 16 * b) : 16;
                { const int hv = wv >> 2;
                if (it.tr) irow = hv * 32 + rp;
                const int nsq = it.tr ? 8 : ns;
                for (int sq = 0; sq < (it.tr ? 2 : 1); ++sq) {
                if (it.tr) { S0 = sq ? R0 : Q0; S1 = sq ? R1 : Q1; }
#define GL_STEP(tt, dec, kv, qd, va, vb, qk) do { float da, db; red16x2(dot4(S0, qd), dot4(S1, qd), lp0, da, db); const float ya = da + va * qk, yb = db + vb * qk; \
                    S0 = S0 * dec + kv * va; S1 = S1 * dec + kv * vb; YKEEP2(tt, ya, yb); } while (0)
                for (int tt = sq * 8; tt < sq * 8 + nsq; tt += 2) {
                    const float* V0 = SL + SL_VEC + tt * VST + sub * 4; const float* V1 = V0 + VST;
                    const f32x4 qd0 = *(const f32x4*)(V0 + 128), dec0 = *(const f32x4*)V0, kv0 = *(const f32x4*)(V0 + 64); const float va0 = SL[SL_VROW + tt * 64 + irow], vb0 = SL[SL_VROW + tt * 64 + irow + 16], qk0 = SL[SL_SCAL + tt * 8];
                    const f32x4 qd1 = *(const f32x4*)(V1 + 128), dec1 = *(const f32x4*)V1, kv1 = *(const f32x4*)(V1 + 64); const float va1 = SL[SL_VROW + (tt + 1) * 64 + irow], vb1 = SL[SL_VROW + (tt + 1) * 64 + irow + 16], qk1 = SL[SL_SCAL + (tt + 1) * 8];
                    GL_STEP(tt, dec0, kv0, qd0, va0, vb0, qk0);
                    GL_STEP(tt + 1, dec1, kv1, qd1, va1, vb1, qk1);
                }
                if (it.tr) { float* o_ = so + sq * (4 * 4096);
#pragma unroll
                    for (int e = 0; e < 4; ++e) { o_[e * 64 + irow] = S0[e]; o_[e * 64 + irow + 16] = S1[e]; } }
                }
#undef GL_STEP
                YSTORE2(b);
                }
            }
        }
        if (!scanner) {
            if (k >= 1 && k - 1 < NBAT && lane < 4) { const int tt = pj * 4 + lane; float* SL = sm + ((k - 1) & 3) * SL_SIZE; const float* P = SL + SL_PART + tt * 16;
                SL[SL_SCAL + tt * 8] = P[0] + P[4] + P[8] + P[12]; }
            if (k < NBAT) {
                float x[4], qq[4], kk[4], vv[4];
#pragma unroll
                for (int i = 0; i < 4; ++i) { float gl[8]; x[i] = gkb; unpack8(cur.g0[i], gl);
#pragma unroll
                    for (int j = 0; j < 8; ++j) x[i] += gl[j] * gkw[j];
                    unpack8(cur.g1[i], gl);
#pragma unroll
                    for (int j = 0; j < 8; ++j) x[i] += gl[j] * gkw[8 + j];
                    qq[i] = cur.q_[i] * 0.125f; kk[i] = cur.k_[i]; vv[i] = cur.v_[i]; }
                if (k + 1 < NBAT) GL_LOAD(cur, k + 1);
                float* SL = sm + (k & 3) * SL_SIZE;
#pragma unroll
                for (int i = 0; i < 4; ++i) { const int tt = fq * 4 + i;
                    const float dec = __expf(-softplusf_(-x[i]) * (1.f / 16.f));
                    float* V = SL + SL_VEC + tt * VST + c; V[0] = dec; V[64] = kk[i]; V[128] = qq[i] * dec; SL[SL_VROW + tt * 64 + c] = vv[i];
                    const float p0 = red16(qq[i] * kk[i]);
                    if (n == 0) SL[SL_PART + tt * 16 + pj * 4] = p0; }
            }
        }
        TICK_BAR();
    }
#undef GL_LOAD
    if (scanner && !it.tr) {
#pragma unroll
        for (int e = 0; e < 4; ++e) { so[e * 64 + irow] = S0[e]; so[e * 64 + irow + 16] = S1[e]; } }
}

__device__ __forceinline__ void scan_dn(const KP& p, int l, const Item& it, float* sm) {
    const int tid = otid(), lane = tid & 63, wv = tid >> 6, T = it.T, NBAT = (T + 15) >> 4;
    const bool scanner = wv < 4;
    const bf16* U = (const bf16*)(p.ws + WS_U) + (size_t)it.row0 * UP + CC;
    const float* cv0 = it.tr ? p.in[5] + ((size_t)l * BS + it.b) * 3 * 768 : nullptr;
    const int rp = (tid & 255) >> 4, sub = tid & 15, nh = it.tr ? 2 : 1; const bool lp0 = (tid & 1) != 0, lp1 = (tid & 2) != 0; int irow = it.half * 32 + rp;
    bf16* Y = (bf16*)(p.ws + WS_H) + (size_t)it.row0 * DM + 2 * 256 + it.h * 64;
    const size_t sbase = (((size_t)l * it.NB + it.b) * 4 + it.h) * 4096;
    f32x4 S0 = {0.f, 0.f, 0.f, 0.f}, S1 = S0, Q0 = S0, Q1 = S0, R0 = S0, R1 = S0; float* so = p.out + (it.tr ? O_SDN : O_PDN) + sbase + (size_t)sub * 4 * 64; const float* si = p.in[6] + sbase + (size_t)sub * 4 * 64;
    if (it.tr) { const int r0 = (wv >> 2) * 32 + rp;
#pragma unroll
        for (int e = 0; e < 4; ++e) { Q0[e] = si[e * 64 + r0]; Q1[e] = si[e * 64 + r0 + 16]; R0[e] = si[4 * 4096 + e * 64 + r0]; R1[e] = si[4 * 4096 + e * 64 + r0 + 16]; } }
    float yk0 = 0.f, yk1 = 0.f;
    const int pj = wv & 3, n = lane & 15, fq = lane >> 4, c = pj * 16 + n, hc = it.h * 64 + c;
    float cw[3][4];
#pragma unroll
    for (int pt = 0; pt < 3; ++pt)
#pragma unroll
        for (int i = 0; i < 4; ++i) cw[pt][i] = p.in[33][((size_t)l * 4 + i) * 768 + pt * 256 + hc];
    const float nA = -__expf(p.in[34][l * 4 + it.h]), dtb = p.in[35][l * 4 + it.h];
    struct DnRaw { float xin[3][7]; } cur;
#define DN_LOAD(R, bb) do { _Pragma("unroll") for (int pt = 0; pt < 3; ++pt) _Pragma("unroll") for (int i = 0; i < 7; ++i) { const int g = 16 * (bb) + fq * 4 - 3 + i; \
        R.xin[pt][i] = (it.tr && fq == 2 && i < 3) ? cv0[(3 + i) * 768 + pt * 256 + hc] : g >= 0 ? ldu(U, g, pt * 256 + hc, T) : (cv0 ? cv0[(3 + g) * 768 + pt * 256 + hc] : 0.f); } } while (0)
    if (!scanner) DN_LOAD(cur, 0);
    for (int k = 0; k < NBAT + 2; ++k) {
        if (scanner || it.tr) {
            const int b = k - 2;
            if (b >= 0 && b < NBAT) {
                const float* SL = sm + (b & 3) * SL_SIZE; const int ns = (T - 16 * b) < 16 ? (T - 16 * b) : 16;
                { const int hv = wv >> 2;
                if (it.tr) irow = hv * 32 + rp;
                const int nsq = it.tr ? 8 : ns;
                for (int sq = 0; sq < (it.tr ? 2 : 1); ++sq) {
                if (it.tr) { S0 = sq ? R0 : Q0; S1 = sq ? R1 : Q1; }
#define DN_STEP(tt, q0, q1, kv, va, vb, sc, sq) do { const f32x2 da = dot4x2(S0, q0, q1), db = dot4x2(S1, q0, q1);        \
                    float a1, a2, b1, b2; red16x4(da.x, da.y, db.x, db.y, lp0, lp1, a1, a2, b1, b2); \
                    const float na = sc[1] * (va - sc[0] * sc[2] * a1), nb = sc[1] * (vb - sc[0] * sc[2] * b1); \
                    const float ya = sc[0] * sc[3] * a2 + na * sq, yb = sc[0] * sc[3] * b2 + nb * sq; \
                    S0 = S0 * sc[0] + kv * (na * sc[2]); S1 = S1 * sc[0] + kv * (nb * sc[2]); YKEEP2(tt, ya, yb); } while (0)
                for (int tt = sq * 8; tt < sq * 8 + nsq; tt += 2) {
                    const float* V0 = SL + SL_VEC + tt * VST + sub * 4; const float* V1 = V0 + VST; const float* P0 = V0 + sub * 4; const float* P1 = P0 + VST;
                    const f32x4 a0 = *(const f32x4*)P0, a1_ = *(const f32x4*)(P0 + 4), kv0 = *(const f32x4*)(V0 + 128);
                    const float va0 = SL[SL_VROW + tt * 64 + irow], vb0 = SL[SL_VROW + tt * 64 + irow + 16]; const f32x4 sc0 = *(const f32x4*)(SL + SL_SCAL + tt * 8); const float sq0 = SL[SL_SCAL + tt * 8 + 4];
                    const f32x4 e0 = *(const f32x4*)P1, e1 = *(const f32x4*)(P1 + 4), kv1 = *(const f32x4*)(V1 + 128);
                    const float va1 = SL[SL_VROW + (tt + 1) * 64 + irow], vb1 = SL[SL_VROW + (tt + 1) * 64 + irow + 16]; const f32x4 sc1 = *(const f32x4*)(SL + SL_SCAL + (tt + 1) * 8); const float sq1 = SL[SL_SCAL + (tt + 1) * 8 + 4];
                    DN_STEP(tt, a0, a1_, kv0, va0, vb0, sc0, sq0);
                    DN_STEP(tt + 1, e0, e1, kv1, va1, vb1, sc1, sq1);
                }
                if (it.tr) { float* o_ = so + sq * (4 * 4096);
#pragma unroll
                    for (int e = 0; e < 4; ++e) { o_[e * 64 + irow] = S0[e]; o_[e * 64 + irow + 16] = S1[e]; } }
                }
#undef DN_STEP
                YSTORE2(b);
                }
            }
        }
        if (!scanner) {
            if (k >= 1 && k - 1 < NBAT && lane < 4) { const int tt = pj * 4 + lane; float* SL = sm + ((k - 1) & 3) * SL_SIZE; const float* P = SL + SL_PART + tt * 16;
                const f32x4 s = *(const f32x4*)P + *(const f32x4*)(P + 4) + *(const f32x4*)(P + 8) + *(const f32x4*)(P + 12);
                const float rq8 = rsqrtf(s[0] + 1e-6f) * 0.125f, rk = rsqrtf(s[1] + 1e-6f);
                int g = 16 * (k - 1) + tt; g = g < T ? g : T - 1;
                const float beta = sigmoidf_(bf2f(U[(size_t)g * UP + 1028 + it.h])), eg = __expf(nA * softplusf_(bf2f(U[(size_t)g * UP + 1024 + it.h]) + dtb));
                *(f32x4*)(SL + SL_SCAL + tt * 8) = (f32x4){eg, beta, rk, rq8}; SL[SL_SCAL + tt * 8 + 4] = s[2] * rq8 * rk; }
            if (k < NBAT) {
                float o[3][4];
#pragma unroll
                for (int pt = 0; pt < 3; ++pt)
#pragma unroll
                    for (int i = 0; i < 4; ++i) o[pt][i] = siluf_(cw[pt][0] * cur.xin[pt][i] + cw[pt][1] * cur.xin[pt][i + 1] + cw[pt][2] * cur.xin[pt][i + 2] + cw[pt][3] * cur.xin[pt][i + 3]);
                if (k + 1 < NBAT) DN_LOAD(cur, k + 1);
                float* SL = sm + (k & 3) * SL_SIZE;
#pragma unroll
                for (int i = 0; i < 4; ++i) { const int tt = fq * 4 + i;
                    float* V = SL + SL_VEC + tt * VST + c; *(f32x2*)(V + c) = (f32x2){o[1][i], o[0][i]}; V[128] = o[1][i]; SL[SL_VROW + tt * 64 + c] = o[2][i];
                    const float p0 = red16(o[0][i] * o[0][i]), p1 = red16(o[1][i] * o[1][i]), p2 = red16(o[0][i] * o[1][i]);
                    if (n == 0) *(f32x4*)(SL + SL_PART + tt * 16 + pj * 4) = (f32x4){p0, p1, p2, 0.f}; }
            }
        }
        TICK_BAR();
    }
#undef DN_LOAD
    if (scanner) { if (!it.tr) {
#pragma unroll
        for (int e = 0; e < 4; ++e) { so[e * 64 + irow] = S0[e]; so[e * 64 + irow + 16] = S1[e]; } } }
    else if (it.h == 0 && it.half == 0) { float* so = p.out + (it.tr ? O_SDNC : O_PDNC) + ((size_t)l * it.NB + it.b) * 3 * 768;
        for (int i = tid - 256; i < 3 * 768; i += 256) { const int rr = i / 768, cc = i % 768; so[i] = bf2f(U[(size_t)((it.tr ? 5 : T - 3) + rr) * UP + cc]); if (it.tr) so[3 * 768 + i] = bf2f(U[(size_t)(13 + rr) * UP + cc]); } }
}

__device__ __forceinline__ void scan_ssd(const KP& p, int l, const Item& it, float* sm) {
    const int tid = otid(), lane = tid & 63, wv = tid >> 6, T = it.T, NBAT = (T + 15) >> 4, grp = it.h >> 1;
    const bool scanner = wv < 4;
    const bf16* U = (const bf16*)(p.ws + WS_U) + (size_t)it.row0 * UP + CD;
    const bf16* UX = U + 256;
    const float* cv0 = it.tr ? p.in[7] + ((size_t)l * BS + it.b) * 3 * 768 : nullptr;
    const int rp = (tid & 255) >> 4, sub = tid & 15, nh = it.tr ? 2 : 1; const bool lp0 = (tid & 1) != 0, lp1 = (tid & 2) != 0; int irow = it.half * 32 + rp;
    bf16* Y = (bf16*)(p.ws + WS_H) + (size_t)it.row0 * DM + 3 * 256 + it.h * 64;
    const size_t sbase = (((size_t)l * it.NB + it.b) * 4 + it.h) * 64 * 128 + sub * 8; float* so = p.out + (it.tr ? O_SSSM : O_PSSM) + sbase; const float* si = p.in[8] + sbase;
    V8 S0, S1; S0.a = (f32x4){0.f, 0.f, 0.f, 0.f}; S0.b = S0.a; S1 = S0;
    V8 Q0 = S0, Q1 = S0, R0 = S0, R1 = S0;
    if (it.tr) { const int r0 = (wv >> 2) * 32 + rp; Q0 = ld8(si + r0 * 128); Q1 = ld8(si + (r0 + 16) * 128); R0 = ld8(si + 4 * 8192 + r0 * 128); R1 = ld8(si + 4 * 8192 + (r0 + 16) * 128); }
    float yk0 = 0.f, yk1 = 0.f;
    const int pj = wv & 3, n = lane & 15, fq = lane >> 4, c = pj * 16 + n;
    int ch[5]; ch[0] = it.h * 64 + c; ch[1] = 256 + grp * 128 + pj * 32 + n; ch[2] = ch[1] + 16; ch[3] = ch[1] + 256; ch[4] = ch[3] + 16;
    float cw[5][4], cb[5];
#pragma unroll
    for (int q = 0; q < 5; ++q) { cb[q] = p.in[38][(size_t)l * 768 + ch[q]];
#pragma unroll
        for (int i = 0; i < 4; ++i) cw[q][i] = p.in[37][((size_t)l * 4 + i) * 768 + ch[q]]; }
    const float nA = -__expf(p.in[40][l * 4 + it.h]), dtb = p.in[39][l * 4 + it.h], Dh = p.in[41][l * 4 + it.h];
    struct SsRaw { float xin[5][7]; } cur;
#define SS_LOAD(R, bb) do { _Pragma("unroll") for (int q = 0; q < 5; ++q) _Pragma("unroll") for (int i = 0; i < 7; ++i) { const int g = 16 * (bb) + fq * 4 - 3 + i; \
        R.xin[q][i] = (it.tr && fq == 2 && i < 3) ? cv0[(3 + i) * 768 + ch[q]] : g >= 0 ? ldu(UX, g, ch[q], T) : (cv0 ? cv0[(3 + g) * 768 + ch[q]] : 0.f); } } while (0)
    if (!scanner) SS_LOAD(cur, 0);
    for (int k = 0; k < NBAT + 2; ++k) {
        if (scanner || it.tr) {
            const int b = k - 2;
            if (b >= 0 && b < NBAT) {
                const float* SL = sm + (b & 3) * SL_SIZE; const int ns = (T - 16 * b) < 16 ? (T - 16 * b) : 16;
                { const int hv = wv >> 2;
                if (it.tr) irow = hv * 32 + rp;
                const int nsq = it.tr ? 8 : ns;
                for (int sq = 0; sq < (it.tr ? 2 : 1); ++sq) {
                if (it.tr) { S0 = sq ? R0 : Q0; S1 = sq ? R1 : Q1; }
#define SS_STEP(tt, Bv, Cv, xa, xb, sc) do { float da, db; red16x2(dot8(S0, Cv), dot8(S1, Cv), lp0, da, db); const float ta = xa * sc[1], tb = xb * sc[1];        \
                    const float ya = sc[0] * da + ta * sc[2] + Dh * xa, yb = sc[0] * db + tb * sc[2] + Dh * xb; \
                    S0.a = S0.a * sc[0] + Bv.a * ta; S0.b = S0.b * sc[0] + Bv.b * ta; S1.a = S1.a * sc[0] + Bv.a * tb; S1.b = S1.b * sc[0] + Bv.b * tb; YKEEP2(tt, ya, yb); } while (0)
                for (int tt = sq * 8; tt < sq * 8 + nsq; tt += 2) {
                    const float* V0 = SL + SL_VEC + tt * VST + sub * 8; const float* V1 = V0 + VST;
                    const V8 C0 = ld8(V0 + 128), B0 = ld8(V0); const float xa0 = SL[SL_VROW + tt * 64 + irow], xb0 = SL[SL_VROW + tt * 64 + irow + 16]; const f32x4 sc0 = *(const f32x4*)(SL + SL_SCAL + tt * 8);
                    const V8 C1 = ld8(V1 + 128), B1 = ld8(V1); const float xa1 = SL[SL_VROW + (tt + 1) * 64 + irow], xb1 = SL[SL_VROW + (tt + 1) * 64 + irow + 16]; const f32x4 sc1 = *(const f32x4*)(SL + SL_SCAL + (tt + 1) * 8);
                    SS_STEP(tt, B0, C0, xa0, xb0, sc0);
                    SS_STEP(tt + 1, B1, C1, xa1, xb1, sc1);
                }
                if (it.tr) { float* o0 = so + sq * (4 * 8192) + irow * 128; float* o1 = o0 + 16 * 128; *(f32x4*)o0 = S0.a; *(f32x4*)(o0 + 4) = S0.b; *(f32x4*)o1 = S1.a; *(f32x4*)(o1 + 4) = S1.b; }
                }
#undef SS_STEP
                YSTORE2(b);
                }
            }
        }
        if (!scanner) {
            if (k >= 1 && k - 1 < NBAT && lane < 4) { const int tt = pj * 4 + lane; float* SL = sm + ((k - 1) & 3) * SL_SIZE; const float* P = SL + SL_PART + tt * 16;
                const float bc = P[0] + P[4] + P[8] + P[12];
                int g = 16 * (k - 1) + tt; g = g < T ? g : T - 1;
                const float dt = softplusf_(bf2f(U[(size_t)g * UP + 1024 + it.h]) + dtb);
                *(f32x4*)(SL + SL_SCAL + tt * 8) = (f32x4){__expf(nA * dt), dt, bc, 0.f}; }
            if (k < NBAT) {
                float o[5][4];
#pragma unroll
                for (int q = 0; q < 5; ++q)
#pragma unroll
                    for (int i = 0; i < 4; ++i) o[q][i] = siluf_(cb[q] + cw[q][0] * cur.xin[q][i] + cw[q][1] * cur.xin[q][i + 1] + cw[q][2] * cur.xin[q][i + 2] + cw[q][3] * cur.xin[q][i + 3]);
                if (k + 1 < NBAT) SS_LOAD(cur, k + 1);
                float* SL = sm + (k & 3) * SL_SIZE;
#pragma unroll
                for (int i = 0; i < 4; ++i) { const int tt = fq * 4 + i;
                    float* V = SL + SL_VEC + tt * VST; V[pj * 32 + n] = o[1][i]; V[pj * 32 + 16 + n] = o[2][i]; V[128 + pj * 32 + n] = o[3][i]; V[128 + pj * 32 + 16 + n] = o[4][i]; SL[SL_VROW + tt * 64 + c] = o[0][i];
                    const float p0 = red16(o[1][i] * o[3][i] + o[2][i] * o[4][i]);
                    if (n == 0) SL[SL_PART + tt * 16 + pj * 4] = p0; }
            }
        }
        TICK_BAR();
    }
#undef SS_LOAD
    if (scanner) { if (!it.tr) { float* o0 = so + irow * 128; float* o1 = so + (irow + 16) * 128; *(f32x4*)o0 = S0.a; *(f32x4*)(o0 + 4) = S0.b; *(f32x4*)o1 = S1.a; *(f32x4*)(o1 + 4) = S1.b; } }
    else if (it.h == 0 && it.half == 0) { float* so = p.out + (it.tr ? O_SSSC : O_PSSC) + ((size_t)l * it.NB + it.b) * 3 * 768;
        for (int i = tid - 256; i < 3 * 768; i += 256) { const int rr = i / 768, cc = i % 768; so[i] = bf2f(UX[(size_t)((it.tr ? 5 : T - 3) + rr) * UP + cc]); if (it.tr) so[3 * 768 + i] = bf2f(UX[(size_t)(13 + rr) * UP + cc]); } }
}

__device__ __forceinline__ void run_item(const KP& p, int l, int tr, int idx, float* sm) {
    Item it; it.tr = tr; const int mixer = idx & 3; int r = idx >> 2; if (tr) it.half = 0; else { it.half = r & 1; r >>= 1; } it.h = r & 3; it.b = tr ? 2 * (r >> 2) : (r >> 2);
    it.T = tr ? 2 * TS : TP; it.NB = tr ? BS : BP; it.row0 = tr ? MP + it.b * TS : it.b * TP;
    if (mixer == 0) scan_rwkv(p, l, it, sm); else if (mixer == 1) scan_gla(p, l, it, sm); else if (mixer == 2) scan_dn(p, l, it, sm); else scan_ssd(p, l, it, sm);
    __syncthreads();
}
__device__ __forceinline__ void flag_signal(unsigned* cnt, unsigned n) {
    asm volatile("s_waitcnt vmcnt(0)" ::: "memory"); __syncthreads();
    if (threadIdx.x == 0 && n) { __builtin_amdgcn_fence(__ATOMIC_RELEASE, "agent"); asm volatile("s_waitcnt vmcnt(0)" ::: "memory"); __hip_atomic_fetch_add(cnt, n, __ATOMIC_RELAXED, __HIP_MEMORY_SCOPE_AGENT); }
}
__device__ __forceinline__ void flag_wait(unsigned* cnt, unsigned target) {
    if (threadIdx.x == 0) { unsigned sp = 0; while (__hip_atomic_load(cnt, __ATOMIC_RELAXED, __HIP_MEMORY_SCOPE_AGENT) < target) { __builtin_amdgcn_s_sleep(4); if (++sp > (1u << 22)) break; }
        __builtin_amdgcn_fence(__ATOMIC_ACQUIRE, "agent"); asm volatile("s_waitcnt vmcnt(0)" ::: "memory"); }
    __syncthreads();
}
__device__ __forceinline__ void phase_scan(const KP& p, int l, float* sm) {
    const int G = gridDim.x;
    constexpr int NPI = 4 * BP * 4 * 2, NSI = 4 * (BS / 2) * 4;
    for (int i = blockIdx.x; i < NPI; i += G) run_item(p, l, 0, i, sm);
    unsigned* q = (unsigned*)(p.ws + WS_BAR) + 4096 + 64 * l;
    flag_wait((unsigned*)(p.ws + WS_BAR) + 4224 + 64 * l, 64u);
    volatile int* slot = (volatile int*)(sm + 4 * SL_SIZE);
    for (;;) {
        if (threadIdx.x == 0) *slot = (int)__hip_atomic_fetch_add(q, 2u, __ATOMIC_RELAXED, __HIP_MEMORY_SCOPE_AGENT);
        __syncthreads();
        const int i0 = *slot;
        __syncthreads();
        if (i0 >= NSI) break;
        run_item(p, l, 1, i0, sm);
        if (i0 + 1 < NSI) run_item(p, l, 1, i0 + 1, sm);
    }
}

__device__ __forceinline__ void ld4bf(const bf16* p, float (&o)[4]) { const uint2 v = *(const uint2*)p; o[0] = __builtin_bit_cast(float, v.x << 16); o[1] = __builtin_bit_cast(float, v.x & 0xffff0000u); o[2] = __builtin_bit_cast(float, v.y << 16); o[3] = __builtin_bit_cast(float, v.y & 0xffff0000u); }
__device__ __forceinline__ void st4bf(bf16* p, const float (&o)[4]) { uint2 v; v.x = pk2(o[0], o[1]); v.y = pk2(o[2], o[3]); *(uint2*)p = v; }
__device__ __forceinline__ void phase_post(const KP& p, int l, float* sm) {
    const int tid = otid(), lane = tid & 63, wv = tid >> 6; const int gw = blockIdx.x * NWAVES + wv, NGW = gridDim.x * NWAVES;
    const bf16* Ub = (const bf16*)(p.ws + WS_U); bf16* Yb = (bf16*)(p.ws + WS_H); const float* auxb = (const float*)(p.ws + WS_AUX);
    const float* mu = p.in[19] + l * 896;
    { const float* g2g = p.in[24] + (size_t)l * 64 * 256;
      for (int i = tid; i < 64 * 256 / 4; i += NTHR) *(f32x4*)(sm + 4 * i) = *(const f32x4*)(g2g + 4 * i);
      __syncthreads(); }
    const float* g2 = sm;
    const int c = lane * 4, hd = lane >> 4;
    const f32x4 lw = *(const f32x4*)(p.in[28] + l * 256 + c), lb = *(const f32x4*)(p.in[29] + l * 256 + c), muv = *(const f32x4*)(mu + 512 + c);
    const f32x4 wgl = *(const f32x4*)(p.in[32] + l * 256 + c), wdn = *(const f32x4*)(p.in[36] + l * 256 + c), wss = *(const f32x4*)(p.in[42] + l * 256 + c);
    const float mug = mu[832 + lane];
    struct PR { float y[4][4], uv[4], pv[4], gg[4], dz[4], sz[4], ug, pg, rkv; } cur, nxt;
#define POST_LOAD(R, row) do { int tr_, b_, t_; if ((row) < MP) { tr_ = 0; b_ = (row) >> 11; t_ = (row) & 2047; } else { tr_ = 1; b_ = ((row) - MP) >> 3; t_ = ((row) - MP) & 7; } \
        const bf16* u_ = Ub + (size_t)(row) * UP; const bf16* y_ = Yb + (size_t)(row) * DM; \
        _Pragma("unroll") for (int m = 0; m < 4; ++m) ld4bf(y_ + 256 * m + c, R.y[m]); \
        ld4bf(u_ + 512 + c, R.uv); ld4bf(u_ + CB + 768 + c, R.gg); ld4bf(u_ + CC + 768 + c, R.dz); ld4bf(u_ + CD + c, R.sz); R.ug = bf2f(u_[832 + lane]); R.rkv = auxb[(size_t)(row) * 4 + hd]; \
        if (t_ > 0) { ld4bf(u_ - UP + 512 + c, R.pv); R.pg = bf2f(u_[832 + lane - UP]); } \
        else if (tr_) { const float* sh0_ = p.in[2] + ((size_t)l * BS + b_) * 896; const f32x4 s_ = *(const f32x4*)(sh0_ + 512 + c); R.pv[0] = s_[0]; R.pv[1] = s_[1]; R.pv[2] = s_[2]; R.pv[3] = s_[3]; R.pg = sh0_[832 + lane]; } \
        else { R.pv[0] = R.pv[1] = R.pv[2] = R.pv[3] = 0.f; R.pg = 0.f; } } while (0)
    if (gw < MROWS) POST_LOAD(cur, gw);
    for (int row = gw; row < MROWS; row += NGW) {
        if (row + NGW < MROWS) POST_LOAD(nxt, row + NGW);
        bf16* y = Yb + (size_t)row * DM;
        { const float m = red16(cur.y[0][0] + cur.y[0][1] + cur.y[0][2] + cur.y[0][3]) * (1.f / 64.f);
          float d[4], vs = 0.f;
#pragma unroll
          for (int e = 0; e < 4; ++e) { d[e] = cur.y[0][e] - m; vs += d[e] * d[e]; }
          const float rs = rsqrtf(red16(vs) * (1.f / 64.f) + 64e-5f);
          const float sg = sigmoidf_(cur.ug + (cur.pg - cur.ug) * mug);
          f32x4 g = {0.f, 0.f, 0.f, 0.f};
#pragma unroll 8
          for (int j = 0; j < 64; ++j) { const float sj = __shfl(sg, j); g += *(const f32x4*)(g2 + j * 256 + c) * sj; }
          float o[4];
#pragma unroll
          for (int e = 0; e < 4; ++e) { const float v = cur.uv[e] + (cur.pv[e] - cur.uv[e]) * muv[e]; o[e] = (d[e] * rs * lw[e] + lb[e] + cur.rkv * v) * g[e]; }
          st4bf(y + c, o); }
        { const float* yv = cur.y[1];
          const float rs = rsqrtf(red16(yv[0] * yv[0] + yv[1] * yv[1] + yv[2] * yv[2] + yv[3] * yv[3]) * (1.f / 64.f) + 1e-6f); float o[4];
#pragma unroll
          for (int e = 0; e < 4; ++e) o[e] = yv[e] * rs * wgl[e] * siluf_(cur.gg[e]);
          st4bf(y + 256 + c, o); }
        { const float* yv = cur.y[2];
          const float rs = rsqrtf(red16(yv[0] * yv[0] + yv[1] * yv[1] + yv[2] * yv[2] + yv[3] * yv[3]) * (1.f / 64.f) + 1e-6f); float o[4];
#pragma unroll
          for (int e = 0; e < 4; ++e) o[e] = yv[e] * rs * wdn[e] * siluf_(cur.dz[e]);
          st4bf(y + 512 + c, o); }
        { float yv[4]; float ss = 0.f;
#pragma unroll
          for (int e = 0; e < 4; ++e) { yv[e] = cur.y[3][e] * siluf_(cur.sz[e]); ss += yv[e] * yv[e]; }
          ss = red16(ss); ss += __shfl_xor(ss, 16);
          const float rs = rsqrtf(ss * (1.f / 128.f) + 1e-6f); float o[4];
#pragma unroll
          for (int e = 0; e < 4; ++e) o[e] = yv[e] * rs * wss[e];
          st4bf(y + 768 + c, o); }
        cur = nxt;
    }
#undef POST_LOAD
}

#define XB_TMO      128
#define XB_XCNT(j)  (256  + 64 * (j))
#define XB_XSUB(j)  (1280 + 64 * (j))
#define XB_XGEN(j)  (2304 + 64 * (j))
#define XB_TOP      3328
#define XB_TOPGEN   3392
#define XCD_BAR_WORDS 3456
#define XB_SPIN_CAP (1u << 18)

__device__ __forceinline__ unsigned xb_ld(unsigned* p)              { return __hip_atomic_load(p, __ATOMIC_RELAXED, __HIP_MEMORY_SCOPE_AGENT); }
__device__ __forceinline__ unsigned xb_add(unsigned* p, unsigned v) { return __hip_atomic_fetch_add(p, v, __ATOMIC_RELAXED, __HIP_MEMORY_SCOPE_AGENT); }
__device__ __forceinline__ unsigned xb_xcc_id() { return (unsigned)__builtin_amdgcn_s_getreg((3 << 11) | 20) & 0xFu; }
#define XB_SPIN(cond, bar) do { unsigned _sp = 0; while (cond) { __builtin_amdgcn_s_sleep(1); \
    if ((++_sp & 255u) == 0u) { if (xb_ld(&(bar)[XB_TMO])) break; if (_sp > XB_SPIN_CAP) { atomicAdd(&(bar)[XB_TMO], 1u); break; } } } } while (0)

struct XcdBarrier {
    unsigned* bar; unsigned x;
    volatile LAS unsigned* st;
};

__device__ __forceinline__ XcdBarrier xcd_barrier_post(unsigned* bar, volatile LAS unsigned* st) {
    XcdBarrier b; b.bar = bar; b.x = xb_xcc_id(); b.st = st;
    if (threadIdx.x == 0) (void)xb_add(&bar[XB_XCNT(b.x)], 1u);
    return b;
}
__device__ __forceinline__ void xcd_barrier_complete(unsigned* bar, unsigned x, unsigned& nloc, unsigned& nx) {
    const unsigned G = gridDim.x * gridDim.y * gridDim.z;
    unsigned sum, cnt, mine, sp = 0u;
    for (;;) {
        sum = 0u; cnt = 0u; mine = 0u;
#pragma unroll
        for (unsigned j = 0; j < 16; ++j) { const unsigned c = xb_ld(&bar[XB_XCNT(j)]); sum += c; cnt += (c > 0u) ? 1u : 0u; mine = (j == x) ? c : mine; }
        if (sum == G) break;
        __builtin_amdgcn_s_sleep(1);
        if ((++sp & 255u) == 0u) { if (xb_ld(&bar[XB_TMO])) break; if (sp > XB_SPIN_CAP) { atomicAdd(&bar[XB_TMO], 1u); break; } }
    }
    nloc = mine > 0u ? mine : 1u; nx = cnt > 0u ? cnt : 1u;
}

__device__ __forceinline__ void xcd_barrier(const XcdBarrier& b) {
    asm volatile("s_waitcnt vmcnt(0)" ::: "memory");
    __syncthreads();
    if (threadIdx.x == 0) {
        unsigned* bar = b.bar;
        __builtin_amdgcn_s_waitcnt(0);
        unsigned nloc = b.st[0], nx = b.st[1];
        if (nloc == 0u) { xcd_barrier_complete(bar, b.x, nloc, nx); b.st[0] = nloc; b.st[1] = nx; }
        const unsigned old = xb_add(&bar[XB_XSUB(b.x)], 1u);
        const unsigned gen = old / nloc;
        if (old + 1u == (gen + 1u) * nloc) {
            __builtin_amdgcn_fence(__ATOMIC_RELEASE, "agent");
            asm volatile("s_waitcnt vmcnt(0)" ::: "memory");
            const unsigned og = xb_add(&bar[XB_TOP], 1u);
            const unsigned tg = og / nx;
            if (og + 1u == (tg + 1u) * nx) xb_add(&bar[XB_TOPGEN], 1u);
            else XB_SPIN(xb_ld(&bar[XB_TOPGEN]) == tg, bar);
            __builtin_amdgcn_fence(__ATOMIC_ACQUIRE, "agent");
            xb_add(&bar[XB_XGEN(b.x)], 1u);
            asm volatile("s_waitcnt vmcnt(0)" ::: "memory");
        } else {
            XB_SPIN(xb_ld(&bar[XB_XGEN(b.x)]) == gen, bar);
            __builtin_amdgcn_fence(__ATOMIC_ACQUIRE, "agent");
            asm volatile("s_waitcnt vmcnt(0)" ::: "memory");
        }
    }
    __syncthreads();
}

__device__ __forceinline__ const void* uni(const void* q) { const unsigned long long v = (unsigned long long)q; const unsigned lo = __builtin_amdgcn_readfirstlane((unsigned)v), hi = __builtin_amdgcn_readfirstlane((unsigned)(v >> 32)); return (const void*)(const GASP char*)(((unsigned long long)hi << 32) | lo); }
__global__ void __launch_bounds__(NTHR, 2) hybrid_fwd(KP kp) {
    extern __shared__ __attribute__((aligned(16))) unsigned char lds[];
    cg::grid_group grid = cg::this_grid();
    KP* lp = (KP*)(lds + 131072);
    if (threadIdx.x == 0) *lp = kp;
    volatile LAS unsigned* xst = (volatile LAS unsigned*)(lds + 131072 + 512);
    if (threadIdx.x < 2) xst[threadIdx.x] = 0u;
    if (blockIdx.x == 0) for (int i = threadIdx.x; i < 4096 + 512; i += NTHR) ((unsigned*)(kp.ws + WS_BAR))[i] = 0u;
    __syncthreads();
    const KP& p = *lp;
    float* sm = (float*)lds;
#define WSB ((unsigned char*)uni(p.ws))
#define OUTB ((float*)uni(p.out))
#define INP(i) ((const float*)uni(p.in[i]))
    phase_p0(p, sm);
    grid.sync();
    const XcdBarrier xbar = xcd_barrier_post((unsigned*)(WSB + WS_BAR), xst);
    for (int l = 0; l < 2; ++l) {
        { const float* modl = (const float*)(WSB + WS_MOD) + (size_t)l * 136 * 6144;
          const float* xP = l == 0 ? INP(0) : nullptr; const float* xS = l == 0 ? INP(1) : nullptr;
          phase_norm(p, xP, xS, INP(13) + l * DM, modl, 0, 1024, l == 0 ? -1 : 5120 - 136 * 6144); }
        xcd_barrier(xbar);
        { unsigned char* ws = WSB; pg8::Gemm g{(const bf16*)(ws + WS_H), (const bf16*)(ws + WS_WTIN) + (size_t)l * UP * DM, MP, UP, DM, DM}; pg8::StaticOrder S; S.init(MP, UP, 1, (int)gridDim.x, (int)blockIdx.x);
          pg8::EpiBf16<0> E{(bf16*)(ws + WS_U), UP}; pg8::gemm_phase<pg8::EpiBf16<0>, pg8::StaticOrder, true, true>((PG8_LAS unsigned char*)lds, g, S, E); }
        xcd_barrier(xbar);
        { unsigned char* ws = WSB; const int G = (int)gridDim.x, bx = (int)blockIdx.x;
          pg8::Gemm g{(const bf16*)(ws + WS_H), (const bf16*)(ws + WS_WTIN) + (size_t)l * UP * DM, MROWS, UP, DM, DM};
          pg8::SampleTilesOrder S{(G + 2) / 4, (bx & 3) == 1 ? (bx >> 2) : -1, 16}; pg8::EpiBf16<0> E{(bf16*)(ws + WS_U), UP};
          const unsigned nd = (S.cs >= 0 && S.cs < 64) ? (unsigned)((64 - S.cs + S.Gs - 1) / S.Gs) : 0u;
          if (nd) pg8::gemm_phase<pg8::EpiBf16<0>, pg8::SampleTilesOrder, false, true>((PG8_LAS unsigned char*)lds, g, S, E);
          flag_signal((unsigned*)(ws + WS_BAR) + 4224 + 64 * l, nd); }
        phase_scan(p, l, sm);
        xcd_barrier(xbar);
        phase_post(p, l, sm);
        xcd_barrier(xbar);
        { unsigned char* ws = WSB; const float* modl = (const float*)(ws + WS_MOD) + (size_t)l * 136 * 6144;
          pg8::Gemm g{(const bf16*)(ws + WS_H), (const bf16*)(ws + WS_WTOUT) + (size_t)l * DM * DM, MP, DM, DM, DM}; pg8::StaticOrder S; S.init(MP, DM, 1, (int)gridDim.x, (int)blockIdx.x);
          if (l == 0) { pg8::EpiRes<true> E{INP(0), (bf16*)(ws + WS_X16), modl + 2048}; pg8::gemm_phase<pg8::EpiRes<true>, pg8::StaticOrder, true, true>((PG8_LAS unsigned char*)lds, g, S, E); }
          else { pg8::EpiRes<false> E{nullptr, (bf16*)(ws + WS_X16), modl + 2048}; pg8::gemm_phase<pg8::EpiRes<false>, pg8::StaticOrder, true, true>((PG8_LAS unsigned char*)lds, g, S, E); }
          pg8::Gemm g2{(const bf16*)(ws + WS_H), (const bf16*)(ws + WS_WTOUT) + (size_t)l * DM * DM, MROWS, DM, DM / 4, DM}; pg8::SampleSplitOrder S2{(int)gridDim.x, (int)blockIdx.x};
          pg8::EpiPart E2{(float*)(ws + WS_PART)}; pg8::gemm_phase<pg8::EpiPart, pg8::SampleSplitOrder, false, true>((PG8_LAS unsigned char*)lds, g2, S2, E2); }
        xcd_barrier(xbar);
        { const float* modl = (const float*)(WSB + WS_MOD) + (size_t)l * 136 * 6144;
          phase_norm(p, nullptr, l == 0 ? INP(1) : nullptr, INP(14) + l * DM, modl, 3072, 4096, 2048); }
        xcd_barrier(xbar);
        { unsigned char* ws = WSB; pg8::Gemm g{(const bf16*)(ws + WS_H), (const bf16*)(ws + WS_WTUP) + (size_t)l * DFF * DM, MP, DFF, DM, DM}; pg8::StaticOrder S; S.init(MP, DFF, 1, (int)gridDim.x, (int)blockIdx.x);
          pg8::EpiBf16<2> E{(bf16*)(ws + WS_U), DFF}; pg8::gemm_phase<pg8::EpiBf16<2>, pg8::StaticOrder, true, true>((PG8_LAS unsigned char*)lds, g, S, E); }
        xcd_barrier(xbar);
        { unsigned char* ws = WSB; const int G = (int)gridDim.x, bx = (int)blockIdx.x;
          pg8::Gemm g{(const bf16*)(ws + WS_H), (const bf16*)(ws + WS_WTUP) + (size_t)l * DFF * DM, MROWS, DFF, DM, DM};
          const int Gs = G < 64 ? G : 64; pg8::SampleTilesOrder S{Gs, bx >= G - Gs ? bx - (G - Gs) : -1, 16}; pg8::EpiBf16<2> E{(bf16*)(ws + WS_U), DFF};
          const unsigned nd = (S.cs >= 0 && S.cs < 64) ? (unsigned)((64 - S.cs + S.Gs - 1) / S.Gs) : 0u;
          if (nd) pg8::gemm_phase<pg8::EpiBf16<2>, pg8::SampleTilesOrder, false, true>((PG8_LAS unsigned char*)lds, g, S, E);
          flag_signal((unsigned*)(ws + WS_BAR) + 4352 + 64 * l, nd); }
        { unsigned char* ws = WSB; const float* modl = (const float*)(ws + WS_MOD) + (size_t)l * 136 * 6144;
          pg8::Gemm g{(const bf16*)(ws + WS_U), (const bf16*)(ws + WS_WTDN) + (size_t)l * DM * DFF, MP, DM, DFF, DFF}; pg8::StaticOrder S; S.init(MP, DM, 1, (int)gridDim.x, (int)blockIdx.x);
          pg8::EpiRes<false> E{nullptr, (bf16*)(ws + WS_X16), modl + 5120}; pg8::gemm_phase<pg8::EpiRes<false>, pg8::StaticOrder, true, true>((PG8_LAS unsigned char*)lds, g, S, E);
          if ((int)blockIdx.x < 64) flag_wait((unsigned*)(ws + WS_BAR) + 4352 + 64 * l, 64u);
          pg8::Gemm g2{(const bf16*)(ws + WS_U), (const bf16*)(ws + WS_WTDN) + (size_t)l * DM * DFF, MROWS, DM, DFF / 4, DFF}; pg8::SampleSplitOrder S2{(int)gridDim.x, (int)blockIdx.x};
          pg8::EpiPart E2{(float*)(ws + WS_PART)}; pg8::gemm_phase<pg8::EpiPart, pg8::SampleSplitOrder, false, true>((PG8_LAS unsigned char*)lds, g2, S2, E2); }
        xcd_barrier(xbar);
    }
    phase_final(p);
}

extern "C" void kernel_launch(void* const* d_in, const int* in_sizes, int n_in, void* d_out, int out_size, void* d_ws, size_t ws_size, hipStream_t stream) {
    static int grid = 0;
    if (grid == 0) {
        if (n_in != 44 || (size_t)out_size != O_TOTAL || ws_size < WS_END) { fprintf(stderr, "kernel_launch: unexpected shapes: n_in %d out %d ws %zu\n", n_in, out_size, ws_size); grid = -1; return; }
        int dev = 0, cus = 0, per_cu = 0;
        hipGetDevice(&dev); hipDeviceGetAttribute(&cus, hipDeviceAttributeMultiprocessorCount, dev);
        if (hipFuncSetAttribute((const void*)hybrid_fwd, hipFuncAttributeMaxDynamicSharedMemorySize, LDS_BYTES) != hipSuccess) { fprintf(stderr, "kernel_launch: hipFuncSetAttribute failed\n"); grid = -1; return; }
        if (hipOccupancyMaxActiveBlocksPerMultiprocessor(&per_cu, (const void*)hybrid_fwd, NTHR, LDS_BYTES) != hipSuccess || per_cu < 1) { fprintf(stderr, "kernel_launch: occupancy query failed (%d)\n", per_cu); grid = -1; return; }
        grid = cus * per_cu;
    }
    if (grid < 0) return;
    KP p{};
    for (int i = 0; i < 44; ++i) p.in.v[i] = (const float*)d_in[i];
    p.out.v = (float*)d_out; p.ws.v = (unsigned char*)d_ws;
    void* args[] = {&p};
    hipError_t e = hipLaunchCooperativeKernel((const void*)hybrid_fwd, dim3(grid), dim3(NTHR), args, LDS_BYTES, stream);
    if (e != hipSuccess) fprintf(stderr, "kernel_launch: cooperative launch failed: %s (grid %d)\n", hipGetErrorString(e), grid);
}
```

```cpp
#include <hip/hip_runtime.h>
#include <hip/hip_cooperative_groups.h>
#include <cstdio>
#include <cstdint>
namespace cg = cooperative_groups;

namespace pg8 {
#define PG8_LAS __attribute__((address_space(3)))
typedef unsigned short bf16_t;
typedef short bf16x8 __attribute__((ext_vector_type(8)));
typedef float f32x4 __attribute__((ext_vector_type(4)));
typedef unsigned u32x4 __attribute__((ext_vector_type(4)));
constexpr int BM = 256, BK = 64, HALF = 128, HTB = HALF * BK * 2, STAGE_BYTES = 8 * HTB, NXCD = 8, WGM = 8;

__host__ __device__ __forceinline__ int lds_byte(int r, int c) { const int st = (r >> 4) * 2 + (c >> 5), rr = r & 15, cc = c & 31, ob = rr * 64 + cc * 2; return st * 1024 + (ob ^ (((ob >> 9) & 1) << 5)); }
__host__ __device__ __forceinline__ void stage_rc(int b, int& R, int& C) { const int st = b / 1024, sb = b % 1024, swz = sb ^ (((sb >> 9) & 1) << 5); R = (st >> 1) * 16 + swz / 64; C = (st & 1) * 32 + (swz % 64) / 2; }
__host__ __device__ __forceinline__ int perm32(int rho) { const int n = rho >> 4, i = rho & 15; return 8 * (i >> 2) + 4 * n + (i & 3); }

struct Unit { int pm, pn, pk; };
struct Gemm { const bf16_t* A; const bf16_t* Bt; int M, N, K, ld; };

struct StaticOrder {
    int nM, nN, nK, ntile, nwg, G, c;
    __host__ __device__ void init(int M, int N, int nK_, int G_, int c_) { nM = M / BM; nN = N / BM; nK = nK_; ntile = nM * nN; nwg = ntile * nK; G = G_; c = c_; }
    __host__ __device__ bool next(int i, Unit& u) const {
        const long L = (long)i * G + c; if (L >= nwg) return false;
        int wgid = (int)L; { const int q = nwg / NXCD, r = nwg % NXCD, xcd = wgid % NXCD, off = wgid / NXCD; wgid = (xcd < r ? xcd * (q + 1) : r * (q + 1) + (xcd - r) * q) + off; }
        u.pk = wgid / ntile; wgid -= u.pk * ntile;
        const int nig = WGM * nN, gid = wgid / nig, fm = gid * WGM, gsz = (nM - fm) < WGM ? (nM - fm) : WGM;
        u.pm = fm + ((wgid % nig) % gsz); u.pn = (wgid % nig) / gsz; return true;
    }
    __device__ __forceinline__ void a_ready(const Unit&) const {}
    __device__ __forceinline__ void done(const Unit&) const {}
};
__device__ __forceinline__ unsigned cvt_pk_bf16(float lo, float hi) { unsigned r; asm volatile("v_cvt_pk_bf16_f32 %0, %1, %2" : "=v"(r) : "v"(lo), "v"(hi)); return r; }

template <int ACT  > struct EpiBf16 {
    static constexpr bool PERM = true, AFTER_DRAIN = false;
    bf16_t* O; int ldc;
    __device__ __forceinline__ void operator()(const f32x4 (&acc)[2][2][4][2], const Unit& u, int wr, int wc, int fr, int fq) const {
        const int row0 = u.pm * BM + wr * 64 + fr, col0 = u.pn * BM + wc * 32 + 8 * fq;
#pragma unroll
        for (int ai = 0; ai < 2; ++ai)
#pragma unroll
            for (int m = 0; m < 4; ++m) { bf16_t* rowp = O + (size_t)(row0 + ai * HALF + m * 16) * ldc + col0;
#pragma unroll
                for (int bj = 0; bj < 2; ++bj) { f32x4 v0 = acc[ai][bj][m][0], v1 = acc[ai][bj][m][1];
                    if (ACT == 2) {
#pragma unroll
                        for (int j = 0; j < 4; ++j) { float a = fmaxf(v0[j], 0.f), b = fmaxf(v1[j], 0.f); v0[j] = a * a; v1[j] = b * b; } }
                    u32x4 w; w.x = cvt_pk_bf16(v0[0], v0[1]); w.y = cvt_pk_bf16(v0[2], v0[3]); w.z = cvt_pk_bf16(v1[0], v1[1]); w.w = cvt_pk_bf16(v1[2], v1[3]);
                    *(u32x4*)(rowp + bj * HALF) = w; } }
    }
};
template <bool SRCF32> struct EpiRes {
    static constexpr bool PERM = true, AFTER_DRAIN = false;
    const float* srcF; bf16_t* X; const float* gate;
    __device__ __forceinline__ void operator()(const f32x4 (&acc)[2][2][4][2], const Unit& u, int wr, int wc, int fr, int fq) const {
        const int row0 = u.pm * BM + wr * 64 + fr, col0 = u.pn * BM + wc * 32 + 8 * fq;
#pragma unroll
        for (int ai = 0; ai < 2; ++ai)
#pragma unroll
            for (int m = 0; m < 4; ++m) { const int row = row0 + ai * HALF + m * 16;
                const int cond = row < 16384 ? (row >> 11) : 8 + ((row - 16384) >> 3);
                const float* g = gate + (size_t)cond * 6144; bf16_t* d = X + (size_t)row * 1024;
#pragma unroll
                for (int bj = 0; bj < 2; ++bj) { const int c = col0 + bj * HALF; const f32x4 g0 = *(const f32x4*)(g + c), g1 = *(const f32x4*)(g + c + 4);
                    f32x4 x0, x1;
                    if (SRCF32) { const float* s = srcF + (size_t)row * 1024 + c; x0 = *(const f32x4*)s; x1 = *(const f32x4*)(s + 4); }
                    else { const u32x4 w = *(const u32x4*)(d + c);
                        x0 = (f32x4){__builtin_bit_cast(float, w.x << 16), __builtin_bit_cast(float, w.x & 0xffff0000u), __builtin_bit_cast(float, w.y << 16), __builtin_bit_cast(float, w.y & 0xffff0000u)};
                        x1 = (f32x4){__builtin_bit_cast(float, w.z << 16), __builtin_bit_cast(float, w.z & 0xffff0000u), __builtin_bit_cast(float, w.w << 16), __builtin_bit_cast(float, w.w & 0xffff0000u)}; }
                    x0 += g0 * acc[ai][bj][m][0]; x1 += g1 * acc[ai][bj][m][1];
                    u32x4 o; o.x = cvt_pk_bf16(x0[0], x0[1]); o.y = cvt_pk_bf16(x0[2], x0[3]); o.z = cvt_pk_bf16(x1[0], x1[1]); o.w = cvt_pk_bf16(x1[2], x1[3]);
                    *(u32x4*)(d + c) = o; } }
    }
};

struct SampleSplitOrder {
    int G, c;
    __device__ bool next(int i, Unit& u) const { const int L = i * G + c; if (L >= 64) return false; u.pk = L & 3; const int t = L >> 2; u.pm = 64 + (t >> 2); u.pn = t & 3; return true; }
    __device__ __forceinline__ void a_ready(const Unit&) const {}
    __device__ __forceinline__ void done(const Unit&) const {}
};
struct EpiPart {
    static constexpr bool PERM = true, AFTER_DRAIN = false;
    float* P;
    __device__ __forceinline__ void operator()(const f32x4 (&acc)[2][2][4][2], const Unit& u, int wr, int wc, int fr, int fq) const {
        const int row0 = (u.pm - 64) * BM + wr * 64 + fr, col0 = u.pn * BM + wc * 32 + 8 * fq;
#pragma unroll
        for (int ai = 0; ai < 2; ++ai)
#pragma unroll
            for (int m = 0; m < 4; ++m) { float* d = P + ((size_t)u.pk * 1024 + row0 + ai * HALF + m * 16) * 1024 + col0;
#pragma unroll
                for (int bj = 0; bj < 2; ++bj) { *(f32x4*)(d + bj * HALF) = acc[ai][bj][m][0]; *(f32x4*)(d + bj * HALF + 4) = acc[ai][bj][m][1]; } }
    }
};

struct SampleTilesOrder {
    int Gs, cs, nN;
    __device__ bool next(int i, Unit& u) const { if (cs < 0) return false; const int L = i * Gs + cs; if (L >= 4 * nN) return false; u.pk = 0; u.pm = 64 + L / nN; u.pn = L % nN; return true; }
    __device__ __forceinline__ void a_ready(const Unit&) const {}
    __device__ __forceinline__ void done(const Unit&) const {}
};

template <class Epi, class Sched, bool ALIGN_EPI = false, bool SP2 = false>
__device__ __forceinline__ void gemm_phase(PG8_LAS unsigned char* lds, const Gemm g, const Sched& S, const Epi& E) {
    int tid_ = threadIdx.x; asm volatile("" : "+v"(tid_));
    const int tid = tid_, wid = __builtin_amdgcn_readfirstlane(tid >> 6), lane = tid & 63, wr = wid >> 2, wc = wid & 3, fr = lane & 15, fq = lane >> 4;
    const int K = g.ld, nt = g.K / BK; const size_t kspl = (size_t)g.K * 2;
    unsigned voffA[2], voffB[2];
#pragma unroll
    for (int i = 0; i < 2; ++i) { int R, C; stage_rc(tid * 16 + i * 8192, R, C); const int Rb = Epi::PERM ? ((R & ~31) + perm32(R & 31)) : R;
        voffA[i] = (unsigned)(R * K + C) * 2u; voffB[i] = (unsigned)(Rb * K + C) * 2u; }
    const size_t kstep = (size_t)(BK * 2);
    const size_t hstep = (size_t)HALF * K * 2;
    const size_t tstep = 2 * hstep;
    const unsigned ldsw = (unsigned)wid * 1024u;
    const int aoff = lds_byte(wr * 64 + fr, fq * 8), boff = lds_byte(wc * 32 + fr, fq * 8);
#define PG8_SA(b, h) (((b) * 2 + (h)) * HTB)
#define PG8_SB(b, h) ((4 + (b) * 2 + (h)) * HTB)
#define PG8_STAGE(bufoff, gbase, voff) do { _Pragma("unroll") for (int _i = 0; _i < 2; ++_i) \
        __builtin_amdgcn_global_load_lds((const unsigned*)((const char*)(gbase) + (voff)[_i]), (PG8_LAS unsigned*)(lds + (bufoff) + ldsw + _i * 8192), 16, 0, 0); } while (0)
#define PG8_LDA(dst, b, h) do { _Pragma("unroll") for (int m = 0; m < 4; ++m) _Pragma("unroll") for (int k = 0; k < 2; ++k) dst[m][k] = *(const PG8_LAS bf16x8*)(lds + PG8_SA(b, h) + aoff + m * 2048 + k * 1024); } while (0)
#define PG8_LDB(dst, b, h) do { _Pragma("unroll") for (int n = 0; n < 2; ++n) _Pragma("unroll") for (int k = 0; k < 2; ++k) dst[n][k] = *(const PG8_LAS bf16x8*)(lds + PG8_SB(b, h) + boff + n * 2048 + k * 1024); } while (0)
#define PG8_MMA(ai, bj, At, Bt) do { __builtin_amdgcn_s_setprio(1); _Pragma("unroll") for (int m = 0; m < 4; ++m) _Pragma("unroll") for (int n = 0; n < 2; ++n) _Pragma("unroll") for (int k = 0; k < 2; ++k) \
        acc[ai][bj][m][n] = __builtin_amdgcn_mfma_f32_16x16x32_bf16(Bt[n][k], At[m][k], acc[ai][bj][m][n], 0, 0, 0); __builtin_amdgcn_s_setprio(0); } while (0)
#define PG8_WAIT_V(n) asm volatile("s_waitcnt vmcnt(" #n ")" ::: "memory")
#define PG8_WAIT_L(n) asm volatile("s_waitcnt lgkmcnt(" #n ")" ::: "memory")
#define PG8_BAR __builtin_amdgcn_s_barrier()
#define PG8_SCHED __builtin_amdgcn_sched_barrier(0)
    Unit cur, nxt; int ui = 0;
    if (!S.next(0, cur)) return;
    f32x4 acc[2][2][4][2];
#pragma unroll
    for (int a = 0; a < 2; ++a)
#pragma unroll
        for (int b = 0; b < 2; ++b)
#pragma unroll
            for (int m = 0; m < 4; ++m)
#pragma unroll
                for (int n = 0; n < 2; ++n) acc[a][b][m][n] = (f32x4){0.f, 0.f, 0.f, 0.f};
    bf16x8 At[4][2], B0[2][2], B1[2][2];
    const char* cA = (const char*)g.A + (size_t)cur.pm * tstep + (size_t)cur.pk * kspl; const char* cB = (const char*)g.Bt + (size_t)cur.pn * tstep + (size_t)cur.pk * kspl;
    S.a_ready(cur);
    if constexpr (SP2) {
        PG8_STAGE(PG8_SB(0, 0), cB, voffB); PG8_STAGE(PG8_SB(0, 1), cB + hstep, voffB); PG8_STAGE(PG8_SA(0, 0), cA, voffA); PG8_STAGE(PG8_SA(0, 1), cA + hstep, voffA);
        if (wr == 1) PG8_BAR;
        PG8_WAIT_V(2); PG8_BAR;
        PG8_STAGE(PG8_SB(1, 0), cB + kstep, voffB); PG8_STAGE(PG8_SA(1, 0), cA + kstep, voffA); PG8_STAGE(PG8_SB(1, 1), cB + hstep + kstep, voffB);
        PG8_WAIT_V(6); PG8_BAR;
    } else {
        PG8_STAGE(PG8_SB(0, 0), cB, voffB); PG8_STAGE(PG8_SA(0, 0), cA, voffA); PG8_STAGE(PG8_SB(0, 1), cB + hstep, voffB); PG8_STAGE(PG8_SA(0, 1), cA + hstep, voffA);
        if (wr == 1) PG8_BAR;
        PG8_WAIT_V(4); PG8_BAR;
        PG8_STAGE(PG8_SB(1, 0), cB + kstep, voffB); PG8_STAGE(PG8_SA(1, 0), cA + kstep, voffA); PG8_STAGE(PG8_SB(1, 1), cB + hstep + kstep, voffB);
        PG8_WAIT_V(6); PG8_BAR;
    }
    for (;;) {
        const bool has_next = S.next(ui + 1, nxt);
        const char* nA = has_next ? (const char*)g.A + (size_t)nxt.pm * tstep + (size_t)nxt.pk * kspl : cA; const char* nB = has_next ? (const char*)g.Bt + (size_t)nxt.pn * tstep + (size_t)nxt.pk * kspl : cB;
        for (int t = 0; t < nt; t += 2) {
            const bool last = (t == nt - 2);
            const char* a1 = cA + (size_t)(t + 1) * kstep;
            const char* a2 = last ? nA : cA + (size_t)(t + 2) * kstep; const char* b2 = last ? nB : cB + (size_t)(t + 2) * kstep;
            const char* a3 = a2 + kstep; const char* b3 = b2 + kstep;
            if (last && has_next) S.a_ready(nxt);
            if constexpr (SP2) {
            PG8_LDB(B0, 0, 0); PG8_LDB(B1, 0, 1); PG8_SCHED; PG8_LDA(At, 0, 0); PG8_STAGE(PG8_SA(1, 1), a1 + hstep, voffA);
            PG8_WAIT_V(8); PG8_WAIT_L(0); PG8_BAR; PG8_MMA(0, 0, At, B0); PG8_MMA(0, 1, At, B1); PG8_BAR; PG8_SCHED;
            PG8_LDA(At, 0, 1); PG8_STAGE(PG8_SB(0, 0), b2, voffB); PG8_STAGE(PG8_SB(0, 1), b2 + hstep, voffB); PG8_STAGE(PG8_SA(0, 0), a2, voffA);
            PG8_WAIT_V(8); PG8_WAIT_L(0); PG8_BAR; PG8_MMA(1, 0, At, B0); PG8_MMA(1, 1, At, B1); PG8_BAR; PG8_SCHED;
            PG8_LDB(B0, 1, 0); PG8_LDB(B1, 1, 1); PG8_SCHED; PG8_LDA(At, 1, 0); PG8_STAGE(PG8_SA(0, 1), a2 + hstep, voffA);
            PG8_WAIT_V(8); PG8_WAIT_L(0); PG8_BAR; PG8_MMA(0, 0, At, B0); PG8_MMA(0, 1, At, B1); PG8_BAR; PG8_SCHED;
            PG8_LDA(At, 1, 1); PG8_STAGE(PG8_SB(1, 0), b3, voffB); PG8_STAGE(PG8_SB(1, 1), b3 + hstep, voffB); PG8_STAGE(PG8_SA(1, 0), a3, voffA);
            PG8_WAIT_V(8); PG8_WAIT_L(0); PG8_BAR; PG8_MMA(1, 0, At, B0); PG8_MMA(1, 1, At, B1); PG8_BAR; PG8_SCHED;
            } else {
            PG8_LDB(B0, 0, 0); PG8_SCHED; PG8_LDA(At, 0, 0); PG8_STAGE(PG8_SA(1, 1), a1 + hstep, voffA);
            PG8_WAIT_L(8); PG8_BAR; PG8_WAIT_L(0); PG8_MMA(0, 0, At, B0); PG8_BAR; PG8_SCHED;
            PG8_LDB(B1, 0, 1); PG8_STAGE(PG8_SB(0, 0), b2, voffB);
            PG8_BAR; PG8_WAIT_L(0); PG8_MMA(0, 1, At, B1); PG8_BAR;
            PG8_LDA(At, 0, 1); PG8_STAGE(PG8_SA(0, 0), a2, voffA);
            PG8_BAR; PG8_WAIT_L(0); PG8_MMA(1, 0, At, B0); PG8_BAR; PG8_SCHED;
            PG8_STAGE(PG8_SB(0, 1), b2 + hstep, voffB);
            PG8_WAIT_V(6); PG8_BAR; PG8_MMA(1, 1, At, B1); PG8_BAR;
            PG8_LDB(B0, 1, 0); PG8_SCHED; PG8_LDA(At, 1, 0); PG8_STAGE(PG8_SA(0, 1), a2 + hstep, voffA);
            PG8_WAIT_L(8); PG8_BAR; PG8_WAIT_L(0); PG8_MMA(0, 0, At, B0); PG8_BAR; PG8_SCHED;
            PG8_LDB(B1, 1, 1); PG8_STAGE(PG8_SB(1, 0), b3, voffB);
            PG8_BAR; PG8_WAIT_L(0); PG8_MMA(0, 1, At, B1); PG8_BAR;
            PG8_LDA(At, 1, 1); PG8_STAGE(PG8_SA(1, 0), a3, voffA);
            PG8_BAR; PG8_WAIT_L(0); PG8_MMA(1, 0, At, B0); PG8_BAR; PG8_SCHED;
            PG8_STAGE(PG8_SB(1, 1), b3 + hstep, voffB);
            PG8_WAIT_V(6); PG8_BAR; PG8_MMA(1, 1, At, B1); PG8_BAR;
            }
        }
        if constexpr (ALIGN_EPI) { if (wr == 0) PG8_BAR; }
        if constexpr (!Epi::AFTER_DRAIN) { E(acc, cur, wr, wc, fr, fq); S.done(cur); }
        if (!has_next) break;
#pragma unroll
        for (int a = 0; a < 2; ++a)
#pragma unroll
            for (int b = 0; b < 2; ++b)
#pragma unroll
                for (int m = 0; m < 4; ++m)
#pragma unroll
                    for (int n = 0; n < 2; ++n) acc[a][b][m][n] = (f32x4){0.f, 0.f, 0.f, 0.f};
        cur = nxt; cA = nA; cB = nB; ++ui;
        if constexpr (ALIGN_EPI) { if (wr == 1) PG8_BAR; }
    }
    PG8_WAIT_V(0);
    if constexpr (!ALIGN_EPI) { if (wr == 0) PG8_BAR; }
    PG8_BAR;
    if constexpr (Epi::AFTER_DRAIN) { E.fused(acc, cur, wr, wc, fr, fq, lds, wid, lane); S.done(cur); }
#undef PG8_SA
#undef PG8_SB
#undef PG8_STAGE
#undef PG8_LDA
#undef PG8_LDB
#undef PG8_MMA
#undef PG8_WAIT_V
#undef PG8_WAIT_L
#undef PG8_BAR
#undef PG8_SCHED
}
}

typedef unsigned short bf16;
#define LAS __attribute__((address_space(3)))
typedef float f32x4 __attribute__((ext_vector_type(4)));
constexpr int DM = 1024, TP = 2048, BP = 8, BS = 128, TS = 8, MP = BP * TP, MS = BS * TS, MROWS = MP + MS, UP = 4096, PT = 3996, DFF = 4096;
constexpr int CA = 0, CB = 896, CC = 1936, CD = 2968;
constexpr int NTHR = 512, NWAVES = 8;
constexpr int LDS_BYTES = 135168;
constexpr size_t MiB = 1u << 20;
constexpr size_t WS_BAR = 59 * MiB + 512 * 1024;
constexpr size_t WS_WTIN = 0, WS_WTOUT = 16 * MiB, WS_WTUP = 20 * MiB, WS_WTDN = 36 * MiB, WS_MOD = 52 * MiB, WS_AUX = 59 * MiB, WS_H = 60 * MiB, WS_U = 94 * MiB, WS_PART = 230 * MiB, WS_X16 = 246 * MiB, WS_END = 280 * MiB;
static_assert(WS_MOD + (size_t)2 * 136 * 6144 * 4 <= WS_AUX && WS_AUX + (size_t)MROWS * 4 * 4 <= WS_H && WS_H + (size_t)MROWS * DM * 2 <= WS_U && WS_U + (size_t)MROWS * UP * 2 <= WS_PART, "ws map");
constexpr size_t O_PSHIFT = (size_t)MROWS * DM, O_PWKV = O_PSHIFT + 2 * 8 * 896, O_PGLA = O_PWKV + 2 * 8 * 4 * 4096, O_PDNC = O_PGLA + 2 * 8 * 4 * 4096, O_PDN = O_PDNC + 2 * 8 * 3 * 768,
                 O_PSSC = O_PDN + 2 * 8 * 4 * 4096, O_PSSM = O_PSSC + 2 * 8 * 3 * 768, O_SSHIFT = O_PSSM + 2 * 8 * 4 * 8192, O_SWKV = O_SSHIFT + 2 * 128 * 896, O_SGLA = O_SWKV + (size_t)2 * 128 * 4 * 4096,
                 O_SDNC = O_SGLA + (size_t)2 * 128 * 4 * 4096, O_SDN = O_SDNC + 2 * 128 * 3 * 768, O_SSSC = O_SDN + (size_t)2 * 128 * 4 * 4096, O_SSSM = O_SSSC + 2 * 128 * 3 * 768, O_TOTAL = O_SSSM + (size_t)2 * 128 * 4 * 8192;

#define GASP __attribute__((address_space(1)))
template <class T> __device__ __forceinline__ T* as_global(T* q) { return (T*)(GASP T*)(unsigned long long)q; }
struct KP {
    struct In { const float* v[44]; __device__ __forceinline__ const float* operator[](int i) const { return as_global(v[i]); } } in;
    struct Out { float* v; __device__ __forceinline__ operator float*() const { return as_global(v); } } out;
    struct Ws { unsigned char* v; __device__ __forceinline__ operator unsigned char*() const { return as_global(v); } } ws;
};

__device__ __forceinline__ int otid() { int t = threadIdx.x; asm volatile("" : "+v"(t)); return t; }
__device__ __forceinline__ float bf2f(bf16 h) { return __builtin_bit_cast(float, (unsigned)h << 16); }
__device__ __forceinline__ unsigned f2bf(float f) { unsigned u = __builtin_bit_cast(unsigned, f); return (u + 0x7fffu + ((u >> 16) & 1u)) >> 16; }
__device__ __forceinline__ unsigned pk2(float lo, float hi) { unsigned r; asm("v_cvt_pk_bf16_f32 %0, %1, %2" : "=v"(r) : "v"(lo), "v"(hi)); return r; }
typedef short bf16x8v __attribute__((ext_vector_type(8)));
__device__ __forceinline__ uint4 pack8f(const float* s) { uint4 v; v.x = pk2(s[0], s[1]); v.y = pk2(s[2], s[3]); v.z = pk2(s[4], s[5]); v.w = pk2(s[6], s[7]); return v; }
template <int CTRL> __device__ __forceinline__ float dppf(float x) { return __builtin_bit_cast(float, __builtin_amdgcn_mov_dpp(__builtin_bit_cast(int, x), CTRL, 0xf, 0xf, true)); }
__device__ __forceinline__ float red16(float v) { v += dppf<0xB1>(v); v += dppf<0x4E>(v); v += dppf<0x141>(v); v += dppf<0x128>(v); return v; }
__device__ __forceinline__ float wave_sum(float v) { v = red16(v); v += __shfl_xor(v, 16); v += __shfl_xor(v, 32); return v; }
__device__ __forceinline__ float sigmoidf_(float x) { return __builtin_amdgcn_rcpf(1.f + __expf(-x)); }
__device__ __forceinline__ float siluf_(float x) { return x * __builtin_amdgcn_rcpf(1.f + __expf(-x)); }
__device__ __forceinline__ float softplusf_(float x) { return fmaxf(x, 0.f) + __logf(1.f + __expf(-fabsf(x))); }
__device__ __forceinline__ float tanhf_(float x) { return 1.f - 2.f * __builtin_amdgcn_rcpf(__expf(2.f * x) + 1.f); }

__device__ __forceinline__ void transpose_item(const float* W, int K, int N, bf16* WT, float* scr, int item, int nblk, int lane) {
    const int kb = item / nblk, nb = item % nblk, k0 = 64 * kb, n0 = 32 * nb;
    const int kr = lane >> 3, c4 = (lane & 7) * 4; const bool ok = n0 + c4 < N;
    f32x4 v[8];
#pragma unroll
    for (int i = 0; i < 8; ++i) v[i] = ok ? *(const f32x4*)(W + (size_t)(k0 + i * 8 + kr) * N + n0 + c4) : (f32x4){0.f, 0.f, 0.f, 0.f};
#pragma unroll
    for (int i = 0; i < 8; ++i) { float* d = scr + (i * 8 + kr) * 33 + c4; d[0] = v[i][0]; d[1] = v[i][1]; d[2] = v[i][2]; d[3] = v[i][3]; }
    __builtin_amdgcn_s_waitcnt(0); __builtin_amdgcn_wave_barrier();
    const int c = lane & 7;
#pragma unroll
    for (int j = 0; j < 4; ++j) { const int nn = (lane >> 3) + 8 * j; const float* s = scr + (8 * c) * 33 + nn;
        uint4 o; o.x = pk2(s[0 * 33], s[1 * 33]); o.y = pk2(s[2 * 33], s[3 * 33]); o.z = pk2(s[4 * 33], s[5 * 33]); o.w = pk2(s[6 * 33], s[7 * 33]);
        *(uint4*)(WT + (size_t)(n0 + nn) * K + k0 + 8 * c) = o; }
    __builtin_amdgcn_s_waitcnt(0); __builtin_amdgcn_wave_barrier();
}

__device__ __forceinline__ void phase_p0(const KP& p, float* sm) {
    const int tid = otid(), lane = tid & 63, wv = tid >> 6, G = gridDim.x;
    { bf16* AS = (bf16*)sm; const int nt = wv & 3, mh = wv >> 2, n = lane & 15, fq = lane >> 4;
      for (int u = blockIdx.x; u < 2 * 96; u += G) {
        const int l = u / 96, n0 = (u % 96) * 64 + nt * 16 + n;
        const float* W = p.in[11] + (size_t)l * DM * 6144 + n0;
        f32x4 acc[5];
#pragma unroll
        for (int m = 0; m < 5; ++m) acc[m] = (f32x4){0.f, 0.f, 0.f, 0.f};
        float wb[2][8];
#pragma unroll
        for (int ks = 0; ks < 2; ++ks)
#pragma unroll
            for (int j = 0; j < 8; ++j) wb[ks][j] = W[(size_t)(ks * 32 + fq * 8 + j) * 6144];
        for (int kc = 0; kc < DM; kc += 64) {
            __syncthreads();
            for (int i = tid; i < 144 * 32; i += NTHR) { const int r = i >> 5, k = (i & 31) * 2;
                float c0 = 0.f, c1 = 0.f;
                if (r < 8) { const float2 c = *(const float2*)(p.in[9] + (size_t)r * DM + kc + k); c0 = siluf_(c.x); c1 = siluf_(c.y); }
                else if (r < 136) { const float2 c = *(const float2*)(p.in[10] + (size_t)(r - 8) * DM + kc + k); c0 = siluf_(c.x); c1 = siluf_(c.y); }
                *(unsigned*)(AS + r * 72 + k) = pk2(c0, c1); }
            __syncthreads();
            bf16x8v B[2];
#pragma unroll
            for (int ks = 0; ks < 2; ++ks) { const uint4 t = pack8f(wb[ks]); B[ks] = __builtin_bit_cast(bf16x8v, t); }
            if (kc + 64 < DM) {
#pragma unroll
                for (int ks = 0; ks < 2; ++ks)
#pragma unroll
                    for (int j = 0; j < 8; ++j) wb[ks][j] = W[(size_t)(kc + 64 + ks * 32 + fq * 8 + j) * 6144]; }
#pragma unroll
            for (int ks = 0; ks < 2; ++ks)
#pragma unroll
                for (int m = 0; m < 5; ++m) { const int mt = mh * 5 + m; if (mt < 9) { const bf16x8v A = *(const bf16x8v*)(AS + (mt * 16 + n) * 72 + ks * 32 + fq * 8);
                    acc[m] = __builtin_amdgcn_mfma_f32_16x16x32_bf16(A, B[ks], acc[m], 0, 0, 0); } }
        }
        const float bias = p.in[12][(size_t)l * 6144 + n0];
        float* M = (float*)(p.ws + WS_MOD) + (size_t)l * 136 * 6144 + n0;
#pragma unroll
        for (int m = 0; m < 5; ++m) { const int mt = mh * 5 + m;
#pragma unroll
            for (int i = 0; i < 4; ++i) { const int row = mt * 16 + fq * 4 + i; if (mt < 9 && row < 136) M[(size_t)row * 6144] = acc[m][i] + bias; } }
      }
      __syncthreads(); }
    const int gw = blockIdx.x * NWAVES + wv, NGW = G * NWAVES;
    float* scr = sm + wv * (64 * 33);
    constexpr int I_IN = 16 * 128, I_OUT = 16 * 32, I_UP = 16 * 128, I_DN = 64 * 32, I_L = I_IN + I_OUT + I_UP + I_DN;
    for (int it = gw; it < 2 * I_L; it += NGW) {
        const int l = it / I_L; int r = it % I_L;
        if (r < I_IN) { transpose_item(p.in[15] + (size_t)l * DM * PT, DM, PT, (bf16*)(p.ws + WS_WTIN) + (size_t)l * UP * DM, scr, r, 128, lane); continue; } r -= I_IN;
        if (r < I_OUT) { transpose_item(p.in[16] + (size_t)l * DM * DM, DM, DM, (bf16*)(p.ws + WS_WTOUT) + (size_t)l * DM * DM, scr, r, 32, lane); continue; } r -= I_OUT;
        if (r < I_UP) { transpose_item(p.in[17] + (size_t)l * DM * DFF, DM, DFF, (bf16*)(p.ws + WS_WTUP) + (size_t)l * DFF * DM, scr, r, 128, lane); continue; } r -= I_UP;
        transpose_item(p.in[18] + (size_t)l * DFF * DM, DFF, DM, (bf16*)(p.ws + WS_WTDN) + (size_t)l * DM * DFF, scr, r, 32, lane);
    }
    __syncthreads();
}

__device__ __forceinline__ void load_xrow(f32x4 (&v)[4], const float* xf, const bf16* x16, int lane) {
    if (xf) {
#pragma unroll
        for (int j = 0; j < 4; ++j) v[j] = *(const f32x4*)(xf + lane * 4 + 256 * j); }
    else {
#pragma unroll
        for (int j = 0; j < 4; ++j) { const uint2 w = *(const uint2*)(x16 + lane * 4 + 256 * j);
            v[j] = (f32x4){__builtin_bit_cast(float, w.x << 16), __builtin_bit_cast(float, w.x & 0xffff0000u), __builtin_bit_cast(float, w.y << 16), __builtin_bit_cast(float, w.y & 0xffff0000u)}; } }
}
__device__ __forceinline__ void phase_norm(const KP& p, const float* xPf, const float* xSf, const float* nw, const float* modl, int sh_off, int sc_off, int gate_off) {
    const int tid = otid(), lane = tid & 63, wv = tid >> 6; const int gw = blockIdx.x * NWAVES + wv, NGW = gridDim.x * NWAVES;
    bf16* H = (bf16*)(p.ws + WS_H); bf16* X16 = (bf16*)(p.ws + WS_X16);
    f32x4 v[4], vn[4];
#define NRM_LOAD(dst, row) load_xrow(dst, (row) < MP ? (xPf ? xPf + (size_t)(row) * DM : nullptr) : (xSf ? xSf + (size_t)((row) - MP) * DM : nullptr), X16 + (size_t)(row) * DM, lane)
    if (gw < MROWS) NRM_LOAD(v, gw);
    for (int row = gw; row < MROWS; row += NGW) {
        if (row + NGW < MROWS) NRM_LOAD(vn, row + NGW);
        const int cond = row < MP ? (row >> 11) : 8 + ((row - MP) >> 3);
        const float* md = modl + (size_t)cond * 6144;
        if (row >= MP && gate_off != -1) {
            const float* P = (const float*)(p.ws + WS_PART) + (size_t)(row - MP) * DM; bf16* xo_ = X16 + (size_t)row * DM;
#pragma unroll
            for (int j = 0; j < 4; ++j) { const int c = lane * 4 + 256 * j; const f32x4 g = *(const f32x4*)(md + gate_off + c);
                const f32x4 sp = (*(const f32x4*)(P + c) + *(const f32x4*)(P + (size_t)1024 * DM + c)) + (*(const f32x4*)(P + (size_t)2048 * DM + c) + *(const f32x4*)(P + (size_t)3072 * DM + c));
                v[j] += g * sp; uint2 o; o.x = pk2(v[j][0], v[j][1]); o.y = pk2(v[j][2], v[j][3]); *(uint2*)(xo_ + c) = o; } }
        float ss = 0.f;
#pragma unroll
        for (int j = 0; j < 4; ++j) ss += v[j][0] * v[j][0] + v[j][1] * v[j][1] + v[j][2] * v[j][2] + v[j][3] * v[j][3];
        const float rs = rsqrtf(wave_sum(ss) * (1.f / DM) + 1e-6f);
#pragma unroll
        for (int j = 0; j < 4; ++j) { const int c = lane * 4 + 256 * j; const f32x4 w = *(const f32x4*)(nw + c), sc = *(const f32x4*)(md + sc_off + c), sh = *(const f32x4*)(md + sh_off + c);
            const f32x4 h = v[j] * rs * w * (sc + 1.f) + sh;
            uint2 o; o.x = pk2(h[0], h[1]); o.y = pk2(h[2], h[3]); *(uint2*)(H + (size_t)row * DM + c) = o; }
#pragma unroll
        for (int j = 0; j < 4; ++j) v[j] = vn[j];
    }
#undef NRM_LOAD
}
__device__ __forceinline__ void phase_final(const KP& p) {
    const int tid = otid(), lane = tid & 63, wv = tid >> 6; const int gw = blockIdx.x * NWAVES + wv, NGW = gridDim.x * NWAVES;
    const float* nw = p.in[43]; const bf16* X16 = (const bf16*)(p.ws + WS_X16);
    f32x4 v[4], vn[4];
    if (gw < MROWS) load_xrow(v, nullptr, X16 + (size_t)gw * DM, lane);
    for (int row = gw; row < MROWS; row += NGW) {
        float* x = p.out + (size_t)row * DM;
        if (row + NGW < MROWS) load_xrow(vn, nullptr, X16 + (size_t)(row + NGW) * DM, lane);
        if (row >= MP) { const float* P = (const float*)(p.ws + WS_PART) + (size_t)(row - MP) * DM; const float* md = (const float*)(p.ws + WS_MOD) + ((size_t)136 + 8 + ((row - MP) >> 3)) * 6144 + 5120;
#pragma unroll
            for (int j = 0; j < 4; ++j) { const int c = lane * 4 + 256 * j; const f32x4 g = *(const f32x4*)(md + c);
                const f32x4 sp = (*(const f32x4*)(P + c) + *(const f32x4*)(P + (size_t)1024 * DM + c)) + (*(const f32x4*)(P + (size_t)2048 * DM + c) + *(const f32x4*)(P + (size_t)3072 * DM + c));
                v[j] += g * sp; } }
        float ss = 0.f;
#pragma unroll
        for (int j = 0; j < 4; ++j) ss += v[j][0] * v[j][0] + v[j][1] * v[j][1] + v[j][2] * v[j][2] + v[j][3] * v[j][3];
        const float rs = rsqrtf(wave_sum(ss) * (1.f / DM) + 1e-6f);
#pragma unroll
        for (int j = 0; j < 4; ++j) { const int c = lane * 4 + 256 * j; *(f32x4*)(x + c) = v[j] * rs * *(const f32x4*)(nw + c); }
#pragma unroll
        for (int j = 0; j < 4; ++j) v[j] = vn[j];
    }
}

typedef float f32x2 __attribute__((ext_vector_type(2)));
constexpr int VST = 320, SL_VEC = 0, SL_VROW = 16 * VST, SL_PART = SL_VROW + 16 * 64, SL_SCAL = SL_PART + 16 * 16, SL_SIZE = SL_SCAL + 16 * 8;
static_assert(4 * SL_SIZE * 4 <= 131072, "scan LDS ring");
struct Item { int tr, b, h, half, T, NB, row0; };
struct V8 { f32x4 a, b; };
__device__ __forceinline__ V8 ld8(const float* q) { V8 v; v.a = *(const f32x4*)q; v.b = *(const f32x4*)(q + 4); return v; }
__device__ __forceinline__ float dot8(const V8& s, const V8& x) { const f32x4 t = s.a * x.a + s.b * x.b; return (t[0] + t[1]) + (t[2] + t[3]); }
__device__ __forceinline__ f32x2 dot8x2(const V8& s, const f32x4& p0, const f32x4& p1, const f32x4& p2, const f32x4& p3) {
    f32x2 a = (f32x2){s.a[0], s.a[0]} * (f32x2){p0[0], p0[1]}; f32x2 b = (f32x2){s.a[1], s.a[1]} * (f32x2){p0[2], p0[3]};
    a += (f32x2){s.a[2], s.a[2]} * (f32x2){p1[0], p1[1]}; b += (f32x2){s.a[3], s.a[3]} * (f32x2){p1[2], p1[3]};
    a += (f32x2){s.b[0], s.b[0]} * (f32x2){p2[0], p2[1]}; b += (f32x2){s.b[1], s.b[1]} * (f32x2){p2[2], p2[3]};
    a += (f32x2){s.b[2], s.b[2]} * (f32x2){p3[0], p3[1]}; b += (f32x2){s.b[3], s.b[3]} * (f32x2){p3[2], p3[3]};
    return a + b; }
__device__ __forceinline__ float red8(float v) { v += dppf<0xB1>(v); v += dppf<0x4E>(v); v += dppf<0x141>(v); return v; }
__device__ __forceinline__ float ldu(const bf16* U, int row, int col, int T) { row = row < T ? row : T - 1; return bf2f(U[(size_t)row * UP + col]); }
__device__ __forceinline__ void unpack8(const uint4 v, float (&o)[8]) {
    o[0] = __builtin_bit_cast(float, v.x << 16); o[1] = __builtin_bit_cast(float, v.x & 0xffff0000u); o[2] = __builtin_bit_cast(float, v.y << 16); o[3] = __builtin_bit_cast(float, v.y & 0xffff0000u);
    o[4] = __builtin_bit_cast(float, v.z << 16); o[5] = __builtin_bit_cast(float, v.z & 0xffff0000u); o[6] = __builtin_bit_cast(float, v.w << 16); o[7] = __builtin_bit_cast(float, v.w & 0xffff0000u); }
#define YKEEP2(tt, ya, yb) do { if ((tt) == sub) { yk0 = (ya); yk1 = (yb); } } while (0)
#define YSTORE2(bb) do { const int g0 = 16 * (bb) + sub; if (g0 < T) { Y[(size_t)g0 * DM + irow] = (bf16)f2bf(yk0); Y[(size_t)g0 * DM + irow + 16] = (bf16)f2bf(yk1); } } while (0)
__device__ __forceinline__ f32x2 dot4x2(const f32x4& s, const f32x4& p0, const f32x4& p1) {
    f32x2 a = (f32x2){s[0], s[0]} * (f32x2){p0[0], p0[1]}; f32x2 b = (f32x2){s[1], s[1]} * (f32x2){p0[2], p0[3]};
    a += (f32x2){s[2], s[2]} * (f32x2){p1[0], p1[1]}; b += (f32x2){s[3], s[3]} * (f32x2){p1[2], p1[3]};
    return a + b; }
__device__ __forceinline__ void red16x4(float x0, float x1, float x2, float x3, bool p0, bool p1, float& r0, float& r1, float& r2, float& r3) {
    float k0 = p0 ? x2 : x0, k1 = p0 ? x3 : x1; const float t0 = p0 ? x0 : x2, t1 = p0 ? x1 : x3;
    k0 += dppf<0xB1>(t0); k1 += dppf<0xB1>(t1);
    float m = p1 ? k1 : k0; const float u = p1 ? k0 : k1;
    m += dppf<0x4E>(u); m += dppf<0x124>(m); m += dppf<0x128>(m);
    r0 = dppf<0x00>(m); r2 = dppf<0x55>(m); r1 = dppf<0xAA>(m); r3 = dppf<0xFF>(m);
}
__device__ __forceinline__ void red16x2(float xa, float xb, bool p0, float& ra, float& rb) {
    float k = p0 ? xb : xa; const float t = p0 ? xa : xb;
    k += dppf<0xB1>(t); k += dppf<0x4E>(k); k += dppf<0x124>(k); k += dppf<0x128>(k);
    ra = dppf<0x00>(k); rb = dppf<0x55>(k);
}
__device__ __forceinline__ float dot4(const f32x4& s, const f32x4& x) { const f32x4 t = s * x; return (t[0] + t[1]) + (t[2] + t[3]); }
#define TICK_BAR() do { asm volatile("s_waitcnt lgkmcnt(0)" ::: "memory"); __builtin_amdgcn_s_barrier(); asm volatile("" ::: "memory"); } while (0)
__device__ __forceinline__ void scan_rwkv(const KP& p, int l, const Item& it, float* sm) {
    const int tid = otid(), lane = tid & 63, wv = tid >> 6, T = it.T, NBAT = (T + 15) >> 4;
    const bool scanner = wv < 4;
    const bf16* U = (const bf16*)(p.ws + WS_U) + (size_t)it.row0 * UP;
    const float* sh0 = it.tr ? p.in[2] + ((size_t)l * BS + it.b) * 896 : nullptr;
    const int rp = (tid & 255) >> 4, sub = tid & 15, nh = it.tr ? 2 : 1; const bool lp0 = (tid & 1) != 0, lp1 = (tid & 2) != 0; int irow = it.half * 32 + rp;
    bf16* Y = (bf16*)(p.ws + WS_H) + (size_t)it.row0 * DM + 0 * 256 + it.h * 64;
    float* sbase_o = p.out + (it.tr ? O_SWKV : O_PWKV) + (((size_t)l * it.NB + it.b) * 4 + it.h) * 4096 + sub * 4;
    const float* sbase_i = p.in[3] + (((size_t)l * BS + it.b) * 4 + it.h) * 4096 + sub * 4;
    f32x4 S0 = {0.f, 0.f, 0.f, 0.f}, S1 = S0, Q0 = S0, Q1 = S0, R0 = S0, R1 = S0;
    if (it.tr) { const float* q = sbase_i + ((wv >> 2) * 32 + rp) * 64; Q0 = *(const f32x4*)q; Q1 = *(const f32x4*)(q + 16 * 64); R0 = *(const f32x4*)(q + 4 * 4096); R1 = *(const f32x4*)(q + 4 * 4096 + 16 * 64); }
    float yk0 = 0.f, yk1 = 0.f;
    const int pj = wv & 3, n = lane & 15, fq = lane >> 4, c = pj * 16 + n, hc = it.h * 64 + c;
    const float* mu = p.in[19] + l * 896;
    bf16x8v Bw, Ba; float muw[8], mua[8];
#pragma unroll
    for (int j = 0; j < 8; ++j) { Bw[j] = (short)f2bf(p.in[21][((size_t)l * 32 + fq * 8 + j) * 256 + hc]); Ba[j] = (short)f2bf(p.in[23][((size_t)l * 32 + fq * 8 + j) * 256 + hc]);
        muw[j] = mu[768 + fq * 8 + j]; mua[j] = mu[800 + fq * 8 + j]; }
    const float w0c = p.in[20][l * 256 + hc], a0c = p.in[22][l * 256 + hc], kkc = p.in[25][l * 256 + hc], kac = p.in[26][l * 256 + hc], rkc = p.in[27][l * 256 + hc];
    const float mur = mu[hc], muk = mu[256 + hc], muv = mu[512 + hc];
    struct RwRaw { uint4 wc, wp, ac, ap; float rr[5], rk[5], rv[5]; } cur;
#define RW_LOAD(R, bb) do { const int ta = 16 * (bb) + n;              \
        { const int tc_ = ta < T ? ta : T - 1; const bf16* q = U + (size_t)tc_ * UP + 768 + fq * 8; R.wc = *(const uint4*)q; R.ac = *(const uint4*)(q + 32); \
          const bool sb_ = it.tr && tc_ == 8; const float* shx_ = sb_ ? sh0 + 896 : sh0;     \
          if (tc_ > 0 && !sb_) { R.wp = *(const uint4*)(q - UP); R.ap = *(const uint4*)(q + 32 - UP); } \
          else if (sh0) { R.wp = pack8f(shx_ + 768 + fq * 8); R.ap = pack8f(shx_ + 800 + fq * 8); } else { R.wp = (uint4){0u, 0u, 0u, 0u}; R.ap = R.wp; } } \
        _Pragma("unroll") for (int i = 0; i < 5; ++i) { const int g = 16 * (bb) + fq * 4 - 1 + i; \
            const bool sb_ = it.tr && fq == 2 && i == 0; const float* shx_ = sb_ ? sh0 + 896 : sh0;     \
            if (g >= 0 && !sb_) { R.rr[i] = ldu(U, g, hc, T); R.rk[i] = ldu(U, g, 256 + hc, T); R.rv[i] = ldu(U, g, 512 + hc, T); } \
            else if (sh0) { R.rr[i] = shx_[hc]; R.rk[i] = shx_[256 + hc]; R.rv[i] = shx_[512 + hc]; } else { R.rr[i] = R.rk[i] = R.rv[i] = 0.f; } } } while (0)
    if (!scanner) RW_LOAD(cur, 0);
    for (int k = 0; k < NBAT + 2; ++k) {
        if (scanner || it.tr) {
            const int b = k - 2;
            if (b >= 0 && b < NBAT) {
                const float* SL = sm + (b & 3) * SL_SIZE; const int ns = (T - 16 * b) < 16 ? (T - 16 * b) : 16;
                { const int hv = wv >> 2;
                if (it.tr) irow = hv * 32 + rp;
                const int nsq = it.tr ? 8 : ns;
                for (int sq = 0; sq < 2; ++sq) {
                if (it.tr) { S0 = sq ? R0 : Q0; S1 = sq ? R1 : Q1; }
#define RW_STEP(tt, q0, q1, w, bb, kp, va, vb, sc) do { const f32x2 da = dot4x2(S0, q0, q1), db = dot4x2(S1, q0, q1); \
                    float a1, a2, b1, b2; red16x4(da.x, da.y, db.x, db.y, lp0, lp1, a1, a2, b1, b2); \
                    const float ca = sc[0] * a1, cb = sc[0] * b1;                                       \
                    const float ya = a2 - ca * sc[1] + va * sc[2], yb = b2 - cb * sc[1] + vb * sc[2]; \
                    S0 = S0 * w + (kp * va - bb * ca); S1 = S1 * w + (kp * vb - bb * cb); YKEEP2(tt, ya, yb); } while (0)
                _Pragma("unroll 2") for (int j_ = 0; j_ < 4; ++j_) { const int tt = sq * 8 + 2 * j_;
                    const float* V0 = SL + SL_VEC + tt * VST + sub * 4; const float* V1 = V0 + VST; const float* P0 = V0 + sub * 4; const float* P1 = P0 + VST;
                    const f32x4 a0 = *(const f32x4*)P0, a1_ = *(const f32x4*)(P0 + 4), w0 = *(const f32x4*)(V0 + 128), bb0 = *(const f32x4*)(V0 + 192), kp0 = *(const f32x4*)(V0 + 256);
                    const float va0 = SL[SL_VROW + tt * 64 + irow], vb0 = SL[SL_VROW + tt * 64 + irow + 16]; const f32x4 sc0 = *(const f32x4*)(SL + SL_SCAL + tt * 8);
                    const f32x4 e0 = *(const f32x4*)P1, e1 = *(const f32x4*)(P1 + 4), w1 = *(const f32x4*)(V1 + 128), bb1 = *(const f32x4*)(V1 + 192), kp1 = *(const f32x4*)(V1 + 256);
                    const float va1 = SL[SL_VROW + (tt + 1) * 64 + irow], vb1 = SL[SL_VROW + (tt + 1) * 64 + irow + 16]; const f32x4 sc1 = *(const f32x4*)(SL + SL_SCAL + (tt + 1) * 8);
                    RW_STEP(tt, a0, a1_, w0, bb0, kp0, va0, vb0, sc0);
                    RW_STEP(tt + 1, e0, e1, w1, bb1, kp1, va1, vb1, sc1);
                }
                if (it.tr) { float* o_ = sbase_o + sq * (4 * 4096); *(f32x4*)(o_ + irow * 64) = S0; *(f32x4*)(o_ + (irow + 16) * 64) = S1; }
                }
#undef RW_STEP
                YSTORE2(b);
                }
            }
        }
        if (!scanner) {
            if (k >= 1 && k - 1 < NBAT && lane < 4) {
                const int tt = pj * 4 + lane; float* SL = sm + ((k - 1) & 3) * SL_SIZE; const float* P = SL + SL_PART + tt * 16;
                const f32x4 s = *(const f32x4*)P + *(const f32x4*)(P + 4) + *(const f32x4*)(P + 8) + *(const f32x4*)(P + 12);
                const float rn2 = __builtin_amdgcn_rcpf(s[0] + 1e-6f);
                *(f32x4*)(SL + SL_SCAL + tt * 8) = (f32x4){rn2, s[1], s[2], 0.f};
                const int g = 16 * (k - 1) + tt; if (it.half == 0 && g < T) ((float*)(p.ws + WS_AUX))[((size_t)it.row0 + g) * 4 + it.h] = s[3];
            }
            if (k < NBAT) {
                float xw[8], xa[8], cu[8], pr[8];
                unpack8(cur.wc, cu); unpack8(cur.wp, pr);
#pragma unroll
                for (int j = 0; j < 8; ++j) xw[j] = tanhf_(cu[j] + (pr[j] - cu[j]) * muw[j]);
                unpack8(cur.ac, cu); unpack8(cur.ap, pr);
#pragma unroll
                for (int j = 0; j < 8; ++j) xa[j] = cu[j] + (pr[j] - cu[j]) * mua[j];
                const uint4 Awu = pack8f(xw), Aau = pack8f(xa);
                const bf16x8v Aw = __builtin_bit_cast(bf16x8v, Awu), Aa = __builtin_bit_cast(bf16x8v, Aau);
                const f32x4 z = {0.f, 0.f, 0.f, 0.f};
                const f32x4 dw = __builtin_amdgcn_mfma_f32_16x16x32_bf16(Aw, Bw, z, 0, 0, 0), da = __builtin_amdgcn_mfma_f32_16x16x32_bf16(Aa, Ba, z, 0, 0, 0);
                float xr_[4], xk_[4], xv_[4];
#pragma unroll
                for (int i = 0; i < 4; ++i) { xr_[i] = cur.rr[i + 1] + (cur.rr[i] - cur.rr[i + 1]) * mur; xk_[i] = cur.rk[i + 1] + (cur.rk[i] - cur.rk[i + 1]) * muk; xv_[i] = cur.rv[i + 1] + (cur.rv[i] - cur.rv[i + 1]) * muv; }
                if (k + 1 < NBAT) RW_LOAD(cur, k + 1);
                float* SL = sm + (k & 3) * SL_SIZE;
#pragma unroll
                for (int i = 0; i < 4; ++i) { const int tt = fq * 4 + i;
                    const float w = __expf(-0.6065306597f * sigmoidf_(w0c + dw[i])), a = sigmoidf_(a0c + da[i]);
                    const float kkraw = xk_[i] * kkc, braw = kkraw * a, kp = xk_[i] * (1.f + (a - 1.f) * kac);
                    float* V = SL + SL_VEC + tt * VST + c; *(f32x2*)(V + c) = (f32x2){kkraw, w * xr_[i]}; V[128] = w; V[192] = braw; V[256] = kp; SL[SL_VROW + tt * 64 + c] = xv_[i];
                    float p0, p1, p2, p3; red16x4(kkraw * kkraw, braw * xr_[i], kp * xr_[i], xr_[i] * kp * rkc, lp0, lp1, p0, p1, p2, p3);
                    if (n == 0) *(f32x4*)(SL + SL_PART + tt * 16 + pj * 4) = (f32x4){p0, p1, p2, p3}; }
            }
        }
        TICK_BAR();
    }
#undef RW_LOAD
    if (scanner) { if (!it.tr) { *(f32x4*)(sbase_o + irow * 64) = S0; *(f32x4*)(sbase_o + (irow + 16) * 64) = S1; } }
    else if (it.h == 0 && it.half == 0) { float* so = p.out + (it.tr ? O_SSHIFT : O_PSHIFT) + ((size_t)l * it.NB + it.b) * 896;
        for (int cc = tid - 256; cc < 896; cc += 256) { so[cc] = bf2f(U[(size_t)(it.tr ? 7 : T - 1) * UP + cc]); if (it.tr) so[896 + cc] = bf2f(U[(size_t)15 * UP + cc]); } }
}

__device__ __forceinline__ void scan_gla(const KP& p, int l, const Item& it, float* sm) {
    const int tid = otid(), lane = tid & 63, wv = tid >> 6, T = it.T, NBAT = (T + 15) >> 4;
    const bool scanner = wv < 4;
    const bf16* U = (const bf16*)(p.ws + WS_U) + (size_t)it.row0 * UP + CB;
    const int rp = (tid & 255) >> 4, sub = tid & 15, nh = it.tr ? 2 : 1; const bool lp0 = (tid & 1) != 0, lp1 = (tid & 2) != 0; int irow = it.half * 32 + rp;
    bf16* Y = (bf16*)(p.ws + WS_H) + (size_t)it.row0 * DM + 1 * 256 + it.h * 64;
    const size_t sbase = (((size_t)l * it.NB + it.b) * 4 + it.h) * 4096;
    f32x4 S0 = {0.f, 0.f, 0.f, 0.f}, S1 = S0, Q0 = S0, Q1 = S0, R0 = S0, R1 = S0; float* so = p.out + (it.tr ? O_SGLA : O_PGLA) + sbase + (size_t)sub * 4 * 64; const float* si = p.in[4] + sbase + (size_t)sub * 4 * 64;
    if (it.tr) { const int r0 = (wv >> 2) * 32 + rp;
#pragma unroll
        for (int e = 0; e < 4; ++e) { Q0[e] = si[e * 64 + r0]; Q1[e] = si[e * 64 + r0 + 16]; R0[e] = si[4 * 4096 + e * 64 + r0]; R1[e] = si[4 * 4096 + e * 64 + r0 + 16]; } }
    float yk0 = 0.f, yk1 = 0.f;
    const int pj = wv & 3, n = lane & 15, fq = lane >> 4, c = pj * 16 + n, hc = it.h * 64 + c;
    float gkw[16];
#pragma unroll
    for (int j = 0; j < 16; ++j) gkw[j] = p.in[30][((size_t)l * 16 + j) * 256 + hc];
    const float gkb = p.in[31][l * 256 + hc];
    struct GlRaw { float q_[4], k_[4], v_[4]; uint4 g0[4], g1[4]; } cur;
#define GL_LOAD(R, bb) do { _Pragma("unroll") for (int i = 0; i < 4; ++i) { int g = 16 * (bb) + fq * 4 + i; g = g < T ? g : T - 1; const bf16* q = U + (size_t)g * UP; \
        R.q_[i] = bf2f(q[hc]); R.k_[i] = bf2f(q[256 + hc]); R.v_[i] = bf2f(q[512 + hc]); R.g0[i] = *(const uint4*)(q + 1024); R.g1[i] = *(const uint4*)(q + 1032); } } while (0)
    if (!scanner) GL_LOAD(cur, 0);
    for (int k = 0; k < NBAT + 2; ++k) {
        if (scanner || it.tr) {
            const int b = k - 2;
            if (b >= 0 && b < NBAT) {
                const float* SL = sm + (b & 3) * SL_SIZE; const int ns = (T - 16 * b) < 16 ? (T - 16 * b) : 16;
                { const int hv = wv >> 2;
                if (it.tr) irow = hv * 32 + rp;
                const int nsq = it.tr ? 8 : ns;
                for (int sq = 0; sq < 2; ++sq) {

                if (it.tr) { S0 = sq ? R0 : Q0; S1 = sq ? R1 : Q1; }
#define GL_STEP(tt, dec, kv, qd, va, vb, qk) do { float da, db; red16x2(dot4(S0, qd), dot4(S1, qd), lp0, da, db); const float ya = da + va * qk, yb = db + vb * qk; \
                    S0 = S0 * dec + kv * va; S1 = S1 * dec + kv * vb; YKEEP2(tt, ya, yb); } while (0)
                _Pragma("unroll 2") for (int j_ = 0; j_ < 4; ++j_) { const int tt = sq * 8 + 2 * j_;
                    const float* V0 = SL + SL_VEC + tt * VST + sub * 4; const float* V1 = V0 + VST;
                    const f32x4 qd0 = *(const f32x4*)(V0 + 128), dec0 = *(const f32x4*)V0, kv0 = *(const f32x4*)(V0 + 64); const float va0 = SL[SL_VROW + tt * 64 + irow], vb0 = SL[SL_VROW + tt * 64 + irow + 16], qk0 = SL[SL_SCAL + tt * 8];
                    const f32x4 qd1 = *(const f32x4*)(V1 + 128), dec1 = *(const f32x4*)V1, kv1 = *(const f32x4*)(V1 + 64); const float va1 = SL[SL_VROW + (tt + 1) * 64 + irow], vb1 = SL[SL_VROW + (tt + 1) * 64 + irow + 16], qk1 = SL[SL_SCAL + (tt + 1) * 8];
                    GL_STEP(tt, dec0, kv0, qd0, va0, vb0, qk0);
                    GL_STEP(tt + 1, dec1, kv1, qd1, va1, vb1, qk1);
                }
                if (it.tr) { float* o_ = so + sq * (4 * 4096);
#pragma unroll
                    for (int e = 0; e < 4; ++e) { o_[e * 64 + irow] = S0[e]; o_[e * 64 + irow + 16] = S1[e]; } }
                }
#undef GL_STEP
                YSTORE2(b);
                }
            }
        }
        if (!scanner) {
            if (k >= 1 && k - 1 < NBAT && lane < 4) { const int tt = pj * 4 + lane; float* SL = sm + ((k - 1) & 3) * SL_SIZE; const float* P = SL + SL_PART + tt * 16;
                SL[SL_SCAL + tt * 8] = P[0] + P[4] + P[8] + P[12]; }
            if (k < NBAT) {
                float x[4], qq[4], kk[4], vv[4];
#pragma unroll
                for (int i = 0; i < 4; ++i) { float gl[8]; x[i] = gkb; unpack8(cur.g0[i], gl);
#pragma unroll
                    for (int j = 0; j < 8; ++j) x[i] += gl[j] * gkw[j];
                    unpack8(cur.g1[i], gl);
#pragma unroll
                    for (int j = 0; j < 8; ++j) x[i] += gl[j] * gkw[8 + j];
                    qq[i] = cur.q_[i] * 0.125f; kk[i] = cur.k_[i]; vv[i] = cur.v_[i]; }
                if (k + 1 < NBAT) GL_LOAD(cur, k + 1);
                float* SL = sm + (k & 3) * SL_SIZE;
#pragma unroll
                for (int i = 0; i < 4; ++i) { const int tt = fq * 4 + i;
                    const float dec = __expf(-softplusf_(-x[i]) * (1.f / 16.f));
                    float* V = SL + SL_VEC + tt * VST + c; V[0] = dec; V[64] = kk[i]; V[128] = qq[i] * dec; SL[SL_VROW + tt * 64 + c] = vv[i];
                    const float p0 = red16(qq[i] * kk[i]);
                    if (n == 0) SL[SL_PART + tt * 16 + pj * 4] = p0; }
            }
        }
        TICK_BAR();
    }
#undef GL_LOAD
    if (scanner && !it.tr) {
#pragma unroll
        for (int e = 0; e < 4; ++e) { so[e * 64 + irow] = S0[e]; so[e * 64 + irow + 16] = S1[e]; } }
}

__device__ __forceinline__ void scan_dn(const KP& p, int l, const Item& it, float* sm) {
    const int tid = otid(), lane = tid & 63, wv = tid >> 6, T = it.T, NBAT = (T + 15) >> 4;
    const bool scanner = wv < 4;
    const bf16* U = (const bf16*)(p.ws + WS_U) + (size_t)it.row0 * UP + CC;
    const float* cv0 = it.tr ? p.in[5] + ((size_t)l * BS + it.b) * 3 * 768 : nullptr;
    const int rp = (tid & 255) >> 4, sub = tid & 15, nh = it.tr ? 2 : 1; const bool lp0 = (tid & 1) != 0, lp1 = (tid & 2) != 0; int irow = it.half * 32 + rp;
    bf16* Y = (bf16*)(p.ws + WS_H) + (size_t)it.row0 * DM + 2 * 256 + it.h * 64;
    const size_t sbase = (((size_t)l * it.NB + it.b) * 4 + it.h) * 4096;
    f32x4 S0 = {0.f, 0.f, 0.f, 0.f}, S1 = S0, Q0 = S0, Q1 = S0, R0 = S0, R1 = S0; float* so = p.out + (it.tr ? O_SDN : O_PDN) + sbase + (size_t)sub * 4 * 64; const float* si = p.in[6] + sbase + (size_t)sub * 4 * 64;
    if (it.tr) { const int r0 = (wv >> 2) * 32 + rp;
#pragma unroll
        for (int e = 0; e < 4; ++e) { Q0[e] = si[e * 64 + r0]; Q1[e] = si[e * 64 + r0 + 16]; R0[e] = si[4 * 4096 + e * 64 + r0]; R1[e] = si[4 * 4096 + e * 64 + r0 + 16]; } }
    float yk0 = 0.f, yk1 = 0.f;
    const int pj = wv & 3, n = lane & 15, fq = lane >> 4, c = pj * 16 + n, hc = it.h * 64 + c;
    float cw[3][4];
#pragma unroll
    for (int pt = 0; pt < 3; ++pt)
#pragma unroll
        for (int i = 0; i < 4; ++i) cw[pt][i] = p.in[33][((size_t)l * 4 + i) * 768 + pt * 256 + hc];
    const float nA = -__expf(p.in[34][l * 4 + it.h]), dtb = p.in[35][l * 4 + it.h];
    struct DnRaw { float xin[3][7]; } cur;
#define DN_LOAD(R, bb) do { _Pragma("unroll") for (int pt = 0; pt < 3; ++pt) _Pragma("unroll") for (int i = 0; i < 7; ++i) { const int g = 16 * (bb) + fq * 4 - 3 + i; \
        R.xin[pt][i] = (it.tr && fq == 2 && i < 3) ? cv0[(3 + i) * 768 + pt * 256 + hc] : g >= 0 ? ldu(U, g, pt * 256 + hc, T) : (cv0 ? cv0[(3 + g) * 768 + pt * 256 + hc] : 0.f); } } while (0)
    if (!scanner) DN_LOAD(cur, 0);
    for (int k = 0; k < NBAT + 2; ++k) {
        if (scanner || it.tr) {
            const int b = k - 2;
            if (b >= 0 && b < NBAT) {
                const float* SL = sm + (b & 3) * SL_SIZE; const int ns = (T - 16 * b) < 16 ? (T - 16 * b) : 16;
                { const int hv = wv >> 2;
                if (it.tr) irow = hv * 32 + rp;
                const int nsq = it.tr ? 8 : ns;
                for (int sq = 0; sq < 2; ++sq) {

                if (it.tr) { S0 = sq ? R0 : Q0; S1 = sq ? R1 : Q1; }
#define DN_STEP(tt, q0, q1, kv, va, vb, sc, sq) do { const f32x2 da = dot4x2(S0, q0, q1), db = dot4x2(S1, q0, q1);        \
                    float a1, a2, b1, b2; red16x4(da.x, da.y, db.x, db.y, lp0, lp1, a1, a2, b1, b2); \
                    const float na = sc[1] * (va - sc[0] * sc[2] * a1), nb = sc[1] * (vb - sc[0] * sc[2] * b1); \
                    const float ya = sc[0] * sc[3] * a2 + na * sq, yb = sc[0] * sc[3] * b2 + nb * sq; \
                    S0 = S0 * sc[0] + kv * (na * sc[2]); S1 = S1 * sc[0] + kv * (nb * sc[2]); YKEEP2(tt, ya, yb); } while (0)
                _Pragma("unroll 2") for (int j_ = 0; j_ < 4; ++j_) { const int tt = sq * 8 + 2 * j_;
                    const float* V0 = SL + SL_VEC + tt * VST + sub * 4; const float* V1 = V0 + VST; const float* P0 = V0 + sub * 4; const float* P1 = P0 + VST;
                    const f32x4 a0 = *(const f32x4*)P0, a1_ = *(const f32x4*)(P0 + 4), kv0 = *(const f32x4*)(V0 + 128);
                    const float va0 = SL[SL_VROW + tt * 64 + irow], vb0 = SL[SL_VROW + tt * 64 + irow + 16]; const f32x4 sc0 = *(const f32x4*)(SL + SL_SCAL + tt * 8); const float sq0 = SL[SL_SCAL + tt * 8 + 4];
                    const f32x4 e0 = *(const f32x4*)P1, e1 = *(const f32x4*)(P1 + 4), kv1 = *(const f32x4*)(V1 + 128);
                    const float va1 = SL[SL_VROW + (tt + 1) * 64 + irow], vb1 = SL[SL_VROW + (tt + 1) * 64 + irow + 16]; const f32x4 sc1 = *(const f32x4*)(SL + SL_SCAL + (tt + 1) * 8); const float sq1 = SL[SL_SCAL + (tt + 1) * 8 + 4];
                    DN_STEP(tt, a0, a1_, kv0, va0, vb0, sc0, sq0);
                    DN_STEP(tt + 1, e0, e1, kv1, va1, vb1, sc1, sq1);
                }
                if (it.tr) { float* o_ = so + sq * (4 * 4096);
#pragma unroll
                    for (int e = 0; e < 4; ++e) { o_[e * 64 + irow] = S0[e]; o_[e * 64 + irow + 16] = S1[e]; } }
                }
#undef DN_STEP
                YSTORE2(b);
                }
            }
        }
        if (!scanner) {
            if (k >= 1 && k - 1 < NBAT && lane < 4) { const int tt = pj * 4 + lane; float* SL = sm + ((k - 1) & 3) * SL_SIZE; const float* P = SL + SL_PART + tt * 16;
                const f32x4 s = *(const f32x4*)P + *(const f32x4*)(P + 4) + *(const f32x4*)(P + 8) + *(const f32x4*)(P + 12);
                const float rq8 = rsqrtf(s[0] + 1e-6f) * 0.125f, rk = rsqrtf(s[1] + 1e-6f);
                int g = 16 * (k - 1) + tt; g = g < T ? g : T - 1;
                const float beta = sigmoidf_(bf2f(U[(size_t)g * UP + 1028 + it.h])), eg = __expf(nA * softplusf_(bf2f(U[(size_t)g * UP + 1024 + it.h]) + dtb));
                *(f32x4*)(SL + SL_SCAL + tt * 8) = (f32x4){eg, beta, rk, rq8}; SL[SL_SCAL + tt * 8 + 4] = s[2] * rq8 * rk; }
            if (k < NBAT) {
                float o[3][4];
#pragma unroll
                for (int pt = 0; pt < 3; ++pt)
#pragma unroll
                    for (int i = 0; i < 4; ++i) o[pt][i] = siluf_(cw[pt][0] * cur.xin[pt][i] + cw[pt][1] * cur.xin[pt][i + 1] + cw[pt][2] * cur.xin[pt][i + 2] + cw[pt][3] * cur.xin[pt][i + 3]);
                if (k + 1 < NBAT) DN_LOAD(cur, k + 1);
                float* SL = sm + (k & 3) * SL_SIZE;
#pragma unroll
                for (int i = 0; i < 4; ++i) { const int tt = fq * 4 + i;
                    float* V = SL + SL_VEC + tt * VST + c; *(f32x2*)(V + c) = (f32x2){o[1][i], o[0][i]}; V[128] = o[1][i]; SL[SL_VROW + tt * 64 + c] = o[2][i];
                    const float p0 = red16(o[0][i] * o[0][i]), p1 = red16(o[1][i] * o[1][i]), p2 = red16(o[0][i] * o[1][i]);
                    if (n == 0) *(f32x4*)(SL + SL_PART + tt * 16 + pj * 4) = (f32x4){p0, p1, p2, 0.f}; }
            }
        }
        TICK_BAR();
    }
#undef DN_LOAD
    if (scanner) { if (!it.tr) {
#pragma unroll
        for (int e = 0; e < 4; ++e) { so[e * 64 + irow] = S0[e]; so[e * 64 + irow + 16] = S1[e]; } } }
    else if (it.h == 0 && it.half == 0) { float* so = p.out + (it.tr ? O_SDNC : O_PDNC) + ((size_t)l * it.NB + it.b) * 3 * 768;
        for (int i = tid - 256; i < 3 * 768; i += 256) { const int rr = i / 768, cc = i % 768; so[i] = bf2f(U[(size_t)((it.tr ? 5 : T - 3) + rr) * UP + cc]); if (it.tr) so[3 * 768 + i] = bf2f(U[(size_t)(13 + rr) * UP + cc]); } }
}

__device__ __forceinline__ void scan_ssd(const KP& p, int l, const Item& it, float* sm) {
    const int tid = otid(), lane = tid & 63, wv = tid >> 6, T = it.T, NBAT = (T + 15) >> 4, grp = it.h >> 1;
    const bool scanner = wv < 4;
    const bf16* U = (const bf16*)(p.ws + WS_U) + (size_t)it.row0 * UP + CD;
    const bf16* UX = U + 256;
    const float* cv0 = it.tr ? p.in[7] + ((size_t)l * BS + it.b) * 3 * 768 : nullptr;
    const int rp = (tid & 255) >> 4, sub = tid & 15, nh = it.tr ? 2 : 1; const bool lp0 = (tid & 1) != 0, lp1 = (tid & 2) != 0; int irow = it.half * 32 + rp;
    bf16* Y = (bf16*)(p.ws + WS_H) + (size_t)it.row0 * DM + 3 * 256 + it.h * 64;
    const size_t sbase = (((size_t)l * it.NB + it.b) * 4 + it.h) * 64 * 128 + sub * 8; float* so = p.out + (it.tr ? O_SSSM : O_PSSM) + sbase; const float* si = p.in[8] + sbase;
    V8 S0, S1; S0.a = (f32x4){0.f, 0.f, 0.f, 0.f}; S0.b = S0.a; S1 = S0;
    V8 Q0 = S0, Q1 = S0, R0 = S0, R1 = S0;
    if (it.tr) { const int r0 = (wv >> 2) * 32 + rp; Q0 = ld8(si + r0 * 128); Q1 = ld8(si + (r0 + 16) * 128); R0 = ld8(si + 4 * 8192 + r0 * 128); R1 = ld8(si + 4 * 8192 + (r0 + 16) * 128); }
    float yk0 = 0.f, yk1 = 0.f;
    const int pj = wv & 3, n = lane & 15, fq = lane >> 4, c = pj * 16 + n;
    int ch[5]; ch[0] = it.h * 64 + c; ch[1] = 256 + grp * 128 + pj * 32 + n; ch[2] = ch[1] + 16; ch[3] = ch[1] + 256; ch[4] = ch[3] + 16;
    float cw[5][4], cb[5];
#pragma unroll
    for (int q = 0; q < 5; ++q) { cb[q] = p.in[38][(size_t)l * 768 + ch[q]];
#pragma unroll
        for (int i = 0; i < 4; ++i) cw[q][i] = p.in[37][((size_t)l * 4 + i) * 768 + ch[q]]; }
    const float nA = -__expf(p.in[40][l * 4 + it.h]), dtb = p.in[39][l * 4 + it.h], Dh = p.in[41][l * 4 + it.h];
    struct SsRaw { float xin[5][7]; } cur;
#define SS_LOAD(R, bb) do { _Pragma("unroll") for (int q = 0; q < 5; ++q) _Pragma("unroll") for (int i = 0; i < 7; ++i) { const int g = 16 * (bb) + fq * 4 - 3 + i; \
        R.xin[q][i] = (it.tr && fq == 2 && i < 3) ? cv0[(3 + i) * 768 + ch[q]] : g >= 0 ? ldu(UX, g, ch[q], T) : (cv0 ? cv0[(3 + g) * 768 + ch[q]] : 0.f); } } while (0)
    if (!scanner) SS_LOAD(cur, 0);
    for (int k = 0; k < NBAT + 2; ++k) {
        if (scanner || it.tr) {
            const int b = k - 2;
            if (b >= 0 && b < NBAT) {
                const float* SL = sm + (b & 3) * SL_SIZE; const int ns = (T - 16 * b) < 16 ? (T - 16 * b) : 16;
                { const int hv = wv >> 2;
                if (it.tr) irow = hv * 32 + rp;
                const int nsq = it.tr ? 8 : ns;
                for (int sq = 0; sq < 2; ++sq) {

                if (it.tr) { S0 = sq ? R0 : Q0; S1 = sq ? R1 : Q1; }
#define SS_STEP(tt, Bv, Cv, xa, xb, sc) do { float da, db; red16x2(dot8(S0, Cv), dot8(S1, Cv), lp0, da, db); const float ta = xa * sc[1], tb = xb * sc[1];        \
                    const float ya = sc[0] * da + ta * sc[2] + Dh * xa, yb = sc[0] * db + tb * sc[2] + Dh * xb; \
                    S0.a = S0.a * sc[0] + Bv.a * ta; S0.b = S0.b * sc[0] + Bv.b * ta; S1.a = S1.a * sc[0] + Bv.a * tb; S1.b = S1.b * sc[0] + Bv.b * tb; YKEEP2(tt, ya, yb); } while (0)
                _Pragma("unroll 2") for (int j_ = 0; j_ < 4; ++j_) { const int tt = sq * 8 + 2 * j_;
                    const float* V0 = SL + SL_VEC + tt * VST + sub * 8; const float* V1 = V0 + VST;
                    const V8 C0 = ld8(V0 + 128), B0 = ld8(V0); const float xa0 = SL[SL_VROW + tt * 64 + irow], xb0 = SL[SL_VROW + tt * 64 + irow + 16]; const f32x4 sc0 = *(const f32x4*)(SL + SL_SCAL + tt * 8);
                    const V8 C1 = ld8(V1 + 128), B1 = ld8(V1); const float xa1 = SL[SL_VROW + (tt + 1) * 64 + irow], xb1 = SL[SL_VROW + (tt + 1) * 64 + irow + 16]; const f32x4 sc1 = *(const f32x4*)(SL + SL_SCAL + (tt + 1) * 8);
                    SS_STEP(tt, B0, C0, xa0, xb0, sc0);
                    SS_STEP(tt + 1, B1, C1, xa1, xb1, sc1);
                }
                if (it.tr) { float* o0 = so + sq * (4 * 8192) + irow * 128; float* o1 = o0 + 16 * 128; *(f32x4*)o0 = S0.a; *(f32x4*)(o0 + 4) = S0.b; *(f32x4*)o1 = S1.a; *(f32x4*)(o1 + 4) = S1.b; }
                }
#undef SS_STEP
                YSTORE2(b);
                }
            }
        }
        if (!scanner) {
            if (k >= 1 && k - 1 < NBAT && lane < 4) { const int tt = pj * 4 + lane; float* SL = sm + ((k - 1) & 3) * SL_SIZE; const float* P = SL + SL_PART + tt * 16;
                const float bc = P[0] + P[4] + P[8] + P[12];
                int g = 16 * (k - 1) + tt; g = g < T ? g : T - 1;
                const float dt = softplusf_(bf2f(U[(size_t)g * UP + 1024 + it.h]) + dtb);
                *(f32x4*)(SL + SL_SCAL + tt * 8) = (f32x4){__expf(nA * dt), dt, bc, 0.f}; }
            if (k < NBAT) {
                float o[5][4];
#pragma unroll
                for (int q = 0; q < 5; ++q)
#pragma unroll
                    for (int i = 0; i < 4; ++i) o[q][i] = siluf_(cb[q] + cw[q][0] * cur.xin[q][i] + cw[q][1] * cur.xin[q][i + 1] + cw[q][2] * cur.xin[q][i + 2] + cw[q][3] * cur.xin[q][i + 3]);
                if (k + 1 < NBAT) SS_LOAD(cur, k + 1);
                float* SL = sm + (k & 3) * SL_SIZE;
#pragma unroll
                for (int i = 0; i < 4; ++i) { const int tt = fq * 4 + i;
                    float* V = SL + SL_VEC + tt * VST; V[pj * 32 + n] = o[1][i]; V[pj * 32 + 16 + n] = o[2][i]; V[128 + pj * 32 + n] = o[3][i]; V[128 + pj * 32 + 16 + n] = o[4][i]; SL[SL_VROW + tt * 64 + c] = o[0][i];
                    const float p0 = red16(o[1][i] * o[3][i] + o[2][i] * o[4][i]);
                    if (n == 0) SL[SL_PART + tt * 16 + pj * 4] = p0; }
            }
        }
        TICK_BAR();
    }
#undef SS_LOAD
    if (scanner) { if (!it.tr) { float* o0 = so + irow * 128; float* o1 = so + (irow + 16) * 128; *(f32x4*)o0 = S0.a; *(f32x4*)(o0 + 4) = S0.b; *(f32x4*)o1 = S1.a; *(f32x4*)(o1 + 4) = S1.b; } }
    else if (it.h == 0 && it.half == 0) { float* so = p.out + (it.tr ? O_SSSC : O_PSSC) + ((size_t)l * it.NB + it.b) * 3 * 768;
        for (int i = tid - 256; i < 3 * 768; i += 256) { const int rr = i / 768, cc = i % 768; so[i] = bf2f(UX[(size_t)((it.tr ? 5 : T - 3) + rr) * UP + cc]); if (it.tr) so[3 * 768 + i] = bf2f(UX[(size_t)(13 + rr) * UP + cc]); } }
}

__device__ __forceinline__ void run_item(const KP& p, int l, int tr, int idx, float* sm) {
    Item it; it.tr = tr; const int mixer = idx & 3; int r = idx >> 2; if (tr) it.half = 0; else { it.half = r & 1; r >>= 1; } it.h = r & 3; it.b = tr ? 2 * (r >> 2) : (r >> 2);
    it.T = tr ? 2 * TS : TP; it.NB = tr ? BS : BP; it.row0 = tr ? MP + it.b * TS : it.b * TP;
    if (mixer == 0) scan_rwkv(p, l, it, sm); else if (mixer == 1) scan_gla(p, l, it, sm); else if (mixer == 2) scan_dn(p, l, it, sm); else scan_ssd(p, l, it, sm);
    __syncthreads();
}
__device__ __forceinline__ void flag_signal(unsigned* cnt, unsigned n) {
    asm volatile("s_waitcnt vmcnt(0)" ::: "memory"); __syncthreads();
    if (threadIdx.x == 0 && n) { __builtin_amdgcn_fence(__ATOMIC_RELEASE, "agent"); asm volatile("s_waitcnt vmcnt(0)" ::: "memory"); __hip_atomic_fetch_add(cnt, n, __ATOMIC_RELAXED, __HIP_MEMORY_SCOPE_AGENT); }
}
__device__ __forceinline__ void flag_wait(unsigned* cnt, unsigned target) {
    if (threadIdx.x == 0) { unsigned sp = 0; while (__hip_atomic_load(cnt, __ATOMIC_RELAXED, __HIP_MEMORY_SCOPE_AGENT) < target) { __builtin_amdgcn_s_sleep(4); if (++sp > (1u << 22)) break; }
        __builtin_amdgcn_fence(__ATOMIC_ACQUIRE, "agent"); asm volatile("s_waitcnt vmcnt(0)" ::: "memory"); }
    __syncthreads();
}
__device__ __forceinline__ void phase_scan(const KP& p, int l, float* sm) {
    const int G = gridDim.x;
    constexpr int NPI = 4 * BP * 4 * 2, NSI = 4 * (BS / 2) * 4;
    for (int i = blockIdx.x; i < NPI; i += G) run_item(p, l, 0, i, sm);
    unsigned* q = (unsigned*)(p.ws + WS_BAR) + 4096 + 64 * l;
    flag_wait((unsigned*)(p.ws + WS_BAR) + 4224 + 64 * l, 64u);
    volatile int* slot = (volatile int*)(sm + 4 * SL_SIZE);
    for (;;) {
        if (threadIdx.x == 0) *slot = (int)__hip_atomic_fetch_add(q, 2u, __ATOMIC_RELAXED, __HIP_MEMORY_SCOPE_AGENT);
        __syncthreads();
        const int i0 = *slot;
        __syncthreads();
        if (i0 >= NSI) break;
        run_item(p, l, 1, i0, sm);
        if (i0 + 1 < NSI) run_item(p, l, 1, i0 + 1, sm);
    }
}

__device__ __forceinline__ void ld4bf(const bf16* p, float (&o)[4]) { const uint2 v = *(const uint2*)p; o[0] = __builtin_bit_cast(float, v.x << 16); o[1] = __builtin_bit_cast(float, v.x & 0xffff0000u); o[2] = __builtin_bit_cast(float, v.y << 16); o[3] = __builtin_bit_cast(float, v.y & 0xffff0000u); }
__device__ __forceinline__ void st4bf(bf16* p, const float (&o)[4]) { uint2 v; v.x = pk2(o[0], o[1]); v.y = pk2(o[2], o[3]); *(uint2*)p = v; }
__device__ __forceinline__ void phase_post(const KP& p, int l, float* sm) {
    const int tid = otid(), lane = tid & 63, wv = tid >> 6; const int gw = blockIdx.x * NWAVES + wv, NGW = gridDim.x * NWAVES;
    const bf16* Ub = (const bf16*)(p.ws + WS_U); bf16* Yb = (bf16*)(p.ws + WS_H); const float* auxb = (const float*)(p.ws + WS_AUX);
    const float* mu = p.in[19] + l * 896;
    { const float* g2g = p.in[24] + (size_t)l * 64 * 256;
      for (int i = tid; i < 64 * 256 / 4; i += NTHR) *(f32x4*)(sm + 4 * i) = *(const f32x4*)(g2g + 4 * i);
      __syncthreads(); }
    const float* g2 = sm;
    const int c = lane * 4, hd = lane >> 4;
    const f32x4 lw = *(const f32x4*)(p.in[28] + l * 256 + c), lb = *(const f32x4*)(p.in[29] + l * 256 + c), muv = *(const f32x4*)(mu + 512 + c);
    const f32x4 wgl = *(const f32x4*)(p.in[32] + l * 256 + c), wdn = *(const f32x4*)(p.in[36] + l * 256 + c), wss = *(const f32x4*)(p.in[42] + l * 256 + c);
    const float mug = mu[832 + lane];
    struct PR { float y[4][4], uv[4], pv[4], gg[4], dz[4], sz[4], ug, pg, rkv; } cur, nxt;
#define POST_LOAD(R, row) do { int tr_, b_, t_; if ((row) < MP) { tr_ = 0; b_ = (row) >> 11; t_ = (row) & 2047; } else { tr_ = 1; b_ = ((row) - MP) >> 3; t_ = ((row) - MP) & 7; } \
        const bf16* u_ = Ub + (size_t)(row) * UP; const bf16* y_ = Yb + (size_t)(row) * DM; \
        _Pragma("unroll") for (int m = 0; m < 4; ++m) ld4bf(y_ + 256 * m + c, R.y[m]); \
        ld4bf(u_ + 512 + c, R.uv); ld4bf(u_ + CB + 768 + c, R.gg); ld4bf(u_ + CC + 768 + c, R.dz); ld4bf(u_ + CD + c, R.sz); R.ug = bf2f(u_[832 + lane]); R.rkv = auxb[(size_t)(row) * 4 + hd]; \
        if (t_ > 0) { ld4bf(u_ - UP + 512 + c, R.pv); R.pg = bf2f(u_[832 + lane - UP]); } \
        else if (tr_) { const float* sh0_ = p.in[2] + ((size_t)l * BS + b_) * 896; const f32x4 s_ = *(const f32x4*)(sh0_ + 512 + c); R.pv[0] = s_[0]; R.pv[1] = s_[1]; R.pv[2] = s_[2]; R.pv[3] = s_[3]; R.pg = sh0_[832 + lane]; } \
        else { R.pv[0] = R.pv[1] = R.pv[2] = R.pv[3] = 0.f; R.pg = 0.f; } } while (0)
    if (gw < MROWS) POST_LOAD(cur, gw);
    for (int row = gw; row < MROWS; row += NGW) {
        if (row + NGW < MROWS) POST_LOAD(nxt, row + NGW);
        bf16* y = Yb + (size_t)row * DM;
        { const float m = red16(cur.y[0][0] + cur.y[0][1] + cur.y[0][2] + cur.y[0][3]) * (1.f / 64.f);
          float d[4], vs = 0.f;
#pragma unroll
          for (int e = 0; e < 4; ++e) { d[e] = cur.y[0][e] - m; vs += d[e] * d[e]; }
          const float rs = rsqrtf(red16(vs) * (1.f / 64.f) + 64e-5f);
          const float sg = sigmoidf_(cur.ug + (cur.pg - cur.ug) * mug);
          f32x4 g = {0.f, 0.f, 0.f, 0.f};
#pragma unroll 8
          for (int j = 0; j < 64; ++j) { const float sj = __shfl(sg, j); g += *(const f32x4*)(g2 + j * 256 + c) * sj; }
          float o[4];
#pragma unroll
          for (int e = 0; e < 4; ++e) { const float v = cur.uv[e] + (cur.pv[e] - cur.uv[e]) * muv[e]; o[e] = (d[e] * rs * lw[e] + lb[e] + cur.rkv * v) * g[e]; }
          st4bf(y + c, o); }
        { const float* yv = cur.y[1];
          const float rs = rsqrtf(red16(yv[0] * yv[0] + yv[1] * yv[1] + yv[2] * yv[2] + yv[3] * yv[3]) * (1.f / 64.f) + 1e-6f); float o[4];
#pragma unroll
          for (int e = 0; e < 4; ++e) o[e] = yv[e] * rs * wgl[e] * siluf_(cur.gg[e]);
          st4bf(y + 256 + c, o); }
        { const float* yv = cur.y[2];
          const float rs = rsqrtf(red16(yv[0] * yv[0] + yv[1] * yv[1] + yv[2] * yv[2] + yv[3] * yv[3]) * (1.f / 64.f) + 1e-6f); float o[4];
#pragma unroll
          for (int e = 0; e < 4; ++e) o[e] = yv[e] * rs * wdn[e] * siluf_(cur.dz[e]);
          st4bf(y + 512 + c, o); }
        { float yv[4]; float ss = 0.f;
#pragma unroll
          for (int e = 0; e < 4; ++e) { yv[e] = cur.y[3][e] * siluf_(cur.sz[e]); ss += yv[e] * yv[e]; }
          ss = red16(ss); ss += __shfl_xor(ss, 16);
          const float rs = rsqrtf(ss * (1.f / 128.f) + 1e-6f); float o[4];
#pragma unroll
          for (int e = 0; e < 4; ++e) o[e] = yv[e] * rs * wss[e];
          st4bf(y + 768 + c, o); }
        cur = nxt;
    }
#undef POST_LOAD
}

#define XB_TMO      128
#define XB_XCNT(j)  (256  + 64 * (j))
#define XB_XSUB(j)  (1280 + 64 * (j))
#define XB_XGEN(j)  (2304 + 64 * (j))
#define XB_TOP      3328
#define XB_TOPGEN   3392
#define XCD_BAR_WORDS 3456
#define XB_SPIN_CAP (1u << 18)

__device__ __forceinline__ unsigned xb_ld(unsigned* p)              { return __hip_atomic_load(p, __ATOMIC_RELAXED, __HIP_MEMORY_SCOPE_AGENT); }
__device__ __forceinline__ unsigned xb_add(unsigned* p, unsigned v) { return __hip_atomic_fetch_add(p, v, __ATOMIC_RELAXED, __HIP_MEMORY_SCOPE_AGENT); }
__device__ __forceinline__ unsigned xb_xcc_id() { return (unsigned)__builtin_amdgcn_s_getreg((3 << 11) | 20) & 0xFu; }
#define XB_SPIN(cond, bar) do { unsigned _sp = 0; while (cond) { __builtin_amdgcn_s_sleep(1); \
    if ((++_sp & 255u) == 0u) { if (xb_ld(&(bar)[XB_TMO])) break; if (_sp > XB_SPIN_CAP) { atomicAdd(&(bar)[XB_TMO], 1u); break; } } } } while (0)

struct XcdBarrier {
    unsigned* bar; unsigned x;
    volatile LAS unsigned* st;
};

__device__ __forceinline__ XcdBarrier xcd_barrier_post(unsigned* bar, volatile LAS unsigned* st) {
    XcdBarrier b; b.bar = bar; b.x = xb_xcc_id(); b.st = st;
    if (threadIdx.x == 0) (void)xb_add(&bar[XB_XCNT(b.x)], 1u);
    return b;
}
__device__ __forceinline__ void xcd_barrier_complete(unsigned* bar, unsigned x, unsigned& nloc, unsigned& nx) {
    const unsigned G = gridDim.x * gridDim.y * gridDim.z;
    unsigned sum, cnt, mine, sp = 0u;
    for (;;) {
        sum = 0u; cnt = 0u; mine = 0u;
#pragma unroll
        for (unsigned j = 0; j < 16; ++j) { const unsigned c = xb_ld(&bar[XB_XCNT(j)]); sum += c; cnt += (c > 0u) ? 1u : 0u; mine = (j == x) ? c : mine; }
        if (sum == G) break;
        __builtin_amdgcn_s_sleep(1);
        if ((++sp & 255u) == 0u) { if (xb_ld(&bar[XB_TMO])) break; if (sp > XB_SPIN_CAP) { atomicAdd(&bar[XB_TMO], 1u); break; } }
    }
    nloc = mine > 0u ? mine : 1u; nx = cnt > 0u ? cnt : 1u;
}

__device__ __forceinline__ void xcd_barrier(const XcdBarrier& b) {
    asm volatile("s_waitcnt vmcnt(0)" ::: "memory");
    __syncthreads();
    if (threadIdx.x == 0) {
        unsigned* bar = b.bar;
        __builtin_amdgcn_s_waitcnt(0);
        unsigned nloc = b.st[0], nx = b.st[1];
        if (nloc == 0u) { xcd_barrier_complete(bar, b.x, nloc, nx); b.st[0] = nloc; b.st[1] = nx; }
        const unsigned old = xb_add(&bar[XB_XSUB(b.x)], 1u);
        const unsigned gen = old / nloc;
        if (old + 1u == (gen + 1u) * nloc) {
            __builtin_amdgcn_fence(__ATOMIC_RELEASE, "agent");
            asm volatile("s_waitcnt vmcnt(0)" ::: "memory");
            const unsigned og = xb_add(&bar[XB_TOP], 1u);
            const unsigned tg = og / nx;
            if (og + 1u == (tg + 1u) * nx) xb_add(&bar[XB_TOPGEN], 1u);
            else XB_SPIN(xb_ld(&bar[XB_TOPGEN]) == tg, bar);
            __builtin_amdgcn_fence(__ATOMIC_ACQUIRE, "agent");
            xb_add(&bar[XB_XGEN(b.x)], 1u);
            asm volatile("s_waitcnt vmcnt(0)" ::: "memory");
        } else {
            XB_SPIN(xb_ld(&bar[XB_XGEN(b.x)]) == gen, bar);
            __builtin_amdgcn_fence(__ATOMIC_ACQUIRE, "agent");
            asm volatile("s_waitcnt vmcnt(0)" ::: "memory");
        }
    }
    __syncthreads();
}

__device__ __forceinline__ const void* uni(const void* q) { const unsigned long long v = (unsigned long long)q; const unsigned lo = __builtin_amdgcn_readfirstlane((unsigned)v), hi = __builtin_amdgcn_readfirstlane((unsigned)(v >> 32)); return (const void*)(const GASP char*)(((unsigned long long)hi << 32) | lo); }
__global__ void __launch_bounds__(NTHR, 2) hybrid_fwd(KP kp) {
    extern __shared__ __attribute__((aligned(16))) unsigned char lds[];
    cg::grid_group grid = cg::this_grid();
    KP* lp = (KP*)(lds + 131072);
    if (threadIdx.x == 0) *lp = kp;
    volatile LAS unsigned* xst = (volatile LAS unsigned*)(lds + 131072 + 512);
    if (threadIdx.x < 2) xst[threadIdx.x] = 0u;
    if (blockIdx.x == 0) for (int i = threadIdx.x; i < 4096 + 512; i += NTHR) ((unsigned*)(kp.ws + WS_BAR))[i] = 0u;
    __syncthreads();
    const KP& p = *lp;
    float* sm = (float*)lds;
#define WSB ((unsigned char*)uni(p.ws))
#define OUTB ((float*)uni(p.out))
#define INP(i) ((const float*)uni(p.in[i]))
    phase_p0(p, sm);
    grid.sync();
    const XcdBarrier xbar = xcd_barrier_post((unsigned*)(WSB + WS_BAR), xst);
    for (int l = 0; l < 2; ++l) {
        { const float* modl = (const float*)(WSB + WS_MOD) + (size_t)l * 136 * 6144;
          const float* xP = l == 0 ? INP(0) : nullptr; const float* xS = l == 0 ? INP(1) : nullptr;
          phase_norm(p, xP, xS, INP(13) + l * DM, modl, 0, 1024, l == 0 ? -1 : 5120 - 136 * 6144); }
        xcd_barrier(xbar);
        { unsigned char* ws = WSB; pg8::Gemm g{(const bf16*)(ws + WS_H), (const bf16*)(ws + WS_WTIN) + (size_t)l * UP * DM, MP, UP, DM, DM}; pg8::StaticOrder S; S.init(MP, UP, 1, (int)gridDim.x, (int)blockIdx.x);
          pg8::EpiBf16<0> E{(bf16*)(ws + WS_U), UP}; pg8::gemm_phase<pg8::EpiBf16<0>, pg8::StaticOrder, true, true>((PG8_LAS unsigned char*)lds, g, S, E); }
        xcd_barrier(xbar);
        { unsigned char* ws = WSB; const int G = (int)gridDim.x, bx = (int)blockIdx.x;
          pg8::Gemm g{(const bf16*)(ws + WS_H), (const bf16*)(ws + WS_WTIN) + (size_t)l * UP * DM, MROWS, UP, DM, DM};
          pg8::SampleTilesOrder S{(G + 2) / 4, (bx & 3) == 1 ? (bx >> 2) : -1, 16}; pg8::EpiBf16<0> E{(bf16*)(ws + WS_U), UP};
          const unsigned nd = (S.cs >= 0 && S.cs < 64) ? (unsigned)((64 - S.cs + S.Gs - 1) / S.Gs) : 0u;
          if (nd) pg8::gemm_phase<pg8::EpiBf16<0>, pg8::SampleTilesOrder, false, true>((PG8_LAS unsigned char*)lds, g, S, E);
          flag_signal((unsigned*)(ws + WS_BAR) + 4224 + 64 * l, nd); }
        phase_scan(p, l, sm);
        xcd_barrier(xbar);
        phase_post(p, l, sm);
        xcd_barrier(xbar);
        { unsigned char* ws = WSB; const float* modl = (const float*)(ws + WS_MOD) + (size_t)l * 136 * 6144;
          pg8::Gemm g{(const bf16*)(ws + WS_H), (const bf16*)(ws + WS_WTOUT) + (size_t)l * DM * DM, MP, DM, DM, DM}; pg8::StaticOrder S; S.init(MP, DM, 1, (int)gridDim.x, (int)blockIdx.x);
          if (l == 0) { pg8::EpiRes<true> E{INP(0), (bf16*)(ws + WS_X16), modl + 2048}; pg8::gemm_phase<pg8::EpiRes<true>, pg8::StaticOrder, true, true>((PG8_LAS unsigned char*)lds, g, S, E); }
          else { pg8::EpiRes<false> E{nullptr, (bf16*)(ws + WS_X16), modl + 2048}; pg8::gemm_phase<pg8::EpiRes<false>, pg8::StaticOrder, true, true>((PG8_LAS unsigned char*)lds, g, S, E); }
          pg8::Gemm g2{(const bf16*)(ws + WS_H), (const bf16*)(ws + WS_WTOUT) + (size_t)l * DM * DM, MROWS, DM, DM / 4, DM}; pg8::SampleSplitOrder S2{(int)gridDim.x, (int)blockIdx.x};
          pg8::EpiPart E2{(float*)(ws + WS_PART)}; pg8::gemm_phase<pg8::EpiPart, pg8::SampleSplitOrder, false, true>((PG8_LAS unsigned char*)lds, g2, S2, E2); }
        xcd_barrier(xbar);
        { const float* modl = (const float*)(WSB + WS_MOD) + (size_t)l * 136 * 6144;
          phase_norm(p, nullptr, l == 0 ? INP(1) : nullptr, INP(14) + l * DM, modl, 3072, 4096, 2048); }
        xcd_barrier(xbar);
        { unsigned char* ws = WSB; pg8::Gemm g{(const bf16*)(ws + WS_H), (const bf16*)(ws + WS_WTUP) + (size_t)l * DFF * DM, MP, DFF, DM, DM}; pg8::StaticOrder S; S.init(MP, DFF, 1, (int)gridDim.x, (int)blockIdx.x);
          pg8::EpiBf16<2> E{(bf16*)(ws + WS_U), DFF}; pg8::gemm_phase<pg8::EpiBf16<2>, pg8::StaticOrder, true, true>((PG8_LAS unsigned char*)lds, g, S, E); }
        xcd_barrier(xbar);
        { unsigned char* ws = WSB; const int G = (int)gridDim.x, bx = (int)blockIdx.x;
          pg8::Gemm g{(const bf16*)(ws + WS_H), (const bf16*)(ws + WS_WTUP) + (size_t)l * DFF * DM, MROWS, DFF, DM, DM};
          const int Gs = G < 64 ? G : 64; pg8::SampleTilesOrder S{Gs, bx >= G - Gs ? bx - (G - Gs) : -1, 16}; pg8::EpiBf16<2> E{(bf16*)(ws + WS_U), DFF};
          const unsigned nd = (S.cs >= 0 && S.cs < 64) ? (unsigned)((64 - S.cs + S.Gs - 1) / S.Gs) : 0u;
          if (nd) pg8::gemm_phase<pg8::EpiBf16<2>, pg8::SampleTilesOrder, false, true>((PG8_LAS unsigned char*)lds, g, S, E);
          flag_signal((unsigned*)(ws + WS_BAR) + 4352 + 64 * l, nd); }
        { unsigned char* ws = WSB; const float* modl = (const float*)(ws + WS_MOD) + (size_t)l * 136 * 6144;
          pg8::Gemm g{(const bf16*)(ws + WS_U), (const bf16*)(ws + WS_WTDN) + (size_t)l * DM * DFF, MP, DM, DFF, DFF}; pg8::StaticOrder S; S.init(MP, DM, 1, (int)gridDim.x, (int)blockIdx.x);
          pg8::EpiRes<false> E{nullptr, (bf16*)(ws + WS_X16), modl + 5120}; pg8::gemm_phase<pg8::EpiRes<false>, pg8::StaticOrder, true, true>((PG8_LAS unsigned char*)lds, g, S, E);
          if ((int)blockIdx.x < 64) flag_wait((unsigned*)(ws + WS_BAR) + 4352 + 64 * l, 64u);
          pg8::Gemm g2{(const bf16*)(ws + WS_U), (const bf16*)(ws + WS_WTDN) + (size_t)l * DM * DFF, MROWS, DM, DFF / 4, DFF}; pg8::SampleSplitOrder S2{(int)gridDim.x, (int)blockIdx.x};
          pg8::EpiPart E2{(float*)(ws + WS_PART)}; pg8::gemm_phase<pg8::EpiPart, pg8::SampleSplitOrder, false, true>((PG8_LAS unsigned char*)lds, g2, S2, E2); }
        xcd_barrier(xbar);
    }
    phase_final(p);
}

extern "C" void kernel_launch(void* const* d_in, const int* in_sizes, int n_in, void* d_out, int out_size, void* d_ws, size_t ws_size, hipStream_t stream) {
    static int grid = 0;
    if (grid == 0) {
        if (n_in != 44 || (size_t)out_size != O_TOTAL || ws_size < WS_END) { fprintf(stderr, "kernel_launch: unexpected shapes: n_in %d out %d ws %zu\n", n_in, out_size, ws_size); grid = -1; return; }
        int dev = 0, cus = 0, per_cu = 0;
        hipGetDevice(&dev); hipDeviceGetAttribute(&cus, hipDeviceAttributeMultiprocessorCount, dev);
        if (hipFuncSetAttribute((const void*)hybrid_fwd, hipFuncAttributeMaxDynamicSharedMemorySize, LDS_BYTES) != hipSuccess) { fprintf(stderr, "kernel_launch: hipFuncSetAttribute failed\n"); grid = -1; return; }
        if (hipOccupancyMaxActiveBlocksPerMultiprocessor(&per_cu, (const void*)hybrid_fwd, NTHR, LDS_BYTES) != hipSuccess || per_cu < 1) { fprintf(stderr, "kernel_launch: occupancy query failed (%d)\n", per_cu); grid = -1; return; }
        grid = cus * per_cu;
    }
    if (grid < 0) return;
    KP p{};
    for (int i = 0; i < 44; ++i) p.in.v[i] = (const float*)d_in[i];
    p.out.v = (float*)d_out; p.ws.v = (unsigned char*)d_ws;
    void* args[] = {&p};
    hipError_t e = hipLaunchCooperativeKernel((const void*)hybrid_fwd, dim3(grid), dim3(NTHR), args, LDS_BYTES, stream);
    if (e != hipSuccess) fprintf(stderr, "kernel_launch: cooperative launch failed: %s (grid %d)\n", hipGetErrorString(e), grid);
}
```

```cpp
#include <hip/hip_runtime.h>
#include <hip/hip_cooperative_groups.h>
#include <cstdio>
#include <cstdint>
namespace cg = cooperative_groups;

namespace pg8 {
#define PG8_LAS __attribute__((address_space(3)))
typedef unsigned short bf16_t;
typedef short bf16x8 __attribute__((ext_vector_type(8)));
typedef float f32x4 __attribute__((ext_vector_type(4)));
typedef unsigned u32x4 __attribute__((ext_vector_type(4)));
constexpr int BM = 256, BK = 64, HALF = 128, HTB = HALF * BK * 2, STAGE_BYTES = 8 * HTB, NXCD = 8, WGM = 8;

__host__ __device__ __forceinline__ int lds_byte(int r, int c) { const int st = (r >> 4) * 2 + (c >> 5), rr = r & 15, cc = c & 31, ob = rr * 64 + cc * 2; return st * 1024 + (ob ^ (((ob >> 9) & 1) << 5)); }
__host__ __device__ __forceinline__ void stage_rc(int b, int& R, int& C) { const int st = b / 1024, sb = b % 1024, swz = sb ^ (((sb >> 9) & 1) << 5); R = (st >> 1) * 16 + swz / 64; C = (st & 1) * 32 + (swz % 64) / 2; }
__host__ __device__ __forceinline__ int perm32(int rho) { const int n = rho >> 4, i = rho & 15; return 8 * (i >> 2) + 4 * n + (i & 3); }

struct Unit { int pm, pn, pk; };
struct Gemm { const bf16_t* A; const bf16_t* Bt; int M, N, K, ld; };

struct StaticOrder {
    int nM, nN, nK, ntile, nwg, G, c;
    __host__ __device__ void init(int M, int N, int nK_, int G_, int c_) { nM = M / BM; nN = N / BM; nK = nK_; ntile = nM * nN; nwg = ntile * nK; G = G_; c = c_; }
    __host__ __device__ bool next(int i, Unit& u) const {
        const long L = (long)i * G + c; if (L >= nwg) return false;
        int wgid = (int)L; { const int q = nwg / NXCD, r = nwg % NXCD, xcd = wgid % NXCD, off = wgid / NXCD; wgid = (xcd < r ? xcd * (q + 1) : r * (q + 1) + (xcd - r) * q) + off; }
        u.pk = wgid / ntile; wgid -= u.pk * ntile;
        const int nig = WGM * nN, gid = wgid / nig, fm = gid * WGM, gsz = (nM - fm) < WGM ? (nM - fm) : WGM;
        u.pm = fm + ((wgid % nig) % gsz); u.pn = (wgid % nig) / gsz; return true;
    }
    __device__ __forceinline__ void a_ready(const Unit&) const {}
    __device__ __forceinline__ void done(const Unit&) const {}
};
__device__ __forceinline__ unsigned cvt_pk_bf16(float lo, float hi) { unsigned r; asm volatile("v_cvt_pk_bf16_f32 %0, %1, %2" : "=v"(r) : "v"(lo), "v"(hi)); return r; }

template <int ACT  > struct EpiBf16 {
    static constexpr bool PERM = true, AFTER_DRAIN = false;
    bf16_t* O; int ldc;
    __device__ __forceinline__ void operator()(const f32x4 (&acc)[2][2][4][2], const Unit& u, int wr, int wc, int fr, int fq) const {
        const int row0 = u.pm * BM + wr * 64 + fr, col0 = u.pn * BM + wc * 32 + 8 * fq;
#pragma unroll
        for (int ai = 0; ai < 2; ++ai)
#pragma unroll
            for (int m = 0; m < 4; ++m) { bf16_t* rowp = O + (size_t)(row0 + ai * HALF + m * 16) * ldc + col0;
#pragma unroll
                for (int bj = 0; bj < 2; ++bj) { f32x4 v0 = acc[ai][bj][m][0], v1 = acc[ai][bj][m][1];
                    if (ACT == 2) {
#pragma unroll
                        for (int j = 0; j < 4; ++j) { float a = fmaxf(v0[j], 0.f), b = fmaxf(v1[j], 0.f); v0[j] = a * a; v1[j] = b * b; } }
                    u32x4 w; w.x = cvt_pk_bf16(v0[0], v0[1]); w.y = cvt_pk_bf16(v0[2], v0[3]); w.z = cvt_pk_bf16(v1[0], v1[1]); w.w = cvt_pk_bf16(v1[2], v1[3]);
                    *(u32x4*)(rowp + bj * HALF) = w; } }
    }
};
template <bool SRCF32> struct EpiRes {
    static constexpr bool PERM = true, AFTER_DRAIN = false;
    const float* srcF; bf16_t* X; const float* gate;
    __device__ __forceinline__ void operator()(const f32x4 (&acc)[2][2][4][2], const Unit& u, int wr, int wc, int fr, int fq) const {
        const int row0 = u.pm * BM + wr * 64 + fr, col0 = u.pn * BM + wc * 32 + 8 * fq;
#pragma unroll
        for (int ai = 0; ai < 2; ++ai)
#pragma unroll
            for (int m = 0; m < 4; ++m) { const int row = row0 + ai * HALF + m * 16;
                const int cond = row < 16384 ? (row >> 11) : 8 + ((row - 16384) >> 3);
                const float* g = gate + (size_t)cond * 6144; bf16_t* d = X + (size_t)row * 1024;
#pragma unroll
                for (int bj = 0; bj < 2; ++bj) { const int c = col0 + bj * HALF; const f32x4 g0 = *(const f32x4*)(g + c), g1 = *(const f32x4*)(g + c + 4);
                    f32x4 x0, x1;
                    if (SRCF32) { const float* s = srcF + (size_t)row * 1024 + c; x0 = *(const f32x4*)s; x1 = *(const f32x4*)(s + 4); }
                    else { const u32x4 w = *(const u32x4*)(d + c);
                        x0 = (f32x4){__builtin_bit_cast(float, w.x << 16), __builtin_bit_cast(float, w.x & 0xffff0000u), __builtin_bit_cast(float, w.y << 16), __builtin_bit_cast(float, w.y & 0xffff0000u)};
                        x1 = (f32x4){__builtin_bit_cast(float, w.z << 16), __builtin_bit_cast(float, w.z & 0xffff0000u), __builtin_bit_cast(float, w.w << 16), __builtin_bit_cast(float, w.w & 0xffff0000u)}; }
                    x0 += g0 * acc[ai][bj][m][0]; x1 += g1 * acc[ai][bj][m][1];
                    u32x4 o; o.x = cvt_pk_bf16(x0[0], x0[1]); o.y = cvt_pk_bf16(x0[2], x0[3]); o.z = cvt_pk_bf16(x1[0], x1[1]); o.w = cvt_pk_bf16(x1[2], x1[3]);
                    *(u32x4*)(d + c) = o; } }
    }
};

struct SampleSplitOrder {
    int G, c;
    __device__ bool next(int i, Unit& u) const { const int L = i * G + c; if (L >= 64) return false; u.pk = L & 3; const int t = L >> 2; u.pm = 64 + (t >> 2); u.pn = t & 3; return true; }
    __device__ __forceinline__ void a_ready(const Unit&) const {}
    __device__ __forceinline__ void done(const Unit&) const {}
};
struct EpiPart {
    static constexpr bool PERM = true, AFTER_DRAIN = false;
    float* P;
    __device__ __forceinline__ void operator()(const f32x4 (&acc)[2][2][4][2], const Unit& u, int wr, int wc, int fr, int fq) const {
        const int row0 = (u.pm - 64) * BM + wr * 64 + fr, col0 = u.pn * BM + wc * 32 + 8 * fq;
#pragma unroll
        for (int ai = 0; ai < 2; ++ai)
#pragma unroll
            for (int m = 0; m < 4; ++m) { float* d = P + ((size_t)u.pk * 1024 + row0 + ai * HALF + m * 16) * 1024 + col0;
#pragma unroll
                for (int bj = 0; bj < 2; ++bj) { *(f32x4*)(d + bj * HALF) = acc[ai][bj][m][0]; *(f32x4*)(d + bj * HALF + 4) = acc[ai][bj][m][1]; } }
    }
};

struct SampleTilesOrder {
    int Gs, cs, nN;
    __device__ bool next(int i, Unit& u) const { if (cs < 0) return false; const int L = i * Gs + cs; if (L >= 4 * nN) return false; u.pk = 0; u.pm = 64 + L / nN; u.pn = L % nN; return true; }
    __device__ __forceinline__ void a_ready(const Unit&) const {}
    __device__ __forceinline__ void done(const Unit&) const {}
};

template <class Epi, class Sched, bool ALIGN_EPI = false, bool SP2 = false>
__device__ __forceinline__ void gemm_phase(PG8_LAS unsigned char* lds, const Gemm g, const Sched& S, const Epi& E) {
    int tid_ = threadIdx.x; asm volatile("" : "+v"(tid_));
    const int tid = tid_, wid = __builtin_amdgcn_readfirstlane(tid >> 6), lane = tid & 63, wr = wid >> 2, wc = wid & 3, fr = lane & 15, fq = lane >> 4;
    const int K = g.ld, nt = g.K / BK; const size_t kspl = (size_t)g.K * 2;
    unsigned voffA[2], voffB[2];
#pragma unroll
    for (int i = 0; i < 2; ++i) { int R, C; stage_rc(tid * 16 + i * 8192, R, C); const int Rb = Epi::PERM ? ((R & ~31) + perm32(R & 31)) : R;
        voffA[i] = (unsigned)(R * K + C) * 2u; voffB[i] = (unsigned)(Rb * K + C) * 2u; }
    const size_t kstep = (size_t)(BK * 2);
    const size_t hstep = (size_t)HALF * K * 2;
    const size_t tstep = 2 * hstep;
    const unsigned ldsw = (unsigned)wid * 1024u;
    const int aoff = lds_byte(wr * 64 + fr, fq * 8), boff = lds_byte(wc * 32 + fr, fq * 8);
#define PG8_SA(b, h) (((b) * 2 + (h)) * HTB)
#define PG8_SB(b, h) ((4 + (b) * 2 + (h)) * HTB)
#define PG8_STAGE(bufoff, gbase, voff) do { _Pragma("unroll") for (int _i = 0; _i < 2; ++_i) \
        __builtin_amdgcn_global_load_lds((const unsigned*)((const char*)(gbase) + (voff)[_i]), (PG8_LAS unsigned*)(lds + (bufoff) + ldsw + _i * 8192), 16, 0, 0); } while (0)
#define PG8_LDA(dst, b, h) do { _Pragma("unroll") for (int m = 0; m < 4; ++m) _Pragma("unroll") for (int k = 0; k < 2; ++k) dst[m][k] = *(const PG8_LAS bf16x8*)(lds + PG8_SA(b, h) + aoff + m * 2048 + k * 1024); } while (0)
#define PG8_LDB(dst, b, h) do { _Pragma("unroll") for (int n = 0; n < 2; ++n) _Pragma("unroll") for (int k = 0; k < 2; ++k) dst[n][k] = *(const PG8_LAS bf16x8*)(lds + PG8_SB(b, h) + boff + n * 2048 + k * 1024); } while (0)
#define PG8_MMA(ai, bj, At, Bt) do { __builtin_amdgcn_s_setprio(1); _Pragma("unroll") for (int m = 0; m < 4; ++m) _Pragma("unroll") for (int n = 0; n < 2; ++n) _Pragma("unroll") for (int k = 0; k < 2; ++k) \
        acc[ai][bj][m][n] = __builtin_amdgcn_mfma_f32_16x16x32_bf16(Bt[n][k], At[m][k], acc[ai][bj][m][n], 0, 0, 0); __builtin_amdgcn_s_setprio(0); } while (0)
#define PG8_WAIT_V(n) asm volatile("s_waitcnt vmcnt(" #n ")" ::: "memory")
#define PG8_WAIT_L(n) asm volatile("s_waitcnt lgkmcnt(" #n ")" ::: "memory")
#define PG8_BAR __builtin_amdgcn_s_barrier()
#define PG8_SCHED __builtin_amdgcn_sched_barrier(0)
    Unit cur, nxt; int ui = 0;
    if (!S.next(0, cur)) return;
    f32x4 acc[2][2][4][2];
#pragma unroll
    for (int a = 0; a < 2; ++a)
#pragma unroll
        for (int b = 0; b < 2; ++b)
#pragma unroll
            for (int m = 0; m < 4; ++m)
#pragma unroll
                for (int n = 0; n < 2; ++n) acc[a][b][m][n] = (f32x4){0.f, 0.f, 0.f, 0.f};
    bf16x8 At[4][2], B0[2][2], B1[2][2];
    const char* cA = (const char*)g.A + (size_t)cur.pm * tstep + (size_t)cur.pk * kspl; const char* cB = (const char*)g.Bt + (size_t)cur.pn * tstep + (size_t)cur.pk * kspl;
    S.a_ready(cur);
    if constexpr (SP2) {
        PG8_STAGE(PG8_SB(0, 0), cB, voffB); PG8_STAGE(PG8_SB(0, 1), cB + hstep, voffB); PG8_STAGE(PG8_SA(0, 0), cA, voffA); PG8_STAGE(PG8_SA(0, 1), cA + hstep, voffA);
        if (wr == 1) PG8_BAR;
        PG8_WAIT_V(2); PG8_BAR;
        PG8_STAGE(PG8_SB(1, 0), cB + kstep, voffB); PG8_STAGE(PG8_SA(1, 0), cA + kstep, voffA); PG8_STAGE(PG8_SB(1, 1), cB + hstep + kstep, voffB);
        PG8_WAIT_V(6); PG8_BAR;
    } else {
        PG8_STAGE(PG8_SB(0, 0), cB, voffB); PG8_STAGE(PG8_SA(0, 0), cA, voffA); PG8_STAGE(PG8_SB(0, 1), cB + hstep, voffB); PG8_STAGE(PG8_SA(0, 1), cA + hstep, voffA);
        if (wr == 1) PG8_BAR;
        PG8_WAIT_V(4); PG8_BAR;
        PG8_STAGE(PG8_SB(1, 0), cB + kstep, voffB); PG8_STAGE(PG8_SA(1, 0), cA + kstep, voffA); PG8_STAGE(PG8_SB(1, 1), cB + hstep + kstep, voffB);
        PG8_WAIT_V(6); PG8_BAR;
    }
    for (;;) {
        const bool has_next = S.next(ui + 1, nxt);
        const char* nA = has_next ? (const char*)g.A + (size_t)nxt.pm * tstep + (size_t)nxt.pk * kspl : cA; const char* nB = has_next ? (const char*)g.Bt + (size_t)nxt.pn * tstep + (size_t)nxt.pk * kspl : cB;
        for (int t = 0; t < nt; t += 2) {
            const bool last = (t == nt - 2);
            const char* a1 = cA + (size_t)(t + 1) * kstep;
            const char* a2 = last ? nA : cA + (size_t)(t + 2) * kstep; const char* b2 = last ? nB : cB + (size_t)(t + 2) * kstep;
            const char* a3 = a2 + kstep; const char* b3 = b2 + kstep;
            if (last && has_next) S.a_ready(nxt);
            if constexpr (SP2) {
            PG8_LDB(B0, 0, 0); PG8_LDB(B1, 0, 1); PG8_SCHED; PG8_LDA(At, 0, 0); PG8_STAGE(PG8_SA(1, 1), a1 + hstep, voffA);
            PG8_WAIT_V(8); PG8_WAIT_L(0); PG8_BAR; PG8_MMA(0, 0, At, B0); PG8_MMA(0, 1, At, B1); PG8_BAR; PG8_SCHED;
            PG8_LDA(At, 0, 1); PG8_STAGE(PG8_SB(0, 0), b2, voffB); PG8_STAGE(PG8_SB(0, 1), b2 + hstep, voffB); PG8_STAGE(PG8_SA(0, 0), a2, voffA);
            PG8_WAIT_V(8); PG8_WAIT_L(0); PG8_BAR; PG8_MMA(1, 0, At, B0); PG8_MMA(1, 1, At, B1); PG8_BAR; PG8_SCHED;
            PG8_LDB(B0, 1, 0); PG8_LDB(B1, 1, 1); PG8_SCHED; PG8_LDA(At, 1, 0); PG8_STAGE(PG8_SA(0, 1), a2 + hstep, voffA);
            PG8_WAIT_V(8); PG8_WAIT_L(0); PG8_BAR; PG8_MMA(0, 0, At, B0); PG8_MMA(0, 1, At, B1); PG8_BAR; PG8_SCHED;
            PG8_LDA(At, 1, 1); PG8_STAGE(PG8_SB(1, 0), b3, voffB); PG8_STAGE(PG8_SB(1, 1), b3 + hstep, voffB); PG8_STAGE(PG8_SA(1, 0), a3, voffA);
            PG8_WAIT_V(8); PG8_WAIT_L(0); PG8_BAR; PG8_MMA(1, 0, At, B0); PG8_MMA(1, 1, At, B1); PG8_BAR; PG8_SCHED;
            } else {
            PG8_LDB(B0, 0, 0); PG8_SCHED; PG8_LDA(At, 0, 0); PG8_STAGE(PG8_SA(1, 1), a1 + hstep, voffA);
            PG8_WAIT_L(8); PG8_BAR; PG8_WAIT_L(0); PG8_MMA(0, 0, At, B0); PG8_BAR; PG8_SCHED;
            PG8_LDB(B1, 0, 1); PG8_STAGE(PG8_SB(0, 0), b2, voffB);
            PG8_BAR; PG8_WAIT_L(0); PG8_MMA(0, 1, At, B1); PG8_BAR;
            PG8_LDA(At, 0, 1); PG8_STAGE(PG8_SA(0, 0), a2, voffA);
            PG8_BAR; PG8_WAIT_L(0); PG8_MMA(1, 0, At, B0); PG8_BAR; PG8_SCHED;
            PG8_STAGE(PG8_SB(0, 1), b2 + hstep, voffB);
            PG8_WAIT_V(6); PG8_BAR; PG8_MMA(1, 1, At, B1); PG8_BAR;
            PG8_LDB(B0, 1, 0); PG8_SCHED; PG8_LDA(At, 1, 0); PG8_STAGE(PG8_SA(0, 1), a2 + hstep, voffA);
            PG8_WAIT_L(8); PG8_BAR; PG8_WAIT_L(0); PG8_MMA(0, 0, At, B0); PG8_BAR; PG8_SCHED;
            PG8_LDB(B1, 1, 1); PG8_STAGE(PG8_SB(1, 0), b3, voffB);
            PG8_BAR; PG8_WAIT_L(0); PG8_MMA(0, 1, At, B1); PG8_BAR;
            PG8_LDA(At, 1, 1); PG8_STAGE(PG8_SA(1, 0), a3, voffA);
            PG8_BAR; PG8_WAIT_L(0); PG8_MMA(1, 0, At, B0); PG8_BAR; PG8_SCHED;
            PG8_STAGE(PG8_SB(1, 1), b3 + hstep, voffB);
            PG8_WAIT_V(6); PG8_BAR; PG8_MMA(1, 1, At, B1); PG8_BAR;
            }
        }
        if constexpr (ALIGN_EPI) { if (wr == 0) PG8_BAR; }
        if constexpr (!Epi::AFTER_DRAIN) { E(acc, cur, wr, wc, fr, fq); S.done(cur); }
        if (!has_next) break;
#pragma unroll
        for (int a = 0; a < 2; ++a)
#pragma unroll
            for (int b = 0; b < 2; ++b)
#pragma unroll
                for (int m = 0; m < 4; ++m)
#pragma unroll
                    for (int n = 0; n < 2; ++n) acc[a][b][m][n] = (f32x4){0.f, 0.f, 0.f, 0.f};
        cur = nxt; cA = nA; cB = nB; ++ui;
        if constexpr (ALIGN_EPI) { if (wr == 1) PG8_BAR; }
    }
    PG8_WAIT_V(0);
    if constexpr (!ALIGN_EPI) { if (wr == 0) PG8_BAR; }
    PG8_BAR;
    if constexpr (Epi::AFTER_DRAIN) { E.fused(acc, cur, wr, wc, fr, fq, lds, wid, lane); S.done(cur); }
#undef PG8_SA
#undef PG8_SB
#undef PG8_STAGE
#undef PG8_LDA
#undef PG8_LDB
#undef PG8_MMA
#undef PG8_WAIT_V
#undef PG8_WAIT_L
#undef PG8_BAR
#undef PG8_SCHED
}
}

typedef unsigned short bf16;
#define LAS __attribute__((address_space(3)))
typedef float f32x4 __attribute__((ext_vector_type(4)));
constexpr int DM = 1024, TP = 2048, BP = 8, BS = 128, TS = 8, MP = BP * TP, MS = BS * TS, MROWS = MP + MS, UP = 4096, PT = 3996, DFF = 4096;
constexpr int CA = 0, CB = 896, CC = 1936, CD = 2968;
constexpr int NTHR = 512, NWAVES = 8;
constexpr int LDS_BYTES = 135168;
constexpr size_t MiB = 1u << 20;
constexpr size_t WS_BAR = 59 * MiB + 512 * 1024;
constexpr size_t WS_WTIN = 0, WS_WTOUT = 16 * MiB, WS_WTUP = 20 * MiB, WS_WTDN = 36 * MiB, WS_MOD = 52 * MiB, WS_AUX = 59 * MiB, WS_H = 60 * MiB, WS_U = 94 * MiB, WS_PART = 230 * MiB, WS_X16 = 246 * MiB, WS_END = 280 * MiB;
static_assert(WS_MOD + (size_t)2 * 136 * 6144 * 4 <= WS_AUX && WS_AUX + (size_t)MROWS * 4 * 4 <= WS_H && WS_H + (size_t)MROWS * DM * 2 <= WS_U && WS_U + (size_t)MROWS * UP * 2 <= WS_PART, "ws map");
constexpr size_t O_PSHIFT = (size_t)MROWS * DM, O_PWKV = O_PSHIFT + 2 * 8 * 896, O_PGLA = O_PWKV + 2 * 8 * 4 * 4096, O_PDNC = O_PGLA + 2 * 8 * 4 * 4096, O_PDN = O_PDNC + 2 * 8 * 3 * 768,
                 O_PSSC = O_PDN + 2 * 8 * 4 * 4096, O_PSSM = O_PSSC + 2 * 8 * 3 * 768, O_SSHIFT = O_PSSM + 2 * 8 * 4 * 8192, O_SWKV = O_SSHIFT + 2 * 128 * 896, O_SGLA = O_SWKV + (size_t)2 * 128 * 4 * 4096,
                 O_SDNC = O_SGLA + (size_t)2 * 128 * 4 * 4096, O_SDN = O_SDNC + 2 * 128 * 3 * 768, O_SSSC = O_SDN + (size_t)2 * 128 * 4 * 4096, O_SSSM = O_SSSC + 2 * 128 * 3 * 768, O_TOTAL = O_SSSM + (size_t)2 * 128 * 4 * 8192;

#define GASP __attribute__((address_space(1)))
template <class T> __device__ __forceinline__ T* as_global(T* q) { return (T*)(GASP T*)(unsigned long long)q; }
struct KP {
    struct In { const float* v[44]; __device__ __forceinline__ const float* operator[](int i) const { return as_global(v[i]); } } in;
    struct Out { float* v; __device__ __forceinline__ operator float*() const { return as_global(v); } } out;
    struct Ws { unsigned char* v; __device__ __forceinline__ operator unsigned char*() const { return as_global(v); } } ws;
};

__device__ __forceinline__ int otid() { int t = threadIdx.x; asm volatile("" : "+v"(t)); return t; }
__device__ __forceinline__ float bf2f(bf16 h) { return __builtin_bit_cast(float, (unsigned)h << 16); }
__device__ __forceinline__ unsigned f2bf(float f) { unsigned u = __builtin_bit_cast(unsigned, f); return (u + 0x7fffu + ((u >> 16) & 1u)) >> 16; }
__device__ __forceinline__ unsigned pk2(float lo, float hi) { unsigned r; asm("v_cvt_pk_bf16_f32 %0, %1, %2" : "=v"(r) : "v"(lo), "v"(hi)); return r; }
typedef short bf16x8v __attribute__((ext_vector_type(8)));
__device__ __forceinline__ uint4 pack8f(const float* s) { uint4 v; v.x = pk2(s[0], s[1]); v.y = pk2(s[2], s[3]); v.z = pk2(s[4], s[5]); v.w = pk2(s[6], s[7]); return v; }
template <int CTRL> __device__ __forceinline__ float dppf(float x) { return __builtin_bit_cast(float, __builtin_amdgcn_mov_dpp(__builtin_bit_cast(int, x), CTRL, 0xf, 0xf, true)); }
__device__ __forceinline__ float red16(float v) { v += dppf<0xB1>(v); v += dppf<0x4E>(v); v += dppf<0x141>(v); v += dppf<0x128>(v); return v; }
__device__ __forceinline__ float wave_sum(float v) { v = red16(v); v += __shfl_xor(v, 16); v += __shfl_xor(v, 32); return v; }
__device__ __forceinline__ float sigmoidf_(float x) { return __builtin_amdgcn_rcpf(1.f + __expf(-x)); }
__device__ __forceinline__ float siluf_(float x) { return x * __builtin_amdgcn_rcpf(1.f + __expf(-x)); }
__device__ __forceinline__ float softplusf_(float x) { return fmaxf(x, 0.f) + __logf(1.f + __expf(-fabsf(x))); }
__device__ __forceinline__ float tanhf_(float x) { return 1.f - 2.f * __builtin_amdgcn_rcpf(__expf(2.f * x) + 1.f); }

__device__ __forceinline__ void transpose_item(const float* W, int K, int N, bf16* WT, float* scr, int item, int nblk, int lane) {
    const int kb = item / nblk, nb = item % nblk, k0 = 64 * kb, n0 = 32 * nb;
    const int kr = lane >> 3, c4 = (lane & 7) * 4; const bool ok = n0 + c4 < N;
    f32x4 v[8];
#pragma unroll
    for (int i = 0; i < 8; ++i) v[i] = ok ? *(const f32x4*)(W + (size_t)(k0 + i * 8 + kr) * N + n0 + c4) : (f32x4){0.f, 0.f, 0.f, 0.f};
#pragma unroll
    for (int i = 0; i < 8; ++i) { float* d = scr + (i * 8 + kr) * 33 + c4; d[0] = v[i][0]; d[1] = v[i][1]; d[2] = v[i][2]; d[3] = v[i][3]; }
    __builtin_amdgcn_s_waitcnt(0); __builtin_amdgcn_wave_barrier();
    const int c = lane & 7;
#pragma unroll
    for (int j = 0; j < 4; ++j) { const int nn = (lane >> 3) + 8 * j; const float* s = scr + (8 * c) * 33 + nn;
        uint4 o; o.x = pk2(s[0 * 33], s[1 * 33]); o.y = pk2(s[2 * 33], s[3 * 33]); o.z = pk2(s[4 * 33], s[5 * 33]); o.w = pk2(s[6 * 33], s[7 * 33]);
        *(uint4*)(WT + (size_t)(n0 + nn) * K + k0 + 8 * c) = o; }
    __builtin_amdgcn_s_waitcnt(0); __builtin_amdgcn_wave_barrier();
}

__device__ __forceinline__ void phase_p0(const KP& p, float* sm) {
    const int tid = otid(), lane = tid & 63, wv = tid >> 6, G = gridDim.x;
    { bf16* AS = (bf16*)sm; const int nt = wv & 3, mh = wv >> 2, n = lane & 15, fq = lane >> 4;
      for (int u = blockIdx.x; u < 2 * 96; u += G) {
        const int l = u / 96, n0 = (u % 96) * 64 + nt * 16 + n;
        const float* W = p.in[11] + (size_t)l * DM * 6144 + n0;
        f32x4 acc[5];
#pragma unroll
        for (int m = 0; m < 5; ++m) acc[m] = (f32x4){0.f, 0.f, 0.f, 0.f};
        float wb[2][8];
#pragma unroll
        for (int ks = 0; ks < 2; ++ks)
#pragma unroll
            for (int j = 0; j < 8; ++j) wb[ks][j] = W[(size_t)(ks * 32 + fq * 8 + j) * 6144];
        for (int kc = 0; kc < DM; kc += 64) {
            __syncthreads();
            for (int i = tid; i < 144 * 32; i += NTHR) { const int r = i >> 5, k = (i & 31) * 2;
                float c0 = 0.f, c1 = 0.f;
                if (r < 8) { const float2 c = *(const float2*)(p.in[9] + (size_t)r * DM + kc + k); c0 = siluf_(c.x); c1 = siluf_(c.y); }
                else if (r < 136) { const float2 c = *(const float2*)(p.in[10] + (size_t)(r - 8) * DM + kc + k); c0 = siluf_(c.x); c1 = siluf_(c.y); }
                *(unsigned*)(AS + r * 72 + k) = pk2(c0, c1); }
            __syncthreads();
            bf16x8v B[2];
#pragma unroll
            for (int ks = 0; ks < 2; ++ks) { const uint4 t = pack8f(wb[ks]); B[ks] = __builtin_bit_cast(bf16x8v, t); }
            if (kc + 64 < DM) {
#pragma unroll
                for (int ks = 0; ks < 2; ++ks)
#pragma unroll
                    for (int j = 0; j < 8; ++j) wb[ks][j] = W[(size_t)(kc + 64 + ks * 32 + fq * 8 + j) * 6144]; }
#pragma unroll
            for (int ks = 0; ks < 2; ++ks)
#pragma unroll
                for (int m = 0; m < 5; ++m) { const int mt = mh * 5 + m; if (mt < 9) { const bf16x8v A = *(const bf16x8v*)(AS + (mt * 16 + n) * 72 + ks * 32 + fq * 8);
                    acc[m] = __builtin_amdgcn_mfma_f32_16x16x32_bf16(A, B[ks], acc[m], 0, 0, 0); } }
        }
        const float bias = p.in[12][(size_t)l * 6144 + n0];
        float* M = (float*)(p.ws + WS_MOD) + (size_t)l * 136 * 6144 + n0;
#pragma unroll
        for (int m = 0; m < 5; ++m) { const int mt = mh * 5 + m;
#pragma unroll
            for (int i = 0; i < 4; ++i) { const int row = mt * 16 + fq * 4 + i; if (mt < 9 && row < 136) M[(size_t)row * 6144] = acc[m][i] + bias; } }
      }
      __syncthreads(); }
    const int gw = blockIdx.x * NWAVES + wv, NGW = G * NWAVES;
    float* scr = sm + wv * (64 * 33);
    constexpr int I_IN = 16 * 128, I_OUT = 16 * 32, I_UP = 16 * 128, I_DN = 64 * 32, I_L = I_IN + I_OUT + I_UP + I_DN;
    for (int it = gw; it < 2 * I_L; it += NGW) {
        const int l = it / I_L; int r = it % I_L;
        if (r < I_IN) { transpose_item(p.in[15] + (size_t)l * DM * PT, DM, PT, (bf16*)(p.ws + WS_WTIN) + (size_t)l * UP * DM, scr, r, 128, lane); continue; } r -= I_IN;
        if (r < I_OUT) { transpose_item(p.in[16] + (size_t)l * DM * DM, DM, DM, (bf16*)(p.ws + WS_WTOUT) + (size_t)l * DM * DM, scr, r, 32, lane); continue; } r -= I_OUT;
        if (r < I_UP) { transpose_item(p.in[17] + (size_t)l * DM * DFF, DM, DFF, (bf16*)(p.ws + WS_WTUP) + (size_t)l * DFF * DM, scr, r, 128, lane); continue; } r -= I_UP;
        transpose_item(p.in[18] + (size_t)l * DFF * DM, DFF, DM, (bf16*)(p.ws + WS_WTDN) + (size_t)l * DM * DFF, scr, r, 32, lane);
    }
    __syncthreads();
}

__device__ __forceinline__ void load_xrow(f32x4 (&v)[4], const float* xf, const bf16* x16, int lane) {
    if (xf) {
#pragma unroll
        for (int j = 0; j < 4; ++j) v[j] = *(const f32x4*)(xf + lane * 4 + 256 * j); }
    else {
#pragma unroll
        for (int j = 0; j < 4; ++j) { const uint2 w = *(const uint2*)(x16 + lane * 4 + 256 * j);
            v[j] = (f32x4){__builtin_bit_cast(float, w.x << 16), __builtin_bit_cast(float, w.x & 0xffff0000u), __builtin_bit_cast(float, w.y << 16), __builtin_bit_cast(float, w.y & 0xffff0000u)}; } }
}
__device__ __forceinline__ void phase_norm(const KP& p, const float* xPf, const float* xSf, const float* nw, const float* modl, int sh_off, int sc_off, int gate_off) {
    const int tid = otid(), lane = tid & 63, wv = tid >> 6; const int gw = blockIdx.x * NWAVES + wv, NGW = gridDim.x * NWAVES;
    bf16* H = (bf16*)(p.ws + WS_H); bf16* X16 = (bf16*)(p.ws + WS_X16);
    f32x4 v[4], vn[4];
#define NRM_LOAD(dst, row) load_xrow(dst, (row) < MP ? (xPf ? xPf + (size_t)(row) * DM : nullptr) : (xSf ? xSf + (size_t)((row) - MP) * DM : nullptr), X16 + (size_t)(row) * DM, lane)
    if (gw < MROWS) NRM_LOAD(v, gw);
    for (int row = gw; row < MROWS; row += NGW) {
        if (row + NGW < MROWS) NRM_LOAD(vn, row + NGW);
        const int cond = row < MP ? (row >> 11) : 8 + ((row - MP) >> 3);
        const float* md = modl + (size_t)cond * 6144;
        if (row >= MP && gate_off != -1) {
            const float* P = (const float*)(p.ws + WS_PART) + (size_t)(row - MP) * DM; bf16* xo_ = X16 + (size_t)row * DM;
#pragma unroll
            for (int j = 0; j < 4; ++j) { const int c = lane * 4 + 256 * j; const f32x4 g = *(const f32x4*)(md + gate_off + c);
                const f32x4 sp = (*(const f32x4*)(P + c) + *(const f32x4*)(P + (size_t)1024 * DM + c)) + (*(const f32x4*)(P + (size_t)2048 * DM + c) + *(const f32x4*)(P + (size_t)3072 * DM + c));
                v[j] += g * sp; uint2 o; o.x = pk2(v[j][0], v[j][1]); o.y = pk2(v[j][2], v[j][3]); *(uint2*)(xo_ + c) = o; } }
        float ss = 0.f;
#pragma unroll
        for (int j = 0; j < 4; ++j) ss += v[j][0] * v[j][0] + v[j][1] * v[j][1] + v[j][2] * v[j][2] + v[j][3] * v[j][3];
        const float rs = rsqrtf(wave_sum(ss) * (1.f / DM) + 1e-6f);
#pragma unroll
        for (int j = 0; j < 4; ++j) { const int c = lane * 4 + 256 * j; const f32x4 w = *(const f32x4*)(nw + c), sc = *(const f32x4*)(md + sc_off + c), sh = *(const f32x4*)(md + sh_off + c);
            const f32x4 h = v[j] * rs * w * (sc + 1.f) + sh;
            uint2 o; o.x = pk2(h[0], h[1]); o.y = pk2(h[2], h[3]); *(uint2*)(H + (size_t)row * DM + c) = o; }
#pragma unroll
        for (int j = 0; j < 4; ++j) v[j] = vn[j];
    }
#undef NRM_LOAD
}
__device__ __forceinline__ void phase_final(const KP& p) {
    const int tid = otid(), lane = tid & 63, wv = tid >> 6; const int gw = blockIdx.x * NWAVES + wv, NGW = gridDim.x * NWAVES;
    const float* nw = p.in[43]; const bf16* X16 = (const bf16*)(p.ws + WS_X16);
    f32x4 v[4], vn[4];
    if (gw < MROWS) load_xrow(v, nullptr, X16 + (size_t)gw * DM, lane);
    for (int row = gw; row < MROWS; row += NGW) {
        float* x = p.out + (size_t)row * DM;
        if (row + NGW < MROWS) load_xrow(vn, nullptr, X16 + (size_t)(row + NGW) * DM, lane);
        if (row >= MP) { const float* P = (const float*)(p.ws + WS_PART) + (size_t)(row - MP) * DM; const float* md = (const float*)(p.ws + WS_MOD) + ((size_t)136 + 8 + ((row - MP) >> 3)) * 6144 + 5120;
#pragma unroll
            for (int j = 0; j < 4; ++j) { const int c = lane * 4 + 256 * j; const f32x4 g = *(const f32x4*)(md + c);
                const f32x4 sp = (*(const f32x4*)(P + c) + *(const f32x4*)(P + (size_t)1024 * DM + c)) + (*(const f32x4*)(P + (size_t)2048 * DM + c) + *(const f32x4*)(P + (size_t)3072 * DM + c));
                v[j] += g * sp; } }
        float ss = 0.f;
#pragma unroll
        for (int j = 0; j < 4; ++j) ss += v[j][0] * v[j][0] + v[j][1] * v[j][1] + v[j][2] * v[j][2] + v[j][3] * v[j][3];
        const float rs = rsqrtf(wave_sum(ss) * (1.f / DM) + 1e-6f);
#pragma unroll
        for (int j = 0; j < 4; ++j) { const int c = lane * 4 + 256 * j; *(f32x4*)(x + c) = v[j] * rs * *(const f32x4*)(nw + c); }
#pragma unroll
        for (int j = 0; j < 4; ++j) v[j] = vn[j];
    }
}

typedef float f32x2 __attribute__((ext_vector_type(2)));
constexpr int VST = 320, SL_VEC = 0, SL_VROW = 16 * VST, SL_PART = SL_VROW + 16 * 64, SL_SCAL = SL_PART + 16 * 16, SL_SIZE = SL_SCAL + 16 * 8;
static_assert(4 * SL_SIZE * 4 <= 131072, "scan LDS ring");
struct Item { int tr, b, h, half, T, NB, row0; };
struct V8 { f32x4 a, b; };
__device__ __forceinline__ V8 ld8(const float* q) { V8 v; v.a = *(const f32x4*)q; v.b = *(const f32x4*)(q + 4); return v; }
__device__ __forceinline__ float dot8(const V8& s, const V8& x) { const f32x4 t = s.a * x.a + s.b * x.b; return (t[0] + t[1]) + (t[2] + t[3]); }
__device__ __forceinline__ f32x2 dot8x2(const V8& s, const f32x4& p0, const f32x4& p1, const f32x4& p2, const f32x4& p3) {
    f32x2 a = (f32x2){s.a[0], s.a[0]} * (f32x2){p0[0], p0[1]}; f32x2 b = (f32x2){s.a[1], s.a[1]} * (f32x2){p0[2], p0[3]};
    a += (f32x2){s.a[2], s.a[2]} * (f32x2){p1[0], p1[1]}; b += (f32x2){s.a[3], s.a[3]} * (f32x2){p1[2], p1[3]};
    a += (f32x2){s.b[0], s.b[0]} * (f32x2){p2[0], p2[1]}; b += (f32x2){s.b[1], s.b[1]} * (f32x2){p2[2], p2[3]};
    a += (f32x2){s.b[2], s.b[2]} * (f32x2){p3[0], p3[1]}; b += (f32x2){s.b[3], s.b[3]} * (f32x2){p3[2], p3[3]};
    return a + b; }
__device__ __forceinline__ float red8(float v) { v += dppf<0xB1>(v); v += dppf<0x4E>(v); v += dppf<0x141>(v); return v; }
__device__ __forceinline__ float ldu(const bf16* U, int row, int col, int T) { row = row < T ? row : T - 1; return bf2f(U[(size_t)row * UP + col]); }
__device__ __forceinline__ void unpack8(const uint4 v, float (&o)[8]) {
    o[0] = __builtin_bit_cast(float, v.x << 16); o[1] = __builtin_bit_cast(float, v.x & 0xffff0000u); o[2] = __builtin_bit_cast(float, v.y << 16); o[3] = __builtin_bit_cast(float, v.y & 0xffff0000u);
    o[4] = __builtin_bit_cast(float, v.z << 16); o[5] = __builtin_bit_cast(float, v.z & 0xffff0000u); o[6] = __builtin_bit_cast(float, v.w << 16); o[7] = __builtin_bit_cast(float, v.w & 0xffff0000u); }
#define YKEEP2(tt, ya, yb) do { if ((tt) == sub) { yk0 = (ya); yk1 = (yb); } } while (0)
#define YSTORE2(bb) do { const int g0 = 16 * (bb) + sub; if (g0 < T) { Y[(size_t)g0 * DM + irow] = (bf16)f2bf(yk0); Y[(size_t)g0 * DM + irow + 16] = (bf16)f2bf(yk1); } } while (0)
__device__ __forceinline__ f32x2 dot4x2(const f32x4& s, const f32x4& p0, const f32x4& p1) {
    f32x2 a = (f32x2){s[0], s[0]} * (f32x2){p0[0], p0[1]}; f32x2 b = (f32x2){s[1], s[1]} * (f32x2){p0[2], p0[3]};
    a += (f32x2){s[2], s[2]} * (f32x2){p1[0], p1[1]}; b += (f32x2){s[3], s[3]} * (f32x2){p1[2], p1[3]};
    return a + b; }
__device__ __forceinline__ void red16x4(float x0, float x1, float x2, float x3, bool p0, bool p1, float& r0, float& r1, float& r2, float& r3) {
    float k0 = p0 ? x2 : x0, k1 = p0 ? x3 : x1; const float t0 = p0 ? x0 : x2, t1 = p0 ? x1 : x3;
    k0 += dppf<0xB1>(t0); k1 += dppf<0xB1>(t1);
    float m = p1 ? k1 : k0; const float u = p1 ? k0 : k1;
    m += dppf<0x4E>(u); m += dppf<0x124>(m); m += dppf<0x128>(m);
    r0 = dppf<0x00>(m); r2 = dppf<0x55>(m); r1 = dppf<0xAA>(m); r3 = dppf<0xFF>(m);
}
__device__ __forceinline__ void red16x2(float xa, float xb, bool p0, float& ra, float& rb) {
    float k = p0 ? xb : xa; const float t = p0 ? xa : xb;
    k += dppf<0xB1>(t); k += dppf<0x4E>(k); k += dppf<0x124>(k); k += dppf<0x128>(k);
    ra = dppf<0x00>(k); rb = dppf<0x55>(k);
}
__device__ __forceinline__ float dot4(const f32x4& s, const f32x4& x) { const f32x4 t = s * x; return (t[0] + t[1]) + (t[2] + t[3]); }
#define TICK_BAR() do { asm volatile("s_waitcnt lgkmcnt(0)" ::: "memory"); __builtin_amdgcn_s_barrier(); asm volatile("" ::: "memory"); } while (0)
__device__ __forceinline__ void scan_rwkv(const KP& p, int l, const Item& it, float* sm) {
    const int tid = otid(), lane = tid & 63, wv = tid >> 6, T = it.T, NBAT = (T + 15) >> 4;
    const bool scanner = wv < 4;
    const bf16* U = (const bf16*)(p.ws + WS_U) + (size_t)it.row0 * UP;
    const float* sh0 = it.tr ? p.in[2] + ((size_t)l * BS + it.b) * 896 : nullptr;
    const int rp = (tid & 255) >> 4, sub = tid & 15, nh = it.tr ? 2 : 1; const bool lp0 = (tid & 1) != 0, lp1 = (tid & 2) != 0; int irow = it.half * 32 + rp;
    bf16* Y = (bf16*)(p.ws + WS_H) + (size_t)it.row0 * DM + 0 * 256 + it.h * 64;
    float* sbase_o = p.out + (it.tr ? O_SWKV : O_PWKV) + (((size_t)l * it.NB + it.b) * 4 + it.h) * 4096 + sub * 4;
    const float* sbase_i = p.in[3] + (((size_t)l * BS + it.b) * 4 + it.h) * 4096 + sub * 4;
    f32x4 S0 = {0.f, 0.f, 0.f, 0.f}, S1 = S0, Q0 = S0, Q1 = S0, R0 = S0, R1 = S0;
    if (it.tr) { const float* q = sbase_i + ((wv >> 2) * 32 + rp) * 64; Q0 = *(const f32x4*)q; Q1 = *(const f32x4*)(q + 16 * 64); R0 = *(const f32x4*)(q + 4 * 4096); R1 = *(const f32x4*)(q + 4 * 4096 + 16 * 64); }
    float yk0 = 0.f, yk1 = 0.f;
    const int pj = wv & 3, n = lane & 15, fq = lane >> 4, c = pj * 16 + n, hc = it.h * 64 + c;
    const float* mu = p.in[19] + l * 896;
    bf16x8v Bw, Ba; float muw[8], mua[8];
#pragma unroll
    for (int j = 0; j < 8; ++j) { Bw[j] = (short)f2bf(p.in[21][((size_t)l * 32 + fq * 8 + j) * 256 + hc]); Ba[j] = (short)f2bf(p.in[23][((size_t)l * 32 + fq * 8 + j) * 256 + hc]);
        muw[j] = mu[768 + fq * 8 + j]; mua[j] = mu[800 + fq * 8 + j]; }
    const float w0c = p.in[20][l * 256 + hc], a0c = p.in[22][l * 256 + hc], kkc = p.in[25][l * 256 + hc], kac = p.in[26][l * 256 + hc], rkc = p.in[27][l * 256 + hc];
    const float mur = mu[hc], muk = mu[256 + hc], muv = mu[512 + hc];
    struct RwRaw { uint4 wc, wp, ac, ap; float rr[5], rk[5], rv[5]; } cur;
#define RW_LOAD(R, bb) do { const int ta = 16 * (bb) + n;              \
        { const int tc_ = ta < T ? ta : T - 1; const bf16* q = U + (size_t)tc_ * UP + 768 + fq * 8; R.wc = *(const uint4*)q; R.ac = *(const uint4*)(q + 32); \
          const bool sb_ = it.tr && tc_ == 8; const float* shx_ = sb_ ? sh0 + 896 : sh0;     \
          if (tc_ > 0 && !sb_) { R.wp = *(const uint4*)(q - UP); R.ap = *(const uint4*)(q + 32 - UP); } \
          else if (sh0) { R.wp = pack8f(shx_ + 768 + fq * 8); R.ap = pack8f(shx_ + 800 + fq * 8); } else { R.wp = (uint4){0u, 0u, 0u, 0u}; R.ap = R.wp; } } \
        _Pragma("unroll") for (int i = 0; i < 5; ++i) { const int g = 16 * (bb) + fq * 4 - 1 + i; \
            const bool sb_ = it.tr && fq == 2 && i == 0; const float* shx_ = sb_ ? sh0 + 896 : sh0;     \
            if (g >= 0 && !sb_) { R.rr[i] = ldu(U, g, hc, T); R.rk[i] = ldu(U, g, 256 + hc, T); R.rv[i] = ldu(U, g, 512 + hc, T); } \
            else if (sh0) { R.rr[i] = shx_[hc]; R.rk[i] = shx_[256 + hc]; R.rv[i] = shx_[512 + hc]; } else { R.rr[i] = R.rk[i] = R.rv[i] = 0.f; } } } while (0)
    if (!scanner) RW_LOAD(cur, 0);
    for (int k = 0; k < NBAT + 2; ++k) {
        if (scanner || it.tr) {
            const int b = k - 2;
            if (b >= 0 && b < NBAT) {
                const float* SL = sm + (b & 3) * SL_SIZE; const int ns = (T - 16 * b) < 16 ? (T - 16 * b) : 16;
                { const int hv = wv >> 2;
                if (it.tr) irow = hv * 32 + rp;
                const int nsq = it.tr ? 8 : ns;
                _Pragma("unroll") for (int sq = 0; sq < 2; ++sq) {
                if (it.tr) { S0 = sq ? R0 : Q0; S1 = sq ? R1 : Q1; }
#define RW_STEP(tt, q0, q1, w, bb, kp, va, vb, sc) do { const f32x2 da = dot4x2(S0, q0, q1), db = dot4x2(S1, q0, q1); \
                    float a1, a2, b1, b2; red16x4(da.x, da.y, db.x, db.y, lp0, lp1, a1, a2, b1, b2); \
                    const float ca = sc[0] * a1, cb = sc[0] * b1;                                       \
                    const float ya = a2 - ca * sc[1] + va * sc[2], yb = b2 - cb * sc[1] + vb * sc[2]; \
                    S0 = S0 * w + (kp * va - bb * ca); S1 = S1 * w + (kp * vb - bb * cb); YKEEP2(tt, ya, yb); } while (0)
                _Pragma("unroll 2") for (int j_ = 0; j_ < 4; ++j_) { const int tt = sq * 8 + 2 * j_;
                    const float* V0 = SL + SL_VEC + tt * VST + sub * 4; const float* V1 = V0 + VST; const float* P0 = V0 + sub * 4; const float* P1 = P0 + VST;
                    const f32x4 a0 = *(const f32x4*)P0, a1_ = *(const f32x4*)(P0 + 4), w0 = *(const f32x4*)(V0 + 128), bb0 = *(const f32x4*)(V0 + 192), kp0 = *(const f32x4*)(V0 + 256);
                    const float va0 = SL[SL_VROW + tt * 64 + irow], vb0 = SL[SL_VROW + tt * 64 + irow + 16]; const f32x4 sc0 = *(const f32x4*)(SL + SL_SCAL + tt * 8);
                    const f32x4 e0 = *(const f32x4*)P1, e1 = *(const f32x4*)(P1 + 4), w1 = *(const f32x4*)(V1 + 128), bb1 = *(const f32x4*)(V1 + 192), kp1 = *(const f32x4*)(V1 + 256);
                    const float va1 = SL[SL_VROW + (tt + 1) * 64 + irow], vb1 = SL[SL_VROW + (tt + 1) * 64 + irow + 16]; const f32x4 sc1 = *(const f32x4*)(SL + SL_SCAL + (tt + 1) * 8);
                    RW_STEP(tt, a0, a1_, w0, bb0, kp0, va0, vb0, sc0);
                    RW_STEP(tt + 1, e0, e1, w1, bb1, kp1, va1, vb1, sc1);
                }
                if (it.tr) { float* o_ = sbase_o + sq * (4 * 4096); *(f32x4*)(o_ + irow * 64) = S0; *(f32x4*)(o_ + (irow + 16) * 64) = S1; }
                }
#undef RW_STEP
                YSTORE2(b);
                }
            }
        }
        if (!scanner) {
            if (k >= 1 && k - 1 < NBAT && lane < 4) {
                const int tt = pj * 4 + lane; float* SL = sm + ((k - 1) & 3) * SL_SIZE; const float* P = SL + SL_PART + tt * 16;
                const f32x4 s = *(const f32x4*)P + *(const f32x4*)(P + 4) + *(const f32x4*)(P + 8) + *(const f32x4*)(P + 12);
                const float rn2 = __builtin_amdgcn_rcpf(s[0] + 1e-6f);
                *(f32x4*)(SL + SL_SCAL + tt * 8) = (f32x4){rn2, s[1], s[2], 0.f};
                const int g = 16 * (k - 1) + tt; if (it.half == 0 && g < T) ((float*)(p.ws + WS_AUX))[((size_t)it.row0 + g) * 4 + it.h] = s[3];
            }
            if (k < NBAT) {
                float xw[8], xa[8], cu[8], pr[8];
                unpack8(cur.wc, cu); unpack8(cur.wp, pr);
#pragma unroll
                for (int j = 0; j < 8; ++j) xw[j] = tanhf_(cu[j] + (pr[j] - cu[j]) * muw[j]);
                unpack8(cur.ac, cu); unpack8(cur.ap, pr);
#pragma unroll
                for (int j = 0; j < 8; ++j) xa[j] = cu[j] + (pr[j] - cu[j]) * mua[j];
                const uint4 Awu = pack8f(xw), Aau = pack8f(xa);
                const bf16x8v Aw = __builtin_bit_cast(bf16x8v, Awu), Aa = __builtin_bit_cast(bf16x8v, Aau);
                const f32x4 z = {0.f, 0.f, 0.f, 0.f};
                const f32x4 dw = __builtin_amdgcn_mfma_f32_16x16x32_bf16(Aw, Bw, z, 0, 0, 0), da = __builtin_amdgcn_mfma_f32_16x16x32_bf16(Aa, Ba, z, 0, 0, 0);
                float xr_[4], xk_[4], xv_[4];
#pragma unroll
                for (int i = 0; i < 4; ++i) { xr_[i] = cur.rr[i + 1] + (cur.rr[i] - cur.rr[i + 1]) * mur; xk_[i] = cur.rk[i + 1] + (cur.rk[i] - cur.rk[i + 1]) * muk; xv_[i] = cur.rv[i + 1] + (cur.rv[i] - cur.rv[i + 1]) * muv; }
                if (k + 1 < NBAT) RW_LOAD(cur, k + 1);
                float* SL = sm + (k & 3) * SL_SIZE;
#pragma unroll
                for (int i = 0; i < 4; ++i) { const int tt = fq * 4 + i;
                    const float w = __expf(-0.6065306597f * sigmoidf_(w0c + dw[i])), a = sigmoidf_(a0c + da[i]);
                    const float kkraw = xk_[i] * kkc, braw = kkraw * a, kp = xk_[i] * (1.f + (a - 1.f) * kac);
                    float* V = SL + SL_VEC + tt * VST + c; *(f32x2*)(V + c) = (f32x2){kkraw, w * xr_[i]}; V[128] = w; V[192] = braw; V[256] = kp; SL[SL_VROW + tt * 64 + c] = xv_[i];
                    float p0, p1, p2, p3; red16x4(kkraw * kkraw, braw * xr_[i], kp * xr_[i], xr_[i] * kp * rkc, lp0, lp1, p0, p1, p2, p3);
                    if (n == 0) *(f32x4*)(SL + SL_PART + tt * 16 + pj * 4) = (f32x4){p0, p1, p2, p3}; }
            }
        }
        TICK_BAR();
    }
#undef RW_LOAD
    if (scanner) { if (!it.tr) { *(f32x4*)(sbase_o + irow * 64) = S0; *(f32x4*)(sbase_o + (irow + 16) * 64) = S1; } }
    else if (it.h == 0 && it.half == 0) { float* so = p.out + (it.tr ? O_SSHIFT : O_PSHIFT) + ((size_t)l * it.NB + it.b) * 896;
        for (int cc = tid - 256; cc < 896; cc += 256) { so[cc] = bf2f(U[(size_t)(it.tr ? 7 : T - 1) * UP + cc]); if (it.tr) so[896 + cc] = bf2f(U[(size_t)15 * UP + cc]); } }
}

__device__ __forceinline__ void scan_gla(const KP& p, int l, const Item& it, float* sm) {
    const int tid = otid(), lane = tid & 63, wv = tid >> 6, T = it.T, NBAT = (T + 15) >> 4;
    const bool scanner = wv < 4;
    const bf16* U = (const bf16*)(p.ws + WS_U) + (size_t)it.row0 * UP + CB;
    const int rp = (tid & 255) >> 4, sub = tid & 15, nh = it.tr ? 2 : 1; const bool lp0 = (tid & 1) != 0, lp1 = (tid & 2) != 0; int irow = it.half * 32 + rp;
    bf16* Y = (bf16*)(p.ws + WS_H) + (size_t)it.row0 * DM + 1 * 256 + it.h * 64;
    const size_t sbase = (((size_t)l * it.NB + it.b) * 4 + it.h) * 4096;
    f32x4 S0 = {0.f, 0.f, 0.f, 0.f}, S1 = S0, Q0 = S0, Q1 = S0, R0 = S0, R1 = S0; float* so = p.out + (it.tr ? O_SGLA : O_PGLA) + sbase + (size_t)sub * 4 * 64; const float* si = p.in[4] + sbase + (size_t)sub * 4 * 64;
    if (it.tr) { const int r0 = (wv >> 2) * 32 + rp;
#pragma unroll
        for (int e = 0; e < 4; ++e) { Q0[e] = si[e * 64 + r0]; Q1[e] = si[e * 64 + r0 + 16]; R0[e] = si[4 * 4096 + e * 64 + r0]; R1[e] = si[4 * 4096 + e * 64 + r0 + 16]; } }
    float yk0 = 0.f, yk1 = 0.f;
    const int pj = wv & 3, n = lane & 15, fq = lane >> 4, c = pj * 16 + n, hc = it.h * 64 + c;
    float gkw[16];
#pragma unroll
    for (int j = 0; j < 16; ++j) gkw[j] = p.in[30][((size_t)l * 16 + j) * 256 + hc];
    const float gkb = p.in[31][l * 256 + hc];
    struct GlRaw { float q_[4], k_[4], v_[4]; uint4 g0[4], g1[4]; } cur;
#define GL_LOAD(R, bb) do { _Pragma("unroll") for (int i = 0; i < 4; ++i) { int g = 16 * (bb) + fq * 4 + i; g = g < T ? g : T - 1; const bf16* q = U + (size_t)g * UP; \
        R.q_[i] = bf2f(q[hc]); R.k_[i] = bf2f(q[256 + hc]); R.v_[i] = bf2f(q[512 + hc]); R.g0[i] = *(const uint4*)(q + 1024); R.g1[i] = *(const uint4*)(q + 1032); } } while (0)
    if (!scanner) GL_LOAD(cur, 0);
    for (int k = 0; k < NBAT + 2; ++k) {
        if (scanner || it.tr) {
            const int b = k - 2;
            if (b >= 0 && b < NBAT) {
                const float* SL = sm + (b & 3) * SL_SIZE; const int ns = (T - 16 * b) < 16 ? (T - 16 * b) : 16;
                { const int hv = wv >> 2;
                if (it.tr) irow = hv * 32 + rp;
                const int nsq = it.tr ? 8 : ns;
                _Pragma("unroll") for (int sq = 0; sq < 2; ++sq) {

                if (it.tr) { S0 = sq ? R0 : Q0; S1 = sq ? R1 : Q1; }
#define GL_STEP(tt, dec, kv, qd, va, vb, qk) do { float da, db; red16x2(dot4(S0, qd), dot4(S1, qd), lp0, da, db); const float ya = da + va * qk, yb = db + vb * qk; \
                    S0 = S0 * dec + kv * va; S1 = S1 * dec + kv * vb; YKEEP2(tt, ya, yb); } while (0)
                _Pragma("unroll 2") for (int j_ = 0; j_ < 4; ++j_) { const int tt = sq * 8 + 2 * j_;
                    const float* V0 = SL + SL_VEC + tt * VST + sub * 4; const float* V1 = V0 + VST;
                    const f32x4 qd0 = *(const f32x4*)(V0 + 128), dec0 = *(const f32x4*)V0, kv0 = *(const f32x4*)(V0 + 64); const float va0 = SL[SL_VROW + tt * 64 + irow], vb0 = SL[SL_VROW + tt * 64 + irow + 16], qk0 = SL[SL_SCAL + tt * 8];
                    const f32x4 qd1 = *(const f32x4*)(V1 + 128), dec1 = *(const f32x4*)V1, kv1 = *(const f32x4*)(V1 + 64); const float va1 = SL[SL_VROW + (tt + 1) * 64 + irow], vb1 = SL[SL_VROW + (tt + 1) * 64 + irow + 16], qk1 = SL[SL_SCAL + (tt + 1) * 8];
                    GL_STEP(tt, dec0, kv0, qd0, va0, vb0, qk0);
                    GL_STEP(tt + 1, dec1, kv1, qd1, va1, vb1, qk1);
                }
                if (it.tr) { float* o_ = so + sq * (4 * 4096);
#pragma unroll
                    for (int e = 0; e < 4; ++e) { o_[e * 64 + irow] = S0[e]; o_[e * 64 + irow + 16] = S1[e]; } }
                }
#undef GL_STEP
                YSTORE2(b);
                }
            }
        }
        if (!scanner) {
            if (k >= 1 && k - 1 < NBAT && lane < 4) { const int tt = pj * 4 + lane; float* SL = sm + ((k - 1) & 3) * SL_SIZE; const float* P = SL + SL_PART + tt * 16;
                SL[SL_SCAL + tt * 8] = P[0] + P[4] + P[8] + P[12]; }
            if (k < NBAT) {
                float x[4], qq[4], kk[4], vv[4];
#pragma unroll
                for (int i = 0; i < 4; ++i) { float gl[8]; x[i] = gkb; unpack8(cur.g0[i], gl);
#pragma unroll
                    for (int j = 0; j < 8; ++j) x[i] += gl[j] * gkw[j];
                    unpack8(cur.g1[i], gl);
#pragma unroll
                    for (int j = 0; j < 8; ++j) x[i] += gl[j] * gkw[8 + j];
                    qq[i] = cur.q_[i] * 0.125f; kk[i] = cur.k_[i]; vv[i] = cur.v_[i]; }
                if (k + 1 < NBAT) GL_LOAD(cur, k + 1);
                float* SL = sm + (k & 3) * SL_SIZE;
#pragma unroll
                for (int i = 0; i < 4; ++i) { const int tt = fq * 4 + i;
                    const float dec = __expf(-softplusf_(-x[i]) * (1.f / 16.f));
                    float* V = SL + SL_VEC + tt * VST + c; V[0] = dec; V[64] = kk[i]; V[128] = qq[i] * dec; SL[SL_VROW + tt * 64 + c] = vv[i];
                    const float p0 = red16(qq[i] * kk[i]);
                    if (n == 0) SL[SL_PART + tt * 16 + pj * 4] = p0; }
            }
        }
        TICK_BAR();
    }
#undef GL_LOAD
    if (scanner && !it.tr) {
#pragma unroll
        for (int e = 0; e < 4; ++e) { so[e * 64 + irow] = S0[e]; so[e * 64 + irow + 16] = S1[e]; } }
}

__device__ __forceinline__ void scan_dn(const KP& p, int l, const Item& it, float* sm) {
    const int tid = otid(), lane = tid & 63, wv = tid >> 6, T = it.T, NBAT = (T + 15) >> 4;
    const bool scanner = wv < 4;
    const bf16* U = (const bf16*)(p.ws + WS_U) + (size_t)it.row0 * UP + CC;
    const float* cv0 = it.tr ? p.in[5] + ((size_t)l * BS + it.b) * 3 * 768 : nullptr;
    const int rp = (tid & 255) >> 4, sub = tid & 15, nh = it.tr ? 2 : 1; const bool lp0 = (tid & 1) != 0, lp1 = (tid & 2) != 0; int irow = it.half * 32 + rp;
    bf16* Y = (bf16*)(p.ws + WS_H) + (size_t)it.row0 * DM + 2 * 256 + it.h * 64;
    const size_t sbase = (((size_t)l * it.NB + it.b) * 4 + it.h) * 4096;
    f32x4 S0 = {0.f, 0.f, 0.f, 0.f}, S1 = S0, Q0 = S0, Q1 = S0, R0 = S0, R1 = S0; float* so = p.out + (it.tr ? O_SDN : O_PDN) + sbase + (size_t)sub * 4 * 64; const float* si = p.in[6] + sbase + (size_t)sub * 4 * 64;
    if (it.tr) { const int r0 = (wv >> 2) * 32 + rp;
#pragma unroll
        for (int e = 0; e < 4; ++e) { Q0[e] = si[e * 64 + r0]; Q1[e] = si[e * 64 + r0 + 16]; R0[e] = si[4 * 4096 + e * 64 + r0]; R1[e] = si[4 * 4096 + e * 64 + r0 + 16]; } }
    float yk0 = 0.f, yk1 = 0.f;
    const int pj = wv & 3, n = lane & 15, fq = lane >> 4, c = pj * 16 + n, hc = it.h * 64 + c;
    float cw[3][4];
#pragma unroll
    for (int pt = 0; pt < 3; ++pt)
#pragma unroll
        for (int i = 0; i < 4; ++i) cw[pt][i] = p.in[33][((size_t)l * 4 + i) * 768 + pt * 256 + hc];
    const float nA = -__expf(p.in[34][l * 4 + it.h]), dtb = p.in[35][l * 4 + it.h];
    struct DnRaw { float xin[3][7]; } cur;
#define DN_LOAD(R, bb) do { _Pragma("unroll") for (int pt = 0; pt < 3; ++pt) _Pragma("unroll") for (int i = 0; i < 7; ++i) { const int g = 16 * (bb) + fq * 4 - 3 + i; \
        R.xin[pt][i] = (it.tr && fq == 2 && i < 3) ? cv0[(3 + i) * 768 + pt * 256 + hc] : g >= 0 ? ldu(U, g, pt * 256 + hc, T) : (cv0 ? cv0[(3 + g) * 768 + pt * 256 + hc] : 0.f); } } while (0)
    if (!scanner) DN_LOAD(cur, 0);
    for (int k = 0; k < NBAT + 2; ++k) {
        if (scanner || it.tr) {
            const int b = k - 2;
            if (b >= 0 && b < NBAT) {
                const float* SL = sm + (b & 3) * SL_SIZE; const int ns = (T - 16 * b) < 16 ? (T - 16 * b) : 16;
                { const int hv = wv >> 2;
                if (it.tr) irow = hv * 32 + rp;
                const int nsq = it.tr ? 8 : ns;
                _Pragma("unroll") for (int sq = 0; sq < 2; ++sq) {

                if (it.tr) { S0 = sq ? R0 : Q0; S1 = sq ? R1 : Q1; }
#define DN_STEP(tt, q0, q1, kv, va, vb, sc, sq) do { const f32x2 da = dot4x2(S0, q0, q1), db = dot4x2(S1, q0, q1);        \
                    float a1, a2, b1, b2; red16x4(da.x, da.y, db.x, db.y, lp0, lp1, a1, a2, b1, b2); \
                    const float na = sc[1] * (va - sc[0] * sc[2] * a1), nb = sc[1] * (vb - sc[0] * sc[2] * b1); \
                    const float ya = sc[0] * sc[3] * a2 + na * sq, yb = sc[0] * sc[3] * b2 + nb * sq; \
                    S0 = S0 * sc[0] + kv * (na * sc[2]); S1 = S1 * sc[0] + kv * (nb * sc[2]); YKEEP2(tt, ya, yb); } while (0)
                _Pragma("unroll 2") for (int j_ = 0; j_ < 4; ++j_) { const int tt = sq * 8 + 2 * j_;
                    const float* V0 = SL + SL_VEC + tt * VST + sub * 4; const float* V1 = V0 + VST; const float* P0 = V0 + sub * 4; const float* P1 = P0 + VST;
                    const f32x4 a0 = *(const f32x4*)P0, a1_ = *(const f32x4*)(P0 + 4), kv0 = *(const f32x4*)(V0 + 128);
                    const float va0 = SL[SL_VROW + tt * 64 + irow], vb0 = SL[SL_VROW + tt * 64 + irow + 16]; const f32x4 sc0 = *(const f32x4*)(SL + SL_SCAL + tt * 8); const float sq0 = SL[SL_SCAL + tt * 8 + 4];
                    const f32x4 e0 = *(const f32x4*)P1, e1 = *(const f32x4*)(P1 + 4), kv1 = *(const f32x4*)(V1 + 128);
                    const float va1 = SL[SL_VROW + (tt + 1) * 64 + irow], vb1 = SL[SL_VROW + (tt + 1) * 64 + irow + 16]; const f32x4 sc1 = *(const f32x4*)(SL + SL_SCAL + (tt + 1) * 8); const float sq1 = SL[SL_SCAL + (tt + 1) * 8 + 4];
                    DN_STEP(tt, a0, a1_, kv0, va0, vb0, sc0, sq0);
                    DN_STEP(tt + 1, e0, e1, kv1, va1, vb1, sc1, sq1);
                }
                if (it.tr) { float* o_ = so + sq * (4 * 4096);
#pragma unroll
                    for (int e = 0; e < 4; ++e) { o_[e * 64 + irow] = S0[e]; o_[e * 64 + irow + 16] = S1[e]; } }
                }
#undef DN_STEP
                YSTORE2(b);
                }
            }
        }
        if (!scanner) {
            if (k >= 1 && k - 1 < NBAT && lane < 4) { const int tt = pj * 4 + lane; float* SL = sm + ((k - 1) & 3) * SL_SIZE; const float* P = SL + SL_PART + tt * 16;
                const f32x4 s = *(const f32x4*)P + *(const f32x4*)(P + 4) + *(const f32x4*)(P + 8) + *(const f32x4*)(P + 12);
                const float rq8 = rsqrtf(s[0] + 1e-6f) * 0.125f, rk = rsqrtf(s[1] + 1e-6f);
                int g = 16 * (k - 1) + tt; g = g < T ? g : T - 1;
                const float beta = sigmoidf_(bf2f(U[(size_t)g * UP + 1028 + it.h])), eg = __expf(nA * softplusf_(bf2f(U[(size_t)g * UP + 1024 + it.h]) + dtb));
                *(f32x4*)(SL + SL_SCAL + tt * 8) = (f32x4){eg, beta, rk, rq8}; SL[SL_SCAL + tt * 8 + 4] = s[2] * rq8 * rk; }
            if (k < NBAT) {
                float o[3][4];
#pragma unroll
                for (int pt = 0; pt < 3; ++pt)
#pragma unroll
                    for (int i = 0; i < 4; ++i) o[pt][i] = siluf_(cw[pt][0] * cur.xin[pt][i] + cw[pt][1] * cur.xin[pt][i + 1] + cw[pt][2] * cur.xin[pt][i + 2] + cw[pt][3] * cur.xin[pt][i + 3]);
                if (k + 1 < NBAT) DN_LOAD(cur, k + 1);
                float* SL = sm + (k & 3) * SL_SIZE;
#pragma unroll
                for (int i = 0; i < 4; ++i) { const int tt = fq * 4 + i;
                    float* V = SL + SL_VEC + tt * VST + c; *(f32x2*)(V + c) = (f32x2){o[1][i], o[0][i]}; V[128] = o[1][i]; SL[SL_VROW + tt * 64 + c] = o[2][i];
                    const float p0 = red16(o[0][i] * o[0][i]), p1 = red16(o[1][i] * o[1][i]), p2 = red16(o[0][i] * o[1][i]);
                    if (n == 0) *(f32x4*)(SL + SL_PART + tt * 16 + pj * 4) = (f32x4){p0, p1, p2, 0.f}; }
            }
        }
        TICK_BAR();
    }
#undef DN_LOAD
    if (scanner) { if (!it.tr) {
#pragma unroll
        for (int e = 0; e < 4; ++e) { so[e * 64 + irow] = S0[e]; so[e * 64 + irow + 16] = S1[e]; } } }
    else if (it.h == 0 && it.half == 0) { float* so = p.out + (it.tr ? O_SDNC : O_PDNC) + ((size_t)l * it.NB + it.b) * 3 * 768;
        for (int i = tid - 256; i < 3 * 768; i += 256) { const int rr = i / 768, cc = i % 768; so[i] = bf2f(U[(size_t)((it.tr ? 5 : T - 3) + rr) * UP + cc]); if (it.tr) so[3 * 768 + i] = bf2f(U[(size_t)(13 + rr) * UP + cc]); } }
}

__device__ __forceinline__ void scan_ssd(const KP& p, int l, const Item& it, float* sm) {
    const int tid = otid(), lane = tid & 63, wv = tid >> 6, T = it.T, NBAT = (T + 15) >> 4, grp = it.h >> 1;
    const bool scanner = wv < 4;
    const bf16* U = (const bf16*)(p.ws + WS_U) + (size_t)it.row0 * UP + CD;
    const bf16* UX = U + 256;
    const float* cv0 = it.tr ? p.in[7] + ((size_t)l * BS + it.b) * 3 * 768 : nullptr;
    const int rp = (tid & 255) >> 4, sub = tid & 15, nh = it.tr ? 2 : 1; const bool lp0 = (tid & 1) != 0, lp1 = (tid & 2) != 0; int irow = it.half * 32 + rp;
    bf16* Y = (bf16*)(p.ws + WS_H) + (size_t)it.row0 * DM + 3 * 256 + it.h * 64;
    const size_t sbase = (((size_t)l * it.NB + it.b) * 4 + it.h) * 64 * 128 + sub * 8; float* so = p.out + (it.tr ? O_SSSM : O_PSSM) + sbase; const float* si = p.in[8] + sbase;
    V8 S0, S1; S0.a = (f32x4){0.f, 0.f, 0.f, 0.f}; S0.b = S0.a; S1 = S0;
    V8 Q0 = S0, Q1 = S0, R0 = S0, R1 = S0;
    if (it.tr) { const int r0 = (wv >> 2) * 32 + rp; Q0 = ld8(si + r0 * 128); Q1 = ld8(si + (r0 + 16) * 128); R0 = ld8(si + 4 * 8192 + r0 * 128); R1 = ld8(si + 4 * 8192 + (r0 + 16) * 128); }
    float yk0 = 0.f, yk1 = 0.f;
    const int pj = wv & 3, n = lane & 15, fq = lane >> 4, c = pj * 16 + n;
    int ch[5]; ch[0] = it.h * 64 + c; ch[1] = 256 + grp * 128 + pj * 32 + n; ch[2] = ch[1] + 16; ch[3] = ch[1] + 256; ch[4] = ch[3] + 16;
    float cw[5][4], cb[5];
#pragma unroll
    for (int q = 0; q < 5; ++q) { cb[q] = p.in[38][(size_t)l * 768 + ch[q]];
#pragma unroll
        for (int i = 0; i < 4; ++i) cw[q][i] = p.in[37][((size_t)l * 4 + i) * 768 + ch[q]]; }
    const float nA = -__expf(p.in[40][l * 4 + it.h]), dtb = p.in[39][l * 4 + it.h], Dh = p.in[41][l * 4 + it.h];
    struct SsRaw { float xin[5][7]; } cur;
#define SS_LOAD(R, bb) do { _Pragma("unroll") for (int q = 0; q < 5; ++q) _Pragma("unroll") for (int i = 0; i < 7; ++i) { const int g = 16 * (bb) + fq * 4 - 3 + i; \
        R.xin[q][i] = (it.tr && fq == 2 && i < 3) ? cv0[(3 + i) * 768 + ch[q]] : g >= 0 ? ldu(UX, g, ch[q], T) : (cv0 ? cv0[(3 + g) * 768 + ch[q]] : 0.f); } } while (0)
    if (!scanner) SS_LOAD(cur, 0);
    for (int k = 0; k < NBAT + 2; ++k) {
        if (scanner || it.tr) {
            const int b = k - 2;
            if (b >= 0 && b < NBAT) {
                const float* SL = sm + (b & 3) * SL_SIZE; const int ns = (T - 16 * b) < 16 ? (T - 16 * b) : 16;
                { const int hv = wv >> 2;
                if (it.tr) irow = hv * 32 + rp;
                const int nsq = it.tr ? 8 : ns;
                _Pragma("unroll") for (int sq = 0; sq < 2; ++sq) {

                if (it.tr) { S0 = sq ? R0 : Q0; S1 = sq ? R1 : Q1; }
#define SS_STEP(tt, Bv, Cv, xa, xb, sc) do { float da, db; red16x2(dot8(S0, Cv), dot8(S1, Cv), lp0, da, db); const float ta = xa * sc[1], tb = xb * sc[1];        \
                    const float ya = sc[0] * da + ta * sc[2] + Dh * xa, yb = sc[0] * db + tb * sc[2] + Dh * xb; \
                    S0.a = S0.a * sc[0] + Bv.a * ta; S0.b = S0.b * sc[0] + Bv.b * ta; S1.a = S1.a * sc[0] + Bv.a * tb; S1.b = S1.b * sc[0] + Bv.b * tb; YKEEP2(tt, ya, yb); } while (0)
                _Pragma("unroll 2") for (int j_ = 0; j_ < 4; ++j_) { const int tt = sq * 8 + 2 * j_;
                    const float* V0 = SL + SL_VEC + tt * VST + sub * 8; const float* V1 = V0 + VST;
                    const V8 C0 = ld8(V0 + 128), B0 = ld8(V0); const float xa0 = SL[SL_VROW + tt * 64 + irow], xb0 = SL[SL_VROW + tt * 64 + irow + 16]; const f32x4 sc0 = *(const f32x4*)(SL + SL_SCAL + tt * 8);
                    const V8 C1 = ld8(V1 + 128), B1 = ld8(V1); const float xa1 = SL[SL_VROW + (tt + 1) * 64 + irow], xb1 = SL[SL_VROW + (tt + 1) * 64 + irow + 16]; const f32x4 sc1 = *(const f32x4*)(SL + SL_SCAL + (tt + 1) * 8);
                    SS_STEP(tt, B0, C0, xa0, xb0, sc0);
                    SS_STEP(tt + 1, B1, C1, xa1, xb1, sc1);
                }
                if (it.tr) { float* o0 = so + sq * (4 * 8192) + irow * 128; float* o1 = o0 + 16 * 128; *(f32x4*)o0 = S0.a; *(f32x4*)(o0 + 4) = S0.b; *(f32x4*)o1 = S1.a; *(f32x4*)(o1 + 4) = S1.b; }
                }
#undef SS_STEP
                YSTORE2(b);
                }
            }
        }
        if (!scanner) {
            if (k >= 1 && k - 1 < NBAT && lane < 4) { const int tt = pj * 4 + lane; float* SL = sm + ((k - 1) & 3) * SL_SIZE; const float* P = SL + SL_PART + tt * 16;
                const float bc = P[0] + P[4] + P[8] + P[12];
                int g = 16 * (k - 1) + tt; g = g < T ? g : T - 1;
                const float dt = softplusf_(bf2f(U[(size_t)g * UP + 1024 + it.h]) + dtb);
                *(f32x4*)(SL + SL_SCAL + tt * 8) = (f32x4){__expf(nA * dt), dt, bc, 0.f}; }
            if (k < NBAT) {
                float o[5][4];
#pragma unroll
                for (int q = 0; q < 5; ++q)
#pragma unroll
                    for (int i = 0; i < 4; ++i) o[q][i] = siluf_(cb[q] + cw[q][0] * cur.xin[q][i] + cw[q][1] * cur.xin[q][i + 1] + cw[q][2] * cur.xin[q][i + 2] + cw[q][3] * cur.xin[q][i + 3]);
                if (k + 1 < NBAT) SS_LOAD(cur, k + 1);
                float* SL = sm + (k & 3) * SL_SIZE;
#pragma unroll
                for (int i = 0; i < 4; ++i) { const int tt = fq * 4 + i;
                    float* V = SL + SL_VEC + tt * VST; V[pj * 32 + n] = o[1][i]; V[pj * 32 + 16 + n] = o[2][i]; V[128 + pj * 32 + n] = o[3][i]; V[128 + pj * 32 + 16 + n] = o[4][i]; SL[SL_VROW + tt * 64 + c] = o[0][i];
                    const float p0 = red16(o[1][i] * o[3][i] + o[2][i] * o[4][i]);
                    if (n == 0) SL[SL_PART + tt * 16 + pj * 4] = p0; }
            }
        }
        TICK_BAR();
    }
#undef SS_LOAD
    if (scanner) { if (!it.tr) { float* o0 = so + irow * 128; float* o1 = so + (irow + 16) * 128; *(f32x4*)o0 = S0.a; *(f32x4*)(o0 + 4) = S0.b; *(f32x4*)o1 = S1.a; *(f32x4*)(o1 + 4) = S1.b; } }
    else if (it.h == 0 && it.half == 0) { float* so = p.out + (it.tr ? O_SSSC : O_PSSC) + ((size_t)l * it.NB + it.b) * 3 * 768;
        for (int i = tid - 256; i < 3 * 768; i += 256) { const int rr = i / 768, cc = i % 768; so[i] = bf2f(UX[(size_t)((it.tr ? 5 : T - 3) + rr) * UP + cc]); if (it.tr) so[3 * 768 + i] = bf2f(UX[(size_t)(13 + rr) * UP + cc]); } }
}

__device__ __forceinline__ void run_item(const KP& p, int l, int tr, int idx, float* sm) {
    Item it; it.tr = tr; const int mixer = idx & 3; int r = idx >> 2; if (tr) it.half = 0; else { it.half = r & 1; r >>= 1; } it.h = r & 3; it.b = tr ? 2 * (r >> 2) : (r >> 2);
    it.T = tr ? 2 * TS : TP; it.NB = tr ? BS : BP; it.row0 = tr ? MP + it.b * TS : it.b * TP;
    if (mixer == 0) scan_rwkv(p, l, it, sm); else if (mixer == 1) scan_gla(p, l, it, sm); else if (mixer == 2) scan_dn(p, l, it, sm); else scan_ssd(p, l, it, sm);
    __syncthreads();
}
__device__ __forceinline__ void flag_signal(unsigned* cnt, unsigned n) {
    asm volatile("s_waitcnt vmcnt(0)" ::: "memory"); __syncthreads();
    if (threadIdx.x == 0 && n) { __builtin_amdgcn_fence(__ATOMIC_RELEASE, "agent"); asm volatile("s_waitcnt vmcnt(0)" ::: "memory"); __hip_atomic_fetch_add(cnt, n, __ATOMIC_RELAXED, __HIP_MEMORY_SCOPE_AGENT); }
}
__device__ __forceinline__ void flag_wait(unsigned* cnt, unsigned target) {
    if (threadIdx.x == 0) { unsigned sp = 0; while (__hip_atomic_load(cnt, __ATOMIC_RELAXED, __HIP_MEMORY_SCOPE_AGENT) < target) { __builtin_amdgcn_s_sleep(4); if (++sp > (1u << 22)) break; }
        __builtin_amdgcn_fence(__ATOMIC_ACQUIRE, "agent"); asm volatile("s_waitcnt vmcnt(0)" ::: "memory"); }
    __syncthreads();
}
__device__ __forceinline__ void phase_scan(const KP& p, int l, float* sm) {
    const int G = gridDim.x;
    constexpr int NPI = 4 * BP * 4 * 2, NSI = 4 * (BS / 2) * 4;
    for (int i = blockIdx.x; i < NPI; i += G) run_item(p, l, 0, i, sm);
    unsigned* q = (unsigned*)(p.ws + WS_BAR) + 4096 + 64 * l;
    flag_wait((unsigned*)(p.ws + WS_BAR) + 4224 + 64 * l, 64u);
    volatile int* slot = (volatile int*)(sm + 4 * SL_SIZE);
    for (;;) {
        if (threadIdx.x == 0) *slot = (int)__hip_atomic_fetch_add(q, 2u, __ATOMIC_RELAXED, __HIP_MEMORY_SCOPE_AGENT);
        __syncthreads();
        const int i0 = *slot;
        __syncthreads();
        if (i0 >= NSI) break;
        run_item(p, l, 1, i0, sm);
        if (i0 + 1 < NSI) run_item(p, l, 1, i0 + 1, sm);
    }
}

__device__ __forceinline__ void ld4bf(const bf16* p, float (&o)[4]) { const uint2 v = *(const uint2*)p; o[0] = __builtin_bit_cast(float, v.x << 16); o[1] = __builtin_bit_cast(float, v.x & 0xffff0000u); o[2] = __builtin_bit_cast(float, v.y << 16); o[3] = __builtin_bit_cast(float, v.y & 0xffff0000u); }
__device__ __forceinline__ void st4bf(bf16* p, const float (&o)[4]) { uint2 v; v.x = pk2(o[0], o[1]); v.y = pk2(o[2], o[3]); *(uint2*)p = v; }
__device__ __forceinline__ void phase_post(const KP& p, int l, float* sm) {
    const int tid = otid(), lane = tid & 63, wv = tid >> 6; const int gw = blockIdx.x * NWAVES + wv, NGW = gridDim.x * NWAVES;
    const bf16* Ub = (const bf16*)(p.ws + WS_U); bf16* Yb = (bf16*)(p.ws + WS_H); const float* auxb = (const float*)(p.ws + WS_AUX);
    const float* mu = p.in[19] + l * 896;
    { const float* g2g = p.in[24] + (size_t)l * 64 * 256;
      for (int i = tid; i < 64 * 256 / 4; i += NTHR) *(f32x4*)(sm + 4 * i) = *(const f32x4*)(g2g + 4 * i);
      __syncthreads(); }
    const float* g2 = sm;
    const int c = lane * 4, hd = lane >> 4;
    const f32x4 lw = *(const f32x4*)(p.in[28] + l * 256 + c), lb = *(const f32x4*)(p.in[29] + l * 256 + c), muv = *(const f32x4*)(mu + 512 + c);
    const f32x4 wgl = *(const f32x4*)(p.in[32] + l * 256 + c), wdn = *(const f32x4*)(p.in[36] + l * 256 + c), wss = *(const f32x4*)(p.in[42] + l * 256 + c);
    const float mug = mu[832 + lane];
    struct PR { float y[4][4], uv[4], pv[4], gg[4], dz[4], sz[4], ug, pg, rkv; } cur, nxt;
#define POST_LOAD(R, row) do { int tr_, b_, t_; if ((row) < MP) { tr_ = 0; b_ = (row) >> 11; t_ = (row) & 2047; } else { tr_ = 1; b_ = ((row) - MP) >> 3; t_ = ((row) - MP) & 7; } \
        const bf16* u_ = Ub + (size_t)(row) * UP; const bf16* y_ = Yb + (size_t)(row) * DM; \
        _Pragma("unroll") for (int m = 0; m < 4; ++m) ld4bf(y_ + 256 * m + c, R.y[m]); \
        ld4bf(u_ + 512 + c, R.uv); ld4bf(u_ + CB + 768 + c, R.gg); ld4bf(u_ + CC + 768 + c, R.dz); ld4bf(u_ + CD + c, R.sz); R.ug = bf2f(u_[832 + lane]); R.rkv = auxb[(size_t)(row) * 4 + hd]; \
        if (t_ > 0) { ld4bf(u_ - UP + 512 + c, R.pv); R.pg = bf2f(u_[832 + lane - UP]); } \
        else if (tr_) { const float* sh0_ = p.in[2] + ((size_t)l * BS + b_) * 896; const f32x4 s_ = *(const f32x4*)(sh0_ + 512 + c); R.pv[0] = s_[0]; R.pv[1] = s_[1]; R.pv[2] = s_[2]; R.pv[3] = s_[3]; R.pg = sh0_[832 + lane]; } \
        else { R.pv[0] = R.pv[1] = R.pv[2] = R.pv[3] = 0.f; R.pg = 0.f; } } while (0)
    if (gw < MROWS) POST_LOAD(cur, gw);
    for (int row = gw; row < MROWS; row += NGW) {
        if (row + NGW < MROWS) POST_LOAD(nxt, row + NGW);
        bf16* y = Yb + (size_t)row * DM;
        { const float m = red16(cur.y[0][0] + cur.y[0][1] + cur.y[0][2] + cur.y[0][3]) * (1.f / 64.f);
          float d[4], vs = 0.f;
#pragma unroll
          for (int e = 0; e < 4; ++e) { d[e] = cur.y[0][e] - m; vs += d[e] * d[e]; }
          const float rs = rsqrtf(red16(vs) * (1.f / 64.f) + 64e-5f);
          const float sg = sigmoidf_(cur.ug + (cur.pg - cur.ug) * mug);
          f32x4 g = {0.f, 0.f, 0.f, 0.f};
#pragma unroll 8
          for (int j = 0; j < 64; ++j) { const float sj = __shfl(sg, j); g += *(const f32x4*)(g2 + j * 256 + c) * sj; }
          float o[4];
#pragma unroll
          for (int e = 0; e < 4; ++e) { const float v = cur.uv[e] + (cur.pv[e] - cur.uv[e]) * muv[e]; o[e] = (d[e] * rs * lw[e] + lb[e] + cur.rkv * v) * g[e]; }
          st4bf(y + c, o); }
        { const float* yv = cur.y[1];
          const float rs = rsqrtf(red16(yv[0] * yv[0] + yv[1] * yv[1] + yv[2] * yv[2] + yv[3] * yv[3]) * (1.f / 64.f) + 1e-6f); float o[4];
#pragma unroll
          for (int e = 0; e < 4; ++e) o[e] = yv[e] * rs * wgl[e] * siluf_(cur.gg[e]);
          st4bf(y + 256 + c, o); }
        { const float* yv = cur.y[2];
          const float rs = rsqrtf(red16(yv[0] * yv[0] + yv[1] * yv[1] + yv[2] * yv[2] + yv[3] * yv[3]) * (1.f / 64.f) + 1e-6f); float o[4];
#pragma unroll
          for (int e = 0; e < 4; ++e) o[e] = yv[e] * rs * wdn[e] * siluf_(cur.dz[e]);
          st4bf(y + 512 + c, o); }
        { float yv[4]; float ss = 0.f;
#pragma unroll
          for (int e = 0; e < 4; ++e) { yv[e] = cur.y[3][e] * siluf_(cur.sz[e]); ss += yv[e] * yv[e]; }
          ss = red16(ss); ss += __shfl_xor(ss, 16);
          const float rs = rsqrtf(ss * (1.f / 128.f) + 1e-6f); float o[4];
#pragma unroll
          for (int e = 0; e < 4; ++e) o[e] = yv[e] * rs * wss[e];
          st4bf(y + 768 + c, o); }
        cur = nxt;
    }
#undef POST_LOAD
}

#define XB_TMO      128
#define XB_XCNT(j)  (256  + 64 * (j))
#define XB_XSUB(j)  (1280 + 64 * (j))
#define XB_XGEN(j)  (2304 + 64 * (j))
#define XB_TOP      3328
#define XB_TOPGEN   3392
#define XCD_BAR_WORDS 3456
#define XB_SPIN_CAP (1u << 18)

__device__ __forceinline__ unsigned xb_ld(unsigned* p)              { return __hip_atomic_load(p, __ATOMIC_RELAXED, __HIP_MEMORY_SCOPE_AGENT); }
__device__ __forceinline__ unsigned xb_add(unsigned* p, unsigned v) { return __hip_atomic_fetch_add(p, v, __ATOMIC_RELAXED, __HIP_MEMORY_SCOPE_AGENT); }
__device__ __forceinline__ unsigned xb_xcc_id() { return (unsigned)__builtin_amdgcn_s_getreg((3 << 11) | 20) & 0xFu; }
#define XB_SPIN(cond, bar) do { unsigned _sp = 0; while (cond) { __builtin_amdgcn_s_sleep(1); \
    if ((++_sp & 255u) == 0u) { if (xb_ld(&(bar)[XB_TMO])) break; if (_sp > XB_SPIN_CAP) { atomicAdd(&(bar)[XB_TMO], 1u); break; } } } } while (0)

struct XcdBarrier {
    unsigned* bar; unsigned x;
    volatile LAS unsigned* st;
};

__device__ __forceinline__ XcdBarrier xcd_barrier_post(unsigned* bar, volatile LAS unsigned* st) {
    XcdBarrier b; b.bar = bar; b.x = xb_xcc_id(); b.st = st;
    if (threadIdx.x == 0) (void)xb_add(&bar[XB_XCNT(b.x)], 1u);
    return b;
}
__device__ __forceinline__ void xcd_barrier_complete(unsigned* bar, unsigned x, unsigned& nloc, unsigned& nx) {
    const unsigned G = gridDim.x * gridDim.y * gridDim.z;
    unsigned sum, cnt, mine, sp = 0u;
    for (;;) {
        sum = 0u; cnt = 0u; mine = 0u;
#pragma unroll
        for (unsigned j = 0; j < 16; ++j) { const unsigned c = xb_ld(&bar[XB_XCNT(j)]); sum += c; cnt += (c > 0u) ? 1u : 0u; mine = (j == x) ? c : mine; }
        if (sum == G) break;
        __builtin_amdgcn_s_sleep(1);
        if ((++sp & 255u) == 0u) { if (xb_ld(&bar[XB_TMO])) break; if (sp > XB_SPIN_CAP) { atomicAdd(&bar[XB_TMO], 1u); break; } }
    }
    nloc = mine > 0u ? mine : 1u; nx = cnt > 0u ? cnt : 1u;
}

__device__ __forceinline__ void xcd_barrier(const XcdBarrier& b) {
    asm volatile("s_waitcnt vmcnt(0)" ::: "memory");
    __syncthreads();
    if (threadIdx.x == 0) {
        unsigned* bar = b.bar;
        __builtin_amdgcn_s_waitcnt(0);
        unsigned nloc = b.st[0], nx = b.st[1];
        if (nloc == 0u) { xcd_barrier_complete(bar, b.x, nloc, nx); b.st[0] = nloc; b.st[1] = nx; }
        const unsigned old = xb_add(&bar[XB_XSUB(b.x)], 1u);
        const unsigned gen = old / nloc;
        if (old + 1u == (gen + 1u) * nloc) {
            __builtin_amdgcn_fence(__ATOMIC_RELEASE, "agent");
            asm volatile("s_waitcnt vmcnt(0)" ::: "memory");
            const unsigned og = xb_add(&bar[XB_TOP], 1u);
            const unsigned tg = og / nx;
            if (og + 1u == (tg + 1u) * nx) xb_add(&bar[XB_TOPGEN], 1u);
            else XB_SPIN(xb_ld(&bar[XB_TOPGEN]) == tg, bar);
            __builtin_amdgcn_fence(__ATOMIC_ACQUIRE, "agent");
            xb_add(&bar[XB_XGEN(b.x)], 1u);
            asm volatile("s_waitcnt vmcnt(0)" ::: "memory");
        } else {
            XB_SPIN(xb_ld(&bar[XB_XGEN(b.x)]) == gen, bar);
            __builtin_amdgcn_fence(__ATOMIC_ACQUIRE, "agent");
            asm volatile("s_waitcnt vmcnt(0)" ::: "memory");
        }
    }
    __syncthreads();
}

__device__ __forceinline__ const void* uni(const void* q) { const unsigned long long v = (unsigned long long)q; const unsigned lo = __builtin_amdgcn_readfirstlane((unsigned)v), hi = __builtin_amdgcn_readfirstlane((unsigned)(v >> 32)); return (const void*)(const GASP char*)(((unsigned long long)hi << 32) | lo); }
__global__ void __launch_bounds__(NTHR, 2) hybrid_fwd(KP kp) {
    extern __shared__ __attribute__((aligned(16))) unsigned char lds[];
    cg::grid_group grid = cg::this_grid();
    KP* lp = (KP*)(lds + 131072);
    if (threadIdx.x == 0) *lp = kp;
    volatile LAS unsigned* xst = (volatile LAS unsigned*)(lds + 131072 + 512);
    if (threadIdx.x < 2) xst[threadIdx.x] = 0u;
    if (blockIdx.x == 0) for (int i = threadIdx.x; i < 4096 + 512; i += NTHR) ((unsigned*)(kp.ws + WS_BAR))[i] = 0u;
    __syncthreads();
    const KP& p = *lp;
    float* sm = (float*)lds;
#define WSB ((unsigned char*)uni(p.ws))
#define OUTB ((float*)uni(p.out))
#define INP(i) ((const float*)uni(p.in[i]))
    phase_p0(p, sm);
    grid.sync();
    const XcdBarrier xbar = xcd_barrier_post((unsigned*)(WSB + WS_BAR), xst);
    for (int l = 0; l < 2; ++l) {
        { const float* modl = (const float*)(WSB + WS_MOD) + (size_t)l * 136 * 6144;
          const float* xP = l == 0 ? INP(0) : nullptr; const float* xS = l == 0 ? INP(1) : nullptr;
          phase_norm(p, xP, xS, INP(13) + l * DM, modl, 0, 1024, l == 0 ? -1 : 5120 - 136 * 6144); }
        xcd_barrier(xbar);
        { unsigned char* ws = WSB; pg8::Gemm g{(const bf16*)(ws + WS_H), (const bf16*)(ws + WS_WTIN) + (size_t)l * UP * DM, MP, UP, DM, DM}; pg8::StaticOrder S; S.init(MP, UP, 1, (int)gridDim.x, (int)blockIdx.x);
          pg8::EpiBf16<0> E{(bf16*)(ws + WS_U), UP}; pg8::gemm_phase<pg8::EpiBf16<0>, pg8::StaticOrder, true, true>((PG8_LAS unsigned char*)lds, g, S, E); }
        xcd_barrier(xbar);
        { unsigned char* ws = WSB; const int G = (int)gridDim.x, bx = (int)blockIdx.x;
          pg8::Gemm g{(const bf16*)(ws + WS_H), (const bf16*)(ws + WS_WTIN) + (size_t)l * UP * DM, MROWS, UP, DM, DM};
          pg8::SampleTilesOrder S{(G + 2) / 4, (bx & 3) == 1 ? (bx >> 2) : -1, 16}; pg8::EpiBf16<0> E{(bf16*)(ws + WS_U), UP};
          const unsigned nd = (S.cs >= 0 && S.cs < 64) ? (unsigned)((64 - S.cs + S.Gs - 1) / S.Gs) : 0u;
          if (nd) pg8::gemm_phase<pg8::EpiBf16<0>, pg8::SampleTilesOrder, false, true>((PG8_LAS unsigned char*)lds, g, S, E);
          flag_signal((unsigned*)(ws + WS_BAR) + 4224 + 64 * l, nd); }
        phase_scan(p, l, sm);
        xcd_barrier(xbar);
        phase_post(p, l, sm);
        xcd_barrier(xbar);
        { unsigned char* ws = WSB; const float* modl = (const float*)(ws + WS_MOD) + (size_t)l * 136 * 6144;
          pg8::Gemm g{(const bf16*)(ws + WS_H), (const bf16*)(ws + WS_WTOUT) + (size_t)l * DM * DM, MP, DM, DM, DM}; pg8::StaticOrder S; S.init(MP, DM, 1, (int)gridDim.x, (int)blockIdx.x);
          if (l == 0) { pg8::EpiRes<true> E{INP(0), (bf16*)(ws + WS_X16), modl + 2048}; pg8::gemm_phase<pg8::EpiRes<true>, pg8::StaticOrder, true, true>((PG8_LAS unsigned char*)lds, g, S, E); }
          else { pg8::EpiRes<false> E{nullptr, (bf16*)(ws + WS_X16), modl + 2048}; pg8::gemm_phase<pg8::EpiRes<false>, pg8::StaticOrder, true, true>((PG8_LAS unsigned char*)lds, g, S, E); }
          pg8::Gemm g2{(const bf16*)(ws + WS_H), (const bf16*)(ws + WS_WTOUT) + (size_t)l * DM * DM, MROWS, DM, DM / 4, DM}; pg8::SampleSplitOrder S2{(int)gridDim.x, (int)blockIdx.x};
          pg8::EpiPart E2{(float*)(ws + WS_PART)}; pg8::gemm_phase<pg8::EpiPart, pg8::SampleSplitOrder, false, true>((PG8_LAS unsigned char*)lds, g2, S2, E2); }
        xcd_barrier(xbar);
        { const float* modl = (const float*)(WSB + WS_MOD) + (size_t)l * 136 * 6144;
          phase_norm(p, nullptr, l == 0 ? INP(1) : nullptr, INP(14) + l * DM, modl, 3072, 4096, 2048); }
        xcd_barrier(xbar);
        { unsigned char* ws = WSB; pg8::Gemm g{(const bf16*)(ws + WS_H), (const bf16*)(ws + WS_WTUP) + (size_t)l * DFF * DM, MP, DFF, DM, DM}; pg8::StaticOrder S; S.init(MP, DFF, 1, (int)gridDim.x, (int)blockIdx.x);
          pg8::EpiBf16<2> E{(bf16*)(ws + WS_U), DFF}; pg8::gemm_phase<pg8::EpiBf16<2>, pg8::StaticOrder, true, true>((PG8_LAS unsigned char*)lds, g, S, E); }
        xcd_barrier(xbar);
        { unsigned char* ws = WSB; const int G = (int)gridDim.x, bx = (int)blockIdx.x;
          pg8::Gemm g{(const bf16*)(ws + WS_H), (const bf16*)(ws + WS_WTUP) + (size_t)l * DFF * DM, MROWS, DFF, DM, DM};
          const int Gs = G < 64 ? G : 64; pg8::SampleTilesOrder S{Gs, bx >= G - Gs ? bx - (G - Gs) : -1, 16}; pg8::EpiBf16<2> E{(bf16*)(ws + WS_U), DFF};
          const unsigned nd = (S.cs >= 0 && S.cs < 64) ? (unsigned)((64 - S.cs + S.Gs - 1) / S.Gs) : 0u;
          if (nd) pg8::gemm_phase<pg8::EpiBf16<2>, pg8::SampleTilesOrder, false, true>((PG8_LAS unsigned char*)lds, g, S, E);
          flag_signal((unsigned*)(ws + WS_BAR) + 4352 + 64 * l, nd); }
        { unsigned char* ws = WSB; const float* modl = (const float*)(ws + WS_MOD) + (size_t)l * 136 * 6144;
          pg8::Gemm g{(const bf16*)(ws + WS_U), (const bf16*)(ws + WS_WTDN) + (size_t)l * DM * DFF, MP, DM, DFF, DFF}; pg8::StaticOrder S; S.init(MP, DM, 1, (int)gridDim.x, (int)blockIdx.x);
          pg8::EpiRes<false> E{nullptr, (bf16*)(ws + WS_X16), modl + 5120}; pg8::gemm_phase<pg8::EpiRes<false>, pg8::StaticOrder, true, true>((PG8_LAS unsigned char*)lds, g, S, E);
          if ((int)blockIdx.x < 64) flag_wait((unsigned*)(ws + WS_BAR) + 4352 + 64 * l, 64u);
          pg8::Gemm g2{(const bf16*)(ws + WS_U), (const bf16*)(ws + WS_WTDN) + (size_t)l * DM * DFF, MROWS, DM, DFF / 4, DFF}; pg8::SampleSplitOrder S2{(int)gridDim.x, (int)blockIdx.x};
          pg8::EpiPart E2{(float*)(ws + WS_PART)}; pg8::gemm_phase<pg8::EpiPart, pg8::SampleSplitOrder, false, true>((PG8_LAS unsigned char*)lds, g2, S2, E2); }
        xcd_barrier(xbar);
    }
    phase_final(p);
}

extern "C" void kernel_launch(void* const* d_in, const int* in_sizes, int n_in, void* d_out, int out_size, void* d_ws, size_t ws_size, hipStream_t stream) {
    static int grid = 0;
    if (grid == 0) {
        if (n_in != 44 || (size_t)out_size != O_TOTAL || ws_size < WS_END) { fprintf(stderr, "kernel_launch: unexpected shapes: n_in %d out %d ws %zu\n", n_in, out_size, ws_size); grid = -1; return; }
        int dev = 0, cus = 0, per_cu = 0;
        hipGetDevice(&dev); hipDeviceGetAttribute(&cus, hipDeviceAttributeMultiprocessorCount, dev);
        if (hipFuncSetAttribute((const void*)hybrid_fwd, hipFuncAttributeMaxDynamicSharedMemorySize, LDS_BYTES) != hipSuccess) { fprintf(stderr, "kernel_launch: hipFuncSetAttribute failed\n"); grid = -1; return; }
        if (hipOccupancyMaxActiveBlocksPerMultiprocessor(&per_cu, (const void*)hybrid_fwd, NTHR, LDS_BYTES) != hipSuccess || per_cu < 1) { fprintf(stderr, "kernel_launch: occupancy query failed (%d)\n", per_cu); grid = -1; return; }
        grid = cus * per_cu;
    }
    if (grid < 0) return;
    KP p{};
    for (int i = 0; i < 44; ++i) p.in.v[i] = (const float*)d_in[i];
    p.out.v = (float*)d_out; p.ws.v = (unsigned char*)d_ws;
    void* args[] = {&p};
    hipError_t e = hipLaunchCooperativeKernel((const void*)hybrid_fwd, dim3(grid), dim3(NTHR), args, LDS_BYTES, stream);
    if (e != hipSuccess) fprintf(stderr, "kernel_launch: cooperative launch failed: %s (grid %d)\n", hipGetErrorString(e), grid);
}
```

```cpp
#include <hip/hip_runtime.h>
#include <hip/hip_cooperative_groups.h>
#include <cstdio>
#include <cstdint>
namespace cg = cooperative_groups;

namespace pg8 {
#define PG8_LAS __attribute__((address_space(3)))
typedef unsigned short bf16_t;
typedef short bf16x8 __attribute__((ext_vector_type(8)));
typedef float f32x4 __attribute__((ext_vector_type(4)));
typedef unsigned u32x4 __attribute__((ext_vector_type(4)));
constexpr int BM = 256, BK = 64, HALF = 128, HTB = HALF * BK * 2, STAGE_BYTES = 8 * HTB, NXCD = 8, WGM = 8;

__host__ __device__ __forceinline__ int lds_byte(int r, int c) { const int st = (r >> 4) * 2 + (c >> 5), rr = r & 15, cc = c & 31, ob = rr * 64 + cc * 2; return st * 1024 + (ob ^ (((ob >> 9) & 1) << 5)); }
__host__ __device__ __forceinline__ void stage_rc(int b, int& R, int& C) { const int st = b / 1024, sb = b % 1024, swz = sb ^ (((sb >> 9) & 1) << 5); R = (st >> 1) * 16 + swz / 64; C = (st & 1) * 32 + (swz % 64) / 2; }
__host__ __device__ __forceinline__ int perm32(int rho) { const int n = rho >> 4, i = rho & 15; return 8 * (i >> 2) + 4 * n + (i & 3); }

struct Unit { int pm, pn, pk; };
struct Gemm { const bf16_t* A; const bf16_t* Bt; int M, N, K, ld; };

struct StaticOrder {
    int nM, nN, nK, ntile, nwg, G, c;
    __host__ __device__ void init(int M, int N, int nK_, int G_, int c_) { nM = M / BM; nN = N / BM; nK = nK_; ntile = nM * nN; nwg = ntile * nK; G = G_; c = c_; }
    __host__ __device__ bool next(int i, Unit& u) const {
        const long L = (long)i * G + c; if (L >= nwg) return false;
        int wgid = (int)L; { const int q = nwg / NXCD, r = nwg % NXCD, xcd = wgid % NXCD, off = wgid / NXCD; wgid = (xcd < r ? xcd * (q + 1) : r * (q + 1) + (xcd - r) * q) + off; }
        u.pk = wgid / ntile; wgid -= u.pk * ntile;
        const int nig = WGM * nN, gid = wgid / nig, fm = gid * WGM, gsz = (nM - fm) < WGM ? (nM - fm) : WGM;
        u.pm = fm + ((wgid % nig) % gsz); u.pn = (wgid % nig) / gsz; return true;
    }
    __device__ __forceinline__ void a_ready(const Unit&) const {}
    __device__ __forceinline__ void done(const Unit&) const {}
};
__device__ __forceinline__ unsigned cvt_pk_bf16(float lo, float hi) { unsigned r; asm volatile("v_cvt_pk_bf16_f32 %0, %1, %2" : "=v"(r) : "v"(lo), "v"(hi)); return r; }

template <int ACT  > struct EpiBf16 {
    static constexpr bool PERM = true, AFTER_DRAIN = false;
    bf16_t* O; int ldc;
    __device__ __forceinline__ void operator()(const f32x4 (&acc)[2][2][4][2], const Unit& u, int wr, int wc, int fr, int fq) const {
        const int row0 = u.pm * BM + wr * 64 + fr, col0 = u.pn * BM + wc * 32 + 8 * fq;
#pragma unroll
        for (int ai = 0; ai < 2; ++ai)
#pragma unroll
            for (int m = 0; m < 4; ++m) { bf16_t* rowp = O + (size_t)(row0 + ai * HALF + m * 16) * ldc + col0;
#pragma unroll
                for (int bj = 0; bj < 2; ++bj) { f32x4 v0 = acc[ai][bj][m][0], v1 = acc[ai][bj][m][1];
                    if (ACT == 2) {
#pragma unroll
                        for (int j = 0; j < 4; ++j) { float a = fmaxf(v0[j], 0.f), b = fmaxf(v1[j], 0.f); v0[j] = a * a; v1[j] = b * b; } }
                    u32x4 w; w.x = cvt_pk_bf16(v0[0], v0[1]); w.y = cvt_pk_bf16(v0[2], v0[3]); w.z = cvt_pk_bf16(v1[0], v1[1]); w.w = cvt_pk_bf16(v1[2], v1[3]);
                    *(u32x4*)(rowp + bj * HALF) = w; } }
    }
};
template <bool SRCF32> struct EpiRes {
    static constexpr bool PERM = true, AFTER_DRAIN = false;
    const float* srcF; bf16_t* X; const float* gate;
    __device__ __forceinline__ void operator()(const f32x4 (&acc)[2][2][4][2], const Unit& u, int wr, int wc, int fr, int fq) const {
        const int row0 = u.pm * BM + wr * 64 + fr, col0 = u.pn * BM + wc * 32 + 8 * fq;
#pragma unroll
        for (int ai = 0; ai < 2; ++ai)
#pragma unroll
            for (int m = 0; m < 4; ++m) { const int row = row0 + ai * HALF + m * 16;
                const int cond = row < 16384 ? (row >> 11) : 8 + ((row - 16384) >> 3);
                const float* g = gate + (size_t)cond * 6144; bf16_t* d = X + (size_t)row * 1024;
#pragma unroll
                for (int bj = 0; bj < 2; ++bj) { const int c = col0 + bj * HALF; const f32x4 g0 = *(const f32x4*)(g + c), g1 = *(const f32x4*)(g + c + 4);
                    f32x4 x0, x1;
                    if (SRCF32) { const float* s = srcF + (size_t)row * 1024 + c; x0 = *(const f32x4*)s; x1 = *(const f32x4*)(s + 4); }
                    else { const u32x4 w = *(const u32x4*)(d + c);
                        x0 = (f32x4){__builtin_bit_cast(float, w.x << 16), __builtin_bit_cast(float, w.x & 0xffff0000u), __builtin_bit_cast(float, w.y << 16), __builtin_bit_cast(float, w.y & 0xffff0000u)};
                        x1 = (f32x4){__builtin_bit_cast(float, w.z << 16), __builtin_bit_cast(float, w.z & 0xffff0000u), __builtin_bit_cast(float, w.w << 16), __builtin_bit_cast(float, w.w & 0xffff0000u)}; }
                    x0 += g0 * acc[ai][bj][m][0]; x1 += g1 * acc[ai][bj][m][1];
                    u32x4 o; o.x = cvt_pk_bf16(x0[0], x0[1]); o.y = cvt_pk_bf16(x0[2], x0[3]); o.z = cvt_pk_bf16(x1[0], x1[1]); o.w = cvt_pk_bf16(x1[2], x1[3]);
                    *(u32x4*)(d + c) = o; } }
    }
};

struct SampleSplitOrder {
    int G, c;
    __device__ bool next(int i, Unit& u) const { const int L = i * G + c; if (L >= 64) return false; u.pk = L & 3; const int t = L >> 2; u.pm = 64 + (t >> 2); u.pn = t & 3; return true; }
    __device__ __forceinline__ void a_ready(const Unit&) const {}
    __device__ __forceinline__ void done(const Unit&) const {}
};
struct EpiPart {
    static constexpr bool PERM = true, AFTER_DRAIN = false;
    float* P;
    __device__ __forceinline__ void operator()(const f32x4 (&acc)[2][2][4][2], const Unit& u, int wr, int wc, int fr, int fq) const {
        const int row0 = (u.pm - 64) * BM + wr * 64 + fr, col0 = u.pn * BM + wc * 32 + 8 * fq;
#pragma unroll
        for (int ai = 0; ai < 2; ++ai)
#pragma unroll
            for (int m = 0; m < 4; ++m) { float* d = P + ((size_t)u.pk * 1024 + row0 + ai * HALF + m * 16) * 1024 + col0;
#pragma unroll
                for (int bj = 0; bj < 2; ++bj) { *(f32x4*)(d + bj * HALF) = acc[ai][bj][m][0]; *(f32x4*)(d + bj * HALF + 4) = acc[ai][bj][m][1]; } }
    }
};

struct SampleTilesOrder {
    int Gs, cs, nN;
    __device__ bool next(int i, Unit& u) const { if (cs < 0) return false; const int L = i * Gs + cs; if (L >= 4 * nN) return false; u.pk = 0; u.pm = 64 + L / nN; u.pn = L % nN; return true; }
    __device__ __forceinline__ void a_ready(const Unit&) const {}
    __device__ __forceinline__ void done(const Unit&) const {}
};

template <class Epi, class Sched, bool ALIGN_EPI = false, bool SP2 = false>
__device__ __forceinline__ void gemm_phase(PG8_LAS unsigned char* lds, const Gemm g, const Sched& S, const Epi& E) {
    int tid_ = threadIdx.x; asm volatile("" : "+v"(tid_));
    const int tid = tid_, wid = __builtin_amdgcn_readfirstlane(tid >> 6), lane = tid & 63, wr = wid >> 2, wc = wid & 3, fr = lane & 15, fq = lane >> 4;
    const int K = g.ld, nt = g.K / BK; const size_t kspl = (size_t)g.K * 2;
    unsigned voffA[2], voffB[2];
#pragma unroll
    for (int i = 0; i < 2; ++i) { int R, C; stage_rc(tid * 16 + i * 8192, R, C); const int Rb = Epi::PERM ? ((R & ~31) + perm32(R & 31)) : R;
        voffA[i] = (unsigned)(R * K + C) * 2u; voffB[i] = (unsigned)(Rb * K + C) * 2u; }
    const size_t kstep = (size_t)(BK * 2);
    const size_t hstep = (size_t)HALF * K * 2;
    const size_t tstep = 2 * hstep;
    const unsigned ldsw = (unsigned)wid * 1024u;
    const int aoff = lds_byte(wr * 64 + fr, fq * 8), boff = lds_byte(wc * 32 + fr, fq * 8);
#define PG8_SA(b, h) (((b) * 2 + (h)) * HTB)
#define PG8_SB(b, h) ((4 + (b) * 2 + (h)) * HTB)
#define PG8_STAGE(bufoff, gbase, voff) do { _Pragma("unroll") for (int _i = 0; _i < 2; ++_i) \
        __builtin_amdgcn_global_load_lds((const unsigned*)((const char*)(gbase) + (voff)[_i]), (PG8_LAS unsigned*)(lds + (bufoff) + ldsw + _i * 8192), 16, 0, 0); } while (0)
#define PG8_LDA(dst, b, h) do { _Pragma("unroll") for (int m = 0; m < 4; ++m) _Pragma("unroll") for (int k = 0; k < 2; ++k) dst[m][k] = *(const PG8_LAS bf16x8*)(lds + PG8_SA(b, h) + aoff + m * 2048 + k * 1024); } while (0)
#define PG8_LDB(dst, b, h) do { _Pragma("unroll") for (int n = 0; n < 2; ++n) _Pragma("unroll") for (int k = 0; k < 2; ++k) dst[n][k] = *(const PG8_LAS bf16x8*)(lds + PG8_SB(b, h) + boff + n * 2048 + k * 1024); } while (0)
#define PG8_MMA(ai, bj, At, Bt) do { __builtin_amdgcn_s_setprio(1); _Pragma("unroll") for (int m = 0; m < 4; ++m) _Pragma("unroll") for (int n = 0; n < 2; ++n) _Pragma("unroll") for (int k = 0; k < 2; ++k) \
        acc[ai][bj][m][n] = __builtin_amdgcn_mfma_f32_16x16x32_bf16(Bt[n][k], At[m][k], acc[ai][bj][m][n], 0, 0, 0); __builtin_amdgcn_s_setprio(0); } while (0)
#define PG8_WAIT_V(n) asm volatile("s_waitcnt vmcnt(" #n ")" ::: "memory")
#define PG8_WAIT_L(n) asm volatile("s_waitcnt lgkmcnt(" #n ")" ::: "memory")
#define PG8_BAR __builtin_amdgcn_s_barrier()
#define PG8_SCHED __builtin_amdgcn_sched_barrier(0)
    Unit cur, nxt; int ui = 0;
    if (!S.next(0, cur)) return;
    f32x4 acc[2][2][4][2];
#pragma unroll
    for (int a = 0; a < 2; ++a)
#pragma unroll
        for (int b = 0; b < 2; ++b)
#pragma unroll
            for (int m = 0; m < 4; ++m)
#pragma unroll
                for (int n = 0; n < 2; ++n) acc[a][b][m][n] = (f32x4){0.f, 0.f, 0.f, 0.f};
    bf16x8 At[4][2], B0[2][2], B1[2][2];
    const char* cA = (const char*)g.A + (size_t)cur.pm * tstep + (size_t)cur.pk * kspl; const char* cB = (const char*)g.Bt + (size_t)cur.pn * tstep + (size_t)cur.pk * kspl;
    S.a_ready(cur);
    if constexpr (SP2) {
        PG8_STAGE(PG8_SB(0, 0), cB, voffB); PG8_STAGE(PG8_SB(0, 1), cB + hstep, voffB); PG8_STAGE(PG8_SA(0, 0), cA, voffA); PG8_STAGE(PG8_SA(0, 1), cA + hstep, voffA);
        if (wr == 1) PG8_BAR;
        PG8_WAIT_V(2); PG8_BAR;
        PG8_STAGE(PG8_SB(1, 0), cB + kstep, voffB); PG8_STAGE(PG8_SA(1, 0), cA + kstep, voffA); PG8_STAGE(PG8_SB(1, 1), cB + hstep + kstep, voffB);
        PG8_WAIT_V(6); PG8_BAR;
    } else {
        PG8_STAGE(PG8_SB(0, 0), cB, voffB); PG8_STAGE(PG8_SA(0, 0), cA, voffA); PG8_STAGE(PG8_SB(0, 1), cB + hstep, voffB); PG8_STAGE(PG8_SA(0, 1), cA + hstep, voffA);
        if (wr == 1) PG8_BAR;
        PG8_WAIT_V(4); PG8_BAR;
        PG8_STAGE(PG8_SB(1, 0), cB + kstep, voffB); PG8_STAGE(PG8_SA(1, 0), cA + kstep, voffA); PG8_STAGE(PG8_SB(1, 1), cB + hstep + kstep, voffB);
        PG8_WAIT_V(6); PG8_BAR;
    }
    for (;;) {
        const bool has_next = S.next(ui + 1, nxt);
        const char* nA = has_next ? (const char*)g.A + (size_t)nxt.pm * tstep + (size_t)nxt.pk * kspl : cA; const char* nB = has_next ? (const char*)g.Bt + (size_t)nxt.pn * tstep + (size_t)nxt.pk * kspl : cB;
        for (int t = 0; t < nt; t += 2) {
            const bool last = (t == nt - 2);
            const char* a1 = cA + (size_t)(t + 1) * kstep;
            const char* a2 = last ? nA : cA + (size_t)(t + 2) * kstep; const char* b2 = last ? nB : cB + (size_t)(t + 2) * kstep;
            const char* a3 = a2 + kstep; const char* b3 = b2 + kstep;
            if (last && has_next) S.a_ready(nxt);
            if constexpr (SP2) {
            PG8_LDB(B0, 0, 0); PG8_LDB(B1, 0, 1); PG8_SCHED; PG8_LDA(At, 0, 0); PG8_STAGE(PG8_SA(1, 1), a1 + hstep, voffA);
            PG8_WAIT_V(8); PG8_WAIT_L(0); PG8_BAR; PG8_MMA(0, 0, At, B0); PG8_MMA(0, 1, At, B1); PG8_BAR; PG8_SCHED;
            PG8_LDA(At, 0, 1); PG8_STAGE(PG8_SB(0, 0), b2, voffB); PG8_STAGE(PG8_SB(0, 1), b2 + hstep, voffB); PG8_STAGE(PG8_SA(0, 0), a2, voffA);
            PG8_WAIT_V(8); PG8_WAIT_L(0); PG8_BAR; PG8_MMA(1, 0, At, B0); PG8_MMA(1, 1, At, B1); PG8_BAR; PG8_SCHED;
            PG8_LDB(B0, 1, 0); PG8_LDB(B1, 1, 1); PG8_SCHED; PG8_LDA(At, 1, 0); PG8_STAGE(PG8_SA(0, 1), a2 + hstep, voffA);
            PG8_WAIT_V(8); PG8_WAIT_L(0); PG8_BAR; PG8_MMA(0, 0, At, B0); PG8_MMA(0, 1, At, B1); PG8_BAR; PG8_SCHED;
            PG8_LDA(At, 1, 1); PG8_STAGE(PG8_SB(1, 0), b3, voffB); PG8_STAGE(PG8_SB(1, 1), b3 + hstep, voffB); PG8_STAGE(PG8_SA(1, 0), a3, voffA);
            PG8_WAIT_V(8); PG8_WAIT_L(0); PG8_BAR; PG8_MMA(1, 0, At, B0); PG8_MMA(1, 1, At, B1); PG8_BAR; PG8_SCHED;
            } else {
            PG8_LDB(B0, 0, 0); PG8_SCHED; PG8_LDA(At, 0, 0); PG8_STAGE(PG8_SA(1, 1), a1 + hstep, voffA);
            PG8_WAIT_L(8); PG8_BAR; PG8_WAIT_L(0); PG8_MMA(0, 0, At, B0); PG8_BAR; PG8_SCHED;
            PG8_LDB(B1, 0, 1); PG8_STAGE(PG8_SB(0, 0), b2, voffB);
            PG8_BAR; PG8_WAIT_L(0); PG8_MMA(0, 1, At, B1); PG8_BAR;
            PG8_LDA(At, 0, 1); PG8_STAGE(PG8_SA(0, 0), a2, voffA);
            PG8_BAR; PG8_WAIT_L(0); PG8_MMA(1, 0, At, B0); PG8_BAR; PG8_SCHED;
            PG8_STAGE(PG8_SB(0, 1), b2 + hstep, voffB);
            PG8_WAIT_V(6); PG8_BAR; PG8_MMA(1, 1, At, B1); PG8_BAR;
            PG8_LDB(B0, 1, 0); PG8_SCHED; PG8_LDA(At, 1, 0); PG8_STAGE(PG8_SA(0, 1), a2 + hstep, voffA);
            PG8_WAIT_L(8); PG8_BAR; PG8_WAIT_L(0); PG8_MMA(0, 0, At, B0); PG8_BAR; PG8_SCHED;
            PG8_LDB(B1, 1, 1); PG8_STAGE(PG8_SB(1, 0), b3, voffB);
            PG8_BAR; PG8_WAIT_L(0); PG8_MMA(0, 1, At, B1); PG8_BAR;
            PG8_LDA(At, 1, 1); PG8_STAGE(PG8_SA(1, 0), a3, voffA);
            PG8_BAR; PG8_WAIT_L(0); PG8_MMA(1, 0, At, B0); PG8_BAR; PG8_SCHED;
            PG8_STAGE(PG8_SB(1, 1), b3 + hstep, voffB);
            PG8_WAIT_V(6); PG8_BAR; PG8_MMA(1, 1, At, B1); PG8_BAR;
            }
        }
        if constexpr (ALIGN_EPI) { if (wr == 0) PG8_BAR; }
        if constexpr (!Epi::AFTER_DRAIN) { E(acc, cur, wr, wc, fr, fq); S.done(cur); }
        if (!has_next) break;
#pragma unroll
        for (int a = 0; a < 2; ++a)
#pragma unroll
            for (int b = 0; b < 2; ++b)
#pragma unroll
                for (int m = 0; m < 4; ++m)
#pragma unroll
                    for (int n = 0; n < 2; ++n) acc[a][b][m][n] = (f32x4){0.f, 0.f, 0.f, 0.f};
        cur = nxt; cA = nA; cB = nB; ++ui;
        if constexpr (ALIGN_EPI) { if (wr == 1) PG8_BAR; }
    }
    PG8_WAIT_V(0);
    if constexpr (!ALIGN_EPI) { if (wr == 0) PG8_BAR; }
    PG8_BAR;
    if constexpr (Epi::AFTER_DRAIN) { E.fused(acc, cur, wr, wc, fr, fq, lds, wid, lane); S.done(cur); }
#undef PG8_SA
#undef PG8_SB
#undef PG8_STAGE
#undef PG8_LDA
#undef PG8_LDB
#undef PG8_MMA
#undef PG8_WAIT_V
#undef PG8_WAIT_L
#undef PG8_BAR
#undef PG8_SCHED
}
}

typedef unsigned short bf16;
#define LAS __attribute__((address_space(3)))
typedef float f32x4 __attribute__((ext_vector_type(4)));
constexpr int DM = 1024, TP = 2048, BP = 8, BS = 128, TS = 8, MP = BP * TP, MS = BS * TS, MROWS = MP + MS, UP = 4096, PT = 3996, DFF = 4096;
constexpr int CA = 0, CB = 896, CC = 1936, CD = 2968;
constexpr int NTHR = 512, NWAVES = 8;
constexpr int LDS_BYTES = 135168;
constexpr size_t MiB = 1u << 20;
constexpr size_t WS_BAR = 59 * MiB + 512 * 1024;
constexpr size_t WS_WTIN = 0, WS_WTOUT = 16 * MiB, WS_WTUP = 20 * MiB, WS_WTDN = 36 * MiB, WS_MOD = 52 * MiB, WS_AUX = 59 * MiB, WS_H = 60 * MiB, WS_U = 94 * MiB, WS_PART = 230 * MiB, WS_X16 = 246 * MiB, WS_END = 280 * MiB;
static_assert(WS_MOD + (size_t)2 * 136 * 6144 * 4 <= WS_AUX && WS_AUX + (size_t)MROWS * 4 * 4 <= WS_H && WS_H + (size_t)MROWS * DM * 2 <= WS_U && WS_U + (size_t)MROWS * UP * 2 <= WS_PART, "ws map");
constexpr size_t O_PSHIFT = (size_t)MROWS * DM, O_PWKV = O_PSHIFT + 2 * 8 * 896, O_PGLA = O_PWKV + 2 * 8 * 4 * 4096, O_PDNC = O_PGLA + 2 * 8 * 4 * 4096, O_PDN = O_PDNC + 2 * 8 * 3 * 768,
                 O_PSSC = O_PDN + 2 * 8 * 4 * 4096, O_PSSM = O_PSSC + 2 * 8 * 3 * 768, O_SSHIFT = O_PSSM + 2 * 8 * 4 * 8192, O_SWKV = O_SSHIFT + 2 * 128 * 896, O_SGLA = O_SWKV + (size_t)2 * 128 * 4 * 4096,
                 O_SDNC = O_SGLA + (size_t)2 * 128 * 4 * 4096, O_SDN = O_SDNC + 2 * 128 * 3 * 768, O_SSSC = O_SDN + (size_t)2 * 128 * 4 * 4096, O_SSSM = O_SSSC + 2 * 128 * 3 * 768, O_TOTAL = O_SSSM + (size_t)2 * 128 * 4 * 8192;

#define GASP __attribute__((address_space(1)))
template <class T> __device__ __forceinline__ T* as_global(T* q) { return (T*)(GASP T*)(unsigned long long)q; }
struct KP {
    struct In { const float* v[44]; __device__ __forceinline__ const float* operator[](int i) const { return as_global(v[i]); } } in;
    struct Out { float* v; __device__ __forceinline__ operator float*() const { return as_global(v); } } out;
    struct Ws { unsigned char* v; __device__ __forceinline__ operator unsigned char*() const { return as_global(v); } } ws;
};

__device__ __forceinline__ int otid() { int t = threadIdx.x; asm volatile("" : "+v"(t)); return t; }
__device__ __forceinline__ float bf2f(bf16 h) { return __builtin_bit_cast(float, (unsigned)h << 16); }
__device__ __forceinline__ unsigned f2bf(float f) { unsigned u = __builtin_bit_cast(unsigned, f); return (u + 0x7fffu + ((u >> 16) & 1u)) >> 16; }
__device__ __forceinline__ unsigned pk2(float lo, float hi) { unsigned r; asm("v_cvt_pk_bf16_f32 %0, %1, %2" : "=v"(r) : "v"(lo), "v"(hi)); return r; }
typedef short bf16x8v __attribute__((ext_vector_type(8)));
__device__ __forceinline__ uint4 pack8f(const float* s) { uint4 v; v.x = pk2(s[0], s[1]); v.y = pk2(s[2], s[3]); v.z = pk2(s[4], s[5]); v.w = pk2(s[6], s[7]); return v; }
template <int CTRL> __device__ __forceinline__ float dppf(float x) { return __builtin_bit_cast(float, __builtin_amdgcn_mov_dpp(__builtin_bit_cast(int, x), CTRL, 0xf, 0xf, true)); }
__device__ __forceinline__ float red16(float v) { v += dppf<0xB1>(v); v += dppf<0x4E>(v); v += dppf<0x141>(v); v += dppf<0x128>(v); return v; }
__device__ __forceinline__ float wave_sum(float v) { v = red16(v); v += __shfl_xor(v, 16); v += __shfl_xor(v, 32); return v; }
__device__ __forceinline__ float sigmoidf_(float x) { return __builtin_amdgcn_rcpf(1.f + __expf(-x)); }
__device__ __forceinline__ float siluf_(float x) { return x * __builtin_amdgcn_rcpf(1.f + __expf(-x)); }
__device__ __forceinline__ float softplusf_(float x) { return fmaxf(x, 0.f) + __logf(1.f + __expf(-fabsf(x))); }
__device__ __forceinline__ float tanhf_(float x) { return 1.f - 2.f * __builtin_amdgcn_rcpf(__expf(2.f * x) + 1.f); }

__device__ __forceinline__ void transpose_item(const float* W, int K, int N, bf16* WT, float* scr, int item, int nblk, int lane) {
    const int kb = item / nblk, nb = item % nblk, k0 = 64 * kb, n0 = 32 * nb;
    const int kr = lane >> 3, c4 = (lane & 7) * 4; const bool ok = n0 + c4 < N;
    f32x4 v[8];
#pragma unroll
    for (int i = 0; i < 8; ++i) v[i] = ok ? *(const f32x4*)(W + (size_t)(k0 + i * 8 + kr) * N + n0 + c4) : (f32x4){0.f, 0.f, 0.f, 0.f};
#pragma unroll
    for (int i = 0; i < 8; ++i) { float* d = scr + (i * 8 + kr) * 33 + c4; d[0] = v[i][0]; d[1] = v[i][1]; d[2] = v[i][2]; d[3] = v[i][3]; }
    __builtin_amdgcn_s_waitcnt(0); __builtin_amdgcn_wave_barrier();
    const int c = lane & 7;
#pragma unroll
    for (int j = 0; j < 4; ++j) { const int nn = (lane >> 3) + 8 * j; const float* s = scr + (8 * c) * 33 + nn;
        uint4 o; o.x = pk2(s[0 * 33], s[1 * 33]); o.y = pk2(s[2 * 33], s[3 * 33]); o.z = pk2(s[4 * 33], s[5 * 33]); o.w = pk2(s[6 * 33], s[7 * 33]);
        *(uint4*)(WT + (size_t)(n0 + nn) * K + k0 + 8 * c) = o; }
    __builtin_amdgcn_s_waitcnt(0); __builtin_amdgcn_wave_barrier();
}

__device__ __forceinline__ void phase_p0(const KP& p, float* sm) {
    const int tid = otid(), lane = tid & 63, wv = tid >> 6, G = gridDim.x;
    { bf16* AS = (bf16*)sm; const int nt = wv & 3, mh = wv >> 2, n = lane & 15, fq = lane >> 4;
      for (int u = blockIdx.x; u < 2 * 96; u += G) {
        const int l = u / 96, n0 = (u % 96) * 64 + nt * 16 + n;
        const float* W = p.in[11] + (size_t)l * DM * 6144 + n0;
        f32x4 acc[5];
#pragma unroll
        for (int m = 0; m < 5; ++m) acc[m] = (f32x4){0.f, 0.f, 0.f, 0.f};
        float wb[2][8];
#pragma unroll
        for (int ks = 0; ks < 2; ++ks)
#pragma unroll
            for (int j = 0; j < 8; ++j) wb[ks][j] = W[(size_t)(ks * 32 + fq * 8 + j) * 6144];
        for (int kc = 0; kc < DM; kc += 64) {
            __syncthreads();
            for (int i = tid; i < 144 * 32; i += NTHR) { const int r = i >> 5, k = (i & 31) * 2;
                float c0 = 0.f, c1 = 0.f;
                if (r < 8) { const float2 c = *(const float2*)(p.in[9] + (size_t)r * DM + kc + k); c0 = siluf_(c.x); c1 = siluf_(c.y); }
                else if (r < 136) { const float2 c = *(const float2*)(p.in[10] + (size_t)(r - 8) * DM + kc + k); c0 = siluf_(c.x); c1 = siluf_(c.y); }
                *(unsigned*)(AS + r * 72 + k) = pk2(c0, c1); }
            __syncthreads();
            bf16x8v B[2];
#pragma unroll
            for (int ks = 0; ks < 2; ++ks) { const uint4 t = pack8f(wb[ks]); B[ks] = __builtin_bit_cast(bf16x8v, t); }
            if (kc + 64 < DM) {
#pragma unroll
                for (int ks = 0; ks < 2; ++ks)
#pragma unroll
                    for (int j = 0; j < 8; ++j) wb[ks][j] = W[(size_t)(kc + 64 + ks * 32 + fq * 8 + j) * 6144]; }
#pragma unroll
            for (int ks = 0; ks < 2; ++ks)
#pragma unroll
                for (int m = 0; m < 5; ++m) { const int mt = mh * 5 + m; if (mt < 9) { const bf16x8v A = *(const bf16x8v*)(AS + (mt * 16 + n) * 72 + ks * 32 + fq * 8);
                    acc[m] = __builtin_amdgcn_mfma_f32_16x16x32_bf16(A, B[ks], acc[m], 0, 0, 0); } }
        }
        const float bias = p.in[12][(size_t)l * 6144 + n0];
        float* M = (float*)(p.ws + WS_MOD) + (size_t)l * 136 * 6144 + n0;
#pragma unroll
        for (int m = 0; m < 5; ++m) { const int mt = mh * 5 + m;
#pragma unroll
            for (int i = 0; i < 4; ++i) { const int row = mt * 16 + fq * 4 + i; if (mt < 9 && row < 136) M[(size_t)row * 6144] = acc[m][i] + bias; } }
      }
      __syncthreads(); }
    const int gw = blockIdx.x * NWAVES + wv, NGW = G * NWAVES;
    float* scr = sm + wv * (64 * 33);
    constexpr int I_IN = 16 * 128, I_OUT = 16 * 32, I_UP = 16 * 128, I_DN = 64 * 32, I_L = I_IN + I_OUT + I_UP + I_DN;
    for (int it = gw; it < 2 * I_L; it += NGW) {
        const int l = it / I_L; int r = it % I_L;
        if (r < I_IN) { transpose_item(p.in[15] + (size_t)l * DM * PT, DM, PT, (bf16*)(p.ws + WS_WTIN) + (size_t)l * UP * DM, scr, r, 128, lane); continue; } r -= I_IN;
        if (r < I_OUT) { transpose_item(p.in[16] + (size_t)l * DM * DM, DM, DM, (bf16*)(p.ws + WS_WTOUT) + (size_t)l * DM * DM, scr, r, 32, lane); continue; } r -= I_OUT;
        if (r < I_UP) { transpose_item(p.in[17] + (size_t)l * DM * DFF, DM, DFF, (bf16*)(p.ws + WS_WTUP) + (size_t)l * DFF * DM, scr, r, 128, lane); continue; } r -= I_UP;
        transpose_item(p.in[18] + (size_t)l * DFF * DM, DFF, DM, (bf16*)(p.ws + WS_WTDN) + (size_t)l * DM * DFF, scr, r, 32, lane);
    }
    __syncthreads();
}

__device__ __forceinline__ void load_xrow(f32x4 (&v)[4], const float* xf, const bf16* x16, int lane) {
    if (xf) {
#pragma unroll
        for (int j = 0; j < 4; ++j) v[j] = *(const f32x4*)(xf + lane * 4 + 256 * j); }
    else {
#pragma unroll
        for (int j = 0; j < 4; ++j) { const uint2 w = *(const uint2*)(x16 + lane * 4 + 256 * j);
            v[j] = (f32x4){__builtin_bit_cast(float, w.x << 16), __builtin_bit_cast(float, w.x & 0xffff0000u), __builtin_bit_cast(float, w.y << 16), __builtin_bit_cast(float, w.y & 0xffff0000u)}; } }
}
__device__ __forceinline__ void phase_norm(const KP& p, const float* xPf, const float* xSf, const float* nw, const float* modl, int sh_off, int sc_off, int gate_off) {
    const int tid = otid(), lane = tid & 63, wv = tid >> 6; const int gw = blockIdx.x * NWAVES + wv, NGW = gridDim.x * NWAVES;
    bf16* H = (bf16*)(p.ws + WS_H); bf16* X16 = (bf16*)(p.ws + WS_X16);
    f32x4 v[4], vn[4];
#define NRM_LOAD(dst, row) load_xrow(dst, (row) < MP ? (xPf ? xPf + (size_t)(row) * DM : nullptr) : (xSf ? xSf + (size_t)((row) - MP) * DM : nullptr), X16 + (size_t)(row) * DM, lane)
    if (gw < MROWS) NRM_LOAD(v, gw);
    for (int row = gw; row < MROWS; row += NGW) {
        if (row + NGW < MROWS) NRM_LOAD(vn, row + NGW);
        const int cond = row < MP ? (row >> 11) : 8 + ((row - MP) >> 3);
        const float* md = modl + (size_t)cond * 6144;
        if (row >= MP && gate_off != -1) {
            const float* P = (const float*)(p.ws + WS_PART) + (size_t)(row - MP) * DM; bf16* xo_ = X16 + (size_t)row * DM;
#pragma unroll
            for (int j = 0; j < 4; ++j) { const int c = lane * 4 + 256 * j; const f32x4 g = *(const f32x4*)(md + gate_off + c);
                const f32x4 sp = (*(const f32x4*)(P + c) + *(const f32x4*)(P + (size_t)1024 * DM + c)) + (*(const f32x4*)(P + (size_t)2048 * DM + c) + *(const f32x4*)(P + (size_t)3072 * DM + c));
                v[j] += g * sp; uint2 o; o.x = pk2(v[j][0], v[j][1]); o.y = pk2(v[j][2], v[j][3]); *(uint2*)(xo_ + c) = o; } }
        float ss = 0.f;
#pragma unroll
        for (int j = 0; j < 4; ++j) ss += v[j][0] * v[j][0] + v[j][1] * v[j][1] + v[j][2] * v[j][2] + v[j][3] * v[j][3];
        const float rs = rsqrtf(wave_sum(ss) * (1.f / DM) + 1e-6f);
#pragma unroll
        for (int j = 0; j < 4; ++j) { const int c = lane * 4 + 256 * j; const f32x4 w = *(const f32x4*)(nw + c), sc = *(const f32x4*)(md + sc_off + c), sh = *(const f32x4*)(md + sh_off + c);
            const f32x4 h = v[j] * rs * w * (sc + 1.f) + sh;
            uint2 o; o.x = pk2(h[0], h[1]); o.y = pk2(h[2], h[3]); *(uint2*)(H + (size_t)row * DM + c) = o; }
#pragma unroll
        for (int j = 0; j < 4; ++j) v[j] = vn[j];
    }
#undef NRM_LOAD
}
__device__ __forceinline__ void phase_final(const KP& p) {
    const int tid = otid(), lane = tid & 63, wv = tid >> 6; const int gw = blockIdx.x * NWAVES + wv, NGW = gridDim.x * NWAVES;
    const float* nw = p.in[43]; const bf16* X16 = (const bf16*)(p.ws + WS_X16);
    f32x4 v[4], vn[4];
    if (gw < MROWS) load_xrow(v, nullptr, X16 + (size_t)gw * DM, lane);
    for (int row = gw; row < MROWS; row += NGW) {
        float* x = p.out + (size_t)row * DM;
        if (row + NGW < MROWS) load_xrow(vn, nullptr, X16 + (size_t)(row + NGW) * DM, lane);
        if (row >= MP) { const float* P = (const float*)(p.ws + WS_PART) + (size_t)(row - MP) * DM; const float* md = (const float*)(p.ws + WS_MOD) + ((size_t)136 + 8 + ((row - MP) >> 3)) * 6144 + 5120;
#pragma unroll
            for (int j = 0; j < 4; ++j) { const int c = lane * 4 + 256 * j; const f32x4 g = *(const f32x4*)(md + c);
                const f32x4 sp = (*(const f32x4*)(P + c) + *(const f32x4*)(P + (size_t)1024 * DM + c)) + (*(const f32x4*)(P + (size_t)2048 * DM + c) + *(const f32x4*)(P + (size_t)3072 * DM + c));
                v[j] += g * sp; } }
        float ss = 0.f;
#pragma unroll
        for (int j = 0; j < 4; ++j) ss += v[j][0] * v[j][0] + v[j][1] * v[j][1] + v[j][2] * v[j][2] + v[j][3] * v[j][3];
        const float rs = rsqrtf(wave_sum(ss) * (1.f / DM) + 1e-6f);
#pragma unroll
        for (int j = 0; j < 4; ++j) { const int c = lane * 4 + 256 * j; *(f32x4*)(x + c) = v[j] * rs * *(const f32x4*)(nw + c); }
#pragma unroll
        for (int j = 0; j < 4; ++j) v[j] = vn[j];
    }
}

typedef float f32x2 __attribute__((ext_vector_type(2)));
constexpr int VST = 320, SL_VEC = 0, SL_VROW = 16 * VST, SL_PART = SL_VROW + 16 * 64, SL_SCAL = SL_PART + 16 * 16, SL_SIZE = SL_SCAL + 16 * 8;
static_assert(4 * SL_SIZE * 4 <= 131072, "scan LDS ring");
struct Item { int tr, b, h, half, T, NB, row0; };
struct V8 { f32x4 a, b; };
__device__ __forceinline__ V8 ld8(const float* q) { V8 v; v.a = *(const f32x4*)q; v.b = *(const f32x4*)(q + 4); return v; }
__device__ __forceinline__ float dot8(const V8& s, const V8& x) { const f32x4 t = s.a * x.a + s.b * x.b; return (t[0] + t[1]) + (t[2] + t[3]); }
__device__ __forceinline__ f32x2 dot8x2(const V8& s, const f32x4& p0, const f32x4& p1, const f32x4& p2, const f32x4& p3) {
    f32x2 a = (f32x2){s.a[0], s.a[0]} * (f32x2){p0[0], p0[1]}; f32x2 b = (f32x2){s.a[1], s.a[1]} * (f32x2){p0[2], p0[3]};
    a += (f32x2){s.a[2], s.a[2]} * (f32x2){p1[0], p1[1]}; b += (f32x2){s.a[3], s.a[3]} * (f32x2){p1[2], p1[3]};
    a += (f32x2){s.b[0], s.b[0]} * (f32x2){p2[0], p2[1]}; b += (f32x2){s.b[1], s.b[1]} * (f32x2){p2[2], p2[3]};
    a += (f32x2){s.b[2], s.b[2]} * (f32x2){p3[0], p3[1]}; b += (f32x2){s.b[3], s.b[3]} * (f32x2){p3[2], p3[3]};
    return a + b; }
__device__ __forceinline__ float red8(float v) { v += dppf<0xB1>(v); v += dppf<0x4E>(v); v += dppf<0x141>(v); return v; }
__device__ __forceinline__ float ldu(const bf16* U, int row, int col, int T) { row = row < T ? row : T - 1; return bf2f(U[(size_t)row * UP + col]); }
__device__ __forceinline__ void unpack8(const uint4 v, float (&o)[8]) {
    o[0] = __builtin_bit_cast(float, v.x << 16); o[1] = __builtin_bit_cast(float, v.x & 0xffff0000u); o[2] = __builtin_bit_cast(float, v.y << 16); o[3] = __builtin_bit_cast(float, v.y & 0xffff0000u);
    o[4] = __builtin_bit_cast(float, v.z << 16); o[5] = __builtin_bit_cast(float, v.z & 0xffff0000u); o[6] = __builtin_bit_cast(float, v.w << 16); o[7] = __builtin_bit_cast(float, v.w & 0xffff0000u); }
#define YKEEP2(tt, ya, yb) do { if ((tt) == sub) { yk0 = (ya); yk1 = (yb); } } while (0)
#define YSTORE2(bb) do { const int g0 = 16 * (bb) + sub; if (g0 < T) { Y[(size_t)g0 * DM + irow] = (bf16)f2bf(yk0); Y[(size_t)g0 * DM + irow + 16] = (bf16)f2bf(yk1); } } while (0)
__device__ __forceinline__ f32x2 dot4x2(const f32x4& s, const f32x4& p0, const f32x4& p1) {
    f32x2 a = (f32x2){s[0], s[0]} * (f32x2){p0[0], p0[1]}; f32x2 b = (f32x2){s[1], s[1]} * (f32x2){p0[2], p0[3]};
    a += (f32x2){s[2], s[2]} * (f32x2){p1[0], p1[1]}; b += (f32x2){s[3], s[3]} * (f32x2){p1[2], p1[3]};
    return a + b; }
__device__ __forceinline__ void red16x4(float x0, float x1, float x2, float x3, bool p0, bool p1, float& r0, float& r1, float& r2, float& r3) {
    float k0 = p0 ? x2 : x0, k1 = p0 ? x3 : x1; const float t0 = p0 ? x0 : x2, t1 = p0 ? x1 : x3;
    k0 += dppf<0xB1>(t0); k1 += dppf<0xB1>(t1);
    float m = p1 ? k1 : k0; const float u = p1 ? k0 : k1;
    m += dppf<0x4E>(u); m += dppf<0x124>(m); m += dppf<0x128>(m);
    r0 = dppf<0x00>(m); r2 = dppf<0x55>(m); r1 = dppf<0xAA>(m); r3 = dppf<0xFF>(m);
}
__device__ __forceinline__ void red16x2(float xa, float xb, bool p0, float& ra, float& rb) {
    float k = p0 ? xb : xa; const float t = p0 ? xa : xb;
    k += dppf<0xB1>(t); k += dppf<0x4E>(k); k += dppf<0x124>(k); k += dppf<0x128>(k);
    ra = dppf<0x00>(k); rb = dppf<0x55>(k);
}
__device__ __forceinline__ float dot4(const f32x4& s, const f32x4& x) { const f32x4 t = s * x; return (t[0] + t[1]) + (t[2] + t[3]); }
#define TICK_BAR() do { asm volatile("s_waitcnt lgkmcnt(0)" ::: "memory"); __builtin_amdgcn_s_barrier(); asm volatile("" ::: "memory"); } while (0)
__device__ __forceinline__ void scan_rwkv(const KP& p, int l, const Item& it, float* sm) {
    const int tid = otid(), lane = tid & 63, wv = tid >> 6, T = it.T, NBAT = (T + 15) >> 4;
    const bool scanner = wv < 4;
    const bf16* U = (const bf16*)(p.ws + WS_U) + (size_t)it.row0 * UP;
    const float* sh0 = it.tr ? p.in[2] + ((size_t)l * BS + it.b) * 896 : nullptr;
    const int rp = (tid & 255) >> 4, sub = tid & 15, nh = it.tr ? 2 : 1; const bool lp0 = (tid & 1) != 0, lp1 = (tid & 2) != 0; int irow = it.half * 32 + rp;
    bf16* Y = (bf16*)(p.ws + WS_H) + (size_t)it.row0 * DM + 0 * 256 + it.h * 64;
    float* sbase_o = p.out + (it.tr ? O_SWKV : O_PWKV) + (((size_t)l * it.NB + it.b) * 4 + it.h) * 4096 + sub * 4;
    const float* sbase_i = p.in[3] + (((size_t)l * BS + it.b) * 4 + it.h) * 4096 + sub * 4;
    f32x4 S0 = {0.f, 0.f, 0.f, 0.f}, S1 = S0, Q0 = S0, Q1 = S0, R0 = S0, R1 = S0;
    if (it.tr) { const float* q = sbase_i + ((wv >> 2) * 32 + rp) * 64; Q0 = *(const f32x4*)q; Q1 = *(const f32x4*)(q + 16 * 64); R0 = *(const f32x4*)(q + 4 * 4096); R1 = *(const f32x4*)(q + 4 * 4096 + 16 * 64); }
    float yk0 = 0.f, yk1 = 0.f;
    const int pj = wv & 3, n = lane & 15, fq = lane >> 4, c = pj * 16 + n, hc = it.h * 64 + c;
    const float* mu = p.in[19] + l * 896;
    bf16x8v Bw, Ba; float muw[8], mua[8];
#pragma unroll
    for (int j = 0; j < 8; ++j) { Bw[j] = (short)f2bf(p.in[21][((size_t)l * 32 + fq * 8 + j) * 256 + hc]); Ba[j] = (short)f2bf(p.in[23][((size_t)l * 32 + fq * 8 + j) * 256 + hc]);
        muw[j] = mu[768 + fq * 8 + j]; mua[j] = mu[800 + fq * 8 + j]; }
    const float w0c = p.in[20][l * 256 + hc], a0c = p.in[22][l * 256 + hc], kkc = p.in[25][l * 256 + hc], kac = p.in[26][l * 256 + hc], rkc = p.in[27][l * 256 + hc];
    const float mur = mu[hc], muk = mu[256 + hc], muv = mu[512 + hc];
    struct RwRaw { uint4 wc, wp, ac, ap; float rr[5], rk[5], rv[5]; } cur;
#define RW_LOAD(R, bb) do { const int ta = 16 * (bb) + n;              \
        { const int tc_ = ta < T ? ta : T - 1; const bf16* q = U + (size_t)tc_ * UP + 768 + fq * 8; R.wc = *(const uint4*)q; R.ac = *(const uint4*)(q + 32); \
          const bool sb_ = it.tr && tc_ == 8; const float* shx_ = sb_ ? sh0 + 896 : sh0;     \
          if (tc_ > 0 && !sb_) { R.wp = *(const uint4*)(q - UP); R.ap = *(const uint4*)(q + 32 - UP); } \
          else if (sh0) { R.wp = pack8f(shx_ + 768 + fq * 8); R.ap = pack8f(shx_ + 800 + fq * 8); } else { R.wp = (uint4){0u, 0u, 0u, 0u}; R.ap = R.wp; } } \
        _Pragma("unroll") for (int i = 0; i < 5; ++i) { const int g = 16 * (bb) + fq * 4 - 1 + i; \
            const bool sb_ = it.tr && fq == 2 && i == 0; const float* shx_ = sb_ ? sh0 + 896 : sh0;     \
            if (g >= 0 && !sb_) { R.rr[i] = ldu(U, g, hc, T); R.rk[i] = ldu(U, g, 256 + hc, T); R.rv[i] = ldu(U, g, 512 + hc, T); } \
            else if (sh0) { R.rr[i] = shx_[hc]; R.rk[i] = shx_[256 + hc]; R.rv[i] = shx_[512 + hc]; } else { R.rr[i] = R.rk[i] = R.rv[i] = 0.f; } } } while (0)
    if (!scanner) RW_LOAD(cur, 0);
    for (int k = 0; k < NBAT + 2; ++k) {
        if (scanner || it.tr) {
            const int b = k - 2;
            if (b >= 0 && b < NBAT) {
                const float* SL = sm + (b & 3) * SL_SIZE; const int ns = (T - 16 * b) < 16 ? (T - 16 * b) : 16;
                { const int hv = wv >> 2;
                if (it.tr) irow = hv * 32 + rp;
                const int nsq = it.tr ? 8 : ns;
                _Pragma("unroll") for (int sq = 0; sq < 2; ++sq) {
                if (it.tr) { S0 = sq ? R0 : Q0; S1 = sq ? R1 : Q1; }
#define RW_STEP(tt, q0, q1, w, bb, kp, va, vb, sc) do { const f32x2 da = dot4x2(S0, q0, q1), db = dot4x2(S1, q0, q1); \
                    float a1, a2, b1, b2; red16x4(da.x, da.y, db.x, db.y, lp0, lp1, a1, a2, b1, b2); \
                    const float ca = sc[0] * a1, cb = sc[0] * b1;                                       \
                    const float ya = a2 - ca * sc[1] + va * sc[2], yb = b2 - cb * sc[1] + vb * sc[2]; \
                    S0 = S0 * w + (kp * va - bb * ca); S1 = S1 * w + (kp * vb - bb * cb); YKEEP2(tt, ya, yb); } while (0)
                _Pragma("unroll 2") for (int j_ = 0; j_ < 4; ++j_) { const int tt = sq * 8 + 2 * j_;
                    const float* V0 = SL + SL_VEC + tt * VST + sub * 4; const float* V1 = V0 + VST; const float* P0 = V0 + sub * 4; const float* P1 = P0 + VST;
                    const f32x4 a0 = *(const f32x4*)P0, a1_ = *(const f32x4*)(P0 + 4), w0 = *(const f32x4*)(V0 + 128), bb0 = *(const f32x4*)(V0 + 192), kp0 = *(const f32x4*)(V0 + 256);
                    const float va0 = SL[SL_VROW + tt * 64 + irow], vb0 = SL[SL_VROW + tt * 64 + irow + 16]; const f32x4 sc0 = *(const f32x4*)(SL + SL_SCAL + tt * 8);
                    const f32x4 e0 = *(const f32x4*)P1, e1 = *(const f32x4*)(P1 + 4), w1 = *(const f32x4*)(V1 + 128), bb1 = *(const f32x4*)(V1 + 192), kp1 = *(const f32x4*)(V1 + 256);
                    const float va1 = SL[SL_VROW + (tt + 1) * 64 + irow], vb1 = SL[SL_VROW + (tt + 1) * 64 + irow + 16]; const f32x4 sc1 = *(const f32x4*)(SL + SL_SCAL + (tt + 1) * 8);
                    RW_STEP(tt, a0, a1_, w0, bb0, kp0, va0, vb0, sc0);
                    RW_STEP(tt + 1, e0, e1, w1, bb1, kp1, va1, vb1, sc1);
                }
                if (it.tr) { float* o_ = sbase_o + sq * (4 * 4096); *(f32x4*)(o_ + irow * 64) = S0; *(f32x4*)(o_ + (irow + 16) * 64) = S1; }
                }
#undef RW_STEP
                YSTORE2(b);
                }
            }
        }
        if (!scanner) {
            if (k >= 1 && k - 1 < NBAT && lane < 4) {
                const int tt = pj * 4 + lane; float* SL = sm + ((k - 1) & 3) * SL_SIZE; const float* P = SL + SL_PART + tt * 16;
                const f32x4 s = *(const f32x4*)P + *(const f32x4*)(P + 4) + *(const f32x4*)(P + 8) + *(const f32x4*)(P + 12);
                const float rn2 = __builtin_amdgcn_rcpf(s[0] + 1e-6f);
                *(f32x4*)(SL + SL_SCAL + tt * 8) = (f32x4){rn2, s[1], s[2], 0.f};
                const int g = 16 * (k - 1) + tt; if (it.half == 0 && g < T) ((float*)(p.ws + WS_AUX))[((size_t)it.row0 + g) * 4 + it.h] = s[3];
            }
            if (k < NBAT) {
                float xw[8], xa[8], cu[8], pr[8];
                unpack8(cur.wc, cu); unpack8(cur.wp, pr);
#pragma unroll
                for (int j = 0; j < 8; ++j) xw[j] = tanhf_(cu[j] + (pr[j] - cu[j]) * muw[j]);
                unpack8(cur.ac, cu); unpack8(cur.ap, pr);
#pragma unroll
                for (int j = 0; j < 8; ++j) xa[j] = cu[j] + (pr[j] - cu[j]) * mua[j];
                const uint4 Awu = pack8f(xw), Aau = pack8f(xa);
                const bf16x8v Aw = __builtin_bit_cast(bf16x8v, Awu), Aa = __builtin_bit_cast(bf16x8v, Aau);
                const f32x4 z = {0.f, 0.f, 0.f, 0.f};
                const f32x4 dw = __builtin_amdgcn_mfma_f32_16x16x32_bf16(Aw, Bw, z, 0, 0, 0), da = __builtin_amdgcn_mfma_f32_16x16x32_bf16(Aa, Ba, z, 0, 0, 0);
                float xr_[4], xk_[4], xv_[4];
#pragma unroll
                for (int i = 0; i < 4; ++i) { xr_[i] = cur.rr[i + 1] + (cur.rr[i] - cur.rr[i + 1]) * mur; xk_[i] = cur.rk[i + 1] + (cur.rk[i] - cur.rk[i + 1]) * muk; xv_[i] = cur.rv[i + 1] + (cur.rv[i] - cur.rv[i + 1]) * muv; }
                if (k + 1 < NBAT) RW_LOAD(cur, k + 1);
                float* SL = sm + (k & 3) * SL_SIZE;
#pragma unroll
                for (int i = 0; i < 4; ++i) { const int tt = fq * 4 + i;
                    const float w = __expf(-0.6065306597f * sigmoidf_(w0c + dw[i])), a = sigmoidf_(a0c + da[i]);
                    const float kkraw = xk_[i] * kkc, braw = kkraw * a, kp = xk_[i] * (1.f + (a - 1.f) * kac);
                    float* V = SL + SL_VEC + tt * VST + c; *(f32x2*)(V + c) = (f32x2){kkraw, w * xr_[i]}; V[128] = w; V[192] = braw; V[256] = kp; SL[SL_VROW + tt * 64 + c] = xv_[i];
                    float p0, p1, p2, p3; red16x4(kkraw * kkraw, braw * xr_[i], kp * xr_[i], xr_[i] * kp * rkc, lp0, lp1, p0, p1, p2, p3);
                    if (n == 0) *(f32x4*)(SL + SL_PART + tt * 16 + pj * 4) = (f32x4){p0, p1, p2, p3}; }
            }
        }
        TICK_BAR();
    }
#undef RW_LOAD
    if (scanner) { if (!it.tr) { *(f32x4*)(sbase_o + irow * 64) = S0; *(f32x4*)(sbase_o + (irow + 16) * 64) = S1; } }
    else if (it.h == 0 && it.half == 0) { float* so = p.out + (it.tr ? O_SSHIFT : O_PSHIFT) + ((size_t)l * it.NB + it.b) * 896;
        for (int cc = tid - 256; cc < 896; cc += 256) { so[cc] = bf2f(U[(size_t)(it.tr ? 7 : T - 1) * UP + cc]); if (it.tr) so[896 + cc] = bf2f(U[(size_t)15 * UP + cc]); } }
}

__device__ __forceinline__ void scan_gla(const KP& p, int l, const Item& it, float* sm) {
    const int tid = otid(), lane = tid & 63, wv = tid >> 6, T = it.T, NBAT = (T + 15) >> 4;
    const bool scanner = wv < 4;
    const bf16* U = (const bf16*)(p.ws + WS_U) + (size_t)it.row0 * UP + CB;
    const int rp = (tid & 255) >> 4, sub = tid & 15, nh = it.tr ? 2 : 1; const bool lp0 = (tid & 1) != 0, lp1 = (tid & 2) != 0; int irow = it.half * 32 + rp;
    bf16* Y = (bf16*)(p.ws + WS_H) + (size_t)it.row0 * DM + 1 * 256 + it.h * 64;
    const size_t sbase = (((size_t)l * it.NB + it.b) * 4 + it.h) * 4096;
    f32x4 S0 = {0.f, 0.f, 0.f, 0.f}, S1 = S0, Q0 = S0, Q1 = S0, R0 = S0, R1 = S0; float* so = p.out + (it.tr ? O_SGLA : O_PGLA) + sbase + (size_t)sub * 4 * 64; const float* si = p.in[4] + sbase + (size_t)sub * 4 * 64;
    if (it.tr) { const int r0 = (wv >> 2) * 32 + rp;
#pragma unroll
        for (int e = 0; e < 4; ++e) { Q0[e] = si[e * 64 + r0]; Q1[e] = si[e * 64 + r0 + 16]; R0[e] = si[4 * 4096 + e * 64 + r0]; R1[e] = si[4 * 4096 + e * 64 + r0 + 16]; } }
    float yk0 = 0.f, yk1 = 0.f;
    const int pj = wv & 3, n = lane & 15, fq = lane >> 4, c = pj * 16 + n, hc = it.h * 64 + c;
    float gkw[16];
#pragma unroll
    for (int j = 0; j < 16; ++j) gkw[j] = p.in[30][((size_t)l * 16 + j) * 256 + hc];
    const float gkb = p.in[31][l * 256 + hc];
    struct GlRaw { float q_[4], k_[4], v_[4]; uint4 g0[4], g1[4]; } cur;
#define GL_LOAD(R, bb) do { _Pragma("unroll") for (int i = 0; i < 4; ++i) { int g = 16 * (bb) + fq * 4 + i; g = g < T ? g : T - 1; const bf16* q = U + (size_t)g * UP; \
        R.q_[i] = bf2f(q[hc]); R.k_[i] = bf2f(q[256 + hc]); R.v_[i] = bf2f(q[512 + hc]); R.g0[i] = *(const uint4*)(q + 1024); R.g1[i] = *(const uint4*)(q + 1032); } } while (0)
    if (!scanner) GL_LOAD(cur, 0);
    for (int k = 0; k < NBAT + 2; ++k) {
        if (scanner || it.tr) {
            const int b = k - 2;
            if (b >= 0 && b < NBAT) {
                const float* SL = sm + (b & 3) * SL_SIZE; const int ns = (T - 16 * b) < 16 ? (T - 16 * b) : 16;
                { const int hv = wv >> 2;
                if (it.tr) irow = hv * 32 + rp;
                const int nsq = it.tr ? 8 : ns;
                _Pragma("unroll") for (int sq = 0; sq < 2; ++sq) {

                if (it.tr) { S0 = sq ? R0 : Q0; S1 = sq ? R1 : Q1; }
#define GL_STEP(tt, dec, kv, qd, va, vb, qk) do { float da, db; red16x2(dot4(S0, qd), dot4(S1, qd), lp0, da, db); const float ya = da + va * qk, yb = db + vb * qk; \
                    S0 = S0 * dec + kv * va; S1 = S1 * dec + kv * vb; YKEEP2(tt, ya, yb); } while (0)
                _Pragma("unroll 2") for (int j_ = 0; j_ < 4; ++j_) { const int tt = sq * 8 + 2 * j_;
                    const float* V0 = SL + SL_VEC + tt * VST + sub * 4; const float* V1 = V0 + VST;
                    const f32x4 qd0 = *(const f32x4*)(V0 + 128), dec0 = *(const f32x4*)V0, kv0 = *(const f32x4*)(V0 + 64); const float va0 = SL[SL_VROW + tt * 64 + irow], vb0 = SL[SL_VROW + tt * 64 + irow + 16], qk0 = SL[SL_SCAL + tt * 8];
                    const f32x4 qd1 = *(const f32x4*)(V1 + 128), dec1 = *(const f32x4*)V1, kv1 = *(const f32x4*)(V1 + 64); const float va1 = SL[SL_VROW + (tt + 1) * 64 + irow], vb1 = SL[SL_VROW + (tt + 1) * 64 + irow + 16], qk1 = SL[SL_SCAL + (tt + 1) * 8];
                    GL_STEP(tt, dec0, kv0, qd0, va0, vb0, qk0);
                    GL_STEP(tt + 1, dec1, kv1, qd1, va1, vb1, qk1);
                }
                if (it.tr) { float* o_ = so + sq * (4 * 4096);
#pragma unroll
                    for (int e = 0; e < 4; ++e) { o_[e * 64 + irow] = S0[e]; o_[e * 64 + irow + 16] = S1[e]; } }
                }
#undef GL_STEP
                YSTORE2(b);
                }
            }
        }
        if (!scanner) {
            if (k >= 1 && k - 1 < NBAT && lane < 4) { const int tt = pj * 4 + lane; float* SL = sm + ((k - 1) & 3) * SL_SIZE; const float* P = SL + SL_PART + tt * 16;
                SL[SL_SCAL + tt * 8] = P[0] + P[4] + P[8] + P[12]; }
            if (k < NBAT) {
                float x[4], qq[4], kk[4], vv[4];
#pragma unroll
                for (int i = 0; i < 4; ++i) { float gl[8]; x[i] = gkb; unpack8(cur.g0[i], gl);
#pragma unroll
                    for (int j = 0; j < 8; ++j) x[i] += gl[j] * gkw[j];
                    unpack8(cur.g1[i], gl);
#pragma unroll
                    for (int j = 0; j < 8; ++j) x[i] += gl[j] * gkw[8 + j];
                    qq[i] = cur.q_[i] * 0.125f; kk[i] = cur.k_[i]; vv[i] = cur.v_[i]; }
                if (k + 1 < NBAT) GL_LOAD(cur, k + 1);
                float* SL = sm + (k & 3) * SL_SIZE;
#pragma unroll
                for (int i = 0; i < 4; ++i) { const int tt = fq * 4 + i;
                    const float dec = __expf(-softplusf_(-x[i]) * (1.f / 16.f));
                    float* V = SL + SL_VEC + tt * VST + c; V[0] = dec; V[64] = kk[i]; V[128] = qq[i] * dec; SL[SL_VROW + tt * 64 + c] = vv[i];
                    const float p0 = red16(qq[i] * kk[i]);
                    if (n == 0) SL[SL_PART + tt * 16 + pj * 4] = p0; }
            }
        }
        TICK_BAR();
    }
#undef GL_LOAD
    if (scanner && !it.tr) {
#pragma unroll
        for (int e = 0; e < 4; ++e) { so[e * 64 + irow] = S0[e]; so[e * 64 + irow + 16] = S1[e]; } }
}

__device__ __forceinline__ void scan_dn(const KP& p, int l, const Item& it, float* sm) {
    const int tid = otid(), lane = tid & 63, wv = tid >> 6, T = it.T, NBAT = (T + 15) >> 4;
    const bool scanner = wv < 4;
    const bf16* U = (const bf16*)(p.ws + WS_U) + (size_t)it.row0 * UP + CC;
    const float* cv0 = it.tr ? p.in[5] + ((size_t)l * BS + it.b) * 3 * 768 : nullptr;
    const int rp = (tid & 255) >> 4, sub = tid & 15, nh = it.tr ? 2 : 1; const bool lp0 = (tid & 1) != 0, lp1 = (tid & 2) != 0; int irow = it.half * 32 + rp;
    bf16* Y = (bf16*)(p.ws + WS_H) + (size_t)it.row0 * DM + 2 * 256 + it.h * 64;
    const size_t sbase = (((size_t)l * it.NB + it.b) * 4 + it.h) * 4096;
    f32x4 S0 = {0.f, 0.f, 0.f, 0.f}, S1 = S0, Q0 = S0, Q1 = S0, R0 = S0, R1 = S0; float* so = p.out + (it.tr ? O_SDN : O_PDN) + sbase + (size_t)sub * 4 * 64; const float* si = p.in[6] + sbase + (size_t)sub * 4 * 64;
    if (it.tr) { const int r0 = (wv >> 2) * 32 + rp;
#pragma unroll
        for (int e = 0; e < 4; ++e) { Q0[e] = si[e * 64 + r0]; Q1[e] = si[e * 64 + r0 + 16]; R0[e] = si[4 * 4096 + e * 64 + r0]; R1[e] = si[4 * 4096 + e * 64 + r0 + 16]; } }
    float yk0 = 0.f, yk1 = 0.f;
    const int pj = wv & 3, n = lane & 15, fq = lane >> 4, c = pj * 16 + n, hc = it.h * 64 + c;
    float cw[3][4];
#pragma unroll
    for (int pt = 0; pt < 3; ++pt)
#pragma unroll
        for (int i = 0; i < 4; ++i) cw[pt][i] = p.in[33][((size_t)l * 4 + i) * 768 + pt * 256 + hc];
    const float nA = -__expf(p.in[34][l * 4 + it.h]), dtb = p.in[35][l * 4 + it.h];
    struct DnRaw { float xin[3][7]; } cur;
#define DN_LOAD(R, bb) do { _Pragma("unroll") for (int pt = 0; pt < 3; ++pt) _Pragma("unroll") for (int i = 0; i < 7; ++i) { const int g = 16 * (bb) + fq * 4 - 3 + i; \
        R.xin[pt][i] = (it.tr && fq == 2 && i < 3) ? cv0[(3 + i) * 768 + pt * 256 + hc] : g >= 0 ? ldu(U, g, pt * 256 + hc, T) : (cv0 ? cv0[(3 + g) * 768 + pt * 256 + hc] : 0.f); } } while (0)
    if (!scanner) DN_LOAD(cur, 0);
    for (int k = 0; k < NBAT + 2; ++k) {
        if (scanner || it.tr) {
            const int b = k - 2;
            if (b >= 0 && b < NBAT) {
                const float* SL = sm + (b & 3) * SL_SIZE; const int ns = (T - 16 * b) < 16 ? (T - 16 * b) : 16;
                { const int hv = wv >> 2;
                if (it.tr) irow = hv * 32 + rp;
                const int nsq = it.tr ? 8 : ns;
                _Pragma("unroll") for (int sq = 0; sq < 2; ++sq) {

                if (it.tr) { S0 = sq ? R0 : Q0; S1 = sq ? R1 : Q1; }
#define DN_STEP(tt, q0, q1, kv, va, vb, sc, sq) do { const f32x2 da = dot4x2(S0, q0, q1), db = dot4x2(S1, q0, q1);        \
                    float a1, a2, b1, b2; red16x4(da.x, da.y, db.x, db.y, lp0, lp1, a1, a2, b1, b2); \
                    const float na = sc[1] * (va - sc[0] * sc[2] * a1), nb = sc[1] * (vb - sc[0] * sc[2] * b1); \
                    const float ya = sc[0] * sc[3] * a2 + na * sq, yb = sc[0] * sc[3] * b2 + nb * sq; \
                    S0 = S0 * sc[0] + kv * (na * sc[2]); S1 = S1 * sc[0] + kv * (nb * sc[2]); YKEEP2(tt, ya, yb); } while (0)
                _Pragma("unroll 2") for (int j_ = 0; j_ < 4; ++j_) { const int tt = sq * 8 + 2 * j_;
                    const float* V0 = SL + SL_VEC + tt * VST + sub * 4; const float* V1 = V0 + VST; const float* P0 = V0 + sub * 4; const float* P1 = P0 + VST;
                    const f32x4 a0 = *(const f32x4*)P0, a1_ = *(const f32x4*)(P0 + 4), kv0 = *(const f32x4*)(V0 + 128);
                    const float va0 = SL[SL_VROW + tt * 64 + irow], vb0 = SL[SL_VROW + tt * 64 + irow + 16]; const f32x4 sc0 = *(const f32x4*)(SL + SL_SCAL + tt * 8); const float sq0 = SL[SL_SCAL + tt * 8 + 4];
                    const f32x4 e0 = *(const f32x4*)P1, e1 = *(const f32x4*)(P1 + 4), kv1 = *(const f32x4*)(V1 + 128);
                    const float va1 = SL[SL_VROW + (tt + 1) * 64 + irow], vb1 = SL[SL_VROW + (tt + 1) * 64 + irow + 16]; const f32x4 sc1 = *(const f32x4*)(SL + SL_SCAL + (tt + 1) * 8); const float sq1 = SL[SL_SCAL + (tt + 1) * 8 + 4];
                    DN_STEP(tt, a0, a1_, kv0, va0, vb0, sc0, sq0);
                    DN_STEP(tt + 1, e0, e1, kv1, va1, vb1, sc1, sq1);
                }
                if (it.tr) { float* o_ = so + sq * (4 * 4096);
#pragma unroll
                    for (int e = 0; e < 4; ++e) { o_[e * 64 + irow] = S0[e]; o_[e * 64 + irow + 16] = S1[e]; } }
                }
#undef DN_STEP
                YSTORE2(b);
                }
            }
        }
        if (!scanner) {
            if (k >= 1 && k - 1 < NBAT && lane < 4) { const int tt = pj * 4 + lane; float* SL = sm + ((k - 1) & 3) * SL_SIZE; const float* P = SL + SL_PART + tt * 16;
                const f32x4 s = *(const f32x4*)P + *(const f32x4*)(P + 4) + *(const f32x4*)(P + 8) + *(const f32x4*)(P + 12);
                const float rq8 = rsqrtf(s[0] + 1e-6f) * 0.125f, rk = rsqrtf(s[1] + 1e-6f);
                int g = 16 * (k - 1) + tt; g = g < T ? g : T - 1;
                const float beta = sigmoidf_(bf2f(U[(size_t)g * UP + 1028 + it.h])), eg = __expf(nA * softplusf_(bf2f(U[(size_t)g * UP + 1024 + it.h]) + dtb));
                *(f32x4*)(SL + SL_SCAL + tt * 8) = (f32x4){eg, beta, rk, rq8}; SL[SL_SCAL + tt * 8 + 4] = s[2] * rq8 * rk; }
            if (k < NBAT) {
                float o[3][4];
#pragma unroll
                for (int pt = 0; pt < 3; ++pt)
#pragma unroll
                    for (int i = 0; i < 4; ++i) o[pt][i] = siluf_(cw[pt][0] * cur.xin[pt][i] + cw[pt][1] * cur.xin[pt][i + 1] + cw[pt][2] * cur.xin[pt][i + 2] + cw[pt][3] * cur.xin[pt][i + 3]);
                if (k + 1 < NBAT) DN_LOAD(cur, k + 1);
                float* SL = sm + (k & 3) * SL_SIZE;
#pragma unroll
                for (int i = 0; i < 4; ++i) { const int tt = fq * 4 + i;
                    float* V = SL + SL_VEC + tt * VST + c; *(f32x2*)(V + c) = (f32x2){o[1][i], o[0][i]}; V[128] = o[1][i]; SL[SL_VROW + tt * 64 + c] = o[2][i];
                    const float p0 = red16(o[0][i] * o[0][i]), p1 = red16(o[1][i] * o[1][i]), p2 = red16(o[0][i] * o[1][i]);
                    if (n == 0) *(f32x4*)(SL + SL_PART + tt * 16 + pj * 4) = (f32x4){p0, p1, p2, 0.f}; }
            }
        }
        TICK_BAR();
    }
#undef DN_LOAD
    if (scanner) { if (!it.tr) {
#pragma unroll
        for (int e = 0; e < 4; ++e) { so[e * 64 + irow] = S0[e]; so[e * 64 + irow + 16] = S1[e]; } } }
    else if (it.h == 0 && it.half == 0) { float* so = p.out + (it.tr ? O_SDNC : O_PDNC) + ((size_t)l * it.NB + it.b) * 3 * 768;
        for (int i = tid - 256; i < 3 * 768; i += 256) { const int rr = i / 768, cc = i % 768; so[i] = bf2f(U[(size_t)((it.tr ? 5 : T - 3) + rr) * UP + cc]); if (it.tr) so[3 * 768 + i] = bf2f(U[(size_t)(13 + rr) * UP + cc]); } }
}

__device__ __forceinline__ void scan_ssd(const KP& p, int l, const Item& it, float* sm) {
    const int tid = otid(), lane = tid & 63, wv = tid >> 6, T = it.T, NBAT = (T + 15) >> 4, grp = it.h >> 1;
    const bool scanner = wv < 4;
    const bf16* U = (const bf16*)(p.ws + WS_U) + (size_t)it.row0 * UP + CD;
    const bf16* UX = U + 256;
    const float* cv0 = it.tr ? p.in[7] + ((size_t)l * BS + it.b) * 3 * 768 : nullptr;
    const int rp = (tid & 255) >> 4, sub = tid & 15, nh = it.tr ? 2 : 1; const bool lp0 = (tid & 1) != 0, lp1 = (tid & 2) != 0; int irow = it.half * 32 + rp;
    bf16* Y = (bf16*)(p.ws + WS_H) + (size_t)it.row0 * DM + 3 * 256 + it.h * 64;
    const size_t sbase = (((size_t)l * it.NB + it.b) * 4 + it.h) * 64 * 128 + sub * 8; float* so = p.out + (it.tr ? O_SSSM : O_PSSM) + sbase; const float* si = p.in[8] + sbase;
    V8 S0, S1; S0.a = (f32x4){0.f, 0.f, 0.f, 0.f}; S0.b = S0.a; S1 = S0;
    V8 Q0 = S0, Q1 = S0, R0 = S0, R1 = S0;
    if (it.tr) { const int r0 = (wv >> 2) * 32 + rp; Q0 = ld8(si + r0 * 128); Q1 = ld8(si + (r0 + 16) * 128); R0 = ld8(si + 4 * 8192 + r0 * 128); R1 = ld8(si + 4 * 8192 + (r0 + 16) * 128); }
    float yk0 = 0.f, yk1 = 0.f;
    const int pj = wv & 3, n = lane & 15, fq = lane >> 4, c = pj * 16 + n;
    int ch[5]; ch[0] = it.h * 64 + c; ch[1] = 256 + grp * 128 + pj * 32 + n; ch[2] = ch[1] + 16; ch[3] = ch[1] + 256; ch[4] = ch[3] + 16;
    float cw[5][4], cb[5];
#pragma unroll
    for (int q = 0; q < 5; ++q) { cb[q] = p.in[38][(size_t)l * 768 + ch[q]];
#pragma unroll
        for (int i = 0; i < 4; ++i) cw[q][i] = p.in[37][((size_t)l * 4 + i) * 768 + ch[q]]; }
    const float nA = -__expf(p.in[40][l * 4 + it.h]), dtb = p.in[39][l * 4 + it.h], Dh = p.in[41][l * 4 + it.h];
    struct SsRaw { float xin[5][7]; } cur;
#define SS_LOAD(R, bb) do { _Pragma("unroll") for (int q = 0; q < 5; ++q) _Pragma("unroll") for (int i = 0; i < 7; ++i) { const int g = 16 * (bb) + fq * 4 - 3 + i; \
        R.xin[q][i] = (it.tr && fq == 2 && i < 3) ? cv0[(3 + i) * 768 + ch[q]] : g >= 0 ? ldu(UX, g, ch[q], T) : (cv0 ? cv0[(3 + g) * 768 + ch[q]] : 0.f); } } while (0)
    if (!scanner) SS_LOAD(cur, 0);
    for (int k = 0; k < NBAT + 2; ++k) {
        if (scanner || it.tr) {
            const int b = k - 2;
            if (b >= 0 && b < NBAT) {
                const float* SL = sm + (b & 3) * SL_SIZE; const int ns = (T - 16 * b) < 16 ? (T - 16 * b) : 16;
                { const int hv = wv >> 2;
                if (it.tr) irow = hv * 32 + rp;
                const int nsq = it.tr ? 8 : ns;
                _Pragma("unroll") for (int sq = 0; sq < 2; ++sq) {

                if (it.tr) { S0 = sq ? R0 : Q0; S1 = sq ? R1 : Q1; }
#define SS_STEP(tt, Bv, Cv, xa, xb, sc) do { float da, db; red16x2(dot8(S0, Cv), dot8(S1, Cv), lp0, da, db); const float ta = xa * sc[1], tb = xb * sc[1];        \
                    const float ya = sc[0] * da + ta * sc[2] + Dh * xa, yb = sc[0] * db + tb * sc[2] + Dh * xb; \
                    S0.a = S0.a * sc[0] + Bv.a * ta; S0.b = S0.b * sc[0] + Bv.b * ta; S1.a = S1.a * sc[0] + Bv.a * tb; S1.b = S1.b * sc[0] + Bv.b * tb; YKEEP2(tt, ya, yb); } while (0)
                _Pragma("unroll 2") for (int j_ = 0; j_ < 4; ++j_) { const int tt = sq * 8 + 2 * j_;
                    const float* V0 = SL + SL_VEC + tt * VST + sub * 8; const float* V1 = V0 + VST;
                    const V8 C0 = ld8(V0 + 128), B0 = ld8(V0); const float xa0 = SL[SL_VROW + tt * 64 + irow], xb0 = SL[SL_VROW + tt * 64 + irow + 16]; const f32x4 sc0 = *(const f32x4*)(SL + SL_SCAL + tt * 8);
                    const V8 C1 = ld8(V1 + 128), B1 = ld8(V1); const float xa1 = SL[SL_VROW + (tt + 1) * 64 + irow], xb1 = SL[SL_VROW + (tt + 1) * 64 + irow + 16]; const f32x4 sc1 = *(const f32x4*)(SL + SL_SCAL + (tt + 1) * 8);
                    SS_STEP(tt, B0, C0, xa0, xb0, sc0);
                    SS_STEP(tt + 1, B1, C1, xa1, xb1, sc1);
                }
                if (it.tr) { float* o0 = so + sq * (4 * 8192) + irow * 128; float* o1 = o0 + 16 * 128; *(f32x4*)o0 = S0.a; *(f32x4*)(o0 + 4) = S0.b; *(f32x4*)o1 = S1.a; *(f32x4*)(o1 + 4) = S1.b; }
                }
#undef SS_STEP
                YSTORE2(b);
                }
            }
        }
        if (!scanner) {
            if (k >= 1 && k - 1 < NBAT && lane < 4) { const int tt = pj * 4 + lane; float* SL = sm + ((k - 1) & 3) * SL_SIZE; const float* P = SL + SL_PART + tt * 16;
                const float bc = P[0] + P[4] + P[8] + P[12];
                int g = 16 * (k - 1) + tt; g = g < T ? g : T - 1;
                const float dt = softplusf_(bf2f(U[(size_t)g * UP + 1024 + it.h]) + dtb);
                *(f32x4*)(SL + SL_SCAL + tt * 8) = (f32x4){__expf(nA * dt), dt, bc, 0.f}; }
            if (k < NBAT) {
                float o[5][4];
#pragma unroll
                for (int q = 0; q < 5; ++q)
#pragma unroll
                    for (int i = 0; i < 4; ++i) o[q][i] = siluf_(cb[q] + cw[q][0] * cur.xin[q][i] + cw[q][1] * cur.xin[q][i + 1] + cw[q][2] * cur.xin[q][i + 2] + cw[q][3] * cur.xin[q][i + 3]);
                if (k + 1 < NBAT) SS_LOAD(cur, k + 1);
                float* SL = sm + (k & 3) * SL_SIZE;
#pragma unroll
                for (int i = 0; i < 4; ++i) { const int tt = fq * 4 + i;
                    float* V = SL + SL_VEC + tt * VST; V[pj * 32 + n] = o[1][i]; V[pj * 32 + 16 + n] = o[2][i]; V[128 + pj * 32 + n] = o[3][i]; V[128 + pj * 32 + 16 + n] = o[4][i]; SL[SL_VROW + tt * 64 + c] = o[0][i];
                    const float p0 = red16(o[1][i] * o[3][i] + o[2][i] * o[4][i]);
                    if (n == 0) SL[SL_PART + tt * 16 + pj * 4] = p0; }
            }
        }
        TICK_BAR();
    }
#undef SS_LOAD
    if (scanner) { if (!it.tr) { float* o0 = so + irow * 128; float* o1 = so + (irow + 16) * 128; *(f32x4*)o0 = S0.a; *(f32x4*)(o0 + 4) = S0.b; *(f32x4*)o1 = S1.a; *(f32x4*)(o1 + 4) = S1.b; } }
    else if (it.h == 0 && it.half == 0) { float* so = p.out + (it.tr ? O_SSSC : O_PSSC) + ((size_t)l * it.NB + it.b) * 3 * 768;
        for (int i = tid - 256; i < 3 * 768; i += 256) { const int rr = i / 768, cc = i % 768; so[i] = bf2f(UX[(size_t)((it.tr ? 5 : T - 3) + rr) * UP + cc]); if (it.tr) so[3 * 768 + i] = bf2f(UX[(size_t)(13 + rr) * UP + cc]); } }
}

__device__ __forceinline__ void run_item(const KP& p, int l, int tr, int idx, float* sm) {
    Item it; it.tr = tr; const int mixer = idx & 3; int r = idx >> 2; if (tr) it.half = 0; else { it.half = r & 1; r >>= 1; } it.h = r & 3; it.b = tr ? 2 * (r >> 2) : (r >> 2);
    it.T = tr ? 2 * TS : TP; it.NB = tr ? BS : BP; it.row0 = tr ? MP + it.b * TS : it.b * TP;
    if (mixer == 0) scan_rwkv(p, l, it, sm); else if (mixer == 1) scan_gla(p, l, it, sm); else if (mixer == 2) scan_dn(p, l, it, sm); else scan_ssd(p, l, it, sm);
    __syncthreads();
}
__device__ __forceinline__ void flag_signal(unsigned* cnt, unsigned n) {
    asm volatile("s_waitcnt vmcnt(0)" ::: "memory"); __syncthreads();
    if (threadIdx.x == 0 && n) { __builtin_amdgcn_fence(__ATOMIC_RELEASE, "agent"); asm volatile("s_waitcnt vmcnt(0)" ::: "memory"); __hip_atomic_fetch_add(cnt, n, __ATOMIC_RELAXED, __HIP_MEMORY_SCOPE_AGENT); }
}
__device__ __forceinline__ void flag_wait(unsigned* cnt, unsigned target) {
    if (threadIdx.x == 0) { unsigned sp = 0; while (__hip_atomic_load(cnt, __ATOMIC_RELAXED, __HIP_MEMORY_SCOPE_AGENT) < target) { __builtin_amdgcn_s_sleep(4); if (++sp > (1u << 22)) break; }
        __builtin_amdgcn_fence(__ATOMIC_ACQUIRE, "agent"); asm volatile("s_waitcnt vmcnt(0)" ::: "memory"); }
    __syncthreads();
}
__device__ __forceinline__ void phase_scan(const KP& p, int l, float* sm) {
    const int G = gridDim.x;
    constexpr int NPI = 4 * BP * 4 * 2, NSI = 4 * (BS / 2) * 4;
    for (int i = blockIdx.x; i < NPI; i += G) run_item(p, l, 0, i, sm);
    unsigned* q = (unsigned*)(p.ws + WS_BAR) + 4096 + 64 * l;
    flag_wait((unsigned*)(p.ws + WS_BAR) + 4224 + 64 * l, 64u);
    volatile int* slot = (volatile int*)(sm + 4 * SL_SIZE);
    for (;;) {
        if (threadIdx.x == 0) *slot = (int)__hip_atomic_fetch_add(q, 1u, __ATOMIC_RELAXED, __HIP_MEMORY_SCOPE_AGENT);
        __syncthreads();
        const int i0 = *slot;
        __syncthreads();
        if (i0 >= NSI) break;
        run_item(p, l, 1, i0, sm);
    }
}

__device__ __forceinline__ void ld4bf(const bf16* p, float (&o)[4]) { const uint2 v = *(const uint2*)p; o[0] = __builtin_bit_cast(float, v.x << 16); o[1] = __builtin_bit_cast(float, v.x & 0xffff0000u); o[2] = __builtin_bit_cast(float, v.y << 16); o[3] = __builtin_bit_cast(float, v.y & 0xffff0000u); }
__device__ __forceinline__ void st4bf(bf16* p, const float (&o)[4]) { uint2 v; v.x = pk2(o[0], o[1]); v.y = pk2(o[2], o[3]); *(uint2*)p = v; }
__device__ __forceinline__ void phase_post(const KP& p, int l, float* sm) {
    const int tid = otid(), lane = tid & 63, wv = tid >> 6; const int gw = blockIdx.x * NWAVES + wv, NGW = gridDim.x * NWAVES;
    const bf16* Ub = (const bf16*)(p.ws + WS_U); bf16* Yb = (bf16*)(p.ws + WS_H); const float* auxb = (const float*)(p.ws + WS_AUX);
    const float* mu = p.in[19] + l * 896;
    { const float* g2g = p.in[24] + (size_t)l * 64 * 256;
      for (int i = tid; i < 64 * 256 / 4; i += NTHR) *(f32x4*)(sm + 4 * i) = *(const f32x4*)(g2g + 4 * i);
      __syncthreads(); }
    const float* g2 = sm;
    const int c = lane * 4, hd = lane >> 4;
    const f32x4 lw = *(const f32x4*)(p.in[28] + l * 256 + c), lb = *(const f32x4*)(p.in[29] + l * 256 + c), muv = *(const f32x4*)(mu + 512 + c);
    const f32x4 wgl = *(const f32x4*)(p.in[32] + l * 256 + c), wdn = *(const f32x4*)(p.in[36] + l * 256 + c), wss = *(const f32x4*)(p.in[42] + l * 256 + c);
    const float mug = mu[832 + lane];
    struct PR { float y[4][4], uv[4], pv[4], gg[4], dz[4], sz[4], ug, pg, rkv; } cur, nxt;
#define POST_LOAD(R, row) do { int tr_, b_, t_; if ((row) < MP) { tr_ = 0; b_ = (row) >> 11; t_ = (row) & 2047; } else { tr_ = 1; b_ = ((row) - MP) >> 3; t_ = ((row) - MP) & 7; } \
        const bf16* u_ = Ub + (size_t)(row) * UP; const bf16* y_ = Yb + (size_t)(row) * DM; \
        _Pragma("unroll") for (int m = 0; m < 4; ++m) ld4bf(y_ + 256 * m + c, R.y[m]); \
        ld4bf(u_ + 512 + c, R.uv); ld4bf(u_ + CB + 768 + c, R.gg); ld4bf(u_ + CC + 768 + c, R.dz); ld4bf(u_ + CD + c, R.sz); R.ug = bf2f(u_[832 + lane]); R.rkv = auxb[(size_t)(row) * 4 + hd]; \
        if (t_ > 0) { ld4bf(u_ - UP + 512 + c, R.pv); R.pg = bf2f(u_[832 + lane - UP]); } \
        else if (tr_) { const float* sh0_ = p.in[2] + ((size_t)l * BS + b_) * 896; const f32x4 s_ = *(const f32x4*)(sh0_ + 512 + c); R.pv[0] = s_[0]; R.pv[1] = s_[1]; R.pv[2] = s_[2]; R.pv[3] = s_[3]; R.pg = sh0_[832 + lane]; } \
        else { R.pv[0] = R.pv[1] = R.pv[2] = R.pv[3] = 0.f; R.pg = 0.f; } } while (0)
    if (gw < MROWS) POST_LOAD(cur, gw);
    for (int row = gw; row < MROWS; row += NGW) {
        if (row + NGW < MROWS) POST_LOAD(nxt, row + NGW);
        bf16* y = Yb + (size_t)row * DM;
        { const float m = red16(cur.y[0][0] + cur.y[0][1] + cur.y[0][2] + cur.y[0][3]) * (1.f / 64.f);
          float d[4], vs = 0.f;
#pragma unroll
          for (int e = 0; e < 4; ++e) { d[e] = cur.y[0][e] - m; vs += d[e] * d[e]; }
          const float rs = rsqrtf(red16(vs) * (1.f / 64.f) + 64e-5f);
          const float sg = sigmoidf_(cur.ug + (cur.pg - cur.ug) * mug);
          f32x4 g = {0.f, 0.f, 0.f, 0.f};
#pragma unroll 8
          for (int j = 0; j < 64; ++j) { const float sj = __shfl(sg, j); g += *(const f32x4*)(g2 + j * 256 + c) * sj; }
          float o[4];
#pragma unroll
          for (int e = 0; e < 4; ++e) { const float v = cur.uv[e] + (cur.pv[e] - cur.uv[e]) * muv[e]; o[e] = (d[e] * rs * lw[e] + lb[e] + cur.rkv * v) * g[e]; }
          st4bf(y + c, o); }
        { const float* yv = cur.y[1];
          const float rs = rsqrtf(red16(yv[0] * yv[0] + yv[1] * yv[1] + yv[2] * yv[2] + yv[3] * yv[3]) * (1.f / 64.f) + 1e-6f); float o[4];
#pragma unroll
          for (int e = 0; e < 4; ++e) o[e] = yv[e] * rs * wgl[e] * siluf_(cur.gg[e]);
          st4bf(y + 256 + c, o); }
        { const float* yv = cur.y[2];
          const float rs = rsqrtf(red16(yv[0] * yv[0] + yv[1] * yv[1] + yv[2] * yv[2] + yv[3] * yv[3]) * (1.f / 64.f) + 1e-6f); float o[4];
#pragma unroll
          for (int e = 0; e < 4; ++e) o[e] = yv[e] * rs * wdn[e] * siluf_(cur.dz[e]);
          st4bf(y + 512 + c, o); }
        { float yv[4]; float ss = 0.f;
#pragma unroll
          for (int e = 0; e < 4; ++e) { yv[e] = cur.y[3][e] * siluf_(cur.sz[e]); ss += yv[e] * yv[e]; }
          ss = red16(ss); ss += __shfl_xor(ss, 16);
          const float rs = rsqrtf(ss * (1.f / 128.f) + 1e-6f); float o[4];
#pragma unroll
          for (int e = 0; e < 4; ++e) o[e] = yv[e] * rs * wss[e];
          st4bf(y + 768 + c, o); }
        cur = nxt;
    }
#undef POST_LOAD
}

#define XB_TMO      128
#define XB_XCNT(j)  (256  + 64 * (j))
#define XB_XSUB(j)  (1280 + 64 * (j))
#define XB_XGEN(j)  (2304 + 64 * (j))
#define XB_TOP      3328
#define XB_TOPGEN   3392
#define XCD_BAR_WORDS 3456
#define XB_SPIN_CAP (1u << 18)

__device__ __forceinline__ unsigned xb_ld(unsigned* p)              { return __hip_atomic_load(p, __ATOMIC_RELAXED, __HIP_MEMORY_SCOPE_AGENT); }
__device__ __forceinline__ unsigned xb_add(unsigned* p, unsigned v) { return __hip_atomic_fetch_add(p, v, __ATOMIC_RELAXED, __HIP_MEMORY_SCOPE_AGENT); }
__device__ __forceinline__ unsigned xb_xcc_id() { return (unsigned)__builtin_amdgcn_s_getreg((3 << 11) | 20) & 0xFu; }
#define XB_SPIN(cond, bar) do { unsigned _sp = 0; while (cond) { __builtin_amdgcn_s_sleep(1); \
    if ((++_sp & 255u) == 0u) { if (xb_ld(&(bar)[XB_TMO])) break; if (_sp > XB_SPIN_CAP) { atomicAdd(&(bar)[XB_TMO], 1u); break; } } } } while (0)

struct XcdBarrier {
    unsigned* bar; unsigned x;
    volatile LAS unsigned* st;
};

__device__ __forceinline__ XcdBarrier xcd_barrier_post(unsigned* bar, volatile LAS unsigned* st) {
    XcdBarrier b; b.bar = bar; b.x = xb_xcc_id(); b.st = st;
    if (threadIdx.x == 0) (void)xb_add(&bar[XB_XCNT(b.x)], 1u);
    return b;
}
__device__ __forceinline__ void xcd_barrier_complete(unsigned* bar, unsigned x, unsigned& nloc, unsigned& nx) {
    const unsigned G = gridDim.x * gridDim.y * gridDim.z;
    unsigned sum, cnt, mine, sp = 0u;
    for (;;) {
        sum = 0u; cnt = 0u; mine = 0u;
#pragma unroll
        for (unsigned j = 0; j < 16; ++j) { const unsigned c = xb_ld(&bar[XB_XCNT(j)]); sum += c; cnt += (c > 0u) ? 1u : 0u; mine = (j == x) ? c : mine; }
        if (sum == G) break;
        __builtin_amdgcn_s_sleep(1);
        if ((++sp & 255u) == 0u) { if (xb_ld(&bar[XB_TMO])) break; if (sp > XB_SPIN_CAP) { atomicAdd(&bar[XB_TMO], 1u); break; } }
    }
    nloc = mine > 0u ? mine : 1u; nx = cnt > 0u ? cnt : 1u;
}

__device__ __forceinline__ void xcd_barrier(const XcdBarrier& b) {
    asm volatile("s_waitcnt vmcnt(0)" ::: "memory");
    __syncthreads();
    if (threadIdx.x == 0) {
        unsigned* bar = b.bar;
        __builtin_amdgcn_s_waitcnt(0);
        unsigned nloc = b.st[0], nx = b.st[1];
        if (nloc == 0u) { xcd_barrier_complete(bar, b.x, nloc, nx); b.st[0] = nloc; b.st[1] = nx; }
        const unsigned old = xb_add(&bar[XB_XSUB(b.x)], 1u);
        const unsigned gen = old / nloc;
        if (old + 1u == (gen + 1u) * nloc) {
            __builtin_amdgcn_fence(__ATOMIC_RELEASE, "agent");
            asm volatile("s_waitcnt vmcnt(0)" ::: "memory");
            const unsigned og = xb_add(&bar[XB_TOP], 1u);
            const unsigned tg = og / nx;
            if (og + 1u == (tg + 1u) * nx) xb_add(&bar[XB_TOPGEN], 1u);
            else XB_SPIN(xb_ld(&bar[XB_TOPGEN]) == tg, bar);
            __builtin_amdgcn_fence(__ATOMIC_ACQUIRE, "agent");
            xb_add(&bar[XB_XGEN(b.x)], 1u);
            asm volatile("s_waitcnt vmcnt(0)" ::: "memory");
        } else {
            XB_SPIN(xb_ld(&bar[XB_XGEN(b.x)]) == gen, bar);
            __builtin_amdgcn_fence(__ATOMIC_ACQUIRE, "agent");
            asm volatile("s_waitcnt vmcnt(0)" ::: "memory");
        }
    }
    __syncthreads();
}

__device__ __forceinline__ const void* uni(const void* q) { const unsigned long long v = (unsigned long long)q; const unsigned lo = __builtin_amdgcn_readfirstlane((unsigned)v), hi = __builtin_amdgcn_readfirstlane((unsigned)(v >> 32)); return (const void*)(const GASP char*)(((unsigned long long)hi << 32) | lo); }
__global__ void __launch_bounds__(NTHR, 2) hybrid_fwd(KP kp) {
    extern __shared__ __attribute__((aligned(16))) unsigned char lds[];
    cg::grid_group grid = cg::this_grid();
    KP* lp = (KP*)(lds + 131072);
    if (threadIdx.x == 0) *lp = kp;
    volatile LAS unsigned* xst = (volatile LAS unsigned*)(lds + 131072 + 512);
    if (threadIdx.x < 2) xst[threadIdx.x] = 0u;
    if (blockIdx.x == 0) for (int i = threadIdx.x; i < 4096 + 512; i += NTHR) ((unsigned*)(kp.ws + WS_BAR))[i] = 0u;
    __syncthreads();
    const KP& p = *lp;
    float* sm = (float*)lds;
#define WSB ((unsigned char*)uni(p.ws))
#define OUTB ((float*)uni(p.out))
#define INP(i) ((const float*)uni(p.in[i]))
    phase_p0(p, sm);
    grid.sync();
    const XcdBarrier xbar = xcd_barrier_post((unsigned*)(WSB + WS_BAR), xst);
    for (int l = 0; l < 2; ++l) {
        { const float* modl = (const float*)(WSB + WS_MOD) + (size_t)l * 136 * 6144;
          const float* xP = l == 0 ? INP(0) : nullptr; const float* xS = l == 0 ? INP(1) : nullptr;
          phase_norm(p, xP, xS, INP(13) + l * DM, modl, 0, 1024, l == 0 ? -1 : 5120 - 136 * 6144); }
        xcd_barrier(xbar);
        { unsigned char* ws = WSB; pg8::Gemm g{(const bf16*)(ws + WS_H), (const bf16*)(ws + WS_WTIN) + (size_t)l * UP * DM, MP, UP, DM, DM}; pg8::StaticOrder S; S.init(MP, UP, 1, (int)gridDim.x, (int)blockIdx.x);
          pg8::EpiBf16<0> E{(bf16*)(ws + WS_U), UP}; pg8::gemm_phase<pg8::EpiBf16<0>, pg8::StaticOrder, true, true>((PG8_LAS unsigned char*)lds, g, S, E); }
        xcd_barrier(xbar);
        { unsigned char* ws = WSB; const int G = (int)gridDim.x, bx = (int)blockIdx.x;
          pg8::Gemm g{(const bf16*)(ws + WS_H), (const bf16*)(ws + WS_WTIN) + (size_t)l * UP * DM, MROWS, UP, DM, DM};
          pg8::SampleTilesOrder S{(G + 2) / 4, (bx & 3) == 1 ? (bx >> 2) : -1, 16}; pg8::EpiBf16<0> E{(bf16*)(ws + WS_U), UP};
          const unsigned nd = (S.cs >= 0 && S.cs < 64) ? (unsigned)((64 - S.cs + S.Gs - 1) / S.Gs) : 0u;
          if (nd) pg8::gemm_phase<pg8::EpiBf16<0>, pg8::SampleTilesOrder, false, true>((PG8_LAS unsigned char*)lds, g, S, E);
          flag_signal((unsigned*)(ws + WS_BAR) + 4224 + 64 * l, nd); }
        phase_scan(p, l, sm);
        xcd_barrier(xbar);
        phase_post(p, l, sm);
        xcd_barrier(xbar);
        { unsigned char* ws = WSB; const float* modl = (const float*)(ws + WS_MOD) + (size_t)l * 136 * 6144;
          pg8::Gemm g{(const bf16*)(ws + WS_H), (const bf16*)(ws + WS_WTOUT) + (size_t)l * DM * DM, MP, DM, DM, DM}; pg8::StaticOrder S; S.init(MP, DM, 1, (int)gridDim.x, (int)blockIdx.x);
          if (l == 0) { pg8::EpiRes<true> E{INP(0), (bf16*)(ws + WS_X16), modl + 2048}; pg8::gemm_phase<pg8::EpiRes<true>, pg8::StaticOrder, true, true>((PG8_LAS unsigned char*)lds, g, S, E); }
          else { pg8::EpiRes<false> E{nullptr, (bf16*)(ws + WS_X16), modl + 2048}; pg8::gemm_phase<pg8::EpiRes<false>, pg8::StaticOrder, true, true>((PG8_LAS unsigned char*)lds, g, S, E); }
          pg8::Gemm g2{(const bf16*)(ws + WS_H), (const bf16*)(ws + WS_WTOUT) + (size_t)l * DM * DM, MROWS, DM, DM / 4, DM}; pg8::SampleSplitOrder S2{(int)gridDim.x, (int)blockIdx.x};
          pg8::EpiPart E2{(float*)(ws + WS_PART)}; pg8::gemm_phase<pg8::EpiPart, pg8::SampleSplitOrder, false, true>((PG8_LAS unsigned char*)lds, g2, S2, E2); }
        xcd_barrier(xbar);
        { const float* modl = (const float*)(WSB + WS_MOD) + (size_t)l * 136 * 6144;
          phase_norm(p, nullptr, l == 0 ? INP(1) : nullptr, INP(14) + l * DM, modl, 3072, 4096, 2048); }
        xcd_barrier(xbar);
        { unsigned char* ws = WSB; pg8::Gemm g{(const bf16*)(ws + WS_H), (const bf16*)(ws + WS_WTUP) + (size_t)l * DFF * DM, MP, DFF, DM, DM}; pg8::StaticOrder S; S.init(MP, DFF, 1, (int)gridDim.x, (int)blockIdx.x);
          pg8::EpiBf16<2> E{(bf16*)(ws + WS_U), DFF}; pg8::gemm_phase<pg8::EpiBf16<2>, pg8::StaticOrder, true, true>((PG8_LAS unsigned char*)lds, g, S, E); }
        xcd_barrier(xbar);
        { unsigned char* ws = WSB; const int G = (int)gridDim.x, bx = (int)blockIdx.x;
          pg8::Gemm g{(const bf16*)(ws + WS_H), (const bf16*)(ws + WS_WTUP) + (size_t)l * DFF * DM, MROWS, DFF, DM, DM};
          const int Gs = G < 64 ? G : 64; pg8::SampleTilesOrder S{Gs, bx >= G - Gs ? bx - (G - Gs) : -1, 16}; pg8::EpiBf16<2> E{(bf16*)(ws + WS_U), DFF};
          const unsigned nd = (S.cs >= 0 && S.cs < 64) ? (unsigned)((64 - S.cs + S.Gs - 1) / S.Gs) : 0u;
          if (nd) pg8::gemm_phase<pg8::EpiBf16<2>, pg8::SampleTilesOrder, false, true>((PG8_LAS unsigned char*)lds, g, S, E);
          flag_signal((unsigned*)(ws + WS_BAR) + 4352 + 64 * l, nd); }
        { unsigned char* ws = WSB; const float* modl = (const float*)(ws + WS_MOD) + (size_t)l * 136 * 6144;
          pg8::Gemm g{(const bf16*)(ws + WS_U), (const bf16*)(ws + WS_WTDN) + (size_t)l * DM * DFF, MP, DM, DFF, DFF}; pg8::StaticOrder S; S.init(MP, DM, 1, (int)gridDim.x, (int)blockIdx.x);
          pg8::EpiRes<false> E{nullptr, (bf16*)(ws + WS_X16), modl + 5120}; pg8::gemm_phase<pg8::EpiRes<false>, pg8::StaticOrder, true, true>((PG8_LAS unsigned char*)lds, g, S, E);
          if ((int)blockIdx.x < 64) flag_wait((unsigned*)(ws + WS_BAR) + 4352 + 64 * l, 64u);
          pg8::Gemm g2{(const bf16*)(ws + WS_U), (const bf16*)(ws + WS_WTDN) + (size_t)l * DM * DFF, MROWS, DM, DFF / 4, DFF}; pg8::SampleSplitOrder S2{(int)gridDim.x, (int)blockIdx.x};
          pg8::EpiPart E2{(float*)(ws + WS_PART)}; pg8::gemm_phase<pg8::EpiPart, pg8::SampleSplitOrder, false, true>((PG8_LAS unsigned char*)lds, g2, S2, E2); }
        xcd_barrier(xbar);
    }
    phase_final(p);
}

extern "C" void kernel_launch(void* const* d_in, const int* in_sizes, int n_in, void* d_out, int out_size, void* d_ws, size_t ws_size, hipStream_t stream) {
    static int grid = 0;
    if (grid == 0) {
        if (n_in != 44 || (size_t)out_size != O_TOTAL || ws_size < WS_END) { fprintf(stderr, "kernel_launch: unexpected shapes: n_in %d out %d ws %zu\n", n_in, out_size, ws_size); grid = -1; return; }
        int dev = 0, cus = 0, per_cu = 0;
        hipGetDevice(&dev); hipDeviceGetAttribute(&cus, hipDeviceAttributeMultiprocessorCount, dev);
        if (hipFuncSetAttribute((const void*)hybrid_fwd, hipFuncAttributeMaxDynamicSharedMemorySize, LDS_BYTES) != hipSuccess) { fprintf(stderr, "kernel_launch: hipFuncSetAttribute failed\n"); grid = -1; return; }
        if (hipOccupancyMaxActiveBlocksPerMultiprocessor(&per_cu, (const void*)hybrid_fwd, NTHR, LDS_BYTES) != hipSuccess || per_cu < 1) { fprintf(stderr, "kernel_launch: occupancy query failed (%d)\n", per_cu); grid = -1; return; }
        grid = cus * per_cu;
    }
    if (grid < 0) return;
    KP p{};
    for (int i = 0; i < 44; ++i) p.in.v[i] = (const float*)d_in[i];
    p.out.v = (float*)d_out; p.ws.v = (unsigned char*)d_ws;
    void* args[] = {&p};
    hipError_t e = hipLaunchCooperativeKernel((const void*)hybrid_fwd, dim3(grid), dim3(NTHR), args, LDS_BYTES, stream);
    if (e != hipSuccess) fprintf(stderr, "kernel_launch: cooperative launch failed: %s (grid %d)\n", hipGetErrorString(e), grid);
}
```

```cpp
#include <hip/hip_runtime.h>
#include <hip/hip_cooperative_groups.h>
#include <cstdio>
#include <cstdint>
namespace cg = cooperative_groups;

namespace pg8 {
#define PG8_LAS __attribute__((address_space(3)))
typedef unsigned short bf16_t;
typedef short bf16x8 __attribute__((ext_vector_type(8)));
typedef float f32x4 __attribute__((ext_vector_type(4)));
typedef unsigned u32x4 __attribute__((ext_vector_type(4)));
constexpr int BM = 256, BK = 64, HALF = 128, HTB = HALF * BK * 2, STAGE_BYTES = 8 * HTB, NXCD = 8, WGM = 8;

__host__ __device__ __forceinline__ int lds_byte(int r, int c) { const int st = (r >> 4) * 2 + (c >> 5), rr = r & 15, cc = c & 31, ob = rr * 64 + cc * 2; return st * 1024 + (ob ^ (((ob >> 9) & 1) << 5)); }
__host__ __device__ __forceinline__ void stage_rc(int b, int& R, int& C) { const int st = b / 1024, sb = b % 1024, swz = sb ^ (((sb >> 9) & 1) << 5); R = (st >> 1) * 16 + swz / 64; C = (st & 1) * 32 + (swz % 64) / 2; }
__host__ __device__ __forceinline__ int perm32(int rho) { const int n = rho >> 4, i = rho & 15; return 8 * (i >> 2) + 4 * n + (i & 3); }

struct Unit { int pm, pn, pk; };
struct Gemm { const bf16_t* A; const bf16_t* Bt; int M, N, K, ld; };

struct StaticOrder {
    int nM, nN, nK, ntile, nwg, G, c;
    __host__ __device__ void init(int M, int N, int nK_, int G_, int c_) { nM = M / BM; nN = N / BM; nK = nK_; ntile = nM * nN; nwg = ntile * nK; G = G_; c = c_; }
    __host__ __device__ bool next(int i, Unit& u) const {
        const long L = (long)i * G + c; if (L >= nwg) return false;
        int wgid = (int)L; { const int q = nwg / NXCD, r = nwg % NXCD, xcd = wgid % NXCD, off = wgid / NXCD; wgid = (xcd < r ? xcd * (q + 1) : r * (q + 1) + (xcd - r) * q) + off; }
        u.pk = wgid / ntile; wgid -= u.pk * ntile;
        const int nig = WGM * nN, gid = wgid / nig, fm = gid * WGM, gsz = (nM - fm) < WGM ? (nM - fm) : WGM;
        u.pm = fm + ((wgid % nig) % gsz); u.pn = (wgid % nig) / gsz; return true;
    }
    __device__ __forceinline__ void a_ready(const Unit&) const {}
    __device__ __forceinline__ void done(const Unit&) const {}
};
__device__ __forceinline__ unsigned cvt_pk_bf16(float lo, float hi) { unsigned r; asm volatile("v_cvt_pk_bf16_f32 %0, %1, %2" : "=v"(r) : "v"(lo), "v"(hi)); return r; }

template <int ACT  > struct EpiBf16 {
    static constexpr bool PERM = true, AFTER_DRAIN = false;
    bf16_t* O; int ldc;
    __device__ __forceinline__ void operator()(const f32x4 (&acc)[2][2][4][2], const Unit& u, int wr, int wc, int fr, int fq) const {
        const int row0 = u.pm * BM + wr * 64 + fr, col0 = u.pn * BM + wc * 32 + 8 * fq;
#pragma unroll
        for (int ai = 0; ai < 2; ++ai)
#pragma unroll
            for (int m = 0; m < 4; ++m) { bf16_t* rowp = O + (size_t)(row0 + ai * HALF + m * 16) * ldc + col0;
#pragma unroll
                for (int bj = 0; bj < 2; ++bj) { f32x4 v0 = acc[ai][bj][m][0], v1 = acc[ai][bj][m][1];
                    if (ACT == 2) {
#pragma unroll
                        for (int j = 0; j < 4; ++j) { float a = fmaxf(v0[j], 0.f), b = fmaxf(v1[j], 0.f); v0[j] = a * a; v1[j] = b * b; } }
                    u32x4 w; w.x = cvt_pk_bf16(v0[0], v0[1]); w.y = cvt_pk_bf16(v0[2], v0[3]); w.z = cvt_pk_bf16(v1[0], v1[1]); w.w = cvt_pk_bf16(v1[2], v1[3]);
                    *(u32x4*)(rowp + bj * HALF) = w; } }
    }
};
template <bool SRCF32> struct EpiRes {
    static constexpr bool PERM = true, AFTER_DRAIN = false;
    const float* srcF; bf16_t* X; const float* gate;
    __device__ __forceinline__ void operator()(const f32x4 (&acc)[2][2][4][2], const Unit& u, int wr, int wc, int fr, int fq) const {
        const int row0 = u.pm * BM + wr * 64 + fr, col0 = u.pn * BM + wc * 32 + 8 * fq;
#pragma unroll
        for (int ai = 0; ai < 2; ++ai)
#pragma unroll
            for (int m = 0; m < 4; ++m) { const int row = row0 + ai * HALF + m * 16;
                const int cond = row < 16384 ? (row >> 11) : 8 + ((row - 16384) >> 3);
                const float* g = gate + (size_t)cond * 6144; bf16_t* d = X + (size_t)row * 1024;
#pragma unroll
                for (int bj = 0; bj < 2; ++bj) { const int c = col0 + bj * HALF; const f32x4 g0 = *(const f32x4*)(g + c), g1 = *(const f32x4*)(g + c + 4);
                    f32x4 x0, x1;
                    if (SRCF32) { const float* s = srcF + (size_t)row * 1024 + c; x0 = *(const f32x4*)s; x1 = *(const f32x4*)(s + 4); }
                    else { const u32x4 w = *(const u32x4*)(d + c);
                        x0 = (f32x4){__builtin_bit_cast(float, w.x << 16), __builtin_bit_cast(float, w.x & 0xffff0000u), __builtin_bit_cast(float, w.y << 16), __builtin_bit_cast(float, w.y & 0xffff0000u)};
                        x1 = (f32x4){__builtin_bit_cast(float, w.z << 16), __builtin_bit_cast(float, w.z & 0xffff0000u), __builtin_bit_cast(float, w.w << 16), __builtin_bit_cast(float, w.w & 0xffff0000u)}; }
                    x0 += g0 * acc[ai][bj][m][0]; x1 += g1 * acc[ai][bj][m][1];
                    u32x4 o; o.x = cvt_pk_bf16(x0[0], x0[1]); o.y = cvt_pk_bf16(x0[2], x0[3]); o.z = cvt_pk_bf16(x1[0], x1[1]); o.w = cvt_pk_bf16(x1[2], x1[3]);
                    *(u32x4*)(d + c) = o; } }
    }
};

struct SampleSplitOrder {
    int G, c;
    __device__ bool next(int i, Unit& u) const { const int L = i * G + c; if (L >= 64) return false; u.pk = L & 3; const int t = L >> 2; u.pm = 64 + (t >> 2); u.pn = t & 3; return true; }
    __device__ __forceinline__ void a_ready(const Unit&) const {}
    __device__ __forceinline__ void done(const Unit&) const {}
};
struct EpiPart {
    static constexpr bool PERM = true, AFTER_DRAIN = false;
    float* P;
    __device__ __forceinline__ void operator()(const f32x4 (&acc)[2][2][4][2], const Unit& u, int wr, int wc, int fr, int fq) const {
        const int row0 = (u.pm - 64) * BM + wr * 64 + fr, col0 = u.pn * BM + wc * 32 + 8 * fq;
#pragma unroll
        for (int ai = 0; ai < 2; ++ai)
#pragma unroll
            for (int m = 0; m < 4; ++m) { float* d = P + ((size_t)u.pk * 1024 + row0 + ai * HALF + m * 16) * 1024 + col0;
#pragma unroll
                for (int bj = 0; bj < 2; ++bj) { *(f32x4*)(d + bj * HALF) = acc[ai][bj][m][0]; *(f32x4*)(d + bj * HALF + 4) = acc[ai][bj][m][1]; } }
    }
};

struct SampleTilesOrder {
    int Gs, cs, nN;
    __device__ bool next(int i, Unit& u) const { if (cs < 0) return false; const int L = i * Gs + cs; if (L >= 4 * nN) return false; u.pk = 0; u.pm = 64 + L / nN; u.pn = L % nN; return true; }
    __device__ __forceinline__ void a_ready(const Unit&) const {}
    __device__ __forceinline__ void done(const Unit&) const {}
};

template <class Epi, class Sched, bool ALIGN_EPI = false, bool SP2 = false>
__device__ __forceinline__ void gemm_phase(PG8_LAS unsigned char* lds, const Gemm g, const Sched& S, const Epi& E) {
    int tid_ = threadIdx.x; asm volatile("" : "+v"(tid_));
    const int tid = tid_, wid = __builtin_amdgcn_readfirstlane(tid >> 6), lane = tid & 63, wr = wid >> 2, wc = wid & 3, fr = lane & 15, fq = lane >> 4;
    const int K = g.ld, nt = g.K / BK; const size_t kspl = (size_t)g.K * 2;
    unsigned voffA[2], voffB[2];
#pragma unroll
    for (int i = 0; i < 2; ++i) { int R, C; stage_rc(tid * 16 + i * 8192, R, C); const int Rb = Epi::PERM ? ((R & ~31) + perm32(R & 31)) : R;
        voffA[i] = (unsigned)(R * K + C) * 2u; voffB[i] = (unsigned)(Rb * K + C) * 2u; }
    const size_t kstep = (size_t)(BK * 2);
    const size_t hstep = (size_t)HALF * K * 2;
    const size_t tstep = 2 * hstep;
    const unsigned ldsw = (unsigned)wid * 1024u;
    const int aoff = lds_byte(wr * 64 + fr, fq * 8), boff = lds_byte(wc * 32 + fr, fq * 8);
#define PG8_SA(b, h) (((b) * 2 + (h)) * HTB)
#define PG8_SB(b, h) ((4 + (b) * 2 + (h)) * HTB)
#define PG8_STAGE(bufoff, gbase, voff) do { _Pragma("unroll") for (int _i = 0; _i < 2; ++_i) \
        __builtin_amdgcn_global_load_lds((const unsigned*)((const char*)(gbase) + (voff)[_i]), (PG8_LAS unsigned*)(lds + (bufoff) + ldsw + _i * 8192), 16, 0, 0); } while (0)
#define PG8_LDA(dst, b, h) do { _Pragma("unroll") for (int m = 0; m < 4; ++m) _Pragma("unroll") for (int k = 0; k < 2; ++k) dst[m][k] = *(const PG8_LAS bf16x8*)(lds + PG8_SA(b, h) + aoff + m * 2048 + k * 1024); } while (0)
#define PG8_LDB(dst, b, h) do { _Pragma("unroll") for (int n = 0; n < 2; ++n) _Pragma("unroll") for (int k = 0; k < 2; ++k) dst[n][k] = *(const PG8_LAS bf16x8*)(lds + PG8_SB(b, h) + boff + n * 2048 + k * 1024); } while (0)
#define PG8_MMA(ai, bj, At, Bt) do { __builtin_amdgcn_s_setprio(1); _Pragma("unroll") for (int m = 0; m < 4; ++m) _Pragma("unroll") for (int n = 0; n < 2; ++n) _Pragma("unroll") for (int k = 0; k < 2; ++k) \
        acc[ai][bj][m][n] = __builtin_amdgcn_mfma_f32_16x16x32_bf16(Bt[n][k], At[m][k], acc[ai][bj][m][n], 0, 0, 0); __builtin_amdgcn_s_setprio(0); } while (0)
#define PG8_WAIT_V(n) asm volatile("s_waitcnt vmcnt(" #n ")" ::: "memory")
#define PG8_WAIT_L(n) asm volatile("s_waitcnt lgkmcnt(" #n ")" ::: "memory")
#define PG8_BAR __builtin_amdgcn_s_barrier()
#define PG8_SCHED __builtin_amdgcn_sched_barrier(0)
    Unit cur, nxt; int ui = 0;
    if (!S.next(0, cur)) return;
    f32x4 acc[2][2][4][2];
#pragma unroll
    for (int a = 0; a < 2; ++a)
#pragma unroll
        for (int b = 0; b < 2; ++b)
#pragma unroll
            for (int m = 0; m < 4; ++m)
#pragma unroll
                for (int n = 0; n < 2; ++n) acc[a][b][m][n] = (f32x4){0.f, 0.f, 0.f, 0.f};
    bf16x8 At[4][2], B0[2][2], B1[2][2];
    const char* cA = (const char*)g.A + (size_t)cur.pm * tstep + (size_t)cur.pk * kspl; const char* cB = (const char*)g.Bt + (size_t)cur.pn * tstep + (size_t)cur.pk * kspl;
    S.a_ready(cur);
    if constexpr (SP2) {
        PG8_STAGE(PG8_SB(0, 0), cB, voffB); PG8_STAGE(PG8_SB(0, 1), cB + hstep, voffB); PG8_STAGE(PG8_SA(0, 0), cA, voffA); PG8_STAGE(PG8_SA(0, 1), cA + hstep, voffA);
        if (wr == 1) PG8_BAR;
        PG8_WAIT_V(2); PG8_BAR;
        PG8_STAGE(PG8_SB(1, 0), cB + kstep, voffB); PG8_STAGE(PG8_SA(1, 0), cA + kstep, voffA); PG8_STAGE(PG8_SB(1, 1), cB + hstep + kstep, voffB);
        PG8_WAIT_V(6); PG8_BAR;
    } else {
        PG8_STAGE(PG8_SB(0, 0), cB, voffB); PG8_STAGE(PG8_SA(0, 0), cA, voffA); PG8_STAGE(PG8_SB(0, 1), cB + hstep, voffB); PG8_STAGE(PG8_SA(0, 1), cA + hstep, voffA);
        if (wr == 1) PG8_BAR;
        PG8_WAIT_V(4); PG8_BAR;
        PG8_STAGE(PG8_SB(1, 0), cB + kstep, voffB); PG8_STAGE(PG8_SA(1, 0), cA + kstep, voffA); PG8_STAGE(PG8_SB(1, 1), cB + hstep + kstep, voffB);
        PG8_WAIT_V(6); PG8_BAR;
    }
    for (;;) {
        const bool has_next = S.next(ui + 1, nxt);
        const char* nA = has_next ? (const char*)g.A + (size_t)nxt.pm * tstep + (size_t)nxt.pk * kspl : cA; const char* nB = has_next ? (const char*)g.Bt + (size_t)nxt.pn * tstep + (size_t)nxt.pk * kspl : cB;
        for (int t = 0; t < nt; t += 2) {
            const bool last = (t == nt - 2);
            const char* a1 = cA + (size_t)(t + 1) * kstep;
            const char* a2 = last ? nA : cA + (size_t)(t + 2) * kstep; const char* b2 = last ? nB : cB + (size_t)(t + 2) * kstep;
            const char* a3 = a2 + kstep; const char* b3 = b2 + kstep;
            if (last && has_next) S.a_ready(nxt);
            if constexpr (SP2) {
            PG8_LDB(B0, 0, 0); PG8_LDB(B1, 0, 1); PG8_SCHED; PG8_LDA(At, 0, 0); PG8_STAGE(PG8_SA(1, 1), a1 + hstep, voffA);
            PG8_WAIT_V(8); PG8_WAIT_L(0); PG8_BAR; PG8_MMA(0, 0, At, B0); PG8_MMA(0, 1, At, B1); PG8_BAR; PG8_SCHED;
            PG8_LDA(At, 0, 1); PG8_STAGE(PG8_SB(0, 0), b2, voffB); PG8_STAGE(PG8_SB(0, 1), b2 + hstep, voffB); PG8_STAGE(PG8_SA(0, 0), a2, voffA);
            PG8_WAIT_V(8); PG8_WAIT_L(0); PG8_BAR; PG8_MMA(1, 0, At, B0); PG8_MMA(1, 1, At, B1); PG8_BAR; PG8_SCHED;
            PG8_LDB(B0, 1, 0); PG8_LDB(B1, 1, 1); PG8_SCHED; PG8_LDA(At, 1, 0); PG8_STAGE(PG8_SA(0, 1), a2 + hstep, voffA);
            PG8_WAIT_V(8); PG8_WAIT_L(0); PG8_BAR; PG8_MMA(0, 0, At, B0); PG8_MMA(0, 1, At, B1); PG8_BAR; PG8_SCHED;
            PG8_LDA(At, 1, 1); PG8_STAGE(PG8_SB(1, 0), b3, voffB); PG8_STAGE(PG8_SB(1, 1), b3 + hstep, voffB); PG8_STAGE(PG8_SA(1, 0), a3, voffA);
            PG8_WAIT_V(8); PG8_WAIT_L(0); PG8_BAR; PG8_MMA(1, 0, At, B0); PG8_MMA(1, 1, At, B1); PG8_BAR; PG8_SCHED;
            } else {
            PG8_LDB(B0, 0, 0); PG8_SCHED; PG8_LDA(At, 0, 0); PG8_STAGE(PG8_SA(1, 1), a1 + hstep, voffA);
            PG8_WAIT_L(8); PG8_BAR; PG8_WAIT_L(0); PG8_MMA(0, 0, At, B0); PG8_BAR; PG8_SCHED;
            PG8_LDB(B1, 0, 1); PG8_STAGE(PG8_SB(0, 0), b2, voffB);
            PG8_BAR; PG8_WAIT_L(0); PG8_MMA(0, 1, At, B1); PG8_BAR;
            PG8_LDA(At, 0, 1); PG8_STAGE(PG8_SA(0, 0), a2, voffA);
            PG8_BAR; PG8_WAIT_L(0); PG8_MMA(1, 0, At, B0); PG8_BAR; PG8_SCHED;
            PG8_STAGE(PG8_SB(0, 1), b2 + hstep, voffB);
            PG8_WAIT_V(6); PG8_BAR; PG8_MMA(1, 1, At, B1); PG8_BAR;
            PG8_LDB(B0, 1, 0); PG8_SCHED; PG8_LDA(At, 1, 0); PG8_STAGE(PG8_SA(0, 1), a2 + hstep, voffA);
            PG8_WAIT_L(8); PG8_BAR; PG8_WAIT_L(0); PG8_MMA(0, 0, At, B0); PG8_BAR; PG8_SCHED;
            PG8_LDB(B1, 1, 1); PG8_STAGE(PG8_SB(1, 0), b3, voffB);
            PG8_BAR; PG8_WAIT_L(0); PG8_MMA(0, 1, At, B1); PG8_BAR;
            PG8_LDA(At, 1, 1); PG8_STAGE(PG8_SA(1, 0), a3, voffA);
            PG8_BAR; PG8_WAIT_L(0); PG8_MMA(1, 0, At, B0); PG8_BAR; PG8_SCHED;
            PG8_STAGE(PG8_SB(1, 1), b3 + hstep, voffB);
            PG8_WAIT_V(6); PG8_BAR; PG8_MMA(1, 1, At, B1); PG8_BAR;
            }
        }
        if constexpr (ALIGN_EPI) { if (wr == 0) PG8_BAR; }
        if constexpr (!Epi::AFTER_DRAIN) { E(acc, cur, wr, wc, fr, fq); S.done(cur); }
        if (!has_next) break;
#pragma unroll
        for (int a = 0; a < 2; ++a)
#pragma unroll
            for (int b = 0; b < 2; ++b)
#pragma unroll
                for (int m = 0; m < 4; ++m)
#pragma unroll
                    for (int n = 0; n < 2; ++n) acc[a][b][m][n] = (f32x4){0.f, 0.f, 0.f, 0.f};
        cur = nxt; cA = nA; cB = nB; ++ui;
        if constexpr (ALIGN_EPI) { if (wr == 1) PG8_BAR; }
    }
    PG8_WAIT_V(0);
    if constexpr (!ALIGN_EPI) { if (wr == 0) PG8_BAR; }
    PG8_BAR;
    if constexpr (Epi::AFTER_DRAIN) { E.fused(acc, cur, wr, wc, fr, fq, lds, wid, lane); S.done(cur); }
#undef PG8_SA
#undef PG8_SB
#undef PG8_STAGE
#undef PG8_LDA
#undef PG8_LDB
#undef PG8_MMA
#undef PG8_WAIT_V
#undef PG8_WAIT_L
#undef PG8_BAR
#undef PG8_SCHED
}
}

typedef unsigned short bf16;
#define LAS __attribute__((address_space(3)))
typedef float f32x4 __attribute__((ext_vector_type(4)));
constexpr int DM = 1024, TP = 2048, BP = 8, BS = 128, TS = 8, MP = BP * TP, MS = BS * TS, MROWS = MP + MS, UP = 4096, PT = 3996, DFF = 4096;
constexpr int CA = 0, CB = 896, CC = 1936, CD = 2968;
constexpr int NTHR = 512, NWAVES = 8;
constexpr int LDS_BYTES = 135168;
constexpr size_t MiB = 1u << 20;
constexpr size_t WS_BAR = 59 * MiB + 512 * 1024;
constexpr size_t WS_WTIN = 0, WS_WTOUT = 16 * MiB, WS_WTUP = 20 * MiB, WS_WTDN = 36 * MiB, WS_MOD = 52 * MiB, WS_AUX = 59 * MiB, WS_H = 60 * MiB, WS_U = 94 * MiB, WS_PART = 230 * MiB, WS_X16 = 246 * MiB, WS_END = 280 * MiB;
static_assert(WS_MOD + (size_t)2 * 136 * 6144 * 4 <= WS_AUX && WS_AUX + (size_t)MROWS * 4 * 4 <= WS_H && WS_H + (size_t)MROWS * DM * 2 <= WS_U && WS_U + (size_t)MROWS * UP * 2 <= WS_PART, "ws map");
constexpr size_t O_PSHIFT = (size_t)MROWS * DM, O_PWKV = O_PSHIFT + 2 * 8 * 896, O_PGLA = O_PWKV + 2 * 8 * 4 * 4096, O_PDNC = O_PGLA + 2 * 8 * 4 * 4096, O_PDN = O_PDNC + 2 * 8 * 3 * 768,
                 O_PSSC = O_PDN + 2 * 8 * 4 * 4096, O_PSSM = O_PSSC + 2 * 8 * 3 * 768, O_SSHIFT = O_PSSM + 2 * 8 * 4 * 8192, O_SWKV = O_SSHIFT + 2 * 128 * 896, O_SGLA = O_SWKV + (size_t)2 * 128 * 4 * 4096,
                 O_SDNC = O_SGLA + (size_t)2 * 128 * 4 * 4096, O_SDN = O_SDNC + 2 * 128 * 3 * 768, O_SSSC = O_SDN + (size_t)2 * 128 * 4 * 4096, O_SSSM = O_SSSC + 2 * 128 * 3 * 768, O_TOTAL = O_SSSM + (size_t)2 * 128 * 4 * 8192;

#define GASP __attribute__((address_space(1)))
template <class T> __device__ __forceinline__ T* as_global(T* q) { return (T*)(GASP T*)(unsigned long long)q; }
struct KP {
    struct In { const float* v[44]; __device__ __forceinline__ const float* operator[](int i) const { return as_global(v[i]); } } in;
    struct Out { float* v; __device__ __forceinline__ operator float*() const { return as_global(v); } } out;
    struct Ws { unsigned char* v; __device__ __forceinline__ operator unsigned char*() const { return as_global(v); } } ws;
};

__device__ __forceinline__ int otid() { int t = threadIdx.x; asm volatile("" : "+v"(t)); return t; }
__device__ __forceinline__ float bf2f(bf16 h) { return __builtin_bit_cast(float, (unsigned)h << 16); }
__device__ __forceinline__ unsigned f2bf(float f) { unsigned u = __builtin_bit_cast(unsigned, f); return (u + 0x7fffu + ((u >> 16) & 1u)) >> 16; }
__device__ __forceinline__ unsigned pk2(float lo, float hi) { unsigned r; asm("v_cvt_pk_bf16_f32 %0, %1, %2" : "=v"(r) : "v"(lo), "v"(hi)); return r; }
typedef short bf16x8v __attribute__((ext_vector_type(8)));
__device__ __forceinline__ uint4 pack8f(const float* s) { uint4 v; v.x = pk2(s[0], s[1]); v.y = pk2(s[2], s[3]); v.z = pk2(s[4], s[5]); v.w = pk2(s[6], s[7]); return v; }
template <int CTRL> __device__ __forceinline__ float dppf(float x) { return __builtin_bit_cast(float, __builtin_amdgcn_mov_dpp(__builtin_bit_cast(int, x), CTRL, 0xf, 0xf, true)); }
__device__ __forceinline__ float red16(float v) { v += dppf<0xB1>(v); v += dppf<0x4E>(v); v += dppf<0x141>(v); v += dppf<0x128>(v); return v; }
__device__ __forceinline__ float wave_sum(float v) { v = red16(v); v += __shfl_xor(v, 16); v += __shfl_xor(v, 32); return v; }
__device__ __forceinline__ float sigmoidf_(float x) { return __builtin_amdgcn_rcpf(1.f + __expf(-x)); }
__device__ __forceinline__ float siluf_(float x) { return x * __builtin_amdgcn_rcpf(1.f + __expf(-x)); }
__device__ __forceinline__ float softplusf_(float x) { return fmaxf(x, 0.f) + __logf(1.f + __expf(-fabsf(x))); }
__device__ __forceinline__ float tanhf_(float x) { return 1.f - 2.f * __builtin_amdgcn_rcpf(__expf(2.f * x) + 1.f); }

__device__ __forceinline__ void transpose_item(const float* W, int K, int N, bf16* WT, float* scr, int item, int nblk, int lane) {
    const int kb = item / nblk, nb = item % nblk, k0 = 64 * kb, n0 = 32 * nb;
    const int kr = lane >> 3, c4 = (lane & 7) * 4; const bool ok = n0 + c4 < N;
    f32x4 v[8];
#pragma unroll
    for (int i = 0; i < 8; ++i) v[i] = ok ? *(const f32x4*)(W + (size_t)(k0 + i * 8 + kr) * N + n0 + c4) : (f32x4){0.f, 0.f, 0.f, 0.f};
#pragma unroll
    for (int i = 0; i < 8; ++i) { float* d = scr + (i * 8 + kr) * 33 + c4; d[0] = v[i][0]; d[1] = v[i][1]; d[2] = v[i][2]; d[3] = v[i][3]; }
    __builtin_amdgcn_s_waitcnt(0); __builtin_amdgcn_wave_barrier();
    const int c = lane & 7;
#pragma unroll
    for (int j = 0; j < 4; ++j) { const int nn = (lane >> 3) + 8 * j; const float* s = scr + (8 * c) * 33 + nn;
        uint4 o; o.x = pk2(s[0 * 33], s[1 * 33]); o.y = pk2(s[2 * 33], s[3 * 33]); o.z = pk2(s[4 * 33], s[5 * 33]); o.w = pk2(s[6 * 33], s[7 * 33]);
        *(uint4*)(WT + (size_t)(n0 + nn) * K + k0 + 8 * c) = o; }
    __builtin_amdgcn_s_waitcnt(0); __builtin_amdgcn_wave_barrier();
}

__device__ __forceinline__ void phase_p0(const KP& p, float* sm) {
    const int tid = otid(), lane = tid & 63, wv = tid >> 6, G = gridDim.x;
    { bf16* AS = (bf16*)sm; const int nt = wv & 3, mh = wv >> 2, n = lane & 15, fq = lane >> 4;
      for (int u = blockIdx.x; u < 2 * 96; u += G) {
        const int l = u / 96, n0 = (u % 96) * 64 + nt * 16 + n;
        const float* W = p.in[11] + (size_t)l * DM * 6144 + n0;
        f32x4 acc[5];
#pragma unroll
        for (int m = 0; m < 5; ++m) acc[m] = (f32x4){0.f, 0.f, 0.f, 0.f};
        float wb[2][8];
#pragma unroll
        for (int ks = 0; ks < 2; ++ks)
#pragma unroll
            for (int j = 0; j < 8; ++j) wb[ks][j] = W[(size_t)(ks * 32 + fq * 8 + j) * 6144];
        for (int kc = 0; kc < DM; kc += 64) {
            __syncthreads();
            for (int i = tid; i < 144 * 32; i += NTHR) { const int r = i >> 5, k = (i & 31) * 2;
                float c0 = 0.f, c1 = 0.f;
                if (r < 8) { const float2 c = *(const float2*)(p.in[9] + (size_t)r * DM + kc + k); c0 = siluf_(c.x); c1 = siluf_(c.y); }
                else if (r < 136) { const float2 c = *(const float2*)(p.in[10] + (size_t)(r - 8) * DM + kc + k); c0 = siluf_(c.x); c1 = siluf_(c.y); }
                *(unsigned*)(AS + r * 72 + k) = pk2(c0, c1); }
            __syncthreads();
            bf16x8v B[2];
#pragma unroll
            for (int ks = 0; ks < 2; ++ks) { const uint4 t = pack8f(wb[ks]); B[ks] = __builtin_bit_cast(bf16x8v, t); }
            if (kc + 64 < DM) {
#pragma unroll
                for (int ks = 0; ks < 2; ++ks)
#pragma unroll
                    for (int j = 0; j < 8; ++j) wb[ks][j] = W[(size_t)(kc + 64 + ks * 32 + fq * 8 + j) * 6144]; }
#pragma unroll
            for (int ks = 0; ks < 2; ++ks)
#pragma unroll
                for (int m = 0; m < 5; ++m) { const int mt = mh * 5 + m; if (mt < 9) { const bf16x8v A = *(const bf16x8v*)(AS + (mt * 16 + n) * 72 + ks * 32 + fq * 8);
                    acc[m] = __builtin_amdgcn_mfma_f32_16x16x32_bf16(A, B[ks], acc[m], 0, 0, 0); } }
        }
        const float bias = p.in[12][(size_t)l * 6144 + n0];
        float* M = (float*)(p.ws + WS_MOD) + (size_t)l * 136 * 6144 + n0;
#pragma unroll
        for (int m = 0; m < 5; ++m) { const int mt = mh * 5 + m;
#pragma unroll
            for (int i = 0; i < 4; ++i) { const int row = mt * 16 + fq * 4 + i; if (mt < 9 && row < 136) M[(size_t)row * 6144] = acc[m][i] + bias; } }
      }
      __syncthreads(); }
    const int gw = blockIdx.x * NWAVES + wv, NGW = G * NWAVES;
    float* scr = sm + wv * (64 * 33);
    constexpr int I_IN = 16 * 128, I_OUT = 16 * 32, I_UP = 16 * 128, I_DN = 64 * 32, I_L = I_IN + I_OUT + I_UP + I_DN;
    for (int it = gw; it < 2 * I_L; it += NGW) {
        const int l = it / I_L; int r = it % I_L;
        if (r < I_IN) { transpose_item(p.in[15] + (size_t)l * DM * PT, DM, PT, (bf16*)(p.ws + WS_WTIN) + (size_t)l * UP * DM, scr, r, 128, lane); continue; } r -= I_IN;
        if (r < I_OUT) { transpose_item(p.in[16] + (size_t)l * DM * DM, DM, DM, (bf16*)(p.ws + WS_WTOUT) + (size_t)l * DM * DM, scr, r, 32, lane); continue; } r -= I_OUT;
        if (r < I_UP) { transpose_item(p.in[17] + (size_t)l * DM * DFF, DM, DFF, (bf16*)(p.ws + WS_WTUP) + (size_t)l * DFF * DM, scr, r, 128, lane); continue; } r -= I_UP;
        transpose_item(p.in[18] + (size_t)l * DFF * DM, DFF, DM, (bf16*)(p.ws + WS_WTDN) + (size_t)l * DM * DFF, scr, r, 32, lane);
    }
    __syncthreads();
}

__device__ __forceinline__ void load_xrow(f32x4 (&v)[4], const float* xf, const bf16* x16, int lane) {
    if (xf) {
#pragma unroll
        for (int j = 0; j < 4; ++j) v[j] = *(const f32x4*)(xf + lane * 4 + 256 * j); }
    else {
#pragma unroll
        for (int j = 0; j < 4; ++j) { const uint2 w = *(const uint2*)(x16 + lane * 4 + 256 * j);
            v[j] = (f32x4){__builtin_bit_cast(float, w.x << 16), __builtin_bit_cast(float, w.x & 0xffff0000u), __builtin_bit_cast(float, w.y << 16), __builtin_bit_cast(float, w.y & 0xffff0000u)}; } }
}
__device__ __forceinline__ void phase_norm(const KP& p, const float* xPf, const float* xSf, const float* nw, const float* modl, int sh_off, int sc_off, int gate_off) {
    const int tid = otid(), lane = tid & 63, wv = tid >> 6; const int gw = blockIdx.x * NWAVES + wv, NGW = gridDim.x * NWAVES;
    bf16* H = (bf16*)(p.ws + WS_H); bf16* X16 = (bf16*)(p.ws + WS_X16);
    f32x4 v[4], vn[4];
#define NRM_LOAD(dst, row) load_xrow(dst, (row) < MP ? (xPf ? xPf + (size_t)(row) * DM : nullptr) : (xSf ? xSf + (size_t)((row) - MP) * DM : nullptr), X16 + (size_t)(row) * DM, lane)
    if (gw < MROWS) NRM_LOAD(v, gw);
    for (int row = gw; row < MROWS; row += NGW) {
        if (row + NGW < MROWS) NRM_LOAD(vn, row + NGW);
        const int cond = row < MP ? (row >> 11) : 8 + ((row - MP) >> 3);
        const float* md = modl + (size_t)cond * 6144;
        if (row >= MP && gate_off != -1) {
            const float* P = (const float*)(p.ws + WS_PART) + (size_t)(row - MP) * DM; bf16* xo_ = X16 + (size_t)row * DM;
#pragma unroll
            for (int j = 0; j < 4; ++j) { const int c = lane * 4 + 256 * j; const f32x4 g = *(const f32x4*)(md + gate_off + c);
                const f32x4 sp = (*(const f32x4*)(P + c) + *(const f32x4*)(P + (size_t)1024 * DM + c)) + (*(const f32x4*)(P + (size_t)2048 * DM + c) + *(const f32x4*)(P + (size_t)3072 * DM + c));
                v[j] += g * sp; uint2 o; o.x = pk2(v[j][0], v[j][1]); o.y = pk2(v[j][2], v[j][3]); *(uint2*)(xo_ + c) = o; } }
        float ss = 0.f;
#pragma unroll
        for (int j = 0; j < 4; ++j) ss += v[j][0] * v[j][0] + v[j][1] * v[j][1] + v[j][2] * v[j][2] + v[j][3] * v[j][3];
        const float rs = rsqrtf(wave_sum(ss) * (1.f / DM) + 1e-6f);
#pragma unroll
        for (int j = 0; j < 4; ++j) { const int c = lane * 4 + 256 * j; const f32x4 w = *(const f32x4*)(nw + c), sc = *(const f32x4*)(md + sc_off + c), sh = *(const f32x4*)(md + sh_off + c);
            const f32x4 h = v[j] * rs * w * (sc + 1.f) + sh;
            uint2 o; o.x = pk2(h[0], h[1]); o.y = pk2(h[2], h[3]); *(uint2*)(H + (size_t)row * DM + c) = o; }
#pragma unroll
        for (int j = 0; j < 4; ++j) v[j] = vn[j];
    }
#undef NRM_LOAD
}
__device__ __forceinline__ void phase_final(const KP& p) {
    const int tid = otid(), lane = tid & 63, wv = tid >> 6; const int gw = blockIdx.x * NWAVES + wv, NGW = gridDim.x * NWAVES;
    const float* nw = p.in[43]; const bf16* X16 = (const bf16*)(p.ws + WS_X16);
    f32x4 v[4], vn[4];
    if (gw < MROWS) load_xrow(v, nullptr, X16 + (size_t)gw * DM, lane);
    for (int row = gw; row < MROWS; row += NGW) {
        float* x = p.out + (size_t)row * DM;
        if (row + NGW < MROWS) load_xrow(vn, nullptr, X16 + (size_t)(row + NGW) * DM, lane);
        if (row >= MP) { const float* P = (const float*)(p.ws + WS_PART) + (size_t)(row - MP) * DM; const float* md = (const float*)(p.ws + WS_MOD) + ((size_t)136 + 8 + ((row - MP) >> 3)) * 6144 + 5120;
#pragma unroll
            for (int j = 0; j < 4; ++j) { const int c = lane * 4 + 256 * j; const f32x4 g = *(const f32x4*)(md + c);
                const f32x4 sp = (*(const f32x4*)(P + c) + *(const f32x4*)(P + (size_t)1024 * DM + c)) + (*(const f32x4*)(P + (size_t)2048 * DM + c) + *(const f32x4*)(P + (size_t)3072 * DM + c));
                v[j] += g * sp; } }
        float ss = 0.f;
#pragma unroll
        for (int j = 0; j < 4; ++j) ss += v[j][0] * v[j][0] + v[j][1] * v[j][1] + v[j][2] * v[j][2] + v[j][3] * v[j][3];
        const float rs = rsqrtf(wave_sum(ss) * (1.f / DM) + 1e-6f);
#pragma unroll
        for (int j = 0; j < 4; ++j) { const int c = lane * 4 + 256 * j; *(f32x4*)(x + c) = v[j] * rs * *(const f32x4*)(nw + c); }
#pragma unroll
        for (int j = 0; j < 4; ++j) v[j] = vn[j];
    }
}

typedef float f32x2 __attribute__((ext_vector_type(2)));
constexpr int VST = 320, SL_VEC = 0, SL_VROW = 16 * VST, SL_PART = SL_VROW + 16 * 64, SL_SCAL = SL_PART + 16 * 16, SL_SIZE = SL_SCAL + 16 * 8;
static_assert(4 * SL_SIZE * 4 <= 131072, "scan LDS ring");
struct Item { int tr, b, h, half, T, NB, row0; };
struct V8 { f32x4 a, b; };
__device__ __forceinline__ V8 ld8(const float* q) { V8 v; v.a = *(const f32x4*)q; v.b = *(const f32x4*)(q + 4); return v; }
__device__ __forceinline__ float dot8(const V8& s, const V8& x) { const f32x4 t = s.a * x.a + s.b * x.b; return (t[0] + t[1]) + (t[2] + t[3]); }
__device__ __forceinline__ f32x2 dot8x2(const V8& s, const f32x4& p0, const f32x4& p1, const f32x4& p2, const f32x4& p3) {
    f32x2 a = (f32x2){s.a[0], s.a[0]} * (f32x2){p0[0], p0[1]}; f32x2 b = (f32x2){s.a[1], s.a[1]} * (f32x2){p0[2], p0[3]};
    a += (f32x2){s.a[2], s.a[2]} * (f32x2){p1[0], p1[1]}; b += (f32x2){s.a[3], s.a[3]} * (f32x2){p1[2], p1[3]};
    a += (f32x2){s.b[0], s.b[0]} * (f32x2){p2[0], p2[1]}; b += (f32x2){s.b[1], s.b[1]} * (f32x2){p2[2], p2[3]};
    a += (f32x2){s.b[2], s.b[2]} * (f32x2){p3[0], p3[1]}; b += (f32x2){s.b[3], s.b[3]} * (f32x2){p3[2], p3[3]};
    return a + b; }
__device__ __forceinline__ float red8(float v) { v += dppf<0xB1>(v); v += dppf<0x4E>(v); v += dppf<0x141>(v); return v; }
__device__ __forceinline__ float ldu(const bf16* U, int row, int col, int T) { row = row < T ? row : T - 1; return bf2f(U[(size_t)row * UP + col]); }
__device__ __forceinline__ void unpack8(const uint4 v, float (&o)[8]) {
    o[0] = __builtin_bit_cast(float, v.x << 16); o[1] = __builtin_bit_cast(float, v.x & 0xffff0000u); o[2] = __builtin_bit_cast(float, v.y << 16); o[3] = __builtin_bit_cast(float, v.y & 0xffff0000u);
    o[4] = __builtin_bit_cast(float, v.z << 16); o[5] = __builtin_bit_cast(float, v.z & 0xffff0000u); o[6] = __builtin_bit_cast(float, v.w << 16); o[7] = __builtin_bit_cast(float, v.w & 0xffff0000u); }
#define YKEEP2(tt, ya, yb) do { if ((tt) == sub) { yk0 = (ya); yk1 = (yb); } } while (0)
#define YSTORE2(bb) do { const int g0 = 16 * (bb) + sub; if (g0 < T) { Y[(size_t)g0 * DM + irow] = (bf16)f2bf(yk0); Y[(size_t)g0 * DM + irow + 16] = (bf16)f2bf(yk1); } } while (0)
__device__ __forceinline__ f32x2 dot4x2(const f32x4& s, const f32x4& p0, const f32x4& p1) {
    f32x2 a = (f32x2){s[0], s[0]} * (f32x2){p0[0], p0[1]}; f32x2 b = (f32x2){s[1], s[1]} * (f32x2){p0[2], p0[3]};
    a += (f32x2){s[2], s[2]} * (f32x2){p1[0], p1[1]}; b += (f32x2){s[3], s[3]} * (f32x2){p1[2], p1[3]};
    return a + b; }
__device__ __forceinline__ void red16x4(float x0, float x1, float x2, float x3, bool p0, bool p1, float& r0, float& r1, float& r2, float& r3) {
    float k0 = p0 ? x2 : x0, k1 = p0 ? x3 : x1; const float t0 = p0 ? x0 : x2, t1 = p0 ? x1 : x3;
    k0 += dppf<0xB1>(t0); k1 += dppf<0xB1>(t1);
    float m = p1 ? k1 : k0; const float u = p1 ? k0 : k1;
    m += dppf<0x4E>(u); m += dppf<0x124>(m); m += dppf<0x128>(m);
    r0 = dppf<0x00>(m); r2 = dppf<0x55>(m); r1 = dppf<0xAA>(m); r3 = dppf<0xFF>(m);
}
__device__ __forceinline__ void red16x2(float xa, float xb, bool p0, float& ra, float& rb) {
    float k = p0 ? xb : xa; const float t = p0 ? xa : xb;
    k += dppf<0xB1>(t); k += dppf<0x4E>(k); k += dppf<0x124>(k); k += dppf<0x128>(k);
    ra = dppf<0x00>(k); rb = dppf<0x55>(k);
}
__device__ __forceinline__ float dot4(const f32x4& s, const f32x4& x) { const f32x4 t = s * x; return (t[0] + t[1]) + (t[2] + t[3]); }
#define TICK_BAR() do { asm volatile("s_waitcnt lgkmcnt(0)" ::: "memory"); __builtin_amdgcn_s_barrier(); asm volatile("" ::: "memory"); } while (0)
__device__ __forceinline__ void scan_rwkv(const KP& p, int l, const Item& it, float* sm) {
    const int tid = otid(), lane = tid & 63, wv = tid >> 6, T = it.T, NBAT = (T + 15) >> 4;
    const bool scanner = wv < 4;
    const bf16* U = (const bf16*)(p.ws + WS_U) + (size_t)it.row0 * UP;
    const float* sh0 = it.tr ? p.in[2] + ((size_t)l * BS + it.b) * 896 : nullptr;
    const int rp = (tid & 255) >> 4, sub = tid & 15, nh = it.tr ? 2 : 1; const bool lp0 = (tid & 1) != 0, lp1 = (tid & 2) != 0; int irow = it.half * 32 + rp;
    bf16* Y = (bf16*)(p.ws + WS_H) + (size_t)it.row0 * DM + 0 * 256 + it.h * 64;
    float* sbase_o = p.out + (it.tr ? O_SWKV : O_PWKV) + (((size_t)l * it.NB + it.b) * 4 + it.h) * 4096 + sub * 4;
    const float* sbase_i = p.in[3] + (((size_t)l * BS + it.b) * 4 + it.h) * 4096 + sub * 4;
    f32x4 S0 = {0.f, 0.f, 0.f, 0.f}, S1 = S0, Q0 = S0, Q1 = S0, R0 = S0, R1 = S0;
    if (it.tr) { const float* q = sbase_i + ((wv >> 2) * 32 + rp) * 64; Q0 = *(const f32x4*)q; Q1 = *(const f32x4*)(q + 16 * 64); R0 = *(const f32x4*)(q + 4 * 4096); R1 = *(const f32x4*)(q + 4 * 4096 + 16 * 64); }
    float yk0 = 0.f, yk1 = 0.f;
    const int pj = wv & 3, n = lane & 15, fq = lane >> 4, c = pj * 16 + n, hc = it.h * 64 + c;
    const float* mu = p.in[19] + l * 896;
    bf16x8v Bw, Ba; float muw[8], mua[8];
#pragma unroll
    for (int j = 0; j < 8; ++j) { Bw[j] = (short)f2bf(p.in[21][((size_t)l * 32 + fq * 8 + j) * 256 + hc]); Ba[j] = (short)f2bf(p.in[23][((size_t)l * 32 + fq * 8 + j) * 256 + hc]);
        muw[j] = mu[768 + fq * 8 + j]; mua[j] = mu[800 + fq * 8 + j]; }
    const float w0c = p.in[20][l * 256 + hc], a0c = p.in[22][l * 256 + hc], kkc = p.in[25][l * 256 + hc], kac = p.in[26][l * 256 + hc], rkc = p.in[27][l * 256 + hc];
    const float mur = mu[hc], muk = mu[256 + hc], muv = mu[512 + hc];
    struct RwRaw { uint4 wc, wp, ac, ap; float rr[5], rk[5], rv[5]; } cur;
#define RW_LOAD(R, bb) do { const int ta = 16 * (bb) + n;              \
        { const int tc_ = ta < T ? ta : T - 1; const bf16* q = U + (size_t)tc_ * UP + 768 + fq * 8; R.wc = *(const uint4*)q; R.ac = *(const uint4*)(q + 32); \
          const bool sb_ = it.tr && tc_ == 8; const float* shx_ = sb_ ? sh0 + 896 : sh0;     \
          if (tc_ > 0 && !sb_) { R.wp = *(const uint4*)(q - UP); R.ap = *(const uint4*)(q + 32 - UP); } \
          else if (sh0) { R.wp = pack8f(shx_ + 768 + fq * 8); R.ap = pack8f(shx_ + 800 + fq * 8); } else { R.wp = (uint4){0u, 0u, 0u, 0u}; R.ap = R.wp; } } \
        _Pragma("unroll") for (int i = 0; i < 5; ++i) { const int g = 16 * (bb) + fq * 4 - 1 + i; \
            const bool sb_ = it.tr && fq == 2 && i == 0; const float* shx_ = sb_ ? sh0 + 896 : sh0;     \
            if (g >= 0 && !sb_) { R.rr[i] = ldu(U, g, hc, T); R.rk[i] = ldu(U, g, 256 + hc, T); R.rv[i] = ldu(U, g, 512 + hc, T); } \
            else if (sh0) { R.rr[i] = shx_[hc]; R.rk[i] = shx_[256 + hc]; R.rv[i] = shx_[512 + hc]; } else { R.rr[i] = R.rk[i] = R.rv[i] = 0.f; } } } while (0)
    if (!scanner) RW_LOAD(cur, 0);
    for (int k = 0; k < NBAT + 2; ++k) {
        if (scanner || it.tr) {
            const int b = k - 2;
            if (b >= 0 && b < NBAT) {
                const float* SL = sm + (b & 3) * SL_SIZE; const int ns = (T - 16 * b) < 16 ? (T - 16 * b) : 16;
                { const int hv = wv >> 2;
                if (it.tr) irow = hv * 32 + rp;
                const int nsq = it.tr ? 8 : ns;
                _Pragma("unroll") for (int sq = 0; sq < 2; ++sq) {
                if (it.tr) { S0 = sq ? R0 : Q0; S1 = sq ? R1 : Q1; }
#define RW_STEP(tt, q0, q1, w, bb, kp, va, vb, sc) do { const f32x2 da = dot4x2(S0, q0, q1), db = dot4x2(S1, q0, q1); \
                    float a1, a2, b1, b2; red16x4(da.x, da.y, db.x, db.y, lp0, lp1, a1, a2, b1, b2); \
                    const float ca = sc[0] * a1, cb = sc[0] * b1;                                       \
                    const float ya = a2 - ca * sc[1] + va * sc[2], yb = b2 - cb * sc[1] + vb * sc[2]; \
                    S0 = S0 * w + (kp * va - bb * ca); S1 = S1 * w + (kp * vb - bb * cb); YKEEP2(tt, ya, yb); } while (0)
                _Pragma("unroll 2") for (int j_ = 0; j_ < 4; ++j_) { const int tt = sq * 8 + 2 * j_;
                    const float* V0 = SL + SL_VEC + tt * VST + sub * 4; const float* V1 = V0 + VST; const float* P0 = V0 + sub * 4; const float* P1 = P0 + VST;
                    const f32x4 a0 = *(const f32x4*)P0, a1_ = *(const f32x4*)(P0 + 4), w0 = *(const f32x4*)(V0 + 128), bb0 = *(const f32x4*)(V0 + 192), kp0 = *(const f32x4*)(V0 + 256);
                    const float va0 = SL[SL_VROW + tt * 64 + irow], vb0 = SL[SL_VROW + tt * 64 + irow + 16]; const f32x4 sc0 = *(const f32x4*)(SL + SL_SCAL + tt * 8);
                    const f32x4 e0 = *(const f32x4*)P1, e1 = *(const f32x4*)(P1 + 4), w1 = *(const f32x4*)(V1 + 128), bb1 = *(const f32x4*)(V1 + 192), kp1 = *(const f32x4*)(V1 + 256);
                    const float va1 = SL[SL_VROW + (tt + 1) * 64 + irow], vb1 = SL[SL_VROW + (tt + 1) * 64 + irow + 16]; const f32x4 sc1 = *(const f32x4*)(SL + SL_SCAL + (tt + 1) * 8);
                    RW_STEP(tt, a0, a1_, w0, bb0, kp0, va0, vb0, sc0);
                    RW_STEP(tt + 1, e0, e1, w1, bb1, kp1, va1, vb1, sc1);
                }
                if (it.tr) { float* o_ = sbase_o + sq * (4 * 4096); *(f32x4*)(o_ + irow * 64) = S0; *(f32x4*)(o_ + (irow + 16) * 64) = S1; }
                }
#undef RW_STEP
                YSTORE2(b);
                }
            }
        }
        if (!scanner) {
            if (k >= 1 && k - 1 < NBAT && lane < 4) {
                const int tt = pj * 4 + lane; float* SL = sm + ((k - 1) & 3) * SL_SIZE; const float* P = SL + SL_PART + tt * 16;
                const f32x4 s = *(const f32x4*)P + *(const f32x4*)(P + 4) + *(const f32x4*)(P + 8) + *(const f32x4*)(P + 12);
                const float rn2 = __builtin_amdgcn_rcpf(s[0] + 1e-6f);
                *(f32x4*)(SL + SL_SCAL + tt * 8) = (f32x4){rn2, s[1], s[2], 0.f};
                const int g = 16 * (k - 1) + tt; if (it.half == 0 && g < T) ((float*)(p.ws + WS_AUX))[((size_t)it.row0 + g) * 4 + it.h] = s[3];
            }
            if (k < NBAT) {
                float xw[8], xa[8], cu[8], pr[8];
                unpack8(cur.wc, cu); unpack8(cur.wp, pr);
#pragma unroll
                for (int j = 0; j < 8; ++j) xw[j] = tanhf_(cu[j] + (pr[j] - cu[j]) * muw[j]);
                unpack8(cur.ac, cu); unpack8(cur.ap, pr);
#pragma unroll
                for (int j = 0; j < 8; ++j) xa[j] = cu[j] + (pr[j] - cu[j]) * mua[j];
                const uint4 Awu = pack8f(xw), Aau = pack8f(xa);
                const bf16x8v Aw = __builtin_bit_cast(bf16x8v, Awu), Aa = __builtin_bit_cast(bf16x8v, Aau);
                const f32x4 z = {0.f, 0.f, 0.f, 0.f};
                const f32x4 dw = __builtin_amdgcn_mfma_f32_16x16x32_bf16(Aw, Bw, z, 0, 0, 0), da = __builtin_amdgcn_mfma_f32_16x16x32_bf16(Aa, Ba, z, 0, 0, 0);
                float xr_[4], xk_[4], xv_[4];
#pragma unroll
                for (int i = 0; i < 4; ++i) { xr_[i] = cur.rr[i + 1] + (cur.rr[i] - cur.rr[i + 1]) * mur; xk_[i] = cur.rk[i + 1] + (cur.rk[i] - cur.rk[i + 1]) * muk; xv_[i] = cur.rv[i + 1] + (cur.rv[i] - cur.rv[i + 1]) * muv; }
                if (k + 1 < NBAT) RW_LOAD(cur, k + 1);
                float* SL = sm + (k & 3) * SL_SIZE;
#pragma unroll
                for (int i = 0; i < 4; ++i) { const int tt = fq * 4 + i;
                    const float w = __expf(-0.6065306597f * sigmoidf_(w0c + dw[i])), a = sigmoidf_(a0c + da[i]);
                    const float kkraw = xk_[i] * kkc, braw = kkraw * a, kp = xk_[i] * (1.f + (a - 1.f) * kac);
                    float* V = SL + SL_VEC + tt * VST + c; *(f32x2*)(V + c) = (f32x2){kkraw, w * xr_[i]}; V[128] = w; V[192] = braw; V[256] = kp; SL[SL_VROW + tt * 64 + c] = xv_[i];
                    float p0, p1, p2, p3; red16x4(kkraw * kkraw, braw * xr_[i], kp * xr_[i], xr_[i] * kp * rkc, lp0, lp1, p0, p1, p2, p3);
                    if (n == 0) *(f32x4*)(SL + SL_PART + tt * 16 + pj * 4) = (f32x4){p0, p1, p2, p3}; }
            }
        }
        TICK_BAR();
    }
#undef RW_LOAD
    if (scanner) { if (!it.tr) { *(f32x4*)(sbase_o + irow * 64) = S0; *(f32x4*)(sbase_o + (irow + 16) * 64) = S1; } }
    else if (it.h == 0 && it.half == 0) { float* so = p.out + (it.tr ? O_SSHIFT : O_PSHIFT) + ((size_t)l * it.NB + it.b) * 896;
        for (int cc = tid - 256; cc < 896; cc += 256) { so[cc] = bf2f(U[(size_t)(it.tr ? 7 : T - 1) * UP + cc]); if (it.tr) so[896 + cc] = bf2f(U[(size_t)15 * UP + cc]); } }
}

__device__ __forceinline__ void scan_gla(const KP& p, int l, const Item& it, float* sm) {
    const int tid = otid(), lane = tid & 63, wv = tid >> 6, T = it.T, NBAT = (T + 15) >> 4;
    const bool scanner = wv < 4;
    const bf16* U = (const bf16*)(p.ws + WS_U) + (size_t)it.row0 * UP + CB;
    const int rp = (tid & 255) >> 4, sub = tid & 15, nh = it.tr ? 2 : 1; const bool lp0 = (tid & 1) != 0, lp1 = (tid & 2) != 0; int irow = it.half * 32 + rp;
    bf16* Y = (bf16*)(p.ws + WS_H) + (size_t)it.row0 * DM + 1 * 256 + it.h * 64;
    const size_t sbase = (((size_t)l * it.NB + it.b) * 4 + it.h) * 4096;
    f32x4 S0 = {0.f, 0.f, 0.f, 0.f}, S1 = S0, Q0 = S0, Q1 = S0, R0 = S0, R1 = S0; float* so = p.out + (it.tr ? O_SGLA : O_PGLA) + sbase + (size_t)sub * 4 * 64; const float* si = p.in[4] + sbase + (size_t)sub * 4 * 64;
    if (it.tr) { const int r0 = (wv >> 2) * 32 + rp;
#pragma unroll
        for (int e = 0; e < 4; ++e) { Q0[e] = si[e * 64 + r0]; Q1[e] = si[e * 64 + r0 + 16]; R0[e] = si[4 * 4096 + e * 64 + r0]; R1[e] = si[4 * 4096 + e * 64 + r0 + 16]; } }
    float yk0 = 0.f, yk1 = 0.f;
    const int pj = wv & 3, n = lane & 15, fq = lane >> 4, c = pj * 16 + n, hc = it.h * 64 + c;
    float gkw[16];
#pragma unroll
    for (int j = 0; j < 16; ++j) gkw[j] = p.in[30][((size_t)l * 16 + j) * 256 + hc];
    const float gkb = p.in[31][l * 256 + hc];
    struct GlRaw { float q_[4], k_[4], v_[4]; uint4 g0[4], g1[4]; } cur;
#define GL_LOAD(R, bb) do { _Pragma("unroll") for (int i = 0; i < 4; ++i) { int g = 16 * (bb) + fq * 4 + i; g = g < T ? g : T - 1; const bf16* q = U + (size_t)g * UP; \
        R.q_[i] = bf2f(q[hc]); R.k_[i] = bf2f(q[256 + hc]); R.v_[i] = bf2f(q[512 + hc]); R.g0[i] = *(const uint4*)(q + 1024); R.g1[i] = *(const uint4*)(q + 1032); } } while (0)
    if (!scanner) GL_LOAD(cur, 0);
    for (int k = 0; k < NBAT + 2; ++k) {
        if (scanner || it.tr) {
            const int b = k - 2;
            if (b >= 0 && b < NBAT) {
                const float* SL = sm + (b & 3) * SL_SIZE; const int ns = (T - 16 * b) < 16 ? (T - 16 * b) : 16;
                { const int hv = wv >> 2;
                if (it.tr) irow = hv * 32 + rp;
                const int nsq = it.tr ? 8 : ns;
                _Pragma("unroll") for (int sq = 0; sq < 2; ++sq) {

                if (it.tr) { S0 = sq ? R0 : Q0; S1 = sq ? R1 : Q1; }
#define GL_STEP(tt, dec, kv, qd, va, vb, qk) do { float da, db; red16x2(dot4(S0, qd), dot4(S1, qd), lp0, da, db); const float ya = da + va * qk, yb = db + vb * qk; \
                    S0 = S0 * dec + kv * va; S1 = S1 * dec + kv * vb; YKEEP2(tt, ya, yb); } while (0)
                _Pragma("unroll 2") for (int j_ = 0; j_ < 4; ++j_) { const int tt = sq * 8 + 2 * j_;
                    const float* V0 = SL + SL_VEC + tt * VST + sub * 4; const float* V1 = V0 + VST;
                    const f32x4 qd0 = *(const f32x4*)(V0 + 128), dec0 = *(const f32x4*)V0, kv0 = *(const f32x4*)(V0 + 64); const float va0 = SL[SL_VROW + tt * 64 + irow], vb0 = SL[SL_VROW + tt * 64 + irow + 16], qk0 = SL[SL_SCAL + tt * 8];
                    const f32x4 qd1 = *(const f32x4*)(V1 + 128), dec1 = *(const f32x4*)V1, kv1 = *(const f32x4*)(V1 + 64); const float va1 = SL[SL_VROW + (tt + 1) * 64 + irow], vb1 = SL[SL_VROW + (tt + 1) * 64 + irow + 16], qk1 = SL[SL_SCAL + (tt + 1) * 8];
                    GL_STEP(tt, dec0, kv0, qd0, va0, vb0, qk0);
                    GL_STEP(tt + 1, dec1, kv1, qd1, va1, vb1, qk1);
                }
                if (it.tr) { float* o_ = so + sq * (4 * 4096);
#pragma unroll
                    for (int e = 0; e < 4; ++e) { o_[e * 64 + irow] = S0[e]; o_[e * 64 + irow + 16] = S1[e]; } }
                }
#undef GL_STEP
                YSTORE2(b);
                }
            }
        }
        if (!scanner) {
            if (k >= 1 && k - 1 < NBAT && lane < 4) { const int tt = pj * 4 + lane; float* SL = sm + ((k - 1) & 3) * SL_SIZE; const float* P = SL + SL_PART + tt * 16;
                SL[SL_SCAL + tt * 8] = P[0] + P[4] + P[8] + P[12]; }
            if (k < NBAT) {
                float x[4], qq[4], kk[4], vv[4];
#pragma unroll
                for (int i = 0; i < 4; ++i) { float gl[8]; x[i] = gkb; unpack8(cur.g0[i], gl);
#pragma unroll
                    for (int j = 0; j < 8; ++j) x[i] += gl[j] * gkw[j];
                    unpack8(cur.g1[i], gl);
#pragma unroll
                    for (int j = 0; j < 8; ++j) x[i] += gl[j] * gkw[8 + j];
                    qq[i] = cur.q_[i] * 0.125f; kk[i] = cur.k_[i]; vv[i] = cur.v_[i]; }
                if (k + 1 < NBAT) GL_LOAD(cur, k + 1);
                float* SL = sm + (k & 3) * SL_SIZE;
#pragma unroll
                for (int i = 0; i < 4; ++i) { const int tt = fq * 4 + i;
                    const float dec = __expf(-softplusf_(-x[i]) * (1.f / 16.f));
                    float* V = SL + SL_VEC + tt * VST + c; V[0] = dec; V[64] = kk[i]; V[128] = qq[i] * dec; SL[SL_VROW + tt * 64 + c] = vv[i];
                    const float p0 = red16(qq[i] * kk[i]);
                    if (n == 0) SL[SL_PART + tt * 16 + pj * 4] = p0; }
            }
        }
        TICK_BAR();
    }
#undef GL_LOAD
    if (scanner && !it.tr) {
#pragma unroll
        for (int e = 0; e < 4; ++e) { so[e * 64 + irow] = S0[e]; so[e * 64 + irow + 16] = S1[e]; } }
}

__device__ __forceinline__ void scan_dn(const KP& p, int l, const Item& it, float* sm) {
    const int tid = otid(), lane = tid & 63, wv = tid >> 6, T = it.T, NBAT = (T + 15) >> 4;
    const bool scanner = wv < 4;
    const bf16* U = (const bf16*)(p.ws + WS_U) + (size_t)it.row0 * UP + CC;
    const float* cv0 = it.tr ? p.in[5] + ((size_t)l * BS + it.b) * 3 * 768 : nullptr;
    const int rp = (tid & 255) >> 4, sub = tid & 15, nh = it.tr ? 2 : 1; const bool lp0 = (tid & 1) != 0, lp1 = (tid & 2) != 0; int irow = it.half * 32 + rp;
    bf16* Y = (bf16*)(p.ws + WS_H) + (size_t)it.row0 * DM + 2 * 256 + it.h * 64;
    const size_t sbase = (((size_t)l * it.NB + it.b) * 4 + it.h) * 4096;
    f32x4 S0 = {0.f, 0.f, 0.f, 0.f}, S1 = S0, Q0 = S0, Q1 = S0, R0 = S0, R1 = S0; float* so = p.out + (it.tr ? O_SDN : O_PDN) + sbase + (size_t)sub * 4 * 64; const float* si = p.in[6] + sbase + (size_t)sub * 4 * 64;
    if (it.tr) { const int r0 = (wv >> 2) * 32 + rp;
#pragma unroll
        for (int e = 0; e < 4; ++e) { Q0[e] = si[e * 64 + r0]; Q1[e] = si[e * 64 + r0 + 16]; R0[e] = si[4 * 4096 + e * 64 + r0]; R1[e] = si[4 * 4096 + e * 64 + r0 + 16]; } }
    float yk0 = 0.f, yk1 = 0.f;
    const int pj = wv & 3, n = lane & 15, fq = lane >> 4, c = pj * 16 + n, hc = it.h * 64 + c;
    float cw[3][4];
#pragma unroll
    for (int pt = 0; pt < 3; ++pt)
#pragma unroll
        for (int i = 0; i < 4; ++i) cw[pt][i] = p.in[33][((size_t)l * 4 + i) * 768 + pt * 256 + hc];
    const float nA = -__expf(p.in[34][l * 4 + it.h]), dtb = p.in[35][l * 4 + it.h];
    struct DnRaw { float xin[3][7]; } cur;
#define DN_LOAD(R, bb) do { _Pragma("unroll") for (int pt = 0; pt < 3; ++pt) _Pragma("unroll") for (int i = 0; i < 7; ++i) { const int g = 16 * (bb) + fq * 4 - 3 + i; \
        R.xin[pt][i] = (it.tr && fq == 2 && i < 3) ? cv0[(3 + i) * 768 + pt * 256 + hc] : g >= 0 ? ldu(U, g, pt * 256 + hc, T) : (cv0 ? cv0[(3 + g) * 768 + pt * 256 + hc] : 0.f); } } while (0)
    if (!scanner) DN_LOAD(cur, 0);
    for (int k = 0; k < NBAT + 2; ++k) {
        if (scanner || it.tr) {
            const int b = k - 2;
            if (b >= 0 && b < NBAT) {
                const float* SL = sm + (b & 3) * SL_SIZE; const int ns = (T - 16 * b) < 16 ? (T - 16 * b) : 16;
                { const int hv = wv >> 2;
                if (it.tr) irow = hv * 32 + rp;
                const int nsq = it.tr ? 8 : ns;
                _Pragma("unroll") for (int sq = 0; sq < 2; ++sq) {

                if (it.tr) { S0 = sq ? R0 : Q0; S1 = sq ? R1 : Q1; }
#define DN_STEP(tt, q0, q1, kv, va, vb, sc, sq) do { const f32x2 da = dot4x2(S0, q0, q1), db = dot4x2(S1, q0, q1);        \
                    float a1, a2, b1, b2; red16x4(da.x, da.y, db.x, db.y, lp0, lp1, a1, a2, b1, b2); \
                    const float na = sc[1] * (va - sc[0] * sc[2] * a1), nb = sc[1] * (vb - sc[0] * sc[2] * b1); \
                    const float ya = sc[0] * sc[3] * a2 + na * sq, yb = sc[0] * sc[3] * b2 + nb * sq; \
                    S0 = S0 * sc[0] + kv * (na * sc[2]); S1 = S1 * sc[0] + kv * (nb * sc[2]); YKEEP2(tt, ya, yb); } while (0)
                _Pragma("unroll 2") for (int j_ = 0; j_ < 4; ++j_) { const int tt = sq * 8 + 2 * j_;
                    const float* V0 = SL + SL_VEC + tt * VST + sub * 4; const float* V1 = V0 + VST; const float* P0 = V0 + sub * 4; const float* P1 = P0 + VST;
                    const f32x4 a0 = *(const f32x4*)P0, a1_ = *(const f32x4*)(P0 + 4), kv0 = *(const f32x4*)(V0 + 128);
                    const float va0 = SL[SL_VROW + tt * 64 + irow], vb0 = SL[SL_VROW + tt * 64 + irow + 16]; const f32x4 sc0 = *(const f32x4*)(SL + SL_SCAL + tt * 8); const float sq0 = SL[SL_SCAL + tt * 8 + 4];
                    const f32x4 e0 = *(const f32x4*)P1, e1 = *(const f32x4*)(P1 + 4), kv1 = *(const f32x4*)(V1 + 128);
                    const float va1 = SL[SL_VROW + (tt + 1) * 64 + irow], vb1 = SL[SL_VROW + (tt + 1) * 64 + irow + 16]; const f32x4 sc1 = *(const f32x4*)(SL + SL_SCAL + (tt + 1) * 8); const float sq1 = SL[SL_SCAL + (tt + 1) * 8 + 4];
                    DN_STEP(tt, a0, a1_, kv0, va0, vb0, sc0, sq0);
                    DN_STEP(tt + 1, e0, e1, kv1, va1, vb1, sc1, sq1);
                }
                if (it.tr) { float* o_ = so + sq * (4 * 4096);
#pragma unroll
                    for (int e = 0; e < 4; ++e) { o_[e * 64 + irow] = S0[e]; o_[e * 64 + irow + 16] = S1[e]; } }
                }
#undef DN_STEP
                YSTORE2(b);
                }
            }
        }
        if (!scanner) {
            if (k >= 1 && k - 1 < NBAT && lane < 4) { const int tt = pj * 4 + lane; float* SL = sm + ((k - 1) & 3) * SL_SIZE; const float* P = SL + SL_PART + tt * 16;
                const f32x4 s = *(const f32x4*)P + *(const f32x4*)(P + 4) + *(const f32x4*)(P + 8) + *(const f32x4*)(P + 12);
                const float rq8 = rsqrtf(s[0] + 1e-6f) * 0.125f, rk = rsqrtf(s[1] + 1e-6f);
                int g = 16 * (k - 1) + tt; g = g < T ? g : T - 1;
                const float beta = sigmoidf_(bf2f(U[(size_t)g * UP + 1028 + it.h])), eg = __expf(nA * softplusf_(bf2f(U[(size_t)g * UP + 1024 + it.h]) + dtb));
                *(f32x4*)(SL + SL_SCAL + tt * 8) = (f32x4){eg, beta, rk, rq8}; SL[SL_SCAL + tt * 8 + 4] = s[2] * rq8 * rk; }
            if (k < NBAT) {
                float o[3][4];
#pragma unroll
                for (int pt = 0; pt < 3; ++pt)
#pragma unroll
                    for (int i = 0; i < 4; ++i) o[pt][i] = siluf_(cw[pt][0] * cur.xin[pt][i] + cw[pt][1] * cur.xin[pt][i + 1] + cw[pt][2] * cur.xin[pt][i + 2] + cw[pt][3] * cur.xin[pt][i + 3]);
                if (k + 1 < NBAT) DN_LOAD(cur, k + 1);
                float* SL = sm + (k & 3) * SL_SIZE;
#pragma unroll
                for (int i = 0; i < 4; ++i) { const int tt = fq * 4 + i;
                    float* V = SL + SL_VEC + tt * VST + c; *(f32x2*)(V + c) = (f32x2){o[1][i], o[0][i]}; V[128] = o[1][i]; SL[SL_VROW + tt * 64 + c] = o[2][i];
                    const float p0 = red16(o[0][i] * o[0][i]), p1 = red16(o[1][i] * o[1][i]), p2 = red16(o[0][i] * o[1][i]);
                    if (n == 0) *(f32x4*)(SL + SL_PART + tt * 16 + pj * 4) = (f32x4){p0, p1, p2, 0.f}; }
            }
        }
        TICK_BAR();
    }
#undef DN_LOAD
    if (scanner) { if (!it.tr) {
#pragma unroll
        for (int e = 0; e < 4; ++e) { so[e * 64 + irow] = S0[e]; so[e * 64 + irow + 16] = S1[e]; } } }
    else if (it.h == 0 && it.half == 0) { float* so = p.out + (it.tr ? O_SDNC : O_PDNC) + ((size_t)l * it.NB + it.b) * 3 * 768;
        for (int i = tid - 256; i < 3 * 768; i += 256) { const int rr = i / 768, cc = i % 768; so[i] = bf2f(U[(size_t)((it.tr ? 5 : T - 3) + rr) * UP + cc]); if (it.tr) so[3 * 768 + i] = bf2f(U[(size_t)(13 + rr) * UP + cc]); } }
}

__device__ __forceinline__ void scan_ssd(const KP& p, int l, const Item& it, float* sm) {
    const int tid = otid(), lane = tid & 63, wv = tid >> 6, T = it.T, NBAT = (T + 15) >> 4, grp = it.h >> 1;
    const bool scanner = wv < 4;
    const bf16* U = (const bf16*)(p.ws + WS_U) + (size_t)it.row0 * UP + CD;
    const bf16* UX = U + 256;
    const float* cv0 = it.tr ? p.in[7] + ((size_t)l * BS + it.b) * 3 * 768 : nullptr;
    const int rp = (tid & 255) >> 4, sub = tid & 15, nh = it.tr ? 2 : 1; const bool lp0 = (tid & 1) != 0, lp1 = (tid & 2) != 0; int irow = it.half * 32 + rp;
    bf16* Y = (bf16*)(p.ws + WS_H) + (size_t)it.row0 * DM + 3 * 256 + it.h * 64;
    const size_t sbase = (((size_t)l * it.NB + it.b) * 4 + it.h) * 64 * 128 + sub * 8; float* so = p.out + (it.tr ? O_SSSM : O_PSSM) + sbase; const float* si = p.in[8] + sbase;
    V8 S0, S1; S0.a = (f32x4){0.f, 0.f, 0.f, 0.f}; S0.b = S0.a; S1 = S0;
    V8 Q0 = S0, Q1 = S0, R0 = S0, R1 = S0;
    if (it.tr) { const int r0 = (wv >> 2) * 32 + rp; Q0 = ld8(si + r0 * 128); Q1 = ld8(si + (r0 + 16) * 128); R0 = ld8(si + 4 * 8192 + r0 * 128); R1 = ld8(si + 4 * 8192 + (r0 + 16) * 128); }
    float yk0 = 0.f, yk1 = 0.f;
    const int pj = wv & 3, n = lane & 15, fq = lane >> 4, c = pj * 16 + n;
    int ch[5]; ch[0] = it.h * 64 + c; ch[1] = 256 + grp * 128 + pj * 32 + n; ch[2] = ch[1] + 16; ch[3] = ch[1] + 256; ch[4] = ch[3] + 16;
    float cw[5][4], cb[5];
#pragma unroll
    for (int q = 0; q < 5; ++q) { cb[q] = p.in[38][(size_t)l * 768 + ch[q]];
#pragma unroll
        for (int i = 0; i < 4; ++i) cw[q][i] = p.in[37][((size_t)l * 4 + i) * 768 + ch[q]]; }
    const float nA = -__expf(p.in[40][l * 4 + it.h]), dtb = p.in[39][l * 4 + it.h], Dh = p.in[41][l * 4 + it.h];
    struct SsRaw { float xin[5][7]; } cur;
#define SS_LOAD(R, bb) do { _Pragma("unroll") for (int q = 0; q < 5; ++q) _Pragma("unroll") for (int i = 0; i < 7; ++i) { const int g = 16 * (bb) + fq * 4 - 3 + i; \
        R.xin[q][i] = (it.tr && fq == 2 && i < 3) ? cv0[(3 + i) * 768 + ch[q]] : g >= 0 ? ldu(UX, g, ch[q], T) : (cv0 ? cv0[(3 + g) * 768 + ch[q]] : 0.f); } } while (0)
    if (!scanner) SS_LOAD(cur, 0);
    for (int k = 0; k < NBAT + 2; ++k) {
        if (scanner || it.tr) {
            const int b = k - 2;
            if (b >= 0 && b < NBAT) {
                const float* SL = sm + (b & 3) * SL_SIZE; const int ns = (T - 16 * b) < 16 ? (T - 16 * b) : 16;
                { const int hv = wv >> 2;
                if (it.tr) irow = hv * 32 + rp;
                const int nsq = it.tr ? 8 : ns;
                _Pragma("unroll") for (int sq = 0; sq < 2; ++sq) {

                if (it.tr) { S0 = sq ? R0 : Q0; S1 = sq ? R1 : Q1; }
#define SS_STEP(tt, Bv, Cv, xa, xb, sc) do { float da, db; red16x2(dot8(S0, Cv), dot8(S1, Cv), lp0, da, db); const float ta = xa * sc[1], tb = xb * sc[1];        \
                    const float ya = sc[0] * da + ta * sc[2] + Dh * xa, yb = sc[0] * db + tb * sc[2] + Dh * xb; \
                    S0.a = S0.a * sc[0] + Bv.a * ta; S0.b = S0.b * sc[0] + Bv.b * ta; S1.a = S1.a * sc[0] + Bv.a * tb; S1.b = S1.b * sc[0] + Bv.b * tb; YKEEP2(tt, ya, yb); } while (0)
                _Pragma("unroll 2") for (int j_ = 0; j_ < 4; ++j_) { const int tt = sq * 8 + 2 * j_;
                    const float* V0 = SL + SL_VEC + tt * VST + sub * 8; const float* V1 = V0 + VST;
                    const V8 C0 = ld8(V0 + 128), B0 = ld8(V0); const float xa0 = SL[SL_VROW + tt * 64 + irow], xb0 = SL[SL_VROW + tt * 64 + irow + 16]; const f32x4 sc0 = *(const f32x4*)(SL + SL_SCAL + tt * 8);
                    const V8 C1 = ld8(V1 + 128), B1 = ld8(V1); const float xa1 = SL[SL_VROW + (tt + 1) * 64 + irow], xb1 = SL[SL_VROW + (tt + 1) * 64 + irow + 16]; const f32x4 sc1 = *(const f32x4*)(SL + SL_SCAL + (tt + 1) * 8);
                    SS_STEP(tt, B0, C0, xa0, xb0, sc0);
                    SS_STEP(tt + 1, B1, C1, xa1, xb1, sc1);
                }
                if (it.tr) { float* o0 = so + sq * (4 * 8192) + irow * 128; float* o1 = o0 + 16 * 128; *(f32x4*)o0 = S0.a; *(f32x4*)(o0 + 4) = S0.b; *(f32x4*)o1 = S1.a; *(f32x4*)(o1 + 4) = S1.b; }
                }
#undef SS_STEP
                YSTORE2(b);
                }
            }
        }
        if (!scanner) {
            if (k >= 1 && k - 1 < NBAT && lane < 4) { const int tt = pj * 4 + lane; float* SL = sm + ((k - 1) & 3) * SL_SIZE; const float* P = SL + SL_PART + tt * 16;
                const float bc = P[0] + P[4] + P[8] + P[12];
                int g = 16 * (k - 1) + tt; g = g < T ? g : T - 1;
                const float dt = softplusf_(bf2f(U[(size_t)g * UP + 1024 + it.h]) + dtb);
                *(f32x4*)(SL + SL_SCAL + tt * 8) = (f32x4){__expf(nA * dt), dt, bc, 0.f}; }
            if (k < NBAT) {
                float o[5][4];
#pragma unroll
                for (int q = 0; q < 5; ++q)
#pragma unroll
                    for (int i = 0; i < 4; ++i) o[q][i] = siluf_(cb[q] + cw[q][0] * cur.xin[q][i] + cw[q][1] * cur.xin[q][i + 1] + cw[q][2] * cur.xin[q][i + 2] + cw[q][3] * cur.xin[q][i + 3]);
                if (k + 1 < NBAT) SS_LOAD(cur, k + 1);
                float* SL = sm + (k & 3) * SL_SIZE;
#pragma unroll
                for (int i = 0; i < 4; ++i) { const int tt = fq * 4 + i;
                    float* V = SL + SL_VEC + tt * VST; V[pj * 32 + n] = o[1][i]; V[pj * 32 + 16 + n] = o[2][i]; V[128 + pj * 32 + n] = o[3][i]; V[128 + pj * 32 + 16 + n] = o[4][i]; SL[SL_VROW + tt * 64 + c] = o[0][i];
                    const float p0 = red16(o[1][i] * o[3][i] + o[2][i] * o[4][i]);
                    if (n == 0) SL[SL_PART + tt * 16 + pj * 4] = p0; }
            }
        }
        TICK_BAR();
    }
#undef SS_LOAD
    if (scanner) { if (!it.tr) { float* o0 = so + irow * 128; float* o1 = so + (irow + 16) * 128; *(f32x4*)o0 = S0.a; *(f32x4*)(o0 + 4) = S0.b; *(f32x4*)o1 = S1.a; *(f32x4*)(o1 + 4) = S1.b; } }
    else if (it.h == 0 && it.half == 0) { float* so = p.out + (it.tr ? O_SSSC : O_PSSC) + ((size_t)l * it.NB + it.b) * 3 * 768;
        for (int i = tid - 256; i < 3 * 768; i += 256) { const int rr = i / 768, cc = i % 768; so[i] = bf2f(UX[(size_t)((it.tr ? 5 : T - 3) + rr) * UP + cc]); if (it.tr) so[3 * 768 + i] = bf2f(UX[(size_t)(13 + rr) * UP + cc]); } }
}

__device__ __forceinline__ void run_item(const KP& p, int l, int tr, int idx, float* sm) {
    Item it; it.tr = tr; const int ms = idx >> 8; const int mixer = tr ? (ms == 0 ? 3 : ms == 1 ? 0 : ms == 2 ? 2 : 1) : (idx & 3);
    int r = tr ? (idx & 255) : (idx >> 2); if (tr) it.half = 0; else { it.half = r & 1; r >>= 1; } it.h = r & 3; it.b = tr ? 2 * (r >> 2) : (r >> 2);
    it.T = tr ? 2 * TS : TP; it.NB = tr ? BS : BP; it.row0 = tr ? MP + it.b * TS : it.b * TP;
    if (mixer == 0) scan_rwkv(p, l, it, sm); else if (mixer == 1) scan_gla(p, l, it, sm); else if (mixer == 2) scan_dn(p, l, it, sm); else scan_ssd(p, l, it, sm);
    __syncthreads();
}
__device__ __forceinline__ void flag_signal(unsigned* cnt, unsigned n) {
    asm volatile("s_waitcnt vmcnt(0)" ::: "memory"); __syncthreads();
    if (threadIdx.x == 0 && n) { __builtin_amdgcn_fence(__ATOMIC_RELEASE, "agent"); asm volatile("s_waitcnt vmcnt(0)" ::: "memory"); __hip_atomic_fetch_add(cnt, n, __ATOMIC_RELAXED, __HIP_MEMORY_SCOPE_AGENT); }
}
__device__ __forceinline__ void flag_wait(unsigned* cnt, unsigned target) {
    if (threadIdx.x == 0) { unsigned sp = 0; while (__hip_atomic_load(cnt, __ATOMIC_RELAXED, __HIP_MEMORY_SCOPE_AGENT) < target) { __builtin_amdgcn_s_sleep(4); if (++sp > (1u << 22)) break; }
        __builtin_amdgcn_fence(__ATOMIC_ACQUIRE, "agent"); asm volatile("s_waitcnt vmcnt(0)" ::: "memory"); }
    __syncthreads();
}
__device__ __forceinline__ void phase_scan(const KP& p, int l, float* sm) {
    const int G = gridDim.x;
    constexpr int NPI = 4 * BP * 4 * 2, NSI = 4 * (BS / 2) * 4;
    for (int i = blockIdx.x; i < NPI; i += G) run_item(p, l, 0, i, sm);
    unsigned* q = (unsigned*)(p.ws + WS_BAR) + 4096 + 64 * l;
    flag_wait((unsigned*)(p.ws + WS_BAR) + 4224 + 64 * l, 64u);
    volatile int* slot = (volatile int*)(sm + 4 * SL_SIZE);
    for (;;) {
        if (threadIdx.x == 0) *slot = (int)__hip_atomic_fetch_add(q, 1u, __ATOMIC_RELAXED, __HIP_MEMORY_SCOPE_AGENT);
        __syncthreads();
        const int i0 = *slot;
        __syncthreads();
        if (i0 >= NSI) break;
        run_item(p, l, 1, i0, sm);
    }
}

__device__ __forceinline__ void ld4bf(const bf16* p, float (&o)[4]) { const uint2 v = *(const uint2*)p; o[0] = __builtin_bit_cast(float, v.x << 16); o[1] = __builtin_bit_cast(float, v.x & 0xffff0000u); o[2] = __builtin_bit_cast(float, v.y << 16); o[3] = __builtin_bit_cast(float, v.y & 0xffff0000u); }
__device__ __forceinline__ void st4bf(bf16* p, const float (&o)[4]) { uint2 v; v.x = pk2(o[0], o[1]); v.y = pk2(o[2], o[3]); *(uint2*)p = v; }
__device__ __forceinline__ void phase_post(const KP& p, int l, float* sm) {
    const int tid = otid(), lane = tid & 63, wv = tid >> 6; const int gw = blockIdx.x * NWAVES + wv, NGW = gridDim.x * NWAVES;
    const bf16* Ub = (const bf16*)(p.ws + WS_U); bf16* Yb = (bf16*)(p.ws + WS_H); const float* auxb = (const float*)(p.ws + WS_AUX);
    const float* mu = p.in[19] + l * 896;
    { const float* g2g = p.in[24] + (size_t)l * 64 * 256;
      for (int i = tid; i < 64 * 256 / 4; i += NTHR) *(f32x4*)(sm + 4 * i) = *(const f32x4*)(g2g + 4 * i);
      __syncthreads(); }
    const float* g2 = sm;
    const int c = lane * 4, hd = lane >> 4;
    const f32x4 lw = *(const f32x4*)(p.in[28] + l * 256 + c), lb = *(const f32x4*)(p.in[29] + l * 256 + c), muv = *(const f32x4*)(mu + 512 + c);
    const f32x4 wgl = *(const f32x4*)(p.in[32] + l * 256 + c), wdn = *(const f32x4*)(p.in[36] + l * 256 + c), wss = *(const f32x4*)(p.in[42] + l * 256 + c);
    const float mug = mu[832 + lane];
    struct PR { float y[4][4], uv[4], pv[4], gg[4], dz[4], sz[4], ug, pg, rkv; } cur, nxt;
#define POST_LOAD(R, row) do { int tr_, b_, t_; if ((row) < MP) { tr_ = 0; b_ = (row) >> 11; t_ = (row) & 2047; } else { tr_ = 1; b_ = ((row) - MP) >> 3; t_ = ((row) - MP) & 7; } \
        const bf16* u_ = Ub + (size_t)(row) * UP; const bf16* y_ = Yb + (size_t)(row) * DM; \
        _Pragma("unroll") for (int m = 0; m < 4; ++m) ld4bf(y_ + 256 * m + c, R.y[m]); \
        ld4bf(u_ + 512 + c, R.uv); ld4bf(u_ + CB + 768 + c, R.gg); ld4bf(u_ + CC + 768 + c, R.dz); ld4bf(u_ + CD + c, R.sz); R.ug = bf2f(u_[832 + lane]); R.rkv = auxb[(size_t)(row) * 4 + hd]; \
        if (t_ > 0) { ld4bf(u_ - UP + 512 + c, R.pv); R.pg = bf2f(u_[832 + lane - UP]); } \
        else if (tr_) { const float* sh0_ = p.in[2] + ((size_t)l * BS + b_) * 896; const f32x4 s_ = *(const f32x4*)(sh0_ + 512 + c); R.pv[0] = s_[0]; R.pv[1] = s_[1]; R.pv[2] = s_[2]; R.pv[3] = s_[3]; R.pg = sh0_[832 + lane]; } \
        else { R.pv[0] = R.pv[1] = R.pv[2] = R.pv[3] = 0.f; R.pg = 0.f; } } while (0)
    if (gw < MROWS) POST_LOAD(cur, gw);
    for (int row = gw; row < MROWS; row += NGW) {
        if (row + NGW < MROWS) POST_LOAD(nxt, row + NGW);
        bf16* y = Yb + (size_t)row * DM;
        { const float m = red16(cur.y[0][0] + cur.y[0][1] + cur.y[0][2] + cur.y[0][3]) * (1.f / 64.f);
          float d[4], vs = 0.f;
#pragma unroll
          for (int e = 0; e < 4; ++e) { d[e] = cur.y[0][e] - m; vs += d[e] * d[e]; }
          const float rs = rsqrtf(red16(vs) * (1.f / 64.f) + 64e-5f);
          const float sg = sigmoidf_(cur.ug + (cur.pg - cur.ug) * mug);
          f32x4 g = {0.f, 0.f, 0.f, 0.f};
#pragma unroll 8
          for (int j = 0; j < 64; ++j) { const float sj = __shfl(sg, j); g += *(const f32x4*)(g2 + j * 256 + c) * sj; }
          float o[4];
#pragma unroll
          for (int e = 0; e < 4; ++e) { const float v = cur.uv[e] + (cur.pv[e] - cur.uv[e]) * muv[e]; o[e] = (d[e] * rs * lw[e] + lb[e] + cur.rkv * v) * g[e]; }
          st4bf(y + c, o); }
        { const float* yv = cur.y[1];
          const float rs = rsqrtf(red16(yv[0] * yv[0] + yv[1] * yv[1] + yv[2] * yv[2] + yv[3] * yv[3]) * (1.f / 64.f) + 1e-6f); float o[4];
#pragma unroll
          for (int e = 0; e < 4; ++e) o[e] = yv[e] * rs * wgl[e] * siluf_(cur.gg[e]);
          st4bf(y + 256 + c, o); }
        { const float* yv = cur.y[2];
          const float rs = rsqrtf(red16(yv[0] * yv[0] + yv[1] * yv[1] + yv[2] * yv[2] + yv[3] * yv[3]) * (1.f / 64.f) + 1e-6f); float o[4];
#pragma unroll
          for (int e = 0; e < 4; ++e) o[e] = yv[e] * rs * wdn[e] * siluf_(cur.dz[e]);
          st4bf(y + 512 + c, o); }
        { float yv[4]; float ss = 0.f;
#pragma unroll
          for (int e = 0; e < 4; ++e) { yv[e] = cur.y[3][e] * siluf_(cur.sz[e]); ss += yv[e] * yv[e]; }
          ss = red16(ss); ss += __shfl_xor(ss, 16);
          const float rs = rsqrtf(ss * (1.f / 128.f) + 1e-6f); float o[4];
#pragma unroll
          for (int e = 0; e < 4; ++e) o[e] = yv[e] * rs * wss[e];
          st4bf(y + 768 + c, o); }
        cur = nxt;
    }
#undef POST_LOAD
}

#define XB_TMO      128
#define XB_XCNT(j)  (256  + 64 * (j))
#define XB_XSUB(j)  (1280 + 64 * (j))
#define XB_XGEN(j)  (2304 + 64 * (j))
#define XB_TOP      3328
#define XB_TOPGEN   3392
#define XCD_BAR_WORDS 3456
#define XB_SPIN_CAP (1u << 18)

__device__ __forceinline__ unsigned xb_ld(unsigned* p)              { return __hip_atomic_load(p, __ATOMIC_RELAXED, __HIP_MEMORY_SCOPE_AGENT); }
__device__ __forceinline__ unsigned xb_add(unsigned* p, unsigned v) { return __hip_atomic_fetch_add(p, v, __ATOMIC_RELAXED, __HIP_MEMORY_SCOPE_AGENT); }
__device__ __forceinline__ unsigned xb_xcc_id() { return (unsigned)__builtin_amdgcn_s_getreg((3 << 11) | 20) & 0xFu; }
#define XB_SPIN(cond, bar) do { unsigned _sp = 0; while (cond) { __builtin_amdgcn_s_sleep(1); \
    if ((++_sp & 255u) == 0u) { if (xb_ld(&(bar)[XB_TMO])) break; if (_sp > XB_SPIN_CAP) { atomicAdd(&(bar)[XB_TMO], 1u); break; } } } } while (0)

struct XcdBarrier {
    unsigned* bar; unsigned x;
    volatile LAS unsigned* st;
};

__device__ __forceinline__ XcdBarrier xcd_barrier_post(unsigned* bar, volatile LAS unsigned* st) {
    XcdBarrier b; b.bar = bar; b.x = xb_xcc_id(); b.st = st;
    if (threadIdx.x == 0) (void)xb_add(&bar[XB_XCNT(b.x)], 1u);
    return b;
}
__device__ __forceinline__ void xcd_barrier_complete(unsigned* bar, unsigned x, unsigned& nloc, unsigned& nx) {
    const unsigned G = gridDim.x * gridDim.y * gridDim.z;
    unsigned sum, cnt, mine, sp = 0u;
    for (;;) {
        sum = 0u; cnt = 0u; mine = 0u;
#pragma unroll
        for (unsigned j = 0; j < 16; ++j) { const unsigned c = xb_ld(&bar[XB_XCNT(j)]); sum += c; cnt += (c > 0u) ? 1u : 0u; mine = (j == x) ? c : mine; }
        if (sum == G) break;
        __builtin_amdgcn_s_sleep(1);
        if ((++sp & 255u) == 0u) { if (xb_ld(&bar[XB_TMO])) break; if (sp > XB_SPIN_CAP) { atomicAdd(&bar[XB_TMO], 1u); break; } }
    }
    nloc = mine > 0u ? mine : 1u; nx = cnt > 0u ? cnt : 1u;
}

__device__ __forceinline__ void xcd_barrier(const XcdBarrier& b) {
    asm volatile("s_waitcnt vmcnt(0)" ::: "memory");
    __syncthreads();
    if (threadIdx.x == 0) {
        unsigned* bar = b.bar;
        __builtin_amdgcn_s_waitcnt(0);
        unsigned nloc = b.st[0], nx = b.st[1];
        if (nloc == 0u) { xcd_barrier_complete(bar, b.x, nloc, nx); b.st[0] = nloc; b.st[1] = nx; }
        const unsigned old = xb_add(&bar[XB_XSUB(b.x)], 1u);
        const unsigned gen = old / nloc;
        if (old + 1u == (gen + 1u) * nloc) {
            __builtin_amdgcn_fence(__ATOMIC_RELEASE, "agent");
            asm volatile("s_waitcnt vmcnt(0)" ::: "memory");
            const unsigned og = xb_add(&bar[XB_TOP], 1u);
            const unsigned tg = og / nx;
            if (og + 1u == (tg + 1u) * nx) xb_add(&bar[XB_TOPGEN], 1u);
            else XB_SPIN(xb_ld(&bar[XB_TOPGEN]) == tg, bar);
            __builtin_amdgcn_fence(__ATOMIC_ACQUIRE, "agent");
            xb_add(&bar[XB_XGEN(b.x)], 1u);
            asm volatile("s_waitcnt vmcnt(0)" ::: "memory");
        } else {
            XB_SPIN(xb_ld(&bar[XB_XGEN(b.x)]) == gen, bar);
            __builtin_amdgcn_fence(__ATOMIC_ACQUIRE, "agent");
            asm volatile("s_waitcnt vmcnt(0)" ::: "memory");
        }
    }
    __syncthreads();
}

__device__ __forceinline__ const void* uni(const void* q) { const unsigned long long v = (unsigned long long)q; const unsigned lo = __builtin_amdgcn_readfirstlane((unsigned)v), hi = __builtin_amdgcn_readfirstlane((unsigned)(v >> 32)); return (const void*)(const GASP char*)(((unsigned long long)hi << 32) | lo); }
__global__ void __launch_bounds__(NTHR, 2) hybrid_fwd(KP kp) {
    extern __shared__ __attribute__((aligned(16))) unsigned char lds[];
    cg::grid_group grid = cg::this_grid();
    KP* lp = (KP*)(lds + 131072);
    if (threadIdx.x == 0) *lp = kp;
    volatile LAS unsigned* xst = (volatile LAS unsigned*)(lds + 131072 + 512);
    if (threadIdx.x < 2) xst[threadIdx.x] = 0u;
    if (blockIdx.x == 0) for (int i = threadIdx.x; i < 4096 + 512; i += NTHR) ((unsigned*)(kp.ws + WS_BAR))[i] = 0u;
    __syncthreads();
    const KP& p = *lp;
    float* sm = (float*)lds;
#define WSB ((unsigned char*)uni(p.ws))
#define OUTB ((float*)uni(p.out))
#define INP(i) ((const float*)uni(p.in[i]))
    phase_p0(p, sm);
    grid.sync();
    const XcdBarrier xbar = xcd_barrier_post((unsigned*)(WSB + WS_BAR), xst);
    for (int l = 0; l < 2; ++l) {
        { const float* modl = (const float*)(WSB + WS_MOD) + (size_t)l * 136 * 6144;
          const float* xP = l == 0 ? INP(0) : nullptr; const float* xS = l == 0 ? INP(1) : nullptr;
          phase_norm(p, xP, xS, INP(13) + l * DM, modl, 0, 1024, l == 0 ? -1 : 5120 - 136 * 6144); }
        xcd_barrier(xbar);
        { unsigned char* ws = WSB; pg8::Gemm g{(const bf16*)(ws + WS_H), (const bf16*)(ws + WS_WTIN) + (size_t)l * UP * DM, MP, UP, DM, DM}; pg8::StaticOrder S; S.init(MP, UP, 1, (int)gridDim.x, (int)blockIdx.x);
          pg8::EpiBf16<0> E{(bf16*)(ws + WS_U), UP}; pg8::gemm_phase<pg8::EpiBf16<0>, pg8::StaticOrder, true, true>((PG8_LAS unsigned char*)lds, g, S, E); }
        xcd_barrier(xbar);
        { unsigned char* ws = WSB; const int G = (int)gridDim.x, bx = (int)blockIdx.x;
          pg8::Gemm g{(const bf16*)(ws + WS_H), (const bf16*)(ws + WS_WTIN) + (size_t)l * UP * DM, MROWS, UP, DM, DM};
          pg8::SampleTilesOrder S{(G + 2) / 4, (bx & 3) == 1 ? (bx >> 2) : -1, 16}; pg8::EpiBf16<0> E{(bf16*)(ws + WS_U), UP};
          const unsigned nd = (S.cs >= 0 && S.cs < 64) ? (unsigned)((64 - S.cs + S.Gs - 1) / S.Gs) : 0u;
          if (nd) pg8::gemm_phase<pg8::EpiBf16<0>, pg8::SampleTilesOrder, false, true>((PG8_LAS unsigned char*)lds, g, S, E);
          flag_signal((unsigned*)(ws + WS_BAR) + 4224 + 64 * l, nd); }
        phase_scan(p, l, sm);
        xcd_barrier(xbar);
        phase_post(p, l, sm);
        xcd_barrier(xbar);
        { unsigned char* ws = WSB; const float* modl = (const float*)(ws + WS_MOD) + (size_t)l * 136 * 6144;
          pg8::Gemm g{(const bf16*)(ws + WS_H), (const bf16*)(ws + WS_WTOUT) + (size_t)l * DM * DM, MP, DM, DM, DM}; pg8::StaticOrder S; S.init(MP, DM, 1, (int)gridDim.x, (int)blockIdx.x);
          if (l == 0) { pg8::EpiRes<true> E{INP(0), (bf16*)(ws + WS_X16), modl + 2048}; pg8::gemm_phase<pg8::EpiRes<true>, pg8::StaticOrder, true, true>((PG8_LAS unsigned char*)lds, g, S, E); }
          else { pg8::EpiRes<false> E{nullptr, (bf16*)(ws + WS_X16), modl + 2048}; pg8::gemm_phase<pg8::EpiRes<false>, pg8::StaticOrder, true, true>((PG8_LAS unsigned char*)lds, g, S, E); }
          pg8::Gemm g2{(const bf16*)(ws + WS_H), (const bf16*)(ws + WS_WTOUT) + (size_t)l * DM * DM, MROWS, DM, DM / 4, DM}; pg8::SampleSplitOrder S2{(int)gridDim.x, (int)blockIdx.x};
          pg8::EpiPart E2{(float*)(ws + WS_PART)}; pg8::gemm_phase<pg8::EpiPart, pg8::SampleSplitOrder, false, true>((PG8_LAS unsigned char*)lds, g2, S2, E2); }
        xcd_barrier(xbar);
        { const float* modl = (const float*)(WSB + WS_MOD) + (size_t)l * 136 * 6144;
          phase_norm(p, nullptr, l == 0 ? INP(1) : nullptr, INP(14) + l * DM, modl, 3072, 4096, 2048); }
        xcd_barrier(xbar);
        { unsigned char* ws = WSB; pg8::Gemm g{(const bf16*)(ws + WS_H), (const bf16*)(ws + WS_WTUP) + (size_t)l * DFF * DM, MP, DFF, DM, DM}; pg8::StaticOrder S; S.init(MP, DFF, 1, (int)gridDim.x, (int)blockIdx.x);
          pg8::EpiBf16<2> E{(bf16*)(ws + WS_U), DFF}; pg8::gemm_phase<pg8::EpiBf16<2>, pg8::StaticOrder, true, true>((PG8_LAS unsigned char*)lds, g, S, E); }
        xcd_barrier(xbar);
        { unsigned char* ws = WSB; const int G = (int)gridDim.x, bx = (int)blockIdx.x;
          pg8::Gemm g{(const bf16*)(ws + WS_H), (const bf16*)(ws + WS_WTUP) + (size_t)l * DFF * DM, MROWS, DFF, DM, DM};
          const int Gs = G < 64 ? G : 64; pg8::SampleTilesOrder S{Gs, bx >= G - Gs ? bx - (G - Gs) : -1, 16}; pg8::EpiBf16<2> E{(bf16*)(ws + WS_U), DFF};
          const unsigned nd = (S.cs >= 0 && S.cs < 64) ? (unsigned)((64 - S.cs + S.Gs - 1) / S.Gs) : 0u;
          if (nd) pg8::gemm_phase<pg8::EpiBf16<2>, pg8::SampleTilesOrder, false, true>((PG8_LAS unsigned char*)lds, g, S, E);
          flag_signal((unsigned*)(ws + WS_BAR) + 4352 + 64 * l, nd); }
        { unsigned char* ws = WSB; const float* modl = (const float*)(ws + WS_MOD) + (size_t)l * 136 * 6144;
          pg8::Gemm g{(const bf16*)(ws + WS_U), (const bf16*)(ws + WS_WTDN) + (size_t)l * DM * DFF, MP, DM, DFF, DFF}; pg8::StaticOrder S; S.init(MP, DM, 1, (int)gridDim.x, (int)blockIdx.x);
          pg8::EpiRes<false> E{nullptr, (bf16*)(ws + WS_X16), modl + 5120}; pg8::gemm_phase<pg8::EpiRes<false>, pg8::StaticOrder, true, true>((PG8_LAS unsigned char*)lds, g, S, E);
          if ((int)blockIdx.x < 64) flag_wait((unsigned*)(ws + WS_BAR) + 4352 + 64 * l, 64u);
          pg8::Gemm g2{(const bf16*)(ws + WS_U), (const bf16*)(ws + WS_WTDN) + (size_t)l * DM * DFF, MROWS, DM, DFF / 4, DFF}; pg8::SampleSplitOrder S2{(int)gridDim.x, (int)blockIdx.x};
          pg8::EpiPart E2{(float*)(ws + WS_PART)}; pg8::gemm_phase<pg8::EpiPart, pg8::SampleSplitOrder, false, true>((PG8_LAS unsigned char*)lds, g2, S2, E2); }
        xcd_barrier(xbar);
    }
    phase_final(p);
}

extern "C" void kernel_launch(void* const* d_in, const int* in_sizes, int n_in, void* d_out, int out_size, void* d_ws, size_t ws_size, hipStream_t stream) {
    static int grid = 0;
    if (grid == 0) {
        if (n_in != 44 || (size_t)out_size != O_TOTAL || ws_size < WS_END) { fprintf(stderr, "kernel_launch: unexpected shapes: n_in %d out %d ws %zu\n", n_in, out_size, ws_size); grid = -1; return; }
        int dev = 0, cus = 0, per_cu = 0;
        hipGetDevice(&dev); hipDeviceGetAttribute(&cus, hipDeviceAttributeMultiprocessorCount, dev);
        if (hipFuncSetAttribute((const void*)hybrid_fwd, hipFuncAttributeMaxDynamicSharedMemorySize, LDS_BYTES) != hipSuccess) { fprintf(stderr, "kernel_launch: hipFuncSetAttribute failed\n"); grid = -1; return; }
        if (hipOccupancyMaxActiveBlocksPerMultiprocessor(&per_cu, (const void*)hybrid_fwd, NTHR, LDS_BYTES) != hipSuccess || per_cu < 1) { fprintf(stderr, "kernel_launch: occupancy query failed (%d)\n", per_cu); grid = -1; return; }
        grid = cus * per_cu;
    }
    if (grid < 0) return;
    KP p{};
    for (int i = 0; i < 44; ++i) p.in.v[i] = (const float*)d_in[i];
    p.out.v = (float*)d_out; p.ws.v = (unsigned char*)d_ws;
    void* args[] = {&p};
    hipError_t e = hipLaunchCooperativeKernel((const void*)hybrid_fwd, dim3(grid), dim3(NTHR), args, LDS_BYTES, stream);
    if (e != hipSuccess) fprintf(stderr, "kernel_launch: cooperative launch failed: %s (grid %d)\n", hipGetErrorString(e), grid);
}
```
